# Optimizing an MI355X kernel written in HIP

```python
import jax, jax.numpy as jnp
from jax import lax
import numpy as np

D_MODEL = 1024
BATCH = 2
SEQ = 8192
DEPTH = 4

GRID_W = 64
CTX_LEN = 256
HEAD_DIM = 64
NA_HEADS = 8
NA_WIN_H = 8
NA_WIN_W = 16
GQA_Q_HEADS = 8
GQA_KV_HEADS = 2
GQA_REP = GQA_Q_HEADS // GQA_KV_HEADS
NA_WIDTH = NA_HEADS * HEAD_DIM
GQA_Q_WIDTH = GQA_Q_HEADS * HEAD_DIM
GQA_KV_WIDTH = GQA_KV_HEADS * HEAD_DIM
IN_SIZES = (NA_WIDTH, NA_WIDTH, NA_WIDTH, GQA_Q_WIDTH, GQA_KV_WIDTH, GQA_KV_WIDTH, D_MODEL, D_MODEL)
IN_COLS = sum(IN_SIZES)
IN_SPLITS = tuple(int(v) for v in np.cumsum(IN_SIZES)[:-1])
D_FF = -(-(8 * D_MODEL) // (3 * 256)) * 256
Q_BLOCK = 128
ROPE_THETA = 10000.0
EPS = 1e-6
SCALE = HEAD_DIM ** -0.5

kernel_name = "hybrid_natten_gqa_prefix_dit"


def rms_norm(x, g):
    xf = x.astype(jnp.float32)
    y = xf * lax.rsqrt(jnp.mean(xf * xf, axis=-1, keepdims=True) + EPS)
    return (y * g.astype(jnp.float32)).astype(x.dtype)


def modulate(h, shift, scale):
    return h * (1 + scale) + shift


def heads(t, n_heads):
    b, n, _ = t.shape
    return t.reshape(b, n, n_heads, HEAD_DIM).transpose(0, 2, 1, 3)


def merge_heads(t):
    b, h, n, d = t.shape
    return t.transpose(0, 2, 1, 3).reshape(b, n, h * d)


def axial_rope_tables(n_tokens):
    t = jnp.arange(n_tokens)
    row = (t // GRID_W).astype(jnp.float32)
    col = (t % GRID_W).astype(jnp.float32)
    half = HEAD_DIM // 2
    inv = ROPE_THETA ** (-jnp.arange(0, half, 2, dtype=jnp.float32) / half)
    ang = jnp.concatenate([row[:, None] * inv, col[:, None] * inv], axis=-1)
    return jnp.cos(ang), jnp.sin(ang)


def apply_rope(x, cos, sin):
    xf = x.astype(jnp.float32).reshape(x.shape[:-1] + (HEAD_DIM // 2, 2))
    x0, x1 = xf[..., 0], xf[..., 1]
    out = jnp.stack([x0 * cos - x1 * sin, x0 * sin + x1 * cos], axis=-1)
    return out.reshape(x.shape).astype(x.dtype)


def na_window_indices(rows):
    kh = min(NA_WIN_H, rows)
    r = jnp.arange(rows)
    col = jnp.arange(GRID_W)
    r_start = jnp.clip(r - kh // 2, 0, rows - kh)
    row_idx = r_start[:, None] + jnp.arange(kh)[None, :]
    c_start = jnp.clip(col - NA_WIN_W // 2, 0, GRID_W - NA_WIN_W)
    in_win = (col[None, :] >= c_start[:, None]) & (col[None, :] < c_start[:, None] + NA_WIN_W)
    dr_idx = row_idx - r[:, None] + (NA_WIN_H - 1)
    dc = col[None, :] - col[:, None]
    dc_idx = jnp.clip(dc, -(NA_WIN_W - 1), NA_WIN_W - 1) + (NA_WIN_W - 1)
    return row_idx, in_win, dr_idx, dc_idx


def na_bias(rpb, in_win, dr_idx, dc_idx):
    b = rpb.astype(jnp.float32)[:, dr_idx[:, None, :, None], dc_idx[None, :, None, :]]
    return jnp.where(in_win[None, None, :, None, :], b, -jnp.inf)


def na_latent(q, k, v, k_ctx, v_ctx, bias, row_idx):
    b, h, s, d = q.shape
    rows = s // GRID_W
    kh = row_idx.shape[1]
    qg = q.reshape(b, h, rows, GRID_W, d)
    kg = k.reshape(b, h, rows, GRID_W, d)[:, :, row_idx]
    vg = v.reshape(b, h, rows, GRID_W, d)[:, :, row_idx]
    s_win = jnp.einsum('bhrwd,bhrjud->bhrwju', qg, kg).astype(jnp.float32) * SCALE + bias[None]
    s_win = s_win.reshape(b, h, rows, GRID_W, kh * GRID_W)
    s_ctx = jnp.einsum('bhrwd,bhld->bhrwl', qg, k_ctx).astype(jnp.float32) * SCALE
    p = jax.nn.softmax(jnp.concatenate([s_win, s_ctx], axis=-1), axis=-1).astype(v.dtype)
    p_win = p[..., :kh * GRID_W].reshape(b, h, rows, GRID_W, kh, GRID_W)
    p_ctx = p[..., kh * GRID_W:]
    o = jnp.einsum('bhrwju,bhrjud->bhrwd', p_win, vg) + jnp.einsum('bhrwl,bhld->bhrwd', p_ctx, v_ctx)
    return o.reshape(b, h, s, d)


def softmax_attn(q, k, v):
    s = jnp.einsum('bgrqd,bgkd->bgrqk', q, k).astype(jnp.float32) * SCALE
    p = jax.nn.softmax(s, axis=-1).astype(v.dtype)
    return jnp.einsum('bgrqk,bgkd->bgrqd', p, v)


def gqa_latent(q, k_all, v_all):
    b, g, r, s, d = q.shape
    nb = s // Q_BLOCK
    qb = q.reshape(b, g, r, nb, Q_BLOCK, d).transpose(3, 0, 1, 2, 4, 5)
    o = lax.map(lambda qblk: softmax_attn(qblk, k_all, v_all), qb)
    return o.transpose(1, 2, 3, 0, 4, 5).reshape(b, g, r, s, d)


def branch_merge(ya, yb, ga, gb, w_pa, w_pb, w_o):
    merged = jax.nn.sigmoid(ga) * (ya @ w_pa) + jax.nn.sigmoid(gb) * (yb @ w_pb)
    return merged @ w_o


def swiglu(h, w_in, w_out):
    a, u = jnp.split(h @ w_in, 2, axis=-1)
    return (jax.nn.silu(a) * u) @ w_out


def setup_inputs(seed: int = 0) -> dict:
    key = jax.random.key(seed)
    ks = jax.random.split(key, 18)
    f32 = jnp.float32
    nrm = lambda k, shp, sc: jax.random.normal(k, shp, f32) * sc
    return {
        "x": nrm(ks[0], (BATCH, SEQ, D_MODEL), 1.0),
        "c": nrm(ks[1], (BATCH, D_MODEL), 1.0),
        "ctx": nrm(ks[2], (BATCH, CTX_LEN, D_MODEL), 1.0),
        "c_ctx": nrm(ks[3], (D_MODEL,), 1.0),
        "w_mod": nrm(ks[4], (DEPTH, D_MODEL, 6 * D_MODEL), D_MODEL ** -0.5),
        "b_mod": nrm(ks[5], (DEPTH, 6 * D_MODEL), 0.01),
        "norm1": 1.0 + nrm(ks[6], (DEPTH, D_MODEL), 0.02),
        "w_in": nrm(ks[7], (DEPTH, D_MODEL, IN_COLS), D_MODEL ** -0.5),
        "na_rpb": nrm(ks[8], (DEPTH, NA_HEADS, 2 * NA_WIN_H - 1, 2 * NA_WIN_W - 1), 0.1),
        "q_gain": 1.0 + nrm(ks[9], (DEPTH, HEAD_DIM), 0.02),
        "k_gain": 1.0 + nrm(ks[10], (DEPTH, HEAD_DIM), 0.02),
        "w_pa": nrm(ks[11], (DEPTH, NA_WIDTH, D_MODEL), NA_WIDTH ** -0.5),
        "w_pb": nrm(ks[12], (DEPTH, GQA_Q_WIDTH, D_MODEL), GQA_Q_WIDTH ** -0.5),
        "w_o": nrm(ks[13], (DEPTH, D_MODEL, D_MODEL), D_MODEL ** -0.5),
        "norm2": 1.0 + nrm(ks[14], (DEPTH, D_MODEL), 0.02),
        "w_ffn_in": nrm(ks[15], (DEPTH, D_MODEL, 2 * D_FF), D_MODEL ** -0.5),
        "w_ffn_out": nrm(ks[16], (DEPTH, D_FF, D_MODEL), D_FF ** -0.5),
        "final_norm": 1.0 + nrm(ks[17], (D_MODEL,), 0.02),
    }


def reference(x, c, ctx, c_ctx, w_mod, b_mod, norm1, w_in, na_rpb, q_gain, k_gain, w_pa, w_pb, w_o,
              norm2, w_ffn_in, w_ffn_out, final_norm):
    b, s, _ = x.shape
    n_ctx = ctx.shape[1]
    rows = s // GRID_W
    cos, sin = axial_rope_tables(s)
    row_idx, in_win, dr_idx, dc_idx = na_window_indices(rows)
    silu_c = jax.nn.silu(c)
    silu_cc = jax.nn.silu(c_ctx)

    for l in range(DEPTH):
        last = l == DEPTH - 1
        mod = silu_c @ w_mod[l] + b_mod[l]
        mod_c = silu_cc @ w_mod[l] + b_mod[l]
        sh1, sc1, g1, sh2, sc2, g2 = jnp.split(mod[:, None, :], 6, axis=-1)
        csh1, csc1, cg1, csh2, csc2, cg2 = jnp.split(mod_c, 6)

        h = modulate(rms_norm(x, norm1[l]), sh1, sc1)
        hc = modulate(rms_norm(ctx, norm1[l]), csh1, csc1)
        na_q, na_k, na_v, gq, gk, gv, ga, gb = jnp.split(h @ w_in[l], IN_SPLITS, axis=-1)
        na_qc, na_kc, na_vc, gqc, gkc, gvc, gac, gbc = jnp.split(hc @ w_in[l], IN_SPLITS, axis=-1)

        qa, ka, va = heads(na_q, NA_HEADS), heads(na_k, NA_HEADS), heads(na_v, NA_HEADS)
        qa_c, ka_c, va_c = heads(na_qc, NA_HEADS), heads(na_kc, NA_HEADS), heads(na_vc, NA_HEADS)
        bias = na_bias(na_rpb[l], in_win, dr_idx, dc_idx)
        ya = merge_heads(na_latent(qa, ka, va, ka_c, va_c, bias, row_idx))

        qb = apply_rope(rms_norm(heads(gq, GQA_Q_HEADS), q_gain[l]), cos, sin)
        kb = apply_rope(rms_norm(heads(gk, GQA_KV_HEADS), k_gain[l]), cos, sin)
        vb = heads(gv, GQA_KV_HEADS)
        qb_c = rms_norm(heads(gqc, GQA_Q_HEADS), q_gain[l])
        kb_c = rms_norm(heads(gkc, GQA_KV_HEADS), k_gain[l])
        vb_c = heads(gvc, GQA_KV_HEADS)
        k_all = jnp.concatenate([kb, kb_c], axis=2)
        v_all = jnp.concatenate([vb, vb_c], axis=2)
        ob = gqa_latent(qb.reshape(b, GQA_KV_HEADS, GQA_REP, s, HEAD_DIM), k_all, v_all)
        yb = merge_heads(ob.reshape(b, GQA_Q_HEADS, s, HEAD_DIM))

        x = x + g1 * branch_merge(ya, yb, ga, gb, w_pa[l], w_pb[l], w_o[l])

        if not last:
            ya_c = merge_heads(softmax_attn(qa_c[:, :, None], ka_c, va_c)[:, :, 0])
            ob_c = softmax_attn(qb_c.reshape(b, GQA_KV_HEADS, GQA_REP, n_ctx, HEAD_DIM), kb_c, vb_c)
            yb_c = merge_heads(ob_c.reshape(b, GQA_Q_HEADS, n_ctx, HEAD_DIM))
            ctx = ctx + cg1 * branch_merge(ya_c, yb_c, gac, gbc, w_pa[l], w_pb[l], w_o[l])

        h2 = modulate(rms_norm(x, norm2[l]), sh2, sc2)
        x = x + g2 * swiglu(h2, w_ffn_in[l], w_ffn_out[l])
        if not last:
            hc2 = modulate(rms_norm(ctx, norm2[l]), csh2, csc2)
            ctx = ctx + cg2 * swiglu(hc2, w_ffn_in[l], w_ffn_out[l])

    return rms_norm(x, final_norm)
```

```cpp
#include <hip/hip_runtime.h>
#include <hip/hip_cooperative_groups.h>
#include <cstdio>
#include <cstdint>
namespace cg = cooperative_groups;
__device__ const float ROPE_TAB[128*16*2] = {
1.000000000e+00f, 0.000000000e+00f, 1.000000000e+00f, 0.000000000e+00f, 1.000000000e+00f, 0.000000000e+00f, 1.000000000e+00f, 0.000000000e+00f, 1.000000000e+00f, 0.000000000e+00f, 1.000000000e+00f, 0.000000000e+00f, 1.000000000e+00f, 0.000000000e+00f, 1.000000000e+00f, 0.000000000e+00f, 1.000000000e+00f, 0.000000000e+00f, 1.000000000e+00f, 0.000000000e+00f, 1.000000000e+00f, 0.000000000e+00f, 1.000000000e+00f, 0.000000000e+00f, 1.000000000e+00f, 0.000000000e+00f, 1.000000000e+00f, 0.000000000e+00f, 1.000000000e+00f, 0.000000000e+00f, 1.000000000e+00f, 0.000000000e+00f,
5.403022766e-01f, 8.414710164e-01f, 8.460091352e-01f, 5.331684351e-01f, 9.504152536e-01f, 3.109835982e-01f, 9.842302203e-01f, 1.768921912e-01f, 9.950041771e-01f, 9.983342141e-02f, 9.984192848e-01f, 5.620449781e-02f, 9.995000362e-01f, 3.161750361e-02f, 9.998418689e-01f, 1.778185740e-02f, 9.999499917e-01f, 9.999833070e-03f, 9.999842048e-01f, 5.623383448e-03f, 9.999949932e-01f, 3.162272274e-03f, 9.999983907e-01f, 1.778278500e-03f, 9.999995232e-01f, 9.999999311e-04f, 9.999998212e-01f, 5.623412435e-04f, 9.999999404e-01f, 3.162277571e-04f, 1.000000000e+00f, 1.778279402e-04f,
-4.161468148e-01f, 9.092974067e-01f, 4.314628243e-01f, 9.021307230e-01f, 8.065783978e-01f, 5.911270976e-01f, 9.374182820e-01f, 3.482052684e-01f, 9.800665975e-01f, 1.986693293e-01f, 9.936820865e-01f, 1.122313142e-01f, 9.980006814e-01f, 6.320339441e-02f, 9.993675947e-01f, 3.555808961e-02f, 9.998000264e-01f, 1.999866590e-02f, 9.999367595e-01f, 1.124658901e-02f, 9.999799728e-01f, 6.324512884e-03f, 9.999936819e-01f, 3.556551412e-03f, 9.999979734e-01f, 1.999998698e-03f, 9.999993443e-01f, 1.124682371e-03f, 9.999998212e-01f, 6.324554561e-04f, 9.999999404e-01f, 3.556558804e-04f,
-9.899924994e-01f, 1.411200017e-01f, -1.159661636e-01f, 9.932531714e-01f, 5.827535987e-01f, 8.126488924e-01f, 8.610406518e-01f, 5.085361004e-01f, 9.553365111e-01f, 2.955202162e-01f, 9.858034849e-01f, 1.679033041e-01f, 9.955033660e-01f, 9.472608566e-02f, 9.985772967e-01f, 5.332308263e-02f, 9.995500445e-01f, 2.999549918e-02f, 9.998577237e-01f, 1.686943881e-02f, 9.999549985e-01f, 9.486690164e-03f, 9.999857545e-01f, 5.334813148e-03f, 9.999955297e-01f, 2.999995602e-03f, 9.999985695e-01f, 1.687023090e-03f, 9.999995232e-01f, 9.486831259e-04f, 9.999998808e-01f, 5.334838061e-04f,
-6.536436081e-01f, -7.568024993e-01f, -6.276797056e-01f, 7.784717083e-01f, 3.011374772e-01f, 9.535807371e-01f, 7.575061917e-01f, 6.528279781e-01f, 9.210609794e-01f, 3.894183338e-01f, 9.748082757e-01f, 2.230444849e-01f, 9.920106530e-01f, 1.261540651e-01f, 9.974712729e-01f, 7.107120752e-02f, 9.992001057e-01f, 3.998933360e-02f, 9.997470379e-01f, 2.249175683e-02f, 9.999200106e-01f, 1.264877338e-02f, 9.999747276e-01f, 7.113057654e-03f, 9.999920130e-01f, 3.999989480e-03f, 9.999974966e-01f, 2.249363344e-03f, 9.999992251e-01f, 1.264910679e-03f, 9.999997616e-01f, 7.113117026e-04f,
2.836621702e-01f, -9.589242935e-01f, -9.460792542e-01f, 3.239352703e-01f, -1.034233812e-02f, 9.999465346e-01f, 6.300802827e-01f, 7.765299678e-01f, 8.775825500e-01f, 4.794255495e-01f, 9.607312679e-01f, 2.774805427e-01f, 9.875259995e-01f, 1.574558765e-01f, 9.960497618e-01f, 8.879686147e-02f, 9.987502694e-01f, 4.997916520e-02f, 9.996047616e-01f, 2.811336145e-02f, 9.998750091e-01f, 1.581072807e-02f, 9.999604821e-01f, 8.891279809e-03f, 9.999874830e-01f, 4.999979399e-03f, 9.999960661e-01f, 2.811702900e-03f, 9.999987483e-01f, 1.581138116e-03f, 9.999995828e-01f, 8.891395992e-04f,
9.601702690e-01f, -2.794154882e-01f, -9.731037021e-01f, -2.303675264e-01f, -3.207963705e-01f, 9.471482038e-01f, 4.827820063e-01f, 8.757405281e-01f, 8.253356218e-01f, 5.646424890e-01f, 9.436169863e-01f, 3.310393095e-01f, 9.820539355e-01f, 1.886002719e-01f, 9.943132997e-01f, 1.064944416e-01f, 9.982005358e-01f, 5.996400490e-02f, 9.994308352e-01f, 3.373407945e-02f, 9.998199940e-01f, 1.897252724e-02f, 9.999430776e-01f, 1.066947449e-02f, 9.999819994e-01f, 5.999964196e-03f, 9.999943376e-01f, 3.374041524e-03f, 9.999982119e-01f, 1.897365320e-03f, 9.999994040e-01f, 1.066967379e-03f,
7.539022565e-01f, 6.569865942e-01f, -7.004297972e-01f, -7.137212753e-01f, -5.994374752e-01f, 8.004215956e-01f, 3.202570081e-01f, 9.473307133e-01f, 7.648422122e-01f, 6.442176700e-01f, 9.235194325e-01f, 3.835515678e-01f, 9.755998850e-01f, 2.195560932e-01f, 9.922624230e-01f, 1.241583377e-01f, 9.975510240e-01f, 6.994284689e-02f, 9.992253184e-01f, 3.935372457e-02f, 9.997550249e-01f, 2.213413455e-02f, 9.999225140e-01f, 1.244763471e-02f, 9.999755025e-01f, 6.999942940e-03f, 9.999922514e-01f, 3.936378751e-03f, 9.999975562e-01f, 2.213592408e-03f, 9.999992251e-01f, 1.244795276e-03f,
-1.455000341e-01f, 9.893582463e-01f, -2.120364457e-01f, -9.772617817e-01f, -8.186324239e-01f, 5.743178129e-01f, 1.476312131e-01f, 9.890424609e-01f, 6.967067122e-01f, 7.173560858e-01f, 9.005023241e-01f, 4.348512292e-01f, 9.681702852e-01f, 2.502923310e-01f, 9.898977876e-01f, 1.417829692e-01f, 9.968017340e-01f, 7.991468906e-02f, 9.989882708e-01f, 4.497213289e-02f, 9.996800423e-01f, 2.529552206e-02f, 9.998987913e-01f, 1.422575582e-02f, 9.999679923e-01f, 7.999914698e-03f, 9.999898672e-01f, 4.498715047e-03f, 9.999967813e-01f, 2.529819263e-03f, 9.999989867e-01f, 1.422623056e-03f,
-9.111302495e-01f, 4.121184647e-01f, 3.416602314e-01f, -9.398235083e-01f, -9.566441774e-01f, 2.912592292e-01f, -2.965079620e-02f, 9.995602965e-01f, 6.216099262e-01f, 7.833269238e-01f, 8.746382594e-01f, 4.847761393e-01f, 9.597726464e-01f, 2.807783186e-01f, 9.872201085e-01f, 1.593627781e-01f, 9.959527254e-01f, 8.987854421e-02f, 9.987195730e-01f, 5.058911815e-02f, 9.995950460e-01f, 2.845665626e-02f, 9.998719096e-01f, 1.600383036e-02f, 9.999595284e-01f, 8.999879472e-03f, 9.999871850e-01f, 5.061050411e-03f, 9.999959469e-01f, 2.846045885e-03f, 9.999987483e-01f, 1.600450720e-03f,
-8.390715122e-01f, -5.440210700e-01f, 7.901318669e-01f, -6.129369140e-01f, -9.997860789e-01f, -2.068356983e-02f, -2.059976310e-01f, 9.785524607e-01f, 5.403022766e-01f, 8.414710164e-01f, 8.460091352e-01f, 5.331684351e-01f, 9.504153132e-01f, 3.109835684e-01f, 9.842302203e-01f, 1.768921912e-01f, 9.950041771e-01f, 9.983341396e-02f, 9.984192848e-01f, 5.620449781e-02f, 9.995000362e-01f, 3.161750361e-02f, 9.998418689e-01f, 1.778185740e-02f, 9.999499917e-01f, 9.999834001e-03f, 9.999842048e-01f, 5.623383448e-03f, 9.999949932e-01f, 3.162272274e-03f, 9.999983907e-01f, 1.778278500e-03f,
4.425697960e-03f, -9.999902248e-01f, 9.952573776e-01f, -9.727646410e-02f, -9.437797070e-01f, -3.305749595e-01f, -3.758473992e-01f, 9.266815782e-01f, 4.535961151e-01f, 8.912073374e-01f, 8.147053123e-01f, 5.798751712e-01f, 9.401075840e-01f, 3.408778608e-01f, 9.809291363e-01f, 1.943656504e-01f, 9.939560890e-01f, 1.097782999e-01f, 9.980874062e-01f, 6.181810424e-02f, 9.993950725e-01f, 3.477803990e-02f, 9.998086691e-01f, 1.955982670e-02f, 9.999395013e-01f, 1.099977922e-02f, 9.999808669e-01f, 6.185714621e-03f, 9.999939203e-01f, 3.478498431e-03f, 9.999980927e-01f, 1.956106164e-03f,
8.438539505e-01f, -5.365729332e-01f, 8.938615918e-01f, 4.483429790e-01f, -7.941793799e-01f, -6.076834202e-01f, -5.338430405e-01f, 8.455836177e-01f, 3.623577356e-01f, 9.320390821e-01f, 7.808259130e-01f, 6.247486472e-01f, 9.288598895e-01f, 3.704312742e-01f, 9.773178697e-01f, 2.117776722e-01f, 9.928086400e-01f, 1.197122037e-01f, 9.977239966e-01f, 6.742975861e-02f, 9.992800951e-01f, 3.793822229e-02f, 9.997723103e-01f, 2.133773454e-02f, 9.999279976e-01f, 1.199971233e-02f, 9.999772310e-01f, 6.748044398e-03f, 9.999927878e-01f, 3.794723889e-03f, 9.999977350e-01f, 2.133933594e-03f,
9.074468017e-01f, 4.201670587e-01f, 5.171728134e-01f, 8.558809757e-01f, -5.658205152e-01f, -8.245284557e-01f, -6.750016809e-01f, 7.378162146e-01f, 2.674987614e-01f, 9.635581970e-01f, 7.444779873e-01f, 6.676470041e-01f, 9.166833758e-01f, 3.996143043e-01f, 9.733975530e-01f, 2.291227132e-01f, 9.915618896e-01f, 1.296341419e-01f, 9.973290563e-01f, 7.303927839e-02f, 9.991551042e-01f, 4.109803215e-02f, 9.997327924e-01f, 2.311557345e-02f, 9.999154806e-01f, 1.299963426e-02f, 9.999732971e-01f, 7.310371846e-03f, 9.999915361e-01f, 4.110949114e-03f, 9.999973178e-01f, 2.311761025e-03f,
1.367372274e-01f, 9.906073809e-01f, -1.879615150e-02f, 9.998233318e-01f, -2.813494802e-01f, -9.596053958e-01f, -7.948708534e-01f, 6.067786217e-01f, 1.699671596e-01f, 9.854497313e-01f, 7.057763338e-01f, 7.084347010e-01f, 9.035902619e-01f, 4.283977747e-01f, 9.691694379e-01f, 2.463953048e-01f, 9.902160168e-01f, 1.395431161e-01f, 9.969025850e-01f, 7.864648104e-02f, 9.990201592e-01f, 4.425742477e-02f, 9.996901155e-01f, 2.489333972e-02f, 9.999020100e-01f, 1.399954315e-02f, 9.999690056e-01f, 7.872696966e-03f, 9.999902248e-01f, 4.427174106e-03f, 9.999969006e-01f, 2.489588689e-03f,
-7.596879005e-01f, 6.502878666e-01f, -5.489754677e-01f, 8.358384371e-01f, 3.102234937e-02f, -9.995186925e-01f, -8.896704316e-01f, 4.566032588e-01f, 7.073719800e-02f, 9.974949956e-01f, 6.648434997e-01f, 7.469826937e-01f, 8.895936012e-01f, 4.567528665e-01f, 9.646348357e-01f, 2.635899782e-01f, 9.887710810e-01f, 1.494381279e-01f, 9.964445233e-01f, 8.425120264e-02f, 9.988752007e-01f, 4.741638154e-02f, 9.996442795e-01f, 2.667102963e-02f, 9.998875260e-01f, 1.499943808e-02f, 9.999644160e-01f, 8.435020223e-03f, 9.999887347e-01f, 4.743398633e-03f, 9.999964237e-01f, 2.667415887e-03f,
-9.576594830e-01f, -2.879033387e-01f, -9.100810885e-01f, 4.144302309e-01f, 3.403181434e-01f, -9.403103590e-01f, -9.564100504e-01f, 2.920270860e-01f, -2.919954434e-02f, 9.995735884e-01f, 6.218088269e-01f, 7.831690907e-01f, 8.747074604e-01f, 4.846512377e-01f, 9.597951770e-01f, 2.807013094e-01f, 9.872272611e-01f, 1.593182087e-01f, 9.959549904e-01f, 8.985326439e-02f, 9.987202883e-01f, 5.057485774e-02f, 9.995952845e-01f, 2.844863199e-02f, 9.998720288e-01f, 1.599931903e-02f, 9.999595284e-01f, 8.997339755e-03f, 9.999871850e-01f, 5.059622694e-03f, 9.999959469e-01f, 2.845243318e-03f,
-2.751633525e-01f, -9.613974690e-01f, -9.908979535e-01f, -1.346151382e-01f, 6.158647537e-01f, -7.878518701e-01f, -9.929850101e-01f, 1.182405204e-01f, -1.288445443e-01f, 9.916648269e-01f, 5.768082738e-01f, 8.168795705e-01f, 8.589466810e-01f, 5.120649934e-01f, 9.546520114e-01f, 2.977238595e-01f, 9.855847955e-01f, 1.691823453e-01f, 9.954339862e-01f, 9.545248002e-02f, 9.985553622e-01f, 5.373282731e-02f, 9.995430708e-01f, 3.022614494e-02f, 9.998555183e-01f, 1.699918136e-02f, 9.999542832e-01f, 9.559656493e-03f, 9.999855757e-01f, 5.375845823e-03f, 9.999954104e-01f, 3.023070283e-03f,
6.603167057e-01f, -7.509872317e-01f, -7.665365338e-01f, -6.422007084e-01f, 8.303361535e-01f, -5.572628975e-01f, -9.982416630e-01f, -5.927551538e-02f, -2.272021621e-01f, 9.738476276e-01f, 5.299841762e-01f, 8.480075598e-01f, 8.423270583e-01f, 5.389667153e-01f, 9.492070079e-01f, 3.146522641e-01f, 9.838436842e-01f, 1.790295690e-01f, 9.948815107e-01f, 1.010486856e-01f, 9.983804226e-01f, 5.689026415e-02f, 9.994877577e-01f, 3.200356290e-02f, 9.998379946e-01f, 1.799902879e-02f, 9.999487996e-01f, 1.012197044e-02f, 9.999837875e-01f, 5.692068953e-03f, 9.999948740e-01f, 3.200897481e-03f,
9.887046218e-01f, 1.498772055e-01f, -3.060954213e-01f, -9.520008564e-01f, 9.624637961e-01f, -2.714101076e-01f, -9.720142484e-01f, -2.349218130e-01f, -3.232895434e-01f, 9.463000894e-01f, 4.814845622e-01f, 8.764545918e-01f, 8.248651624e-01f, 5.653295517e-01f, 9.434618354e-01f, 3.314811885e-01f, 9.820042253e-01f, 1.888588965e-01f, 9.942975044e-01f, 1.066416800e-01f, 9.981955290e-01f, 6.004713103e-02f, 9.994292855e-01f, 3.378088027e-02f, 9.998195171e-01f, 1.899885759e-02f, 9.999428988e-01f, 1.068428159e-02f, 9.999819398e-01f, 6.008291151e-03f, 9.999942780e-01f, 3.378724447e-03f,
4.080820680e-01f, 9.129452705e-01f, 2.486167252e-01f, -9.686019421e-01f, 9.991443753e-01f, 4.135829210e-02f, -9.151299596e-01f, -4.031589925e-01f, -4.161468148e-01f, 9.092974067e-01f, 4.314628243e-01f, 9.021307230e-01f, 8.065784574e-01f, 5.911270380e-01f, 9.374182820e-01f, 3.482052684e-01f, 9.800665975e-01f, 1.986693144e-01f, 9.936820865e-01f, 1.122313142e-01f, 9.980006814e-01f, 6.320339441e-02f, 9.993675947e-01f, 3.555808961e-02f, 9.998000264e-01f, 1.999866776e-02f, 9.999367595e-01f, 1.124658901e-02f, 9.999799728e-01f, 6.324512884e-03f, 9.999936819e-01f, 3.556551412e-03f,
-5.477292538e-01f, 8.366556168e-01f, 7.267602682e-01f, -6.868911982e-01f, 9.367404580e-01f, 3.500247598e-01f, -8.293829560e-01f, -5.586804748e-01f, -5.048462152e-01f, 8.632093072e-01f, 3.800770044e-01f, 9.249548316e-01f, 7.874851823e-01f, 6.163335443e-01f, 9.310783744e-01f, 3.648192585e-01f, 9.780309200e-01f, 2.084598988e-01f, 9.930352569e-01f, 1.178173944e-01f, 9.977958202e-01f, 6.635902822e-02f, 9.993028045e-01f, 3.733518720e-02f, 9.997795224e-01f, 2.099845745e-02f, 9.999302626e-01f, 1.180889271e-02f, 9.999779463e-01f, 6.640734151e-03f, 9.999930263e-01f, 3.734378144e-03f,
-9.999608397e-01f, -8.851309307e-03f, 9.810745716e-01f, -1.936302334e-01f, 7.814403772e-01f, 6.239799261e-01f, -7.174775004e-01f, -6.965817213e-01f, -5.885011554e-01f, 8.084963560e-01f, 3.274896145e-01f, 9.448547959e-01f, 7.676045895e-01f, 6.409237385e-01f, 9.244439602e-01f, 3.813178837e-01f, 9.758974314e-01f, 2.182296216e-01f, 9.923570156e-01f, 1.233997419e-01f, 9.975810051e-01f, 6.951400638e-02f, 9.992348552e-01f, 3.911216930e-02f, 9.997580051e-01f, 2.199822664e-02f, 9.999234676e-01f, 1.237119269e-02f, 9.999758005e-01f, 6.956954487e-03f, 9.999923706e-01f, 3.912204877e-03f,
-5.328330398e-01f, -8.462203741e-01f, 9.332357645e-01f, 3.592645228e-01f, 5.486452579e-01f, 8.360552788e-01f, -5.829432607e-01f, -8.125128746e-01f, -6.662759781e-01f, 7.457052469e-01f, 2.738668621e-01f, 9.617676139e-01f, 7.469564080e-01f, 6.648730636e-01f, 9.175173044e-01f, 3.976959288e-01f, 9.736663699e-01f, 2.279775143e-01f, 9.916474223e-01f, 1.289781928e-01f, 9.973561764e-01f, 7.266827673e-02f, 9.991636872e-01f, 4.088902473e-02f, 9.997355342e-01f, 2.299797349e-02f, 9.999163747e-01f, 1.293348987e-02f, 9.999735355e-01f, 7.273174357e-03f, 9.999916553e-01f, 4.090031609e-03f,
4.241790175e-01f, -9.055783749e-01f, 5.979771614e-01f, 8.015131354e-01f, 2.614417076e-01f, 9.652192593e-01f, -4.300232828e-01f, -9.028177857e-01f, -7.373937964e-01f, 6.754631400e-01f, 2.193782777e-01f, 9.756398797e-01f, 7.255613208e-01f, 6.881574988e-01f, 9.103004336e-01f, 4.139482081e-01f, 9.713379741e-01f, 2.377026230e-01f, 9.909064770e-01f, 1.345525682e-01f, 9.971213937e-01f, 7.582182437e-02f, 9.990894198e-01f, 4.266574979e-02f, 9.997119904e-01f, 2.399769612e-02f, 9.999089241e-01f, 1.349578146e-02f, 9.999712110e-01f, 7.589393295e-03f, 9.999908805e-01f, 4.267857410e-03f,
9.912028313e-01f, -1.323517561e-01f, 7.855226099e-02f, 9.969099760e-01f, -5.168933049e-02f, 9.986631870e-01f, -2.635405958e-01f, -9.646483064e-01f, -8.011435866e-01f, 5.984721780e-01f, 1.641961634e-01f, 9.864277244e-01f, 7.034407258e-01f, 7.107539177e-01f, 9.027957320e-01f, 4.300695956e-01f, 9.689124227e-01f, 2.474039644e-01f, 9.901341200e-01f, 1.401226968e-01f, 9.968765974e-01f, 7.897461206e-02f, 9.990119338e-01f, 4.444234073e-02f, 9.996874928e-01f, 2.499739639e-02f, 9.999011755e-01f, 1.405806933e-02f, 9.999687672e-01f, 7.905611768e-03f, 9.999901056e-01f, 4.445684142e-03f,
6.469193697e-01f, 7.625584006e-01f, -4.650644958e-01f, 8.852767944e-01f, -3.596943319e-01f, 9.330701828e-01f, -8.874549717e-02f, -9.960543513e-01f, -8.568888307e-01f, 5.155012608e-01f, 1.084949449e-01f, 9.940969944e-01f, 6.806167960e-01f, 7.326396108e-01f, 8.950055242e-01f, 4.460549951e-01f, 9.663899541e-01f, 2.570805550e-01f, 9.893305302e-01f, 1.456883848e-01f, 9.966219068e-01f, 8.212661743e-02f, 9.989313483e-01f, 4.621879384e-02f, 9.996620417e-01f, 2.599707060e-02f, 9.998931289e-01f, 1.462035347e-02f, 9.999662042e-01f, 8.221829310e-03f, 9.999893308e-01f, 4.623509943e-03f,
-2.921388149e-01f, 9.563759565e-01f, -8.654506207e-01f, 5.009942055e-01f, -6.320286393e-01f, 7.749450207e-01f, 8.884812146e-02f, -9.960451722e-01f, -9.040721655e-01f, 4.273798466e-01f, 5.245061219e-02f, 9.986234903e-01f, 6.571123004e-01f, 7.537927032e-01f, 8.869323730e-01f, 4.618993104e-01f, 9.637709260e-01f, 2.667314112e-01f, 9.884956479e-01f, 1.512494683e-01f, 9.963572025e-01f, 8.527779579e-02f, 9.988475442e-01f, 4.799510166e-02f, 9.996355176e-01f, 2.699672058e-02f, 9.998847246e-01f, 1.518263202e-02f, 9.999635220e-01f, 8.538045920e-03f, 9.999884963e-01f, 4.801335745e-03f,
-9.626058936e-01f, 2.709057927e-01f, -9.992933869e-01f, -3.758566082e-02f, -8.416849375e-01f, 5.399689674e-01f, 2.636395097e-01f, -9.646213055e-01f, -9.422222972e-01f, 3.349882066e-01f, -3.759419080e-03f, 9.999929070e-01f, 6.329506636e-01f, 7.741921544e-01f, 8.785787225e-01f, 4.775975943e-01f, 9.610554576e-01f, 2.763556540e-01f, 9.876294732e-01f, 1.568057537e-01f, 9.960825443e-01f, 8.842811733e-02f, 9.987606406e-01f, 4.977125302e-02f, 9.996080399e-01f, 2.799634263e-02f, 9.998760223e-01f, 1.574490592e-02f, 9.999607801e-01f, 8.854261599e-03f, 9.999876022e-01f, 4.979162011e-03f,
-7.480575442e-01f, -6.636338830e-01f, -8.253716230e-01f, -5.645897985e-01f, -9.678714871e-01f, 2.514452934e-01f, 4.301158488e-01f, -9.027737379e-01f, -9.709581733e-01f, 2.392492294e-01f, -5.995756760e-02f, 9.982009530e-01f, 6.081562042e-01f, 7.938174009e-01f, 8.699471951e-01f, 4.931448400e-01f, 9.582439065e-01f, 2.859522104e-01f, 9.867320657e-01f, 1.623570919e-01f, 9.957979321e-01f, 9.157756716e-02f, 9.986705780e-01f, 5.154724792e-02f, 9.995795488e-01f, 2.899593674e-02f, 9.998670220e-01f, 1.630717516e-02f, 9.999579787e-01f, 9.170476347e-03f, 9.999867082e-01f, 5.156987347e-03f,
1.542514563e-01f, -9.880316257e-01f, -3.972518742e-01f, -9.177096486e-01f, -9.980752468e-01f, -6.201483682e-02f, 5.830269456e-01f, -8.124528527e-01f, -9.899924994e-01f, 1.411200017e-01f, -1.159661636e-01f, 9.932531714e-01f, 5.827535987e-01f, 8.126488924e-01f, 8.610406518e-01f, 5.085361004e-01f, 9.553365111e-01f, 2.955201864e-01f, 9.858034849e-01f, 1.679033041e-01f, 9.955033660e-01f, 9.472609311e-02f, 9.985772967e-01f, 5.332308263e-02f, 9.995500445e-01f, 2.999550104e-02f, 9.998577237e-01f, 1.686943881e-02f, 9.999549985e-01f, 9.486690164e-03f, 9.999857545e-01f, 5.334813148e-03f,
9.147423506e-01f, -4.040376544e-01f, 1.532154679e-01f, -9.881927967e-01f, -9.293003082e-01f, -3.693250120e-01f, 7.175492644e-01f, -6.965078115e-01f, -9.991351366e-01f, 4.158052057e-02f, -1.716081351e-01f, 9.851652980e-01f, 5.567683578e-01f, 8.306677938e-01f, 8.518617749e-01f, 5.237666368e-01f, 9.523335695e-01f, 3.050586283e-01f, 9.848436713e-01f, 1.734442115e-01f, 9.951988459e-01f, 9.787366539e-02f, 9.984809160e-01f, 5.509874597e-02f, 9.995195270e-01f, 3.099503554e-02f, 9.998480678e-01f, 1.743169688e-02f, 9.999519587e-01f, 9.802903049e-03f, 9.999848008e-01f, 5.512638018e-03f,
8.342233300e-01f, 5.514267087e-01f, 6.564951539e-01f, -7.543302178e-01f, -7.683671117e-01f, -6.400093436e-01f, 8.294403553e-01f, -5.585952401e-01f, -9.982947707e-01f, -5.837418884e-02f, -2.267075926e-01f, 9.739628434e-01f, 5.302263498e-01f, 8.478561044e-01f, 8.424135447e-01f, 5.388315320e-01f, 9.492354393e-01f, 3.145665526e-01f, 9.838528037e-01f, 1.789796203e-01f, 9.948843718e-01f, 1.010202691e-01f, 9.983813763e-01f, 5.687423423e-02f, 9.994880557e-01f, 3.199454024e-02f, 9.998381138e-01f, 1.799395122e-02f, 9.999487996e-01f, 1.011911593e-02f, 9.999837875e-01f, 5.690463353e-03f,
-1.327674743e-02f, 9.999118447e-01f, 9.575860500e-01f, -2.881473601e-01f, -5.312352777e-01f, -8.472243547e-01f, 9.151713848e-01f, -4.030649364e-01f, -9.874798059e-01f, -1.577456445e-01f, -2.810902894e-01f, 9.596813321e-01f, 5.031541586e-01f, 8.641966581e-01f, 8.326989412e-01f, 5.537260175e-01f, 9.460423589e-01f, 3.240430057e-01f, 9.828307629e-01f, 1.845093668e-01f, 9.945599437e-01f, 1.041658595e-01f, 9.982786179e-01f, 5.864954367e-02f, 9.994555712e-01f, 3.299400955e-02f, 9.998278022e-01f, 1.855619811e-02f, 9.999455214e-01f, 1.043532696e-02f, 9.999827743e-01f, 5.868288688e-03f,
-8.485702872e-01f, 5.290827155e-01f, 9.637575150e-01f, 2.667797208e-01f, -2.414211035e-01f, -9.704204202e-01f, 9.720383286e-01f, -2.348221242e-01f, -9.667981863e-01f, -2.555412054e-01f, -3.345843554e-01f, 9.423658252e-01f, 4.755789042e-01f, 8.796730638e-01f, 8.227210045e-01f, 5.684453845e-01f, 9.427546859e-01f, 3.334870934e-01f, 9.817776680e-01f, 1.900332868e-01f, 9.942255616e-01f, 1.073104069e-01f, 9.981727600e-01f, 6.042466685e-02f, 9.994220734e-01f, 3.399345279e-02f, 9.998172522e-01f, 1.911843941e-02f, 9.999421835e-01f, 1.075153705e-02f, 9.999817014e-01f, 6.046113092e-03f,
-9.036921859e-01f, -4.281826615e-01f, 6.731102467e-01f, 7.395421863e-01f, 7.233466953e-02f, -9.973804355e-01f, 9.982477427e-01f, -5.917267874e-02f, -9.364566803e-01f, -3.507832289e-01f, -3.870206773e-01f, 9.220710397e-01f, 4.475280643e-01f, 8.942698836e-01f, 8.124829531e-01f, 5.829849839e-01f, 9.393727183e-01f, 3.428978026e-01f, 9.806935191e-01f, 1.955512017e-01f, 9.938812256e-01f, 1.104538813e-01f, 9.980637431e-01f, 6.219960377e-02f, 9.993875623e-01f, 3.499285504e-02f, 9.998063445e-01f, 1.968067512e-02f, 9.999387264e-01f, 1.106774528e-02f, 9.999806285e-01f, 6.223937962e-03f,
-1.279636919e-01f, -9.917788506e-01f, 1.751565337e-01f, 9.845405817e-01f, 3.789161742e-01f, -9.254310131e-01f, 9.929728508e-01f, 1.183425784e-01f, -8.967583776e-01f, -4.425205886e-01f, -4.382335246e-01f, 8.988611698e-01f, 4.190297425e-01f, 9.079725146e-01f, 8.019878864e-01f, 5.973402858e-01f, 9.358968139e-01f, 3.522742093e-01f, 9.795783162e-01f, 2.010629177e-01f, 9.935269952e-01f, 1.135962531e-01f, 9.979515672e-01f, 6.397433579e-02f, 9.993520975e-01f, 3.599222749e-02f, 9.997950792e-01f, 2.024290524e-02f, 9.999352098e-01f, 1.138395350e-02f, 9.999794960e-01f, 6.401761901e-03f,
7.654140592e-01f, -6.435381174e-01f, -3.767422736e-01f, 9.263181090e-01f, 6.479216814e-01f, -7.617069483e-01f, 9.563800097e-01f, 2.921253741e-01f, -8.481000066e-01f, -5.298361778e-01f, -4.880608618e-01f, 8.728095889e-01f, 3.901124299e-01f, 9.207672477e-01f, 7.912392616e-01f, 6.115067005e-01f, 9.323273301e-01f, 3.616154492e-01f, 9.784321785e-01f, 2.065682709e-01f, 9.931628108e-01f, 1.167374924e-01f, 9.978361726e-01f, 6.574887782e-02f, 9.993155599e-01f, 3.699155897e-02f, 9.997835755e-01f, 2.080512606e-02f, 9.999315739e-01f, 1.170015987e-02f, 9.999783635e-01f, 6.579586305e-03f,
9.550736547e-01f, 2.963685691e-01f, -8.126112223e-01f, 5.828061700e-01f, 8.526731133e-01f, -5.224447846e-01f, 8.896234632e-01f, 4.566946924e-01f, -7.909677625e-01f, -6.118578315e-01f, -5.363451838e-01f, 8.439987302e-01f, 3.608050346e-01f, 9.326412678e-01f, 7.802404165e-01f, 6.254796982e-01f, 9.286646247e-01f, 3.709204793e-01f, 9.772551060e-01f, 2.120671123e-01f, 9.927886724e-01f, 1.198775545e-01f, 9.977176785e-01f, 6.752320379e-02f, 9.992780685e-01f, 3.799085692e-02f, 9.997717142e-01f, 2.136734314e-02f, 9.999278188e-01f, 1.201636530e-02f, 9.999771714e-01f, 6.757410709e-03f,
2.666429281e-01f, 9.637953639e-01f, -9.982103705e-01f, 5.980031565e-02f, 9.728653431e-01f, -2.313720286e-01f, 7.948083878e-01f, 6.068604589e-01f, -7.259323001e-01f, -6.877661943e-01f, -5.829339027e-01f, 8.125195503e-01f, 3.311368823e-01f, 9.435827136e-01f, 7.689949274e-01f, 6.392549276e-01f, 9.249090552e-01f, 3.801884055e-01f, 9.760470986e-01f, 2.175592482e-01f, 9.924046397e-01f, 1.230164245e-01f, 9.975960255e-01f, 6.929731369e-02f, 9.992396235e-01f, 3.899011388e-02f, 9.997594953e-01f, 2.192955278e-02f, 9.999239445e-01f, 1.233256981e-02f, 9.999759793e-01f, 6.935234182e-03f,
-6.669380665e-01f, 7.451131940e-01f, -8.763794303e-01f, -4.816212952e-01f, 9.965789914e-01f, 8.264580369e-02f, 6.749256253e-01f, 7.378857732e-01f, -6.536436081e-01f, -7.568024993e-01f, -6.276797056e-01f, 7.784717083e-01f, 3.011375964e-01f, 9.535806775e-01f, 7.575061917e-01f, 6.528279781e-01f, 9.210609794e-01f, 3.894183338e-01f, 9.748082757e-01f, 2.230444849e-01f, 9.920106530e-01f, 1.261540651e-01f, 9.974712729e-01f, 7.107120752e-02f, 9.992001057e-01f, 3.998933733e-02f, 9.997470379e-01f, 2.249175683e-02f, 9.999200106e-01f, 1.264877338e-02f, 9.999747276e-01f, 7.113057654e-03f,
-9.873392582e-01f, -1.586226672e-01f, -4.846394062e-01f, -8.747140765e-01f, 9.214623570e-01f, 3.884676993e-01f, 5.337560773e-01f, 8.456385136e-01f, -5.748240352e-01f, -8.182770610e-01f, -6.704410911e-01f, 7.419627309e-01f, 2.708370984e-01f, 9.626252055e-01f, 7.457779050e-01f, 6.661946774e-01f, 9.171208143e-01f, 3.986093104e-01f, 9.735385776e-01f, 2.285226882e-01f, 9.916067719e-01f, 1.292904317e-01f, 9.973433018e-01f, 7.284487784e-02f, 9.991596341e-01f, 4.098851606e-02f, 9.997342229e-01f, 2.305394970e-02f, 9.999159575e-01f, 1.296497509e-02f, 9.999734163e-01f, 7.290880661e-03f,
-3.999853134e-01f, -9.165215492e-01f, 5.636094138e-02f, -9.984104633e-01f, 7.549653053e-01f, 6.557646990e-01f, 3.757521510e-01f, 9.267202020e-01f, -4.902605712e-01f, -8.715758920e-01f, -7.110829353e-01f, 7.031081319e-01f, 2.402658761e-01f, 9.707071185e-01f, 7.338138223e-01f, 6.793506742e-01f, 9.130889177e-01f, 4.077604413e-01f, 9.722381234e-01f, 2.339936644e-01f, 9.911929369e-01f, 1.324255317e-01f, 9.972121716e-01f, 7.461831719e-02f, 9.991181493e-01f, 4.198765755e-02f, 9.997211099e-01f, 2.361613885e-02f, 9.999117851e-01f, 1.328117587e-02f, 9.999721050e-01f, 7.468704134e-03f,
5.551133156e-01f, -8.317747116e-01f, 5.800030828e-01f, -8.146142364e-01f, 5.135983825e-01f, 8.580306768e-01f, 2.058971673e-01f, 9.785736203e-01f, -4.007990062e-01f, -9.161660075e-01f, -7.494767308e-01f, 6.620306969e-01f, 2.094544172e-01f, 9.778184295e-01f, 7.216176391e-01f, 6.922917962e-01f, 9.089657664e-01f, 4.168707728e-01f, 9.709069133e-01f, 2.394572198e-01f, 9.907692075e-01f, 1.355592906e-01f, 9.970778823e-01f, 7.639151812e-02f, 9.990756512e-01f, 4.298675060e-02f, 9.997076392e-01f, 2.417832054e-02f, 9.999075532e-01f, 1.359737478e-02f, 9.999707937e-01f, 7.646527141e-03f,
9.998432994e-01f, 1.770192571e-02f, 9.250146747e-01f, -3.799313903e-01f, 2.212981731e-01f, 9.752061963e-01f, 2.954782173e-02f, 9.995633960e-01f, -3.073327839e-01f, -9.516021013e-01f, -7.855011225e-01f, 6.188602448e-01f, 1.784335226e-01f, 9.839519858e-01f, 7.091933489e-01f, 7.050140500e-01f, 9.047516584e-01f, 4.259394705e-01f, 9.695450068e-01f, 2.449132055e-01f, 9.903355837e-01f, 1.386916935e-01f, 9.969404936e-01f, 7.816448808e-02f, 9.990321398e-01f, 4.398580641e-02f, 9.996939301e-01f, 2.474049293e-02f, 9.999032021e-01f, 1.391357277e-02f, 9.999693632e-01f, 7.824349217e-03f,
5.253220201e-01f, 8.509035110e-01f, 9.851381779e-01f, 1.717635691e-01f, -9.294810891e-02f, 9.956709743e-01f, -1.477329880e-01f, 9.890272617e-01f, -2.107957900e-01f, -9.775301218e-01f, -8.190422058e-01f, 5.737333298e-01f, 1.472342163e-01f, 9.891016483e-01f, 6.965447664e-01f, 7.175133228e-01f, 9.004471302e-01f, 4.349655211e-01f, 9.681524038e-01f, 2.503614724e-01f, 9.898920655e-01f, 1.418227106e-01f, 9.967998862e-01f, 7.993719727e-02f, 9.989876747e-01f, 4.498481750e-02f, 9.996798635e-01f, 2.530265786e-02f, 9.998987317e-01f, 1.422976889e-02f, 9.999679923e-01f, 8.002171293e-03f,
-4.321779609e-01f, 9.017883539e-01f, 7.418580055e-01f, 6.705570221e-01f, -3.979767561e-01f, 9.173954725e-01f, -3.203543723e-01f, 9.472977519e-01f, -1.121526212e-01f, -9.936909676e-01f, -8.499938846e-01f, 5.267925262e-01f, 1.158876941e-01f, 9.932623506e-01f, 6.836758852e-01f, 7.297858000e-01f, 8.960524797e-01f, 4.439480901e-01f, 9.667292237e-01f, 2.558017969e-01f, 9.894386530e-01f, 1.449523121e-01f, 9.966561794e-01f, 8.170966059e-02f, 9.989421964e-01f, 4.598378390e-02f, 9.996654391e-01f, 2.586481534e-02f, 9.998942018e-01f, 1.454596408e-02f, 9.999665618e-01f, 8.179994300e-03f,
-9.923354983e-01f, 1.235731244e-01f, 2.700984478e-01f, 9.628326893e-01f, -6.635382771e-01f, 7.481423020e-01f, -4.828719497e-01f, 8.756909966e-01f, -1.238837745e-02f, -9.999232888e-01f, -8.782584071e-01f, 4.781863391e-01f, 8.442528546e-02f, 9.964298010e-01f, 6.705908179e-01f, 7.418274283e-01f, 8.915683031e-01f, 4.528862834e-01f, 9.652754664e-01f, 2.612340748e-01f, 9.889753461e-01f, 1.480804533e-01f, 9.965093136e-01f, 8.348185569e-02f, 9.988957047e-01f, 4.698270187e-02f, 9.996507764e-01f, 2.642696351e-02f, 9.998895526e-01f, 1.486215740e-02f, 9.999650717e-01f, 8.357816376e-03f,
-6.401443481e-01f, -7.682546377e-01f, -2.848466039e-01f, 9.585731030e-01f, -8.632964492e-01f, 5.046971440e-01f, -6.301599741e-01f, 7.764653563e-01f, 8.749917895e-02f, -9.961646199e-01f, -9.037463665e-01f, 4.280683994e-01f, 5.287845805e-02f, 9.986009598e-01f, 6.572937369e-01f, 7.536345124e-01f, 8.869948983e-01f, 4.617791772e-01f, 9.637911916e-01f, 2.666580379e-01f, 9.885020852e-01f, 1.512071192e-01f, 9.963592887e-01f, 8.525379747e-02f, 9.988481998e-01f, 4.798157141e-02f, 9.996357560e-01f, 2.698910423e-02f, 9.998847842e-01f, 1.517834887e-02f, 9.999635816e-01f, 8.535637520e-03f,
3.005925417e-01f, -9.537526369e-01f, -7.520639896e-01f, 6.590901017e-01f, -9.774427414e-01f, 2.112006694e-01f, -7.575730681e-01f, 6.527503729e-01f, 1.865124702e-01f, -9.824525714e-01f, -9.263771176e-01f, 3.765971363e-01f, 2.127875946e-02f, 9.997735620e-01f, 6.437888145e-01f, 7.652031779e-01f, 8.823328614e-01f, 4.706258774e-01f, 9.622764587e-01f, 2.720735669e-01f, 9.880189896e-01f, 1.543322802e-01f, 9.962061048e-01f, 8.702547103e-02f, 9.987997413e-01f, 4.898039624e-02f, 9.996203780e-01f, 2.755123749e-02f, 9.998799562e-01f, 1.549453940e-02f, 9.999620318e-01f, 8.713459596e-03f,
9.649659991e-01f, -2.623748481e-01f, -9.876590967e-01f, 1.566190720e-01f, -9.946564436e-01f, -1.032404676e-01f, -8.610926867e-01f, 5.084480047e-01f, 2.836621702e-01f, -9.589242935e-01f, -9.460792542e-01f, 3.239352703e-01f, -1.034221891e-02f, 9.999465346e-01f, 6.300802827e-01f, 7.765299678e-01f, 8.775825500e-01f, 4.794255495e-01f, 9.607312679e-01f, 2.774805427e-01f, 9.875259995e-01f, 1.574558914e-01f, 9.960497618e-01f, 8.879686147e-02f, 9.987502694e-01f, 4.997916892e-02f, 9.996047616e-01f, 2.811335959e-02f, 9.998750091e-01f, 1.581072807e-02f, 9.999604821e-01f, 8.891279809e-03f,
7.421542406e-01f, 6.702291369e-01f, -9.190735221e-01f, -3.940860629e-01f, -9.132301211e-01f, -4.074441493e-01f, -9.374542832e-01f, 3.481085002e-01f, 3.779776394e-01f, -9.258147478e-01f, -9.627903700e-01f, 2.702493370e-01f, -4.195285589e-02f, 9.991195798e-01f, 6.161724925e-01f, 7.876112461e-01f, 8.727445006e-01f, 4.881772399e-01f, 9.591556787e-01f, 2.828786969e-01f, 9.870231748e-01f, 1.605779380e-01f, 9.958902597e-01f, 9.056797624e-02f, 9.986997843e-01f, 5.097789690e-02f, 9.995887876e-01f, 2.867547423e-02f, 9.998699427e-01f, 1.612691768e-02f, 9.999588728e-01f, 9.069100954e-03f,
-1.629907787e-01f, 9.866275787e-01f, -5.674300194e-01f, -8.234215975e-01f, -7.412399650e-01f, -6.712400913e-01f, -9.842484593e-01f, 1.767906845e-01f, 4.685169160e-01f, -8.834545016e-01f, -9.764577150e-01f, 2.157090008e-01f, -7.352153957e-02f, 9.972936511e-01f, 6.020698547e-01f, 7.984433770e-01f, 8.678191900e-01f, 4.968801141e-01f, 9.575498104e-01f, 2.882679403e-01f, 9.865104556e-01f, 1.636983752e-01f, 9.957276583e-01f, 9.233880043e-02f, 9.986482859e-01f, 5.197656900e-02f, 9.995725155e-01f, 2.923758142e-02f, 9.998648167e-01f, 1.644310169e-02f, 9.999572635e-01f, 9.246920235e-03f,
-9.182828069e-01f, 3.959251344e-01f, -4.102819040e-02f, -9.991579652e-01f, -4.957418144e-01f, -8.684699535e-01f, -1.000000000e+00f, -1.030206768e-04f, 5.543745160e-01f, -8.322673440e-01f, -9.870380163e-01f, 1.604867131e-01f, -1.050167158e-01f, 9.944704771e-01f, 5.877768993e-01f, 8.090230227e-01f, 8.628070951e-01f, 5.055333376e-01f, 9.559136033e-01f, 2.936480343e-01f, 9.859878421e-01f, 1.668171734e-01f, 9.955618382e-01f, 9.410934150e-02f, 9.985958338e-01f, 5.297519267e-02f, 9.995558858e-01f, 2.979967557e-02f, 9.998595715e-01f, 1.675928757e-02f, 9.999555945e-01f, 9.424741380e-03f,
-8.293098211e-01f, -5.587890744e-01f, 4.980095923e-01f, -8.671715260e-01f, -2.010796219e-01f, -9.795749187e-01f, -9.842120409e-01f, -1.769934893e-01f, 6.346929669e-01f, -7.727644444e-01f, -9.944978952e-01f, 1.047568321e-01f, -1.364068687e-01f, 9.906529188e-01f, 5.732980371e-01f, 8.193469048e-01f, 8.577086926e-01f, 5.141359568e-01f, 9.542471766e-01f, 2.990188897e-01f, 9.854553938e-01f, 1.699342877e-01f, 9.953929186e-01f, 9.587957710e-02f, 9.985423684e-01f, 5.397376046e-02f, 9.995389581e-01f, 3.036176413e-02f, 9.998542070e-01f, 1.707546785e-02f, 9.999538660e-01f, 9.602561593e-03f,
2.212675475e-02f, -9.997551441e-01f, 8.836693168e-01f, -4.681116939e-01f, 1.135217771e-01f, -9.935355186e-01f, -9.373825192e-01f, -3.483016491e-01f, 7.086697817e-01f, -7.055402994e-01f, -9.988136292e-01f, 4.869600013e-02f, -1.676606387e-01f, 9.858447909e-01f, 5.586378574e-01f, 8.294116855e-01f, 8.525245190e-01f, 5.226872563e-01f, 9.525505900e-01f, 3.043802381e-01f, 9.849131107e-01f, 1.730497181e-01f, 9.952208400e-01f, 9.764950722e-02f, 9.984878898e-01f, 5.497227982e-02f, 9.995217323e-01f, 3.092384152e-02f, 9.998487830e-01f, 1.739165001e-02f, 9.999521971e-01f, 9.780380875e-03f,
8.532201052e-01f, -5.215510130e-01f, 9.971746206e-01f, 7.511820644e-02f, 4.168670774e-01f, -9.089674354e-01f, -8.609884381e-01f, -5.086245537e-01f, 7.755658031e-01f, -6.312667131e-01f, -9.999717474e-01f, -7.518785074e-03f, -1.987468749e-01f, 9.800508618e-01f, 5.438010693e-01f, 8.392141461e-01f, 8.472551107e-01f, 5.311862230e-01f, 9.508239031e-01f, 3.097319603e-01f, 9.843609333e-01f, 1.761634201e-01f, 9.950456619e-01f, 9.941913933e-02f, 9.984323978e-01f, 5.597073585e-02f, 9.995042086e-01f, 3.148590773e-02f, 9.998431802e-01f, 1.770782843e-02f, 9.999504089e-01f, 9.958200157e-03f,
8.998668194e-01f, 4.361647666e-01f, 8.035690784e-01f, 5.952115059e-01f, 6.788702011e-01f, -7.342582941e-01f, -7.574391961e-01f, -6.529057026e-01f, 8.347129226e-01f, -5.506852865e-01f, -9.979684949e-01f, -6.370980293e-02f, -2.296342701e-01f, 9.732769728e-01f, 5.287922621e-01f, 8.487513065e-01f, 8.419009447e-01f, 5.396320224e-01f, 9.490671158e-01f, 3.150739372e-01f, 9.837989211e-01f, 1.792753637e-01f, 9.948672652e-01f, 1.011884511e-01f, 9.983759522e-01f, 5.696914345e-02f, 9.994863272e-01f, 3.204796836e-02f, 9.998375773e-01f, 1.802400686e-02f, 9.999486208e-01f, 1.013601944e-02f,
1.191801354e-01f, 9.928726554e-01f, 3.624766469e-01f, 9.319928288e-01f, 8.735505342e-01f, -4.867334962e-01f, -6.300007105e-01f, -7.765945792e-01f, 8.855196238e-01f, -4.646020234e-01f, -9.928101897e-01f, -1.196994036e-01f, -2.602920234e-01f, 9.655299187e-01f, 5.136163235e-01f, 8.580200076e-01f, 8.364626765e-01f, 5.480239391e-01f, 9.472803473e-01f, 3.204059005e-01f, 9.832270741e-01f, 1.823855042e-01f, 9.946857691e-01f, 1.029574350e-01f, 9.983184934e-01f, 5.796748772e-02f, 9.994681478e-01f, 3.261001408e-02f, 9.998317957e-01f, 1.834018156e-02f, 9.999468327e-01f, 1.031383779e-02f,
-7.710802555e-01f, 6.367380023e-01f, -1.902491003e-01f, 9.817358255e-01f, 9.816020727e-01f, -1.909380108e-01f, -4.826923311e-01f, -8.757900000e-01f, 9.274784923e-01f, -3.738765717e-01f, -9.845131636e-01f, -1.753105819e-01f, -2.906895280e-01f, 9.568174481e-01f, 4.982779026e-01f, 8.670173883e-01f, 8.309406638e-01f, 5.563610196e-01f, 9.454635978e-01f, 3.257277906e-01f, 9.826454520e-01f, 1.854938269e-01f, 9.945011139e-01f, 1.047261059e-01f, 9.982600212e-01f, 5.896577984e-02f, 9.994496703e-01f, 3.317204863e-02f, 9.998259544e-01f, 1.865635626e-02f, 9.999449849e-01f, 1.049165614e-02f,
-9.524129629e-01f, -3.048106432e-01f, -6.843819022e-01f, 7.291237116e-01f, 9.923083186e-01f, 1.237909496e-01f, -3.201591969e-01f, -9.473637342e-01f, 9.601702690e-01f, -2.794154882e-01f, -9.731037021e-01f, -2.303675264e-01f, -3.207963705e-01f, 9.471482038e-01f, 4.827820063e-01f, 8.757405281e-01f, 8.253356218e-01f, 5.646424294e-01f, 9.436169863e-01f, 3.310393095e-01f, 9.820539355e-01f, 1.886002868e-01f, 9.943132997e-01f, 1.064944416e-01f, 9.982005358e-01f, 5.996400863e-02f, 9.994308352e-01f, 3.373407945e-02f, 9.998199940e-01f, 1.897252724e-02f, 9.999430776e-01f, 1.066947449e-02f,
-2.581016421e-01f, -9.661177397e-01f, -9.677396417e-01f, 2.519522905e-01f, 9.046075344e-01f, 4.262454212e-01f, -1.475291997e-01f, -9.890577197e-01f, 9.832684398e-01f, -1.821625978e-01f, -9.586178064e-01f, -2.846961617e-01f, -3.505824506e-01f, 9.365319014e-01f, 4.671334028e-01f, 8.841868639e-01f, 8.196480274e-01f, 5.728674531e-01f, 9.417404532e-01f, 3.363404274e-01f, 9.814526439e-01f, 1.917048544e-01f, 9.941223264e-01f, 1.082624346e-01f, 9.981400967e-01f, 6.096218154e-02f, 9.994117022e-01f, 3.429609165e-02f, 9.998139739e-01f, 1.928869821e-02f, 9.999411702e-01f, 1.084729191e-02f,
6.735071540e-01f, -7.391806841e-01f, -9.530500174e-01f, -3.028128445e-01f, 7.271980643e-01f, 6.864277124e-01f, 2.975377068e-02f, -9.995572567e-01f, 9.965420961e-01f, -8.308912069e-02f, -9.411013126e-01f, -3.381247520e-01f, -3.800179660e-01f, 9.249790907e-01f, 4.513370693e-01f, 8.923535347e-01f, 8.138784766e-01f, 5.810351968e-01f, 9.398342371e-01f, 3.416308761e-01f, 9.808415174e-01f, 1.948075294e-01f, 9.939282537e-01f, 1.100300923e-01f, 9.980786443e-01f, 6.196028739e-02f, 9.993922710e-01f, 3.485809639e-02f, 9.998078346e-01f, 1.960486546e-02f, 9.999392033e-01f, 1.102510840e-02f,
9.858965874e-01f, 1.673557013e-01f, -6.448370218e-01f, -7.643201351e-01f, 4.776714444e-01f, 8.785385489e-01f, 2.060983330e-01f, -9.785313010e-01f, 9.998586178e-01f, 1.681409217e-02f, -9.206095338e-01f, -3.904843926e-01f, -4.090735018e-01f, 9.125014544e-01f, 4.353979826e-01f, 9.002380967e-01f, 8.080275059e-01f, 5.891447663e-01f, 9.378982186e-01f, 3.469105363e-01f, 9.802205563e-01f, 1.979082376e-01f, 9.937310219e-01f, 1.117973924e-01f, 9.980161786e-01f, 6.295833737e-02f, 9.993724823e-01f, 3.542009369e-02f, 9.998015761e-01f, 1.992103085e-02f, 9.999372363e-01f, 1.120292582e-02f,
3.918572366e-01f, 9.200260639e-01f, -1.380281597e-01f, -9.904283285e-01f, 1.807759702e-01f, 9.835243225e-01f, 3.759426475e-01f, -9.266429543e-01f, 9.931849241e-01f, 1.165492982e-01f, -8.972073197e-01f, -4.416095316e-01f, -4.377200007e-01f, 8.991113305e-01f, 4.193212092e-01f, 9.078379273e-01f, 8.020957708e-01f, 5.971954465e-01f, 9.359325767e-01f, 3.521791995e-01f, 9.795898199e-01f, 2.010069788e-01f, 9.935306311e-01f, 1.135643497e-01f, 9.979526997e-01f, 6.395632029e-02f, 9.993524551e-01f, 3.598207608e-02f, 9.997951984e-01f, 2.023719437e-02f, 9.999352098e-01f, 1.138074230e-02f,
-5.624538660e-01f, 8.268286586e-01f, 4.112906456e-01f, -9.115042686e-01f, -1.340468824e-01f, 9.909749627e-01f, 5.339299440e-01f, -8.455287218e-01f, 9.765876532e-01f, 2.151199877e-01f, -8.709686995e-01f, -4.913385212e-01f, -4.659289122e-01f, 8.848221898e-01f, 4.031118751e-01f, 9.151507020e-01f, 7.960838079e-01f, 6.051864028e-01f, 9.339373708e-01f, 3.574367166e-01f, 9.789492488e-01f, 2.041037083e-01f, 9.933271408e-01f, 1.153309494e-01f, 9.978882670e-01f, 6.495424360e-02f, 9.993320704e-01f, 3.654404357e-02f, 9.997887611e-01f, 2.055335604e-02f, 9.999331832e-01f, 1.155855879e-02f,
-9.996474385e-01f, -2.655115537e-02f, 8.339421749e-01f, -5.518518090e-01f, -4.355781674e-01f, 9.001508951e-01f, 6.750773191e-01f, -7.377469540e-01f, 9.502326250e-01f, 3.115412891e-01f, -8.419764638e-01f, -5.395141840e-01f, -4.936717451e-01f, 8.696483374e-01f, 3.867750466e-01f, 9.221740961e-01f, 7.899922729e-01f, 6.131168008e-01f, 9.319126010e-01f, 3.626829684e-01f, 9.782989621e-01f, 2.071983814e-01f, 9.931204915e-01f, 1.170971766e-01f, 9.978227615e-01f, 6.595209241e-02f, 9.993113279e-01f, 3.710600734e-02f, 9.997822046e-01f, 2.086951770e-02f, 9.999310970e-01f, 1.173637528e-02f,
-5.177697539e-01f, -8.555200100e-01f, 9.997526407e-01f, -2.224157006e-02f, -6.939117312e-01f, 7.200600505e-01f, 7.949331403e-01f, -6.066970825e-01f, 9.143830538e-01f, 4.048501849e-01f, -8.103224635e-01f, -5.859842300e-01f, -5.209211111e-01f, 8.536047935e-01f, 3.703159094e-01f, 9.289059043e-01f, 7.838217020e-01f, 6.209859252e-01f, 9.298583269e-01f, 3.679177165e-01f, 9.776388407e-01f, 2.102909982e-01f, 9.929106832e-01f, 1.188630387e-01f, 9.977563620e-01f, 6.694988906e-02f, 9.992902875e-01f, 3.766795248e-02f, 9.997755289e-01f, 2.118567377e-02f, 9.999290109e-01f, 1.191418990e-02f,
4.401430190e-01f, -8.979277015e-01f, 8.576571345e-01f, 5.142219663e-01f, -8.834316730e-01f, 4.685599506e-01f, 8.897171617e-01f, -4.565122128e-01f, 8.693974018e-01f, 4.941135347e-01f, -7.761065960e-01f, -6.306017041e-01f, -5.476494431e-01f, 8.367078900e-01f, 3.537396789e-01f, 9.353439212e-01f, 7.775726914e-01f, 6.287930012e-01f, 9.277747273e-01f, 3.731408715e-01f, 9.769689441e-01f, 2.133814991e-01f, 9.926977158e-01f, 1.206285134e-01f, 9.976888895e-01f, 6.794761121e-02f, 9.992689490e-01f, 3.822989017e-02f, 9.997687936e-01f, 2.150182985e-02f, 9.999268651e-01f, 1.209200546e-02f,
9.933903813e-01f, -1.147848144e-01f, 4.514202476e-01f, 8.923114538e-01f, -9.853413105e-01f, 1.705945879e-01f, 9.564402103e-01f, -2.919283211e-01f, 8.157250285e-01f, 5.784398317e-01f, -7.394371629e-01f, -6.732255816e-01f, -5.738303661e-01f, 8.189741969e-01f, 3.370516896e-01f, 9.414861202e-01f, 7.712460160e-01f, 6.365371943e-01f, 9.256617427e-01f, 3.783521950e-01f, 9.762892723e-01f, 2.164698690e-01f, 9.924816489e-01f, 1.223936230e-01f, 9.976204634e-01f, 6.894526631e-02f, 9.992473125e-01f, 3.879181668e-02f, 9.997619390e-01f, 2.181798220e-02f, 9.999247193e-01f, 1.226981916e-02f,
6.333191991e-01f, 7.738906741e-01f, -9.384513646e-02f, 9.955868125e-01f, -9.895353913e-01f, -1.442903578e-01f, 9.929971695e-01f, -1.181379855e-01f, 7.539022565e-01f, 6.569865942e-01f, -7.004299760e-01f, -7.137210965e-01f, -5.994372964e-01f, 8.004217148e-01f, 3.202570081e-01f, 9.473307133e-01f, 7.648422122e-01f, 6.442176700e-01f, 9.235194325e-01f, 3.835515678e-01f, 9.755998850e-01f, 2.195560932e-01f, 9.922624230e-01f, 1.241583377e-01f, 9.975510240e-01f, 6.994284689e-02f, 9.992253184e-01f, 3.935372457e-02f, 9.997550249e-01f, 2.213413455e-02f, 9.999225140e-01f, 1.244763471e-02f,
-3.090227246e-01f, 9.510546327e-01f, -6.102110744e-01f, 7.922388911e-01f, -8.955979943e-01f, -4.448643327e-01f, 9.982355237e-01f, 5.937835947e-02f, 6.845467091e-01f, 7.289689779e-01f, -6.592084765e-01f, -7.519602180e-01f, -6.244450212e-01f, 7.810688019e-01f, 3.033610582e-01f, 9.528756738e-01f, 7.583618760e-01f, 6.518337727e-01f, 9.213479757e-01f, 3.887388110e-01f, 9.749007225e-01f, 2.226400971e-01f, 9.920400381e-01f, 1.259226501e-01f, 9.974805713e-01f, 7.094036788e-02f, 9.992030263e-01f, 3.991562501e-02f, 9.997479320e-01f, 2.245028317e-02f, 9.999203086e-01f, 1.262544841e-02f,
-9.672505856e-01f, 2.538233697e-01f, -9.386403561e-01f, 3.448974490e-01f, -7.128450871e-01f, -7.013215423e-01f, 9.719900489e-01f, 2.350219339e-01f, 6.083510518e-01f, 7.936680317e-01f, -6.159027219e-01f, -7.878221869e-01f, -6.488281488e-01f, 7.609349489e-01f, 2.863692045e-01f, 9.581193328e-01f, 7.518057823e-01f, 6.593846679e-01f, 9.191473722e-01f, 3.939137757e-01f, 9.741917849e-01f, 2.257218957e-01f, 9.918145537e-01f, 1.276865751e-01f, 9.974091053e-01f, 7.193781435e-02f, 9.991804361e-01f, 4.047751427e-02f, 9.997408390e-01f, 2.276643179e-02f, 9.999180436e-01f, 1.280326117e-02f,
-7.361927032e-01f, -6.767719388e-01f, -9.779862761e-01f, -2.086692750e-01f, -4.593983889e-01f, -8.882303238e-01f, 9.150884748e-01f, 4.032530487e-01f, 5.260773301e-01f, 8.504367471e-01f, -5.706502199e-01f, -8.211932182e-01f, -6.725627184e-01f, 7.400401235e-01f, 2.692867517e-01f, 9.630600214e-01f, 7.451744676e-01f, 6.668695807e-01f, 9.169177413e-01f, 3.990762532e-01f, 9.734731317e-01f, 2.288014293e-01f, 9.915859103e-01f, 1.294501126e-01f, 9.973366857e-01f, 7.293518633e-02f, 9.991575480e-01f, 4.103938490e-02f, 9.997335672e-01f, 2.308257483e-02f, 9.999157190e-01f, 1.298107579e-02f,
1.717173457e-01f, -9.851462841e-01f, -7.161304951e-01f, -6.979663968e-01f, -1.603949666e-01f, -9.870529175e-01f, 8.293254972e-01f, 5.587657690e-01f, 4.385472536e-01f, 8.987081051e-01f, -5.235932469e-01f, -8.519684076e-01f, -6.956245899e-01f, 7.184054852e-01f, 2.521191835e-01f, 9.676961899e-01f, 7.384685278e-01f, 6.742879152e-01f, 9.146590829e-01f, 4.042260945e-01f, 9.727447033e-01f, 2.318786681e-01f, 9.913541675e-01f, 1.312132180e-01f, 9.972632527e-01f, 7.393248379e-02f, 9.991343021e-01f, 4.160124436e-02f, 9.997262359e-01f, 2.339871787e-02f, 9.999133945e-01f, 1.315888762e-02f,
9.217512608e-01f, -3.877816498e-01f, -2.337207645e-01f, -9.723037481e-01f, 1.545165181e-01f, -9.879902005e-01f, 7.174060345e-01f, 6.966552734e-01f, 3.466353416e-01f, 9.379999638e-01f, -4.748813212e-01f, -8.800498247e-01f, -7.179910541e-01f, 6.960523129e-01f, 2.348718494e-01f, 9.720263481e-01f, 7.316888571e-01f, 6.816387773e-01f, 9.123715162e-01f, 4.093632102e-01f, 9.720066190e-01f, 2.349535823e-01f, 9.911192656e-01f, 1.329759061e-01f, 9.971888065e-01f, 7.492970675e-02f, 9.991107583e-01f, 4.216309637e-02f, 9.997187853e-01f, 2.371485718e-02f, 9.999110699e-01f, 1.333669946e-02f,
8.243313432e-01f, 5.661076307e-01f, 3.206739426e-01f, -9.471896291e-01f, 4.541028738e-01f, -8.909492493e-01f, 5.828598738e-01f, 8.125726581e-01f, 2.512599528e-01f, 9.679196477e-01f, -4.246677160e-01f, -9.053493142e-01f, -7.396394610e-01f, 6.730033755e-01f, 2.175502628e-01f, 9.760491252e-01f, 7.248359919e-01f, 6.889214516e-01f, 9.100551009e-01f, 4.144873321e-01f, 9.712587595e-01f, 2.380261570e-01f, 9.908812046e-01f, 1.347381920e-01f, 9.971134067e-01f, 7.592686266e-02f, 9.990868568e-01f, 4.272492975e-02f, 9.997112155e-01f, 2.403099649e-02f, 9.999086857e-01f, 1.351451222e-02f,
-3.097503260e-02f, 9.995201826e-01f, 7.763037086e-01f, -6.303589940e-01f, 7.086563706e-01f, -7.055538297e-01f, 4.299306870e-01f, 9.028618932e-01f, 1.533735693e-01f, 9.881682992e-01f, -3.731119633e-01f, -9.277863503e-01f, -7.605484128e-01f, 6.492812634e-01f, 2.001598924e-01f, 9.797632694e-01f, 7.179107070e-01f, 6.961352229e-01f, 9.077098370e-01f, 4.195984006e-01f, 9.705011845e-01f, 2.410963625e-01f, 9.906400442e-01f, 1.365000308e-01f, 9.970369935e-01f, 7.692394406e-02f, 9.990627170e-01f, 4.328674823e-02f, 9.997035861e-01f, 2.434713021e-02f, 9.999062419e-01f, 1.369232405e-02f,
-8.578031063e-01f, 5.139784217e-01f, 9.928478599e-01f, -1.193865910e-01f, 8.929339647e-01f, -4.501876533e-01f, 2.634407580e-01f, 9.646756053e-01f, 5.395522714e-02f, 9.985433817e-01f, -3.203761876e-01f, -9.472904205e-01f, -7.806967497e-01f, 6.249100566e-01f, 1.827063411e-01f, 9.831675291e-01f, 7.109135985e-01f, 7.032793760e-01f, 9.053359628e-01f, 4.246961474e-01f, 9.697338939e-01f, 2.441641390e-01f, 9.903957844e-01f, 1.382614523e-01f, 9.969595671e-01f, 7.792093605e-02f, 9.990381598e-01f, 4.384855926e-02f, 9.996958375e-01f, 2.466326393e-02f, 9.999037981e-01f, 1.387013402e-02f,
-8.959709406e-01f, -4.441126585e-01f, 9.036121368e-01f, 4.283516109e-01f, 9.886589646e-01f, -1.501781940e-01f, 8.864288777e-02f, 9.960634708e-01f, -4.600222036e-02f, 9.989413619e-01f, -2.666280270e-01f, -9.637995362e-01f, -8.000645638e-01f, 5.999138951e-01f, 1.651948988e-01f, 9.862609506e-01f, 7.038453221e-01f, 7.103532553e-01f, 9.029334188e-01f, 4.297804832e-01f, 9.689569473e-01f, 2.472294867e-01f, 9.901483059e-01f, 1.400224417e-01f, 9.968811274e-01f, 7.891785353e-02f, 9.990133643e-01f, 4.441035166e-02f, 9.996879697e-01f, 2.497939393e-02f, 9.999012947e-01f, 1.404794492e-02f,
-1.103872433e-01f, -9.938886762e-01f, 5.360818505e-01f, 8.441659808e-01f, 9.863393307e-01f, 1.647261530e-01f, -8.895073086e-02f, 9.960360527e-01f, -1.455000341e-01f, 9.893582463e-01f, -2.120364457e-01f, -9.772617817e-01f, -8.186323047e-01f, 5.743179917e-01f, 1.476312131e-01f, 9.890424609e-01f, 6.967067122e-01f, 7.173560858e-01f, 9.005023241e-01f, 4.348512292e-01f, 9.681702852e-01f, 2.502923310e-01f, 9.898977876e-01f, 1.417829692e-01f, 9.968017340e-01f, 7.991469651e-02f, 9.989882708e-01f, 4.497213289e-02f, 9.996800423e-01f, 2.529552206e-02f, 9.998987913e-01f, 1.422575582e-02f,
7.766859531e-01f, -6.298879981e-01f, 3.445185488e-03f, 9.999940395e-01f, 8.862052560e-01f, 4.632928669e-01f, -2.637388706e-01f, 9.645941257e-01f, -2.435445338e-01f, 9.698897004e-01f, -1.567750126e-01f, -9.876343608e-01f, -8.363815546e-01f, 5.481476784e-01f, 1.300208420e-01f, 9.915112853e-01f, 6.894984245e-01f, 7.242871523e-01f, 8.980427384e-01f, 4.399082065e-01f, 9.673739672e-01f, 2.533527315e-01f, 9.896440506e-01f, 1.435430646e-01f, 9.967212677e-01f, 8.091145754e-02f, 9.989628196e-01f, 4.553389549e-02f, 9.996719956e-01f, 2.561164647e-02f, 9.998962879e-01f, 1.440356486e-02f,
9.496777058e-01f, 3.132287860e-01f, -5.302492976e-01f, 8.478417993e-01f, 6.981857419e-01f, 7.159166336e-01f, -4.302088320e-01f, 9.027293921e-01f, -3.391546607e-01f, 9.407306314e-01f, -1.010174751e-01f, -9.948846698e-01f, -8.532945514e-01f, 5.214292407e-01f, 1.123693660e-01f, 9.936665297e-01f, 6.822211742e-01f, 7.311458588e-01f, 8.955547810e-01f, 4.449512959e-01f, 9.665679932e-01f, 2.564105392e-01f, 9.893872738e-01f, 1.453027129e-01f, 9.966399074e-01f, 8.190813661e-02f, 9.989370108e-01f, 4.609564692e-02f, 9.996638298e-01f, 2.592777088e-02f, 9.998936653e-01f, 1.458137389e-02f,
2.495401055e-01f, 9.683644772e-01f, -9.006391764e-01f, 4.345676303e-01f, 4.409287572e-01f, 8.975421190e-01f, -5.831102729e-01f, 8.123930097e-01f, -4.313769937e-01f, 9.021717310e-01f, -4.494105279e-02f, -9.989896417e-01f, -8.693541884e-01f, 4.941895902e-01f, 9.468235075e-02f, 9.955075383e-01f, 6.748757362e-01f, 7.379313707e-01f, 8.930384517e-01f, 4.499803185e-01f, 9.657523036e-01f, 2.594658434e-01f, 9.891272783e-01f, 1.470618844e-01f, 9.965574741e-01f, 8.290474117e-02f, 9.989109635e-01f, 4.665738344e-02f, 9.996555448e-01f, 2.624388970e-02f, 9.998911023e-01f, 1.475918386e-02f,
-6.800234914e-01f, 7.331902981e-01f, -9.936468601e-01f, -1.125427037e-01f, 1.399453431e-01f, 9.901592135e-01f, -7.176206112e-01f, 6.964342594e-01f, -5.192891359e-01f, 8.545985818e-01f, 1.127792522e-02f, -9.999364018e-01f, -8.845446110e-01f, 4.664555788e-01f, 7.696539164e-02f, 9.970337749e-01f, 6.674628258e-01f, 7.446430922e-01f, 8.904939294e-01f, 4.549950957e-01f, 9.649269581e-01f, 2.625184953e-01f, 9.888642430e-01f, 1.488205791e-01f, 9.964740872e-01f, 8.390125632e-02f, 9.988845587e-01f, 4.721910506e-02f, 9.996472001e-01f, 2.656000853e-02f, 9.998884201e-01f, 1.493699197e-02f,
-9.843766689e-01f, -1.760756075e-01f, -7.806286812e-01f, -6.249951124e-01f, -1.749181598e-01f, 9.845829606e-01f, -8.294976354e-01f, 5.585102439e-01f, -6.020119190e-01f, 7.984871268e-01f, 6.746077538e-02f, -9.977219105e-01f, -8.988505006e-01f, 4.382553995e-01f, 5.922409892e-02f, 9.982447028e-01f, 6.599831581e-01f, 7.512803674e-01f, 8.879212737e-01f, 4.599954784e-01f, 9.640919566e-01f, 2.655685544e-01f, 9.885979891e-01f, 1.505788416e-01f, 9.963896871e-01f, 8.489768207e-02f, 9.988578558e-01f, 4.778081179e-02f, 9.996387959e-01f, 2.687612176e-02f, 9.998857379e-01f, 1.511479914e-02f,
-3.836984336e-01f, -9.234584570e-01f, -3.271927834e-01f, -9.449576139e-01f, -4.724333286e-01f, 8.813664317e-01f, -9.152126908e-01f, 4.029710889e-01f, -6.787203550e-01f, 7.343968153e-01f, 1.234308258e-01f, -9.923532009e-01f, -9.122576714e-01f, 4.096167684e-01f, 4.146407545e-02f, 9.991400242e-01f, 6.524375081e-01f, 7.578425407e-01f, 8.853204846e-01f, 4.649813473e-01f, 9.632473588e-01f, 2.686159313e-01f, 9.883286953e-01f, 1.523365974e-01f, 9.963042736e-01f, 8.589403331e-02f, 9.988307953e-01f, 4.834250361e-02f, 9.996302128e-01f, 2.719223499e-02f, 9.998830557e-01f, 1.529260725e-02f,
5.697503090e-01f, -8.218178153e-01f, 2.270120084e-01f, -9.738919735e-01f, -7.230991125e-01f, 6.907442808e-01f, -9.720626473e-01f, 2.347215265e-01f, -7.486464977e-01f, 6.629694104e-01f, 1.790106595e-01f, -9.838471413e-01f, -9.247525930e-01f, 3.805688024e-01f, 2.369106375e-02f, 9.997193217e-01f, 6.448265314e-01f, 7.643289566e-01f, 8.826917410e-01f, 4.699524939e-01f, 9.623931050e-01f, 2.716606259e-01f, 9.880561829e-01f, 1.540938765e-01f, 9.962179065e-01f, 8.689029515e-02f, 9.988034964e-01f, 4.890418053e-02f, 9.996215701e-01f, 2.750834450e-02f, 9.998803139e-01f, 1.547041349e-02f,
9.993732572e-01f, 3.539830074e-02f, 7.113042474e-01f, -7.028842568e-01f, -9.020542502e-01f, 4.316227138e-01f, -9.982538819e-01f, 5.906983837e-02f, -8.110930920e-01f, 5.849170685e-01f, 2.340240777e-01f, -9.722307920e-01f, -9.363229275e-01f, 3.511400521e-01f, 5.910437554e-03f, 9.999825358e-01f, 6.371511221e-01f, 7.707388997e-01f, 8.800350428e-01f, 4.749087691e-01f, 9.615292549e-01f, 2.747026384e-01f, 9.877806306e-01f, 1.558506787e-01f, 9.961305261e-01f, 8.788647503e-02f, 9.987758398e-01f, 4.946583882e-02f, 9.996128082e-01f, 2.782445215e-02f, 9.998775721e-01f, 1.564821973e-02f,
5.101770163e-01f, 8.600693941e-01f, 9.765252471e-01f, -2.154029608e-01f, -9.915538430e-01f, 1.296956539e-01f, -9.929606318e-01f, -1.184448823e-01f, -8.654354811e-01f, 5.010203719e-01f, 2.882981002e-01f, -9.575406909e-01f, -9.469569325e-01f, 3.213604093e-01f, -1.187205687e-02f, 9.999295473e-01f, 6.294120550e-01f, 7.770717740e-01f, 8.773505092e-01f, 4.798500240e-01f, 9.606557488e-01f, 2.777418792e-01f, 9.875019193e-01f, 1.576069742e-01f, 9.960421324e-01f, 8.888255060e-02f, 9.987478256e-01f, 5.002748594e-02f, 9.996039867e-01f, 2.814055420e-02f, 9.998747706e-01f, 1.582602598e-02f,
-4.480736256e-01f, 8.939966559e-01f, 9.409945607e-01f, 3.384217024e-01f, -9.827213287e-01f, -1.850914657e-01f, -9.563499093e-01f, -2.922239304e-01f, -9.111302495e-01f, 4.121184647e-01f, 3.416602314e-01f, -9.398235083e-01f, -9.566441774e-01f, 2.912592292e-01f, -2.965079620e-02f, 9.995602965e-01f, 6.216099858e-01f, 7.833269238e-01f, 8.746382594e-01f, 4.847761393e-01f, 9.597726464e-01f, 2.807783484e-01f, 9.872201085e-01f, 1.593627781e-01f, 9.959527254e-01f, 8.987855166e-02f, 9.987195730e-01f, 5.058911443e-02f, 9.995950460e-01f, 2.845665626e-02f, 9.998719096e-01f, 1.600383036e-02f,
-9.943674803e-01f, 1.059875116e-01f, 6.156554222e-01f, 7.880154848e-01f, -8.764333129e-01f, -4.815232456e-01f, -8.895764351e-01f, -4.567863345e-01f, -9.477217197e-01f, 3.190979958e-01f, 3.939426839e-01f, -9.191350341e-01f, -9.653747678e-01f, 2.608670294e-01f, -4.742016271e-02f, 9.988750219e-01f, 6.137457490e-01f, 7.895037532e-01f, 8.718983531e-01f, 4.896869063e-01f, 9.588799477e-01f, 2.838120162e-01f, 9.869351387e-01f, 1.611180753e-01f, 9.958623648e-01f, 9.087446332e-02f, 9.986909628e-01f, 5.115072429e-02f, 9.995859861e-01f, 2.877275459e-02f, 9.998690486e-01f, 1.618163660e-02f,
-6.264444590e-01f, -7.794660926e-01f, 1.007066220e-01f, 9.949161410e-01f, -6.832289696e-01f, -7.302041650e-01f, -7.947461605e-01f, -6.069419384e-01f, -9.748435616e-01f, 2.228900939e-01f, 4.449792802e-01f, -8.955408931e-01f, -9.731400609e-01f, 2.302137464e-01f, -6.517452747e-02f, 9.978739023e-01f, 6.058201790e-01f, 7.956016064e-01f, 8.691309094e-01f, 4.945821762e-01f, 9.579776525e-01f, 2.868428528e-01f, 9.866470695e-01f, 1.628728807e-01f, 9.957709908e-01f, 9.187027812e-02f, 9.986619949e-01f, 5.171232671e-02f, 9.995768070e-01f, 2.908885106e-02f, 9.998661876e-01f, 1.635944098e-02f,
3.174287081e-01f, -9.482821226e-01f, -4.452612102e-01f, 8.954007030e-01f, -4.222704768e-01f, -9.064698815e-01f, -6.748499870e-01f, -7.379549146e-01f, -9.922253489e-01f, 1.244542375e-01f, 4.946095049e-01f, -8.691152930e-01f, -9.799323082e-01f, 1.993305236e-01f, -8.290828764e-02f, 9.965571761e-01f, 5.978339314e-01f, 8.016199470e-01f, 8.663359284e-01f, 4.994617999e-01f, 9.570658207e-01f, 2.898707688e-01f, 9.863558412e-01f, 1.646271497e-01f, 9.956786036e-01f, 9.286600351e-02f, 9.986327887e-01f, 5.227390677e-02f, 9.995675683e-01f, 2.940494195e-02f, 9.998632669e-01f, 1.653724350e-02f,
9.694593549e-01f, -2.452519834e-01f, -8.540936708e-01f, 5.201192498e-01f, -1.194339693e-01f, -9.928421378e-01f, -5.336694121e-01f, -8.456931710e-01f, -9.996930361e-01f, 2.477485314e-02f, 5.426756740e-01f, -8.399423361e-01f, -9.857447147e-01f, 1.682477444e-01f, -1.006158292e-01f, 9.949253798e-01f, 5.897880197e-01f, 8.075581193e-01f, 8.635135293e-01f, 5.043256879e-01f, 9.561443329e-01f, 2.928958237e-01f, 9.860615730e-01f, 1.663808972e-01f, 9.955852628e-01f, 9.386163205e-02f, 9.986032248e-01f, 5.283546820e-02f, 9.995582104e-01f, 2.972103283e-02f, 9.998602867e-01f, 1.671504788e-02f,
7.301735282e-01f, 6.832616925e-01f, -9.998821616e-01f, -1.535241678e-02f, 1.952449679e-01f, -9.807544947e-01f, -3.756571114e-01f, -9.267587066e-01f, -9.971721768e-01f, -7.515111566e-02f, 5.890265703e-01f, -8.081136942e-01f, -9.905714393e-01f, 1.369969547e-01f, -1.182915568e-01f, 9.929789305e-01f, 5.816830993e-01f, 8.134155273e-01f, 8.606638908e-01f, 5.091735721e-01f, 9.552133679e-01f, 2.959179580e-01f, 9.857641459e-01f, 1.681341380e-01f, 9.954909086e-01f, 9.485717118e-02f, 9.985733628e-01f, 5.339701846e-02f, 9.995487928e-01f, 3.003711812e-02f, 9.998573065e-01f, 1.689285226e-02f,
-1.804304570e-01f, 9.835877419e-01f, -8.377248049e-01f, -5.460926294e-01f, 4.905616641e-01f, -8.714064956e-01f, -2.057968229e-01f, -9.785947204e-01f, -9.846878052e-01f, -1.743271649e-01f, 6.335148811e-01f, -7.737304568e-01f, -9.944077134e-01f, 1.056089550e-01f, -1.359298676e-01f, 9.907184839e-01f, 5.735200047e-01f, 8.191915751e-01f, 8.577870131e-01f, 5.140053630e-01f, 9.542728066e-01f, 2.989371121e-01f, 9.854635596e-01f, 1.698868275e-01f, 9.953955412e-01f, 9.585261345e-02f, 9.985432029e-01f, 5.395854637e-02f, 9.995392561e-01f, 3.035320155e-02f, 9.998542666e-01f, 1.707065292e-02f,
-9.251475334e-01f, 3.796077371e-01f, -4.175648987e-01f, -9.086471200e-01f, 7.372311950e-01f, -6.756405830e-01f, -2.944579907e-02f, -9.995663762e-01f, -9.623649120e-01f, -2.717604339e-01f, 6.760007739e-01f, -7.369009256e-01f, -9.972496629e-01f, 7.411535084e-02f, -1.535250843e-01f, 9.881447554e-01f, 5.652995706e-01f, 8.248857260e-01f, 8.548829556e-01f, 5.188208818e-01f, 9.533227086e-01f, 3.019533157e-01f, 9.851599336e-01f, 1.716389805e-01f, 9.952991605e-01f, 9.684795886e-02f, 9.985126853e-01f, 5.452005938e-02f, 9.995296001e-01f, 3.066928312e-02f, 9.998512268e-01f, 1.724845544e-02f,
-8.192882538e-01f, -5.733818412e-01f, 1.312005073e-01f, -9.913558364e-01f, 9.107885361e-01f, -4.128731191e-01f, 1.478339285e-01f, -9.890121818e-01f, -9.304261804e-01f, -3.664793074e-01f, 7.163491845e-01f, -6.977419257e-01f, -9.990944266e-01f, 4.254788160e-02f, -1.710718721e-01f, 9.852585793e-01f, 5.570225716e-01f, 8.304973245e-01f, 8.519519567e-01f, 5.236200094e-01f, 9.523630738e-01f, 3.049664497e-01f, 9.848531485e-01f, 1.733906120e-01f, 9.952018261e-01f, 9.784321487e-02f, 9.984818697e-01f, 5.508155748e-02f, 9.995198250e-01f, 3.098535910e-02f, 9.998481274e-01f, 1.742625609e-02f,
3.982087970e-02f, -9.992068410e-01f, 6.395553350e-01f, -7.687450647e-01f, 9.940242171e-01f, -1.091595069e-01f, 3.204510510e-01f, -9.472650886e-01f, -8.891909122e-01f, -4.575363994e-01f, 7.544332147e-01f, -6.563767791e-01f, -9.999401569e-01f, 1.093762368e-02f, -1.885645688e-01f, 9.820607901e-01f, 5.486899018e-01f, 8.360259533e-01f, 8.489939570e-01f, 5.284025669e-01f, 9.513939619e-01f, 3.079765737e-01f, 9.845432639e-01f, 1.751416773e-01f, 9.951034784e-01f, 9.883836657e-02f, 9.984506965e-01f, 5.564303696e-02f, 9.995099902e-01f, 3.130143136e-02f, 9.998450279e-01f, 1.760405675e-02f,
8.623188734e-01f, -5.063656569e-01f, 9.509409070e-01f, -3.093724847e-01f, 9.786828160e-01f, 2.053775787e-01f, 4.829612970e-01f, -8.756417036e-01f, -8.390715122e-01f, -5.440210700e-01f, 7.901318669e-01f, -6.129369140e-01f, -9.997860789e-01f, -2.068333142e-02f, -2.059976310e-01f, 9.785524607e-01f, 5.403022766e-01f, 8.414710164e-01f, 8.460091352e-01f, 5.331684351e-01f, 9.504152536e-01f, 3.109835982e-01f, 9.842302203e-01f, 1.768921912e-01f, 9.950041771e-01f, 9.983342141e-02f, 9.984192848e-01f, 5.620449409e-02f, 9.995000362e-01f, 3.161750361e-02f, 9.998418689e-01f, 1.778185740e-02f,
8.920048475e-01f, 4.520258009e-01f, 9.694527388e-01f, 2.452782542e-01f, 8.662855029e-01f, 4.995492697e-01f, 6.302406788e-01f, -7.763997912e-01f, -7.805679440e-01f, -6.250709295e-01f, 8.233328462e-01f, -5.675588250e-01f, -9.986322522e-01f, -5.228384212e-02f, -2.233655602e-01f, 9.747347236e-01f, 5.318607092e-01f, 8.468318582e-01f, 8.429974914e-01f, 5.379174352e-01f, 9.494271278e-01f, 3.139874935e-01f, 9.839141369e-01f, 1.786421537e-01f, 9.949038625e-01f, 1.008283719e-01f, 9.983875155e-01f, 5.676594004e-02f, 9.994900227e-01f, 3.193357214e-02f, 9.998387098e-01f, 1.795965619e-02f,
1.015857086e-01f, 9.948267937e-01f, 6.893923283e-01f, 7.243881822e-01f, 6.679785848e-01f, 7.441805601e-01f, 7.576409578e-01f, -6.526715755e-01f, -7.142657638e-01f, -6.998745203e-01f, 8.539305925e-01f, -5.203868747e-01f, -9.964799285e-01f, -8.383183926e-02f, -2.406628430e-01f, 9.706087708e-01f, 5.233659744e-01f, 8.521080017e-01f, 8.399593234e-01f, 5.426494479e-01f, 9.484294653e-01f, 3.169882894e-01f, 9.835948944e-01f, 1.803915352e-01f, 9.948025346e-01f, 1.018232331e-01f, 9.983554482e-01f, 5.732736737e-02f, 9.994798303e-01f, 3.224964067e-02f, 9.998354912e-01f, 1.813745499e-02f,
-7.822308540e-01f, 6.229886413e-01f, 1.970090568e-01f, 9.804016948e-01f, 4.034298062e-01f, 9.150105715e-01f, 8.611455560e-01f, -5.083584189e-01f, -6.408262849e-01f, -7.676859498e-01f, 8.818289638e-01f, -4.715693891e-01f, -9.933311343e-01f, -1.152962446e-01f, -2.578840256e-01f, 9.661758542e-01f, 5.148188472e-01f, 8.572989702e-01f, 8.368944526e-01f, 5.473642945e-01f, 9.474223256e-01f, 3.199858963e-01f, 9.832725525e-01f, 1.821403503e-01f, 9.947001934e-01f, 1.028179824e-01f, 9.983230233e-01f, 5.788877234e-02f, 9.994695783e-01f, 3.256569803e-02f, 9.998322725e-01f, 1.831525378e-02f,
-9.468680024e-01f, -3.216224015e-01f, -3.560463190e-01f, 9.344683290e-01f, 9.887336940e-02f, 9.951000214e-01f, 9.374901056e-01f, -3.480119109e-01f, -5.609837770e-01f, -8.278267980e-01f, 9.069392681e-01f, -4.212614298e-01f, -9.891891479e-01f, -1.466451287e-01f, -2.750236690e-01f, 9.614374638e-01f, 5.062202811e-01f, 8.624042273e-01f, 8.338031769e-01f, 5.520617962e-01f, 9.464057088e-01f, 3.229803145e-01f, 9.829471111e-01f, 1.838885993e-01f, 9.945968986e-01f, 1.038126275e-01f, 9.982903004e-01f, 5.845016241e-02f, 9.994592667e-01f, 3.288175911e-02f, 9.998289943e-01f, 1.849305071e-02f,
-2.409590483e-01f, -9.705352783e-01f, -7.994487882e-01f, 6.007342339e-01f, -2.154882401e-01f, 9.765064120e-01f, 9.842666984e-01f, -1.766892821e-01f, -4.755369425e-01f, -8.796957731e-01f, 9.291825294e-01f, -3.696212471e-01f, -9.840580225e-01f, -1.778476238e-01f, -2.920763195e-01f, 9.563950300e-01f, 4.975710809e-01f, 8.674232364e-01f, 8.306855559e-01f, 5.567418337e-01f, 9.453796148e-01f, 3.259714842e-01f, 9.826185107e-01f, 1.856362671e-01f, 9.944925904e-01f, 1.048071757e-01f, 9.982572794e-01f, 5.901153386e-02f, 9.994487762e-01f, 3.319781274e-02f, 9.998256564e-01f, 1.867084950e-02f,
6.864865422e-01f, -7.271425128e-01f, -9.966333508e-01f, 8.198728412e-02f, -5.084800720e-01f, 8.610737324e-01f, 1.000000000e+00f, 2.060413535e-04f, -3.853378594e-01f, -9.227755666e-01f, 9.484879971e-01f, -3.168129921e-01f, -9.779430032e-01f, -2.088720351e-01f, -3.090365231e-01f, 9.510501623e-01f, 4.888721108e-01f, 8.723554611e-01f, 8.275416493e-01f, 5.614042878e-01f, 9.443440437e-01f, 3.289594054e-01f, 9.822868705e-01f, 1.873833388e-01f, 9.943872690e-01f, 1.058016121e-01f, 9.982239604e-01f, 5.957288295e-02f, 9.994382262e-01f, 3.351386636e-02f, 9.998223782e-01f, 1.884864643e-02f,
9.827795625e-01f, 1.847817302e-01f, -8.868746758e-01f, -4.620101154e-01f, -7.510490417e-01f, 6.602464318e-01f, 9.841938019e-01f, 1.770948619e-01f, -2.912894785e-01f, -9.566349387e-01f, 9.647951126e-01f, -2.630026639e-01f, -9.708499908e-01f, -2.396878302e-01f, -3.258991241e-01f, 9.454045296e-01f, 4.801242650e-01f, 8.772004843e-01f, 8.243715763e-01f, 5.660489798e-01f, 9.432991147e-01f, 3.319440186e-01f, 9.819520712e-01f, 1.891298145e-01f, 9.942809343e-01f, 1.067959517e-01f, 9.981902838e-01f, 6.013421714e-02f, 9.994276166e-01f, 3.382991254e-02f, 9.998189807e-01f, 1.902644150e-02f,
3.755095899e-01f, 9.268184900e-01f, -5.039728284e-01f, -8.637195230e-01f, -9.191339612e-01f, 3.939450979e-01f, 9.373466372e-01f, 3.483982384e-01f, -1.943297088e-01f, -9.809362888e-01f, 9.780520201e-01f, -2.083608955e-01f, -9.627863169e-01f, -2.702637315e-01f, -3.426586390e-01f, 9.394599795e-01f, 4.713284373e-01f, 8.819577694e-01f, 8.211753964e-01f, 5.706758499e-01f, 9.422446489e-01f, 3.349253237e-01f, 9.816142321e-01f, 1.908757091e-01f, 9.941736460e-01f, 1.077901721e-01f, 9.981563091e-01f, 6.069553271e-02f, 9.994168282e-01f, 3.414595872e-02f, 9.998155832e-01f, 1.920423657e-02f,
-5.770022273e-01f, 8.167425990e-01f, 3.414078429e-02f, -9.994170070e-01f, -9.960693717e-01f, 8.857665956e-02f, 8.609359860e-01f, 5.087132454e-01f, -9.542828053e-02f, -9.954363108e-01f, 9.882167578e-01f, -1.530608535e-01f, -9.537598491e-01f, -3.005696237e-01f, -3.593098223e-01f, 9.332183003e-01f, 4.624853432e-01f, 8.866268992e-01f, 8.179532886e-01f, 5.752846003e-01f, 9.411808252e-01f, 3.379032910e-01f, 9.812732339e-01f, 1.926209927e-01f, 9.940654039e-01f, 1.087842956e-01f, 9.981220365e-01f, 6.125682592e-02f, 9.994059801e-01f, 3.446200117e-02f, 9.998121262e-01f, 1.938203163e-02f,
-9.990208149e-01f, -4.424267635e-02f, 5.617429614e-01f, -8.273118138e-01f, -9.742255807e-01f, -2.255758345e-01f, 7.573719025e-01f, 6.529837251e-01f, 4.425697960e-03f, -9.999902248e-01f, 9.952573776e-01f, -9.727646410e-02f, -9.437798262e-01f, -3.305747509e-01f, -3.758473992e-01f, 9.266815782e-01f, 4.535961151e-01f, 8.912073374e-01f, 8.147053123e-01f, 5.798751712e-01f, 9.401075840e-01f, 3.408778608e-01f, 9.809291363e-01f, 1.943656504e-01f, 9.939560890e-01f, 1.097783074e-01f, 9.980874062e-01f, 6.181810424e-02f, 9.993950725e-01f, 3.477803990e-02f, 9.998086691e-01f, 1.955982484e-02f,
-5.025443435e-01f, -8.645514250e-01f, 9.163355827e-01f, -4.004111886e-01f, -8.557689190e-01f, -5.173581839e-01f, 6.299206614e-01f, 7.766594887e-01f, 1.042364091e-01f, -9.945525527e-01f, 9.991515279e-01f, -4.118499532e-02f, -9.328559637e-01f, -3.602495193e-01f, -3.922660947e-01f, 9.198517799e-01f, 4.446615279e-01f, 8.956986666e-01f, 8.114315867e-01f, 5.844473839e-01f, 9.390249252e-01f, 3.438490629e-01f, 9.805819392e-01f, 1.961097270e-01f, 9.938458204e-01f, 1.107722074e-01f, 9.980525374e-01f, 6.237935647e-02f, 9.993839860e-01f, 3.509407118e-02f, 9.998052120e-01f, 1.973761991e-02f,
4.559690952e-01f, -8.899955750e-01f, 9.887145162e-01f, 1.498119384e-01f, -6.524437070e-01f, -7.578372359e-01f, 4.826020896e-01f, 8.758397102e-01f, 2.030046880e-01f, -9.791777730e-01f, 9.998869300e-01f, 1.503714453e-02f, -9.209993482e-01f, -3.895640969e-01f, -4.085607529e-01f, 9.127311110e-01f, 4.356824458e-01f, 9.001004100e-01f, 8.081322312e-01f, 5.890011191e-01f, 9.379329085e-01f, 3.468167782e-01f, 9.802316427e-01f, 1.978531629e-01f, 9.937345386e-01f, 1.117659956e-01f, 9.980172515e-01f, 6.294059008e-02f, 9.993728399e-01f, 3.541010246e-02f, 9.998016953e-01f, 1.991541311e-02f,
9.952666163e-01f, -9.718190879e-02f, 7.565875053e-01f, 6.538924575e-01f, -3.844182491e-01f, -9.231590629e-01f, 3.200624883e-01f, 9.473964572e-01f, 2.997455299e-01f, -9.540191889e-01f, 9.974612594e-01f, 7.121126354e-02f, -9.082219005e-01f, -4.184889197e-01f, -4.247261286e-01f, 9.053218961e-01f, 4.266598225e-01f, 9.044122100e-01f, 8.048072457e-01f, 5.935363173e-01f, 9.368314743e-01f, 3.497810662e-01f, 9.798783064e-01f, 1.995959580e-01f, 9.936223030e-01f, 1.127596796e-01f, 9.979817271e-01f, 6.350180507e-02f, 9.993616343e-01f, 3.572613373e-02f, 9.997981191e-01f, 2.009320445e-02f,
6.195206046e-01f, 7.849804163e-01f, 2.914465666e-01f, 9.565871358e-01f, -7.827047259e-02f, -9.969321489e-01f, 1.474282593e-01f, 9.890727401e-01f, 3.934913874e-01f, -9.193283319e-01f, 9.918821454e-01f, 1.271607429e-01f, -8.945361972e-01f, -4.469954967e-01f, -4.407573938e-01f, 8.976262808e-01f, 4.175945222e-01f, 9.086334705e-01f, 8.014568090e-01f, 5.980526209e-01f, 9.357206821e-01f, 3.527418077e-01f, 9.795218110e-01f, 2.013381571e-01f, 9.935090542e-01f, 1.137532443e-01f, 9.979458451e-01f, 6.406301260e-02f, 9.993502498e-01f, 3.604215756e-02f, 9.997945428e-01f, 2.027099766e-02f,
-3.258098066e-01f, 9.454353452e-01f, -2.634541392e-01f, 9.646719098e-01f, 2.356393039e-01f, -9.718405604e-01f, -2.985579334e-02f, 9.995542169e-01f, 4.833047390e-01f, -8.754521608e-01f, 9.831672907e-01f, 1.827077270e-01f, -8.799561262e-01f, -4.750549197e-01f, -4.566490650e-01f, 8.896468878e-01f, 4.084874690e-01f, 9.127639532e-01f, 7.980811000e-01f, 6.025500894e-01f, 9.346005321e-01f, 3.556990325e-01f, 9.791622162e-01f, 2.030797005e-01f, 9.933947921e-01f, 1.147466898e-01f, 9.979096651e-01f, 6.462418288e-02f, 9.993388057e-01f, 3.635817394e-02f, 9.997909069e-01f, 2.044878900e-02f,
-9.715921879e-01f, 2.366613895e-01f, -7.372213602e-01f, 6.756513119e-01f, 5.261809826e-01f, -8.503726125e-01f, -2.061982006e-01f, 9.785102606e-01f, 5.682899356e-01f, -8.228283525e-01f, 9.713441133e-01f, 2.376775593e-01f, -8.644961119e-01f, -5.026394725e-01f, -4.723965526e-01f, 8.813861012e-01f, 3.993395865e-01f, 9.168030620e-01f, 7.946801186e-01f, 6.070284247e-01f, 9.334710836e-01f, 3.586527407e-01f, 9.787995219e-01f, 2.048205882e-01f, 9.932795167e-01f, 1.157400310e-01f, 9.978731871e-01f, 6.518533826e-02f, 9.993273020e-01f, 3.667419404e-02f, 9.997872710e-01f, 2.062657848e-02f,
-7.240971923e-01f, -6.896979213e-01f, -9.839316607e-01f, 1.785455495e-01f, 7.645443082e-01f, -6.445711255e-01f, -3.760372102e-01f, 9.266045690e-01f, 6.475961804e-01f, -7.619836926e-01f, 9.564502239e-01f, 2.918955386e-01f, -8.481717706e-01f, -5.297213197e-01f, -4.879944921e-01f, 8.728467226e-01f, 3.901517391e-01f, 9.207505584e-01f, 7.912539840e-01f, 6.114876866e-01f, 9.323322177e-01f, 3.616028130e-01f, 9.784337282e-01f, 2.065608501e-01f, 9.931632876e-01f, 1.167332530e-01f, 9.978363514e-01f, 6.574647129e-02f, 9.993156195e-01f, 3.699020669e-02f, 9.997835755e-01f, 2.080436796e-02f,
1.891294271e-01f, -9.819521904e-01f, -9.276105762e-01f, -3.735487163e-01f, 9.270853400e-01f, -3.748503029e-01f, -5.340162516e-01f, 8.454742432e-01f, 7.204326391e-01f, -6.935249567e-01f, 9.385324121e-01f, 3.451911509e-01f, -8.309991956e-01f, -5.562736392e-01f, -5.034382939e-01f, 8.640311956e-01f, 3.809248805e-01f, 9.246059656e-01f, 7.878028154e-01f, 6.159275174e-01f, 9.311841130e-01f, 3.645493090e-01f, 9.780648947e-01f, 2.083004564e-01f, 9.930460453e-01f, 1.177263632e-01f, 9.977992177e-01f, 6.630758941e-02f, 9.993038774e-01f, 3.730621934e-02f, 9.997798800e-01f, 2.098215744e-02f,
9.284713268e-01f, -3.714041114e-01f, -5.856038332e-01f, -8.105974197e-01f, 9.976883531e-01f, -6.795591116e-02f, -6.751540303e-01f, 7.376767993e-01f, 7.860706449e-01f, -6.181366444e-01f, 9.176476598e-01f, 3.973950148e-01f, -8.129957914e-01f, -5.822695494e-01f, -5.187226534e-01f, 8.549425602e-01f, 3.716599345e-01f, 9.283689260e-01f, 7.843267918e-01f, 6.203478575e-01f, 9.300266504e-01f, 3.674921393e-01f, 9.776929021e-01f, 2.100393921e-01f, 9.929278493e-01f, 1.187193394e-01f, 9.977617860e-01f, 6.686867774e-02f, 9.992920160e-01f, 3.762222081e-02f, 9.997761250e-01f, 2.115994506e-02f,
8.141809702e-01f, 5.806111693e-01f, -6.324278563e-02f, -9.979981780e-01f, 9.693515897e-01f, 2.456775755e-01f, -7.949962020e-01f, 6.066144109e-01f, 8.438539505e-01f, -5.365729332e-01f, 8.938615918e-01f, 4.483429790e-01f, -7.941793799e-01f, -6.076834202e-01f, -5.338430405e-01f, 8.455836177e-01f, 3.623578250e-01f, 9.320390821e-01f, 7.808259130e-01f, 6.247486472e-01f, 9.288598895e-01f, 3.704313040e-01f, 9.773178697e-01f, 2.117776722e-01f, 9.928086400e-01f, 1.197122112e-01f, 9.977239966e-01f, 6.742975861e-02f, 9.992800951e-01f, 3.793822229e-02f, 9.997723103e-01f, 2.133773454e-02f,
-4.866360873e-02f, 9.988152385e-01f, 4.786024988e-01f, -8.780316710e-01f, 8.448832631e-01f, 5.349507332e-01f, -8.897646070e-01f, 4.564197063e-01f, 8.932062984e-01f, -4.496471286e-01f, 8.672499061e-01f, 4.978730977e-01f, -7.745689750e-01f, -6.324894428e-01f, -5.487948060e-01f, 8.359571099e-01f, 3.530194759e-01f, 9.356159568e-01f, 7.773004174e-01f, 6.291296482e-01f, 9.276838303e-01f, 3.733667731e-01f, 9.769397378e-01f, 2.135152817e-01f, 9.926884174e-01f, 1.207049638e-01f, 9.976859689e-01f, 6.799080223e-02f, 9.992680550e-01f, 3.825422376e-02f, 9.997684956e-01f, 2.151552029e-02f,
-8.667671084e-01f, 4.987131655e-01f, 8.730400801e-01f, -4.876484275e-01f, 6.366297007e-01f, 7.711696625e-01f, -9.564702511e-01f, 2.918297648e-01f, 9.336335659e-01f, -3.582294583e-01f, 8.378961682e-01f, 5.458296537e-01f, -7.541838884e-01f, -6.566632986e-01f, -5.635727644e-01f, 8.260664344e-01f, 3.436457217e-01f, 9.390993714e-01f, 7.737502456e-01f, 6.334908009e-01f, 9.264984727e-01f, 3.762984574e-01f, 9.765585065e-01f, 2.152522057e-01f, 9.925672412e-01f, 1.216975898e-01f, 9.976475835e-01f, 6.855183095e-02f, 9.992558956e-01f, 3.857021779e-02f, 9.997646809e-01f, 2.169330604e-02f,
-8.879688978e-01f, -4.599034786e-01f, 9.985986948e-01f, 5.292089656e-02f, 3.652422130e-01f, 9.309124947e-01f, -9.930093288e-01f, 1.180356890e-01f, 9.647326469e-01f, -2.632316053e-01f, 8.058937788e-01f, 5.920601487e-01f, -7.330448627e-01f, -6.801803112e-01f, -5.781728029e-01f, 8.159143329e-01f, 3.342377245e-01f, 9.424887896e-01f, 7.701756358e-01f, 6.378318667e-01f, 9.253038764e-01f, 3.792264462e-01f, 9.761741757e-01f, 2.169884592e-01f, 9.924450517e-01f, 1.226900965e-01f, 9.976088405e-01f, 6.911283731e-02f, 9.992436171e-01f, 3.888620436e-02f, 9.997608066e-01f, 2.187109366e-02f,
-9.277620912e-02f, -9.956870079e-01f, 8.166087270e-01f, 5.771915913e-01f, 5.763408914e-02f, 9.983377457e-01f, -9.982294440e-01f, -5.948119611e-02f, 9.861924052e-01f, -1.656036228e-01f, 7.713432908e-01f, 6.364192963e-01f, -7.111726999e-01f, -7.030173540e-01f, -5.925897360e-01f, 8.055044413e-01f, 3.247962892e-01f, 9.457839727e-01f, 7.665767074e-01f, 6.421527267e-01f, 9.241000414e-01f, 3.821505904e-01f, 9.757867455e-01f, 2.187240422e-01f, 9.923218489e-01f, 1.236824766e-01f, 9.975697994e-01f, 6.967382133e-02f, 9.992312789e-01f, 3.920219466e-02f, 9.997568727e-01f, 2.204887755e-02f,
7.877145410e-01f, -6.160404682e-01f, 3.831194937e-01f, 9.236987829e-01f, -2.556895912e-01f, 9.667589068e-01f, -9.719658494e-01f, -2.351220697e-01f, 9.977982640e-01f, -6.632189453e-02f, 7.343545556e-01f, 6.787660718e-01f, -6.885895729e-01f, -7.251513004e-01f, -6.068195105e-01f, 7.948396206e-01f, 3.153223693e-01f, 9.489846230e-01f, 7.629535198e-01f, 6.464533210e-01f, 9.228869677e-01f, 3.850709498e-01f, 9.753962755e-01f, 2.204589099e-01f, 9.921976924e-01f, 1.246747300e-01f, 9.975304604e-01f, 7.023479044e-02f, 9.992188811e-01f, 3.951817751e-02f, 9.997529387e-01f, 2.222666144e-02f,
9.439841509e-01f, 3.299908042e-01f, -1.683704406e-01f, 9.857237935e-01f, -5.436599255e-01f, 8.393055797e-01f, -9.150469303e-01f, -4.033473432e-01f, 9.994345903e-01f, 3.362342715e-02f, 6.950438619e-01f, 7.189673185e-01f, -6.653177142e-01f, -7.465603352e-01f, -6.208572388e-01f, 7.839236856e-01f, 3.058169186e-01f, 9.520903230e-01f, 7.593061924e-01f, 6.507335305e-01f, 9.216646552e-01f, 3.879874349e-01f, 9.750027061e-01f, 2.221930772e-01f, 9.920725226e-01f, 1.256668717e-01f, 9.974908233e-01f, 7.079573721e-02f, 9.992063046e-01f, 3.983415663e-02f, 9.997490048e-01f, 2.240444534e-02f,
2.323590964e-01f, 9.726300836e-01f, -6.679986119e-01f, 7.441624999e-01f, -7.777124643e-01f, 6.286201477e-01f, -8.292679787e-01f, -5.588511825e-01f, 9.910848737e-01f, 1.332318485e-01f, 6.535362005e-01f, 7.568953037e-01f, -6.413808465e-01f, -7.672226429e-01f, -6.346988082e-01f, 7.727596164e-01f, 2.962808907e-01f, 9.551008344e-01f, 7.556348443e-01f, 6.549931169e-01f, 9.204331040e-01f, 3.909000754e-01f, 9.746060371e-01f, 2.239265591e-01f, 9.919463396e-01f, 1.266588867e-01f, 9.974508882e-01f, 7.135665417e-02f, 9.991936684e-01f, 4.015012830e-02f, 9.997450113e-01f, 2.258222736e-02f
};
namespace pg8 {
#define PG8_LAS __attribute__((address_space(3)))
typedef unsigned short bf16_t;
typedef short bf16x8 __attribute__((ext_vector_type(8)));
typedef float f32x4 __attribute__((ext_vector_type(4)));
typedef unsigned u32x4 __attribute__((ext_vector_type(4)));
constexpr int BM = 256, BK = 64, HALF = 128, HTB = HALF * BK * 2  , STAGE_BYTES = 8 * HTB, NXCD = 8, WGM = 8;

__host__ __device__ __forceinline__ int lds_byte(int r, int c) { const int st = (r >> 4) * 2 + (c >> 5), rr = r & 15, cc = c & 31, ob = rr * 64 + cc * 2; return st * 1024 + (ob ^ (((ob >> 9) & 1) << 5)); }
__host__ __device__ __forceinline__ void stage_rc(int b, int& R, int& C) { const int st = b / 1024, sb = b % 1024, swz = sb ^ (((sb >> 9) & 1) << 5); R = (st >> 1) * 16 + swz / 64; C = (st & 1) * 32 + (swz % 64) / 2; }
__host__ __device__ __forceinline__ int perm32(int rho) { const int n = rho >> 4, i = rho & 15; return 8 * (i >> 2) + 4 * n + (i & 3); }

struct Unit { int pm, pn; };
struct Gemm { const bf16_t* A; const bf16_t* Bt; int M, N, K; };

struct StaticOrder {
    int nM, nN, nwg, G, c;
    __host__ __device__ void init(int M, int N, int G_, int c_) { nM = M / BM; nN = N / BM; nwg = nM * nN; G = G_; c = c_; }
    __host__ __device__ bool next(int i, Unit& u) const {
        const long L = (long)i * G + c; if (L >= nwg) return false;
        int wgid = (int)L; { const int q = nwg / NXCD, r = nwg % NXCD, xcd = wgid % NXCD, off = wgid / NXCD; wgid = (xcd < r ? xcd * (q + 1) : r * (q + 1) + (xcd - r) * q) + off; }
        const int nig = WGM * nN, gid = wgid / nig, fm = gid * WGM, gsz = (nM - fm) < WGM ? (nM - fm) : WGM;
        u.pm = fm + ((wgid % nig) % gsz); u.pn = (wgid % nig) / gsz; return true;
    }
    __device__ __forceinline__ void a_ready(const Unit&) const {}
    __device__ __forceinline__ void done(const Unit&) const {}
};

__device__ __forceinline__ unsigned cvt_pk_bf16(float lo, float hi) { unsigned r; asm volatile("v_cvt_pk_bf16_f32 %0, %1, %2" : "=v"(r) : "v"(lo), "v"(hi)); return r; }
template <class Epi, class Sched, bool ALIGN_EPI = false, bool SP2 = false>
__device__ __forceinline__ void gemm_phase(PG8_LAS unsigned char* lds, const Gemm g, const Sched& S, const Epi& E) {
    int tid_ = threadIdx.x; asm volatile("" : "+v"(tid_));
    const int tid = tid_, wid = __builtin_amdgcn_readfirstlane(tid >> 6), lane = tid & 63, wr = wid >> 2, wc = wid & 3, fr = lane & 15, fq = lane >> 4;
    const int K = g.K, nt = K / BK;
    unsigned voffA[2], voffB[2];
#pragma unroll
    for (int i = 0; i < 2; ++i) { int R, C; stage_rc(tid * 16 + i * 8192, R, C); const int Rb = Epi::PERM ? ((R & ~31) + perm32(R & 31)) : R;
        voffA[i] = (unsigned)(R * K + C) * 2u; voffB[i] = (unsigned)(Rb * K + C) * 2u; }
    const size_t kstep = (size_t)(BK * 2);
    const size_t hstep = (size_t)HALF * K * 2;
    const size_t tstep = 2 * hstep;
    const unsigned ldsw = (unsigned)wid * 1024u;
    const int aoff = lds_byte(wr * 64 + fr, fq * 8), boff = lds_byte(wc * 32 + fr, fq * 8);
#define PG8_SA(b, h) (((b) * 2 + (h)) * HTB)
#define PG8_SB(b, h) ((4 + (b) * 2 + (h)) * HTB)
#define PG8_STAGE(bufoff, gbase, voff) do { _Pragma("unroll") for (int _i = 0; _i < 2; ++_i) \
        __builtin_amdgcn_global_load_lds((const unsigned*)((const char*)(gbase) + (voff)[_i]), (PG8_LAS unsigned*)(lds + (bufoff) + ldsw + _i * 8192), 16, 0, 0); } while (0)
#define PG8_LDA(dst, b, h) do { _Pragma("unroll") for (int m = 0; m < 4; ++m) _Pragma("unroll") for (int k = 0; k < 2; ++k) dst[m][k] = *(const PG8_LAS bf16x8*)(lds + PG8_SA(b, h) + aoff + m * 2048 + k * 1024); } while (0)
#define PG8_LDB(dst, b, h) do { _Pragma("unroll") for (int n = 0; n < 2; ++n) _Pragma("unroll") for (int k = 0; k < 2; ++k) dst[n][k] = *(const PG8_LAS bf16x8*)(lds + PG8_SB(b, h) + boff + n * 2048 + k * 1024); } while (0)
#define PG8_MMA(ai, bj, At, Bt) do { __builtin_amdgcn_s_setprio(1); _Pragma("unroll") for (int m = 0; m < 4; ++m) _Pragma("unroll") for (int n = 0; n < 2; ++n) _Pragma("unroll") for (int k = 0; k < 2; ++k) \
        acc[ai][bj][m][n] = __builtin_amdgcn_mfma_f32_16x16x32_bf16(Bt[n][k], At[m][k], acc[ai][bj][m][n], 0, 0, 0); __builtin_amdgcn_s_setprio(0); } while (0)
#define PG8_WAIT_V(n) asm volatile("s_waitcnt vmcnt(" #n ")" ::: "memory")
#define PG8_WAIT_L(n) asm volatile("s_waitcnt lgkmcnt(" #n ")" ::: "memory")
#define PG8_BAR __builtin_amdgcn_s_barrier()
#define PG8_SCHED __builtin_amdgcn_sched_barrier(0)
    Unit cur, nxt; int ui = 0;
    if (!S.next(0, cur)) return;
    f32x4 acc[2][2][4][2];
#pragma unroll
    for (int a = 0; a < 2; ++a)
#pragma unroll
        for (int b = 0; b < 2; ++b)
#pragma unroll
            for (int m = 0; m < 4; ++m)
#pragma unroll
                for (int n = 0; n < 2; ++n) acc[a][b][m][n] = (f32x4){0.f, 0.f, 0.f, 0.f};
    bf16x8 At[4][2], B0[2][2], B1[2][2];
    const char* cA = (const char*)g.A + (size_t)cur.pm * tstep; const char* cB = (const char*)g.Bt + (size_t)cur.pn * tstep;
    S.a_ready(cur);
    if constexpr (SP2) {
        PG8_STAGE(PG8_SB(0, 0), cB, voffB); PG8_STAGE(PG8_SB(0, 1), cB + hstep, voffB); PG8_STAGE(PG8_SA(0, 0), cA, voffA); PG8_STAGE(PG8_SA(0, 1), cA + hstep, voffA);
        if (wr == 1) PG8_BAR;
        PG8_WAIT_V(2); PG8_BAR;
        PG8_STAGE(PG8_SB(1, 0), cB + kstep, voffB); PG8_STAGE(PG8_SA(1, 0), cA + kstep, voffA); PG8_STAGE(PG8_SB(1, 1), cB + hstep + kstep, voffB);
        PG8_WAIT_V(6); PG8_BAR;
    } else {
        PG8_STAGE(PG8_SB(0, 0), cB, voffB); PG8_STAGE(PG8_SA(0, 0), cA, voffA); PG8_STAGE(PG8_SB(0, 1), cB + hstep, voffB); PG8_STAGE(PG8_SA(0, 1), cA + hstep, voffA);
        if (wr == 1) PG8_BAR;
        PG8_WAIT_V(4); PG8_BAR;
        PG8_STAGE(PG8_SB(1, 0), cB + kstep, voffB); PG8_STAGE(PG8_SA(1, 0), cA + kstep, voffA); PG8_STAGE(PG8_SB(1, 1), cB + hstep + kstep, voffB);
        PG8_WAIT_V(6); PG8_BAR;
    }
    for (;;) {
        const bool has_next = S.next(ui + 1, nxt);
        const char* nA = has_next ? (const char*)g.A + (size_t)nxt.pm * tstep : cA; const char* nB = has_next ? (const char*)g.Bt + (size_t)nxt.pn * tstep : cB;
        for (int t = 0; t < nt; t += 2) {
            const bool last = (t == nt - 2);
            const char* a1 = cA + (size_t)(t + 1) * kstep;
            const char* a2 = last ? nA : cA + (size_t)(t + 2) * kstep; const char* b2 = last ? nB : cB + (size_t)(t + 2) * kstep;
            const char* a3 = a2 + kstep; const char* b3 = b2 + kstep;
            if (last && has_next) S.a_ready(nxt);
            if constexpr (SP2) {
            PG8_LDB(B0, 0, 0); PG8_LDB(B1, 0, 1); PG8_SCHED; PG8_LDA(At, 0, 0); PG8_STAGE(PG8_SA(1, 1), a1 + hstep, voffA);
            PG8_WAIT_V(8); PG8_WAIT_L(0); PG8_BAR; PG8_MMA(0, 0, At, B0); PG8_MMA(0, 1, At, B1); PG8_BAR; PG8_SCHED;
            PG8_LDA(At, 0, 1); PG8_STAGE(PG8_SB(0, 0), b2, voffB); PG8_STAGE(PG8_SB(0, 1), b2 + hstep, voffB); PG8_STAGE(PG8_SA(0, 0), a2, voffA);
            PG8_WAIT_V(8); PG8_WAIT_L(0); PG8_BAR; PG8_MMA(1, 0, At, B0); PG8_MMA(1, 1, At, B1); PG8_BAR; PG8_SCHED;
            PG8_LDB(B0, 1, 0); PG8_LDB(B1, 1, 1); PG8_SCHED; PG8_LDA(At, 1, 0); PG8_STAGE(PG8_SA(0, 1), a2 + hstep, voffA);
            PG8_WAIT_V(8); PG8_WAIT_L(0); PG8_BAR; PG8_MMA(0, 0, At, B0); PG8_MMA(0, 1, At, B1); PG8_BAR; PG8_SCHED;
            PG8_LDA(At, 1, 1); PG8_STAGE(PG8_SB(1, 0), b3, voffB); PG8_STAGE(PG8_SB(1, 1), b3 + hstep, voffB); PG8_STAGE(PG8_SA(1, 0), a3, voffA);
            PG8_WAIT_V(8); PG8_WAIT_L(0); PG8_BAR; PG8_MMA(1, 0, At, B0); PG8_MMA(1, 1, At, B1); PG8_BAR; PG8_SCHED;
            } else {
            PG8_LDB(B0, 0, 0); PG8_SCHED; PG8_LDA(At, 0, 0); PG8_STAGE(PG8_SA(1, 1), a1 + hstep, voffA);
            PG8_WAIT_L(8); PG8_BAR; PG8_WAIT_L(0); PG8_MMA(0, 0, At, B0); PG8_BAR; PG8_SCHED;
            PG8_LDB(B1, 0, 1); PG8_STAGE(PG8_SB(0, 0), b2, voffB);
            PG8_BAR; PG8_WAIT_L(0); PG8_MMA(0, 1, At, B1); PG8_BAR;
            PG8_LDA(At, 0, 1); PG8_STAGE(PG8_SA(0, 0), a2, voffA);
            PG8_BAR; PG8_WAIT_L(0); PG8_MMA(1, 0, At, B0); PG8_BAR; PG8_SCHED;
            PG8_STAGE(PG8_SB(0, 1), b2 + hstep, voffB);
            PG8_WAIT_V(6); PG8_BAR; PG8_MMA(1, 1, At, B1); PG8_BAR;
            PG8_LDB(B0, 1, 0); PG8_SCHED; PG8_LDA(At, 1, 0); PG8_STAGE(PG8_SA(0, 1), a2 + hstep, voffA);
            PG8_WAIT_L(8); PG8_BAR; PG8_WAIT_L(0); PG8_MMA(0, 0, At, B0); PG8_BAR; PG8_SCHED;
            PG8_LDB(B1, 1, 1); PG8_STAGE(PG8_SB(1, 0), b3, voffB);
            PG8_BAR; PG8_WAIT_L(0); PG8_MMA(0, 1, At, B1); PG8_BAR;
            PG8_LDA(At, 1, 1); PG8_STAGE(PG8_SA(1, 0), a3, voffA);
            PG8_BAR; PG8_WAIT_L(0); PG8_MMA(1, 0, At, B0); PG8_BAR; PG8_SCHED;
            PG8_STAGE(PG8_SB(1, 1), b3 + hstep, voffB);
            PG8_WAIT_V(6); PG8_BAR; PG8_MMA(1, 1, At, B1); PG8_BAR;
            }
        }
        if constexpr (ALIGN_EPI) { if (wr == 0) PG8_BAR; }
        if constexpr (!Epi::AFTER_DRAIN) { E(acc, cur, wr, wc, fr, fq); S.done(cur); }
        if (!has_next) break;
#pragma unroll
        for (int a = 0; a < 2; ++a)
#pragma unroll
            for (int b = 0; b < 2; ++b)
#pragma unroll
                for (int m = 0; m < 4; ++m)
#pragma unroll
                    for (int n = 0; n < 2; ++n) acc[a][b][m][n] = (f32x4){0.f, 0.f, 0.f, 0.f};
        cur = nxt; cA = nA; cB = nB; ++ui;
        if constexpr (ALIGN_EPI) { if (wr == 1) PG8_BAR; }
    }
    PG8_WAIT_V(0);
    if constexpr (!ALIGN_EPI) { if (wr == 0) PG8_BAR; }
    PG8_BAR;
    if constexpr (Epi::AFTER_DRAIN) { E.fused(acc, cur, wr, wc, fr, fq, lds, wid, lane); S.done(cur); }
#undef PG8_SA
#undef PG8_SB
#undef PG8_STAGE
#undef PG8_LDA
#undef PG8_LDB
#undef PG8_MMA
#undef PG8_WAIT_V
#undef PG8_WAIT_L
#undef PG8_BAR
#undef PG8_SCHED
}
}

#define LAS __attribute__((address_space(3)))
typedef unsigned short bf16;
typedef unsigned u32x4 __attribute__((ext_vector_type(4)));
typedef unsigned u32x2 __attribute__((ext_vector_type(2)));
typedef float f32x4 __attribute__((ext_vector_type(4)));
typedef float f32x16 __attribute__((ext_vector_type(16)));
typedef short bf16x8 __attribute__((ext_vector_type(8)));
typedef short s16x4 __attribute__((ext_vector_type(4)));

constexpr int DM = 1024, NL = 16384, MT = 16896, SEQ = 8192;
constexpr int INC = 4352, FF = 2816, FF2 = 5632, DEPTH = 4;
constexpr float EPS = 1e-6f;
constexpr float LOG2E = 1.4426950408889634f;
constexpr float C2 = 0.125f * 1.4426950408889634f;
constexpr int NWAVES = 8, NTHREADS = 512;

constexpr size_t MiB = 1u << 20;
constexpr size_t WS_MODS = 1 * MiB;
constexpr size_t WS_WIN = 2 * MiB;
constexpr size_t WS_WPA = 11 * MiB, WS_WPB = 12 * MiB;
constexpr size_t WS_WO = 13 * MiB;
constexpr size_t WS_WFI = 15 * MiB;
constexpr size_t WS_WFO = 26 * MiB;
constexpr size_t WS_X = 32 * MiB;
constexpr size_t WS_H = 98 * MiB;
constexpr size_t SZ512 = (size_t)MT * 512 * 2, SZ128 = (size_t)MT * 128 * 2, SZ1024 = (size_t)MT * 1024 * 2;
constexpr size_t WS_NAQ = 131 * MiB, WS_NAK = WS_NAQ + SZ512, WS_NAV = WS_NAK + SZ512, WS_GQ = WS_NAV + SZ512, WS_GK = WS_GQ + SZ512, WS_GV = WS_GK + SZ128;
constexpr size_t WS_SA = WS_GV + SZ128, WS_SB = WS_SA + SZ1024, WS_YA = WS_SB + SZ1024, WS_YB = WS_YA + SZ512, WS_END = WS_YB + SZ512;
constexpr size_t WS_ACT = 131 * MiB;
static_assert(WS_ACT + (size_t)MT * FF * 2 <= WS_END, "act overlay");
static_assert(WS_WFO + (size_t)DM * FF * 2 <= WS_X && WS_WFI + (size_t)FF2 * DM * 2 <= WS_WFO && WS_WIN + (size_t)INC * DM * 2 <= WS_WPA, "weights map");

constexpr int RING_BYTES = 131072;
constexpr int LDS_BYTES = 147456;
constexpr int A_K = 0, A_V = 16384, A_WS = 32768, A_OST = 34816, A_RPB = 67584;

__device__ __forceinline__ unsigned f2bf(float f) { unsigned u = __builtin_bit_cast(unsigned, f); return (u + 0x7fffu + ((u >> 16) & 1u)) >> 16; }
__device__ __forceinline__ unsigned pk2(float lo, float hi) { return f2bf(lo) | (f2bf(hi) << 16); }
__device__ __forceinline__ float bflo(unsigned w) { return __builtin_bit_cast(float, w << 16); }
__device__ __forceinline__ float bfhi(unsigned w) { return __builtin_bit_cast(float, w & 0xffff0000u); }
__device__ __forceinline__ float wave_sum(float v) {
#pragma unroll
    for (int o = 1; o < 64; o <<= 1) v += __shfl_xor(v, o);
    return v;
}
__device__ __forceinline__ int launder(int v) { asm volatile("" : "+v"(v)); return v; }
__device__ __forceinline__ float sigmoidf_(float x) { return __builtin_amdgcn_rcpf(1.0f + __expf(-x)); }

using pg8::Unit; using pg8::cvt_pk_bf16;
typedef f32x4 Acc[2][2][4][2];

struct EpiIn {
    static constexpr bool PERM = true, AFTER_DRAIN = false;
    bf16 *NAQ, *NAK, *NAV, *GQ, *GK, *GV, *SA, *SB; const float* qgain; const float* kgain;
    __device__ __forceinline__ void operator()(const Acc& acc, const Unit& u, int wr, int wc, int fr, int fq) const {
        const int pm = u.pm, pn = u.pn;
        const int rbase = pm * 256 + wr * 64 + fr;
        const int kvd = pm < 32 ? 0 : (pm < 64 ? 256 : (pm == 64 ? -8192 : 0));
        if (pn < 6 || pn >= 9) {
            bf16* dst; int ld, colt, rowd = 0; float sc = 1.f; bool sig = false;
            if (pn < 2) { dst = NAQ; ld = 512; colt = pn * 256; sc = C2; }
            else if (pn < 4) { dst = NAK; ld = 512; colt = (pn - 2) * 256; rowd = kvd; }
            else if (pn < 6) { dst = NAV; ld = 512; colt = (pn - 4) * 256; rowd = kvd; }
            else if (pn < 13) { dst = SA; ld = 1024; colt = (pn - 9) * 256; sig = true; }
            else { dst = SB; ld = 1024; colt = (pn - 13) * 256; sig = true; }
            const int col0 = colt + wc * 32 + 8 * fq;
#pragma unroll
            for (int ai = 0; ai < 2; ++ai)
#pragma unroll
                for (int m = 0; m < 4; ++m) {
                    bf16* rowp = dst + (size_t)(rbase + ai * 128 + m * 16 + rowd) * ld + col0;
#pragma unroll
                    for (int bj = 0; bj < 2; ++bj) {
                        f32x4 v0 = acc[ai][bj][m][0], v1 = acc[ai][bj][m][1];
                        if (sig) {
#pragma unroll
                            for (int e = 0; e < 4; ++e) { v0[e] = sigmoidf_(v0[e]); v1[e] = sigmoidf_(v1[e]); }
                        } else { v0 = v0 * sc; v1 = v1 * sc; }
                        u32x4 w; w.x = cvt_pk_bf16(v0[0], v0[1]); w.y = cvt_pk_bf16(v0[2], v0[3]); w.z = cvt_pk_bf16(v1[0], v1[1]); w.w = cvt_pk_bf16(v1[2], v1[3]);
                        *(u32x4*)(rowp + bj * 128) = w;
                    }
                }
        } else {
            const int hidx = 4 * (pn - 6) + wc;
            const bool isv = hidx >= 10, isk = (hidx >= 8) && !isv;
            bf16* dst; int ld, hcol, rowd; float sc = 1.f;
            if (isv) { dst = GV; ld = 128; hcol = (hidx - 10) * 64; rowd = kvd; }
            else if (isk) { dst = GK; ld = 128; hcol = (hidx - 8) * 64; rowd = kvd; }
            else { dst = GQ; ld = 512; hcol = hidx * 64; rowd = 0; sc = C2; }
            const float* gain = isk ? kgain : qgain;
            f32x4 gv[2][2];
#pragma unroll
            for (int bj = 0; bj < 2; ++bj)
#pragma unroll
                for (int n = 0; n < 2; ++n) gv[bj][n] = *(const f32x4*)(gain + 32 * bj + 8 * fq + 4 * n);
            const bool latent = pm < 64;
#pragma unroll
            for (int ai = 0; ai < 2; ++ai)
#pragma unroll
                for (int m = 0; m < 4; ++m) {
                    const int row = rbase + ai * 128 + m * 16;
                    bf16* rowp = dst + (size_t)(row + rowd) * ld + hcol + 8 * fq;
                    if (isv) {
#pragma unroll
                        for (int bj = 0; bj < 2; ++bj) {
                            const f32x4 v0 = acc[ai][bj][m][0], v1 = acc[ai][bj][m][1];
                            u32x4 w; w.x = cvt_pk_bf16(v0[0], v0[1]); w.y = cvt_pk_bf16(v0[2], v0[3]); w.z = cvt_pk_bf16(v1[0], v1[1]); w.w = cvt_pk_bf16(v1[2], v1[3]);
                            *(u32x4*)(rowp + bj * 32) = w;
                        }
                    } else {
                        float ss = 0.f;
#pragma unroll
                        for (int bj = 0; bj < 2; ++bj)
#pragma unroll
                            for (int n = 0; n < 2; ++n) { const f32x4 x = acc[ai][bj][m][n]; ss += (x[0] * x[0] + x[1] * x[1]) + (x[2] * x[2] + x[3] * x[3]); }
                        ss += __shfl_xor(ss, 16); ss += __shfl_xor(ss, 32);
                        const float rinv = rsqrtf(ss * (1.0f / 64.0f) + EPS);
                        const int s = row & (SEQ - 1);
#pragma unroll
                        for (int bj = 0; bj < 2; ++bj) {
                            f32x4 v0 = acc[ai][bj][m][0] * rinv * gv[bj][0], v1 = acc[ai][bj][m][1] * rinv * gv[bj][1];
                            if (latent) {
                                const int pos = bj == 0 ? (s >> 6) : (s & 63);
                                const f32x4 t0 = *(const f32x4*)(ROPE_TAB + (pos * 16 + 4 * fq) * 2);
                                const f32x4 t1 = *(const f32x4*)(ROPE_TAB + (pos * 16 + 4 * fq) * 2 + 4);
                                f32x4 r0, r1;
                                r0[0] = v0[0] * t0[0] - v0[1] * t0[1]; r0[1] = v0[0] * t0[1] + v0[1] * t0[0];
                                r0[2] = v0[2] * t0[2] - v0[3] * t0[3]; r0[3] = v0[2] * t0[3] + v0[3] * t0[2];
                                r1[0] = v1[0] * t1[0] - v1[1] * t1[1]; r1[1] = v1[0] * t1[1] + v1[1] * t1[0];
                                r1[2] = v1[2] * t1[2] - v1[3] * t1[3]; r1[3] = v1[2] * t1[3] + v1[3] * t1[2];
                                v0 = r0; v1 = r1;
                            }
                            v0 = v0 * sc; v1 = v1 * sc;
                            u32x4 w; w.x = cvt_pk_bf16(v0[0], v0[1]); w.y = cvt_pk_bf16(v0[2], v0[3]); w.z = cvt_pk_bf16(v1[0], v1[1]); w.w = cvt_pk_bf16(v1[2], v1[3]);
                            *(u32x4*)(rowp + bj * 32) = w;
                        }
                    }
                }
        }
    }
};

struct EpiMerge {
    static constexpr bool PERM = true, AFTER_DRAIN = false;
    const bf16* S; bf16* O; int second;
    __device__ __forceinline__ void operator()(const Acc& acc, const Unit& u, int wr, int wc, int fr, int fq) const {
        const int rbase = u.pm * 256 + wr * 64 + fr, col0 = u.pn * 256 + wc * 32 + 8 * fq;
#pragma unroll
        for (int ai = 0; ai < 2; ++ai)
#pragma unroll
            for (int m = 0; m < 4; ++m)
#pragma unroll
                for (int bj = 0; bj < 2; ++bj) {
                    const size_t off = (size_t)(rbase + ai * 128 + m * 16) * 1024 + col0 + bj * 128;
                    const u32x4 b = *(const u32x4*)(S + off);
                    u32x4 p = {0u, 0u, 0u, 0u};
                    if (second) p = *(const u32x4*)(O + off);
                    const f32x4 v0 = acc[ai][bj][m][0], v1 = acc[ai][bj][m][1];
                    u32x4 w;
                    w.x = cvt_pk_bf16(bflo(p.x) + v0[0] * bflo(b.x), bfhi(p.x) + v0[1] * bfhi(b.x)); w.y = cvt_pk_bf16(bflo(p.y) + v0[2] * bflo(b.y), bfhi(p.y) + v0[3] * bfhi(b.y));
                    w.z = cvt_pk_bf16(bflo(p.z) + v1[0] * bflo(b.z), bfhi(p.z) + v1[1] * bfhi(b.z)); w.w = cvt_pk_bf16(bflo(p.w) + v1[2] * bflo(b.w), bfhi(p.w) + v1[3] * bfhi(b.w));
                    *(u32x4*)(O + off) = w;
                }
    }
};

struct EpiRes {
    static constexpr bool PERM = false, AFTER_DRAIN = false;
    float* X; const float* gate;
    __device__ __forceinline__ void operator()(const Acc& acc, const Unit& u, int wr, int wc, int fr, int fq) const {
        const int pm = u.pm, v = pm < 32 ? 0 : (pm < 64 ? 1 : 2);
        const int rbase = pm * 256 + wr * 64 + fr, col0 = u.pn * 256 + wc * 32 + 4 * fq;
        const float* g = gate + v * 6144 + col0;
        f32x4 gv[2][2];
#pragma unroll
        for (int bj = 0; bj < 2; ++bj)
#pragma unroll
            for (int n = 0; n < 2; ++n) gv[bj][n] = *(const f32x4*)(g + bj * 128 + 16 * n);
#pragma unroll
        for (int ai = 0; ai < 2; ++ai)
#pragma unroll
            for (int m = 0; m < 4; ++m) {
                float* rowp = X + (size_t)(rbase + ai * 128 + m * 16) * DM + col0;
#pragma unroll
                for (int bj = 0; bj < 2; ++bj)
#pragma unroll
                    for (int n = 0; n < 2; ++n) {
                        f32x4* p = (f32x4*)(rowp + bj * 128 + 16 * n);
                        *p = *p + gv[bj][n] * acc[ai][bj][m][n];
                    }
            }
    }
};

struct EpiSwiglu {
    static constexpr bool PERM = true, AFTER_DRAIN = false;
    bf16* O;
    __device__ __forceinline__ void operator()(const Acc& acc, const Unit& u, int wr, int wc, int fr, int fq) const {
        const int rbase = u.pm * 256 + wr * 64 + fr, col0 = u.pn * 128 + wc * 32 + 8 * fq;
#pragma unroll
        for (int ai = 0; ai < 2; ++ai)
#pragma unroll
            for (int m = 0; m < 4; ++m) {
                f32x4 r[2];
#pragma unroll
                for (int n = 0; n < 2; ++n) {
                    const f32x4 a = acc[ai][0][m][n], uu = acc[ai][1][m][n];
#pragma unroll
                    for (int e = 0; e < 4; ++e) r[n][e] = a[e] * sigmoidf_(a[e]) * uu[e];
                }
                u32x4 w; w.x = cvt_pk_bf16(r[0][0], r[0][1]); w.y = cvt_pk_bf16(r[0][2], r[0][3]); w.z = cvt_pk_bf16(r[1][0], r[1][1]); w.w = cvt_pk_bf16(r[1][2], r[1][3]);
                *(u32x4*)(O + (size_t)(rbase + ai * 128 + m * 16) * FF + col0) = w;
            }
    }
};

namespace att {
__device__ __forceinline__ int crow(int r, int hi) { return (r & 3) + 8 * (r >> 2) + 4 * hi; }
__device__ __forceinline__ void glds16(const void* gsrc, unsigned lds_dst) { unsigned keep;
    asm volatile("s_mov_b32 %0, m0\n\ts_mov_b32 m0, %2\n\ts_nop 0\n\tglobal_load_lds_dwordx4 %1, off\n\ts_mov_b32 m0, %0" : "=&s"(keep) : "v"(gsrc), "s"(lds_dst) : "memory"); }
typedef float f32x2_t __attribute__((ext_vector_type(2))); typedef __bf16 bf16x2_t __attribute__((ext_vector_type(2)));
__device__ __forceinline__ unsigned cvtpk_s(float lo, float hi) { f32x2_t v = {lo, hi}; bf16x2_t b = __builtin_convertvector(v, bf16x2_t); return __builtin_bit_cast(unsigned, b); }
__device__ __forceinline__ void qkt(f32x16& p0, f32x16& p1, const char* Kslot, const bf16x8* qr, int r32, int hi) {
    const char* kb = Kslot + hi * 1024 + r32 * 16; const f32x16 z = f32x16{};
#pragma unroll
    for (int d0 = 0; d0 < 4; ++d0) {
        const bf16x8 b0 = *reinterpret_cast<const bf16x8*>(kb + d0 * 2048);
        const bf16x8 b1 = *reinterpret_cast<const bf16x8*>(kb + d0 * 2048 + 512);
        if (d0 == 0) { p0 = __builtin_amdgcn_mfma_f32_32x32x16_bf16(b0, qr[0], z, 0, 0, 0); p1 = __builtin_amdgcn_mfma_f32_32x32x16_bf16(b1, qr[0], z, 0, 0, 0); }
        else { p0 = __builtin_amdgcn_mfma_f32_32x32x16_bf16(b0, qr[d0], p0, 0, 0, 0); p1 = __builtin_amdgcn_mfma_f32_32x32x16_bf16(b1, qr[d0], p1, 0, 0, 0); } }
}
__device__ __forceinline__ void pv(f32x16* o, int vb, bf16x8 pa0, bf16x8 pa1, bf16x8 pa2, bf16x8 pa3) {
#pragma unroll
    for (int d0 = 0; d0 < 2; ++d0) { s16x4 lo[4], hi[4];
#pragma unroll
        for (int ks = 0; ks < 4; ++ks) {
            asm volatile("ds_read_b64_tr_b16 %0,%1 offset:%c2" : "=&v"(lo[ks]) : "v"(vb), "i"(d0 * 4096 + ks * 1024) : "memory");
            asm volatile("ds_read_b64_tr_b16 %0,%1 offset:%c2" : "=&v"(hi[ks]) : "v"(vb), "i"(d0 * 4096 + ks * 1024 + 512) : "memory"); }
        asm volatile("s_waitcnt lgkmcnt(0)" ::: "memory"); __builtin_amdgcn_sched_barrier(0);
#define PK(k) (bf16x8){lo[k][0], lo[k][1], lo[k][2], lo[k][3], hi[k][0], hi[k][1], hi[k][2], hi[k][3]}
        o[d0] = __builtin_amdgcn_mfma_f32_32x32x16_bf16(pa0, PK(0), o[d0], 0, 0, 0);
        o[d0] = __builtin_amdgcn_mfma_f32_32x32x16_bf16(pa1, PK(1), o[d0], 0, 0, 0);
        o[d0] = __builtin_amdgcn_mfma_f32_32x32x16_bf16(pa2, PK(2), o[d0], 0, 0, 0);
        o[d0] = __builtin_amdgcn_mfma_f32_32x32x16_bf16(pa3, PK(3), o[d0], 0, 0, 0);
#undef PK
    }
}
__device__ __forceinline__ float rowmax(const f32x16& p0, const f32x16& p1) {
    float a = fmaxf(p0[0], p1[0]);
#pragma unroll
    for (int r = 1; r < 16; ++r) a = fmaxf(a, fmaxf(p0[r], p1[r]));
    auto rr = __builtin_amdgcn_permlane32_swap(__float_as_uint(a), __float_as_uint(a), false, false);
    return fmaxf(__uint_as_float(rr[0]), __uint_as_float(rr[1]));
}
#define WAIT_BAR0() asm volatile("s_waitcnt vmcnt(0) lgkmcnt(0)\n\ts_barrier" ::: "memory")

__device__ __forceinline__ void unit(const bf16* Qp, const bf16* Kp, const bf16* Vp, int KP, bf16* Op, int kr0, int nwin, int nt, bool na, int qgr0, const float* rpb_h, char* shm) {
    int tid_ = threadIdx.x; asm volatile("" : "+v"(tid_));
    const int tid = tid_, lane = tid & 63, r32 = lane & 31, hi = lane >> 5; const int wid = __builtin_amdgcn_readfirstlane(tid >> 6);
    const unsigned lds0 = (unsigned)(uintptr_t)shm;
    float* wsf = (float*)(shm + A_WS) + wid * 64;
    float* rpbL = (float*)(shm + A_RPB);
    if (na) { for (int i = tid; i < 465; i += NTHREADS) rpbL[i] = rpb_h[i] * LOG2E; }
    const bf16* Qw = Qp + (size_t)(wid * 32) * 512;
    bf16x8 qr[4];
#pragma unroll
    for (int d0 = 0; d0 < 4; ++d0) qr[d0] = *reinterpret_cast<const bf16x8*>(&Qw[(size_t)r32 * 512 + d0 * 16 + hi * 8]);
    const bf16* ksrc = Kp + (size_t)lane * KP + wid * 8;
    const bf16* vsrc = Vp + (size_t)(16 * (wid & 3) + (lane >> 2)) * KP + (wid >> 2) * 32 + (lane & 3) * 8;
    const unsigned kdst = lds0 + A_K + wid * 1024, vdst = lds0 + A_V + wid * 1024;
    const int vb0 = (int)(lds0 + A_V) + ((lane >> 4) & 1) * 32 + (lane & 3) * 8 + (4 * hi + ((lane & 15) >> 2)) * 64;
#define KROW(t) ((t) < nwin ? (kr0 + (t)) * 64 : 8192 + ((t) - nwin) * 64)
    float mrun = -1e30f, lrun = 0.f; f32x16 o[2]; o[0] = f32x16{}; o[1] = f32x16{};
    const int qgr = qgr0 + (wid >> 1), qc = (wid & 1) * 32 + r32;
    const int rs = min(max(qgr - 4, 0), 120), cs = min(max(qc - 8, 0), 48);
    { const size_t r = (size_t)KROW(0) * KP; glds16(ksrc + r, (unsigned)__builtin_amdgcn_readfirstlane(kdst)); glds16(vsrc + r, (unsigned)__builtin_amdgcn_readfirstlane(vdst)); }
    for (int t = 0; t < nt; ++t) {
        const int slot = (t & 1) * 8192;
        WAIT_BAR0();
        if (t + 1 < nt) { const size_t r = (size_t)KROW(t + 1) * KP; const int ns = ((t + 1) & 1) * 8192;
            glds16(ksrc + r, (unsigned)__builtin_amdgcn_readfirstlane(kdst + ns)); glds16(vsrc + r, (unsigned)__builtin_amdgcn_readfirstlane(vdst + ns)); }
        const bool win = na && (t < nwin);
        const int kr = kr0 + t;
        if (win && (kr < rs || kr >= rs + 8)) continue;
        f32x16 p0, p1;
        qkt(p0, p1, shm + A_K + slot, qr, r32, hi);
        if (win) {
            const int brow = (kr - qgr + 7) * 31 + 15 - qc;
#pragma unroll
            for (int r = 0; r < 16; ++r) {
                const int kc = crow(r, hi);
                { const bool ok = (kc >= cs) && (kc < cs + 16); const int idx = min(max(brow + kc, 0), 464); const float bv = rpbL[idx]; p0[r] = ok ? p0[r] + bv : -INFINITY; }
                { const int kc2 = kc + 32; const bool ok = (kc2 >= cs) && (kc2 < cs + 16); const int idx = min(max(brow + kc2, 0), 464); const float bv = rpbL[idx]; p1[r] = ok ? p1[r] + bv : -INFINITY; }
            }
        }
        const float rm = rowmax(p0, p1);
        const float mnew = fmaxf(mrun, rm);
        const float alpha = __builtin_amdgcn_exp2f(mrun - mnew);
        mrun = mnew;
        float ls = 0.f;
#pragma unroll
        for (int r = 0; r < 16; ++r) { p0[r] = __builtin_amdgcn_exp2f(p0[r] - mnew); p1[r] = __builtin_amdgcn_exp2f(p1[r] - mnew); ls += p0[r] + p1[r]; }
        lrun = lrun * alpha + ls;
        if (__any(alpha < 1.0f)) {
            if (hi == 0) wsf[r32] = alpha;
            asm volatile("s_waitcnt lgkmcnt(0)" ::: "memory");
#pragma unroll
            for (int d = 0; d < 2; ++d)
#pragma unroll
                for (int r = 0; r < 16; ++r) o[d][r] *= wsf[crow(r, hi)];
        }
        u32x4 pw0, pw1, pw2, pw3;
        pw0 = (u32x4){cvtpk_s(p0[0], p0[1]), cvtpk_s(p0[2], p0[3]), cvtpk_s(p0[4], p0[5]), cvtpk_s(p0[6], p0[7])};
        pw1 = (u32x4){cvtpk_s(p0[8], p0[9]), cvtpk_s(p0[10], p0[11]), cvtpk_s(p0[12], p0[13]), cvtpk_s(p0[14], p0[15])};
        pw2 = (u32x4){cvtpk_s(p1[0], p1[1]), cvtpk_s(p1[2], p1[3]), cvtpk_s(p1[4], p1[5]), cvtpk_s(p1[6], p1[7])};
        pw3 = (u32x4){cvtpk_s(p1[8], p1[9]), cvtpk_s(p1[10], p1[11]), cvtpk_s(p1[12], p1[13]), cvtpk_s(p1[14], p1[15])};
        pv(o, vb0 + slot, __builtin_bit_cast(bf16x8, pw0), __builtin_bit_cast(bf16x8, pw1), __builtin_bit_cast(bf16x8, pw2), __builtin_bit_cast(bf16x8, pw3));
    }
#undef KROW
    { auto rr = __builtin_amdgcn_permlane32_swap(__float_as_uint(lrun), __float_as_uint(lrun), false, false); lrun = __uint_as_float(rr[0]) + __uint_as_float(rr[1]); }
    if (hi == 0) wsf[32 + r32] = lrun;
    asm volatile("s_waitcnt lgkmcnt(0)" ::: "memory");
    float rli[16];
#pragma unroll
    for (int r = 0; r < 16; ++r) rli[r] = __builtin_amdgcn_rcpf(wsf[32 + crow(r, hi)]);
    bf16* Ow = Op + (size_t)(wid * 32) * 512;
    { bf16* stg = (bf16*)(shm + A_OST) + wid * 2048;
#pragma unroll
        for (int r = 0; r < 16; ++r) { const int orow = crow(r, hi);
#pragma unroll
            for (int d0 = 0; d0 < 2; ++d0) stg[orow * 64 + d0 * 32 + r32] = (bf16)f2bf(o[d0][r] * rli[r]); }
        asm volatile("s_waitcnt lgkmcnt(0)" ::: "memory");
#pragma unroll
        for (int i = 0; i < 4; ++i) { const int row = i * 8 + (lane >> 3), ch = lane & 7; const u32x4 v = *(const u32x4*)(stg + row * 64 + ch * 8); *(u32x4*)(Ow + (size_t)row * 512 + ch * 8) = v; } }
    asm volatile("s_waitcnt vmcnt(0) lgkmcnt(0)\n\ts_barrier" ::: "memory");
}
}

template <int MAP>
__device__ __forceinline__ void transpose_item(const float* W, int N, bf16* WT, int ldk, int koff, LAS float* scr, int item, int lane) {
    const int nblk = N / 32, kb = item / nblk, nb = item % nblk, k0 = 64 * kb, n0 = 32 * nb;
#pragma unroll 8
    for (int i = 0; i < 32; ++i) { const int kk = 2 * i + (lane >> 5); scr[kk * 33 + (lane & 31)] = W[(size_t)(k0 + kk) * N + n0 + (lane & 31)]; }
    asm volatile("s_waitcnt lgkmcnt(0)" ::: "memory");
    int r0 = n0;
    if (MAP == 1) { if (n0 >= 1536 && n0 < 2304) { const int tile = n0 >> 8, within = n0 & 255, hw = within >> 6, bj = (within & 63) >> 5; r0 = tile * 256 + 128 * bj + 32 * hw; } }
    if (MAP == 2) { if (n0 < FF) { r0 = (n0 >> 7) * 256 + (n0 & 127); } else { const int n1 = n0 - FF; r0 = (n1 >> 7) * 256 + 128 + (n1 & 127); } }
    const int c = lane & 7;
#pragma unroll
    for (int j = 0; j < 4; ++j) { const int n = (lane >> 3) + 8 * j; const LAS float* s = scr + (8 * c) * 33 + n;
        u32x4 o; o.x = pk2(s[0 * 33], s[1 * 33]); o.y = pk2(s[2 * 33], s[3 * 33]); o.z = pk2(s[4 * 33], s[5 * 33]); o.w = pk2(s[6 * 33], s[7 * 33]);
        *(u32x4*)(WT + (size_t)(r0 + n) * ldk + koff + k0 + 8 * c) = o; }
    asm volatile("s_waitcnt lgkmcnt(0)" ::: "memory");
}

struct Params {
    const float *x, *c, *ctx, *c_ctx, *w_mod, *b_mod, *norm1, *w_in, *na_rpb, *q_gain, *k_gain, *w_pa, *w_pb, *w_o, *norm2, *w_ffn_in, *w_ffn_out, *final_norm;
    float* out; unsigned char* ws;
};

__device__ __forceinline__ void phase_wconv(const Params& P, int l, unsigned char* ws, LAS unsigned char* lds, int gw, int NGW, int wave, int lane) {
    LAS float* scr = (LAS float*)(lds + wave * 16384);
    constexpr int I_IN = (DM / 64) * (INC / 32), I_PA = (512 / 64) * (DM / 32), I_O = (DM / 64) * (DM / 32), I_FI = (DM / 64) * (FF2 / 32), I_FO = (FF / 64) * (DM / 32);
    constexpr int NITEMS = I_IN + 2 * I_PA + I_O + I_FI + I_FO;
    for (int it = gw; it < NITEMS; it += NGW) {
        int r = it;
        if (r < I_IN) { transpose_item<1>(P.w_in + (size_t)l * DM * INC, INC, (bf16*)(ws + WS_WIN), DM, 0, scr, r, lane); continue; } r -= I_IN;
        if (r < I_PA) { transpose_item<0>(P.w_pa + (size_t)l * 512 * DM, DM, (bf16*)(ws + WS_WPA), 512, 0, scr, r, lane); continue; } r -= I_PA;
        if (r < I_PA) { transpose_item<0>(P.w_pb + (size_t)l * 512 * DM, DM, (bf16*)(ws + WS_WPB), 512, 0, scr, r, lane); continue; } r -= I_PA;
        if (r < I_O) { transpose_item<0>(P.w_o + (size_t)l * DM * DM, DM, (bf16*)(ws + WS_WO), DM, 0, scr, r, lane); continue; } r -= I_O;
        if (r < I_FI) { transpose_item<2>(P.w_ffn_in + (size_t)l * DM * FF2, FF2, (bf16*)(ws + WS_WFI), DM, 0, scr, r, lane); continue; } r -= I_FI;
        transpose_item<0>(P.w_ffn_out + (size_t)l * FF * DM, DM, (bf16*)(ws + WS_WFO), FF, 0, scr, r, lane);
    }
}

__device__ __forceinline__ void norm_row(const float* xrow, float* xcopy, const float* gamma, const float* sh, const float* sc, bf16* hrow, int lane) {
    const f32x4* xr = (const f32x4*)xrow + lane;
    f32x4 v[4]; float s = 0.f;
#pragma unroll
    for (int j = 0; j < 4; ++j) { v[j] = xr[64 * j]; s += (v[j].x * v[j].x + v[j].y * v[j].y) + (v[j].z * v[j].z + v[j].w * v[j].w); }
    const float r = rsqrtf(wave_sum(s) * (1.0f / DM) + EPS);
    if (xcopy) {
#pragma unroll
        for (int j = 0; j < 4; ++j) ((f32x4*)xcopy + lane)[64 * j] = v[j];
    }
    unsigned long long* o8 = (unsigned long long*)hrow + lane;
#pragma unroll
    for (int j = 0; j < 4; ++j) {
        const f32x4 g = ((const f32x4*)gamma + lane)[64 * j], a = ((const f32x4*)sc + lane)[64 * j], b = ((const f32x4*)sh + lane)[64 * j];
        const f32x4 y = (v[j] * r) * g * (a + 1.0f) + b;
        o8[64 * j] = (unsigned long long)pk2(y.x, y.y) | ((unsigned long long)pk2(y.z, y.w) << 32);
    }
}

__global__ void __launch_bounds__(NTHREADS, 2) mega_fwd(Params P) {
    extern __shared__ __attribute__((aligned(16))) unsigned char lds[];
    cg::grid_group grid = cg::this_grid();
    LAS unsigned char* ldsl = (LAS unsigned char*)lds;
    const int tid = threadIdx.x, lane = tid & 63, wave = __builtin_amdgcn_readfirstlane(tid >> 6);
    const int G = gridDim.x, bx = blockIdx.x;
    const int vcu = (G % 8 == 0) ? (bx % 8) * (G / 8) + bx / 8 : bx;
    const int gw = vcu * NWAVES + wave, NGW = G * NWAVES;
    unsigned char* ws = P.ws;
    float* MODS = (float*)(ws + WS_MODS);
    float* X = (float*)(ws + WS_X);
    bf16* H = (bf16*)(ws + WS_H);
    bf16 *NAQ = (bf16*)(ws + WS_NAQ), *NAK = (bf16*)(ws + WS_NAK), *NAV = (bf16*)(ws + WS_NAV), *GQ = (bf16*)(ws + WS_GQ), *GK = (bf16*)(ws + WS_GK), *GV = (bf16*)(ws + WS_GV);
    bf16 *SA = (bf16*)(ws + WS_SA), *SB = (bf16*)(ws + WS_SB), *YA = (bf16*)(ws + WS_YA), *YB = (bf16*)(ws + WS_YB), *ACT = (bf16*)(ws + WS_ACT);

    {
        float* sl = (float*)lds;
        f32x4* red = (f32x4*)(lds + 16384);
        for (int i = tid; i < 3072; i += NTHREADS) { const int v = i >> 10, k = i & 1023; const float xv = v < 2 ? P.c[v * 1024 + k] : P.c_ctx[k]; sl[i] = xv * sigmoidf_(xv); }
        __syncthreads();
        const int cgi = tid & 31, kc = tid >> 5;
        for (int item = bx; item < 192; item += G) {
            const int l = item / 48, jb = (item % 48) * 128;
            const float* w = P.w_mod + (size_t)l * DM * 6144 + jb + cgi * 4;
            f32x4 a0 = {0.f, 0.f, 0.f, 0.f}, a1 = a0, a2 = a0;
#pragma unroll 8
            for (int kk = 0; kk < 64; ++kk) { const int k = kc * 64 + kk; const f32x4 wv = *(const f32x4*)(w + (size_t)k * 6144);
                a0 = a0 + wv * sl[k]; a1 = a1 + wv * sl[1024 + k]; a2 = a2 + wv * sl[2048 + k]; }
            red[(kc * 3 + 0) * 32 + cgi] = a0; red[(kc * 3 + 1) * 32 + cgi] = a1; red[(kc * 3 + 2) * 32 + cgi] = a2;
            __syncthreads();
            if (tid < 384) { const int v = tid >> 7, cc = tid & 127; float s = 0.f;
#pragma unroll
                for (int q = 0; q < 16; ++q) s += ((const float*)&red[(q * 3 + v) * 32 + (cc >> 2)])[cc & 3];
                MODS[(size_t)(l * 3 + v) * 6144 + jb + cc] = s + P.b_mod[l * 6144 + jb + cc]; }
            __syncthreads();
        }
        __syncthreads();
        phase_wconv(P, 0, ws, ldsl, gw, NGW, wave, launder(lane));
    }
    grid.sync();

    for (int l = 0; l < DEPTH; ++l) {
        const bool last = (l == DEPTH - 1);
        const float* mods = MODS + (size_t)l * 3 * 6144;
        const int MG = last ? NL : MT;
        if (l > 0) phase_wconv(P, l, ws, ldsl, gw, NGW, wave, launder(lane));
        { const int ln = launder(lane);
        for (int row = gw; row < MT; row += NGW) {
            const int v = row < NL ? (row >> 13) : 2;
            const float* xr = (l == 0) ? (row < NL ? P.x + (size_t)row * DM : P.ctx + (size_t)(row - NL) * DM) : X + (size_t)row * DM;
            norm_row(xr, l == 0 ? X + (size_t)row * DM : nullptr, P.norm1 + l * DM, mods + v * 6144 + 0, mods + v * 6144 + 1024, H + (size_t)row * DM, ln);
        } }
        grid.sync();
        {
            pg8::Gemm g{H, (const bf16*)(ws + WS_WIN), MT, INC, DM}; pg8::StaticOrder S; S.init(MT, INC, G, bx);
            EpiIn E{NAQ, NAK, NAV, GQ, GK, GV, SA, SB, P.q_gain + l * 64, P.k_gain + l * 64};
            pg8::gemm_phase<EpiIn, pg8::StaticOrder, true, true>(ldsl, g, S, E);
        }
        grid.sync();
        {
            char* shm = (char*)lds;
            const int total = last ? 1024 : 1056;
            for (int idx = vcu; idx < total; idx += G) {
                const bf16 *Qp, *Kp, *Vp; bf16* Op; int KP, kr0 = 0, nwin = 0, nt = 4, qgr0 = 0; bool na = false; const float* rpbh = P.na_rpb;
                if (idx < 512) {
                    const int b = idx >> 8, hq = (idx >> 5) & 7, qb = idx & 31, kvh = hq >> 2;
                    Qp = GQ + (size_t)(b * SEQ + qb * 256) * 512 + hq * 64; Kp = GK + (size_t)(b * 8448) * 128 + kvh * 64; Vp = GV + (size_t)(b * 8448) * 128 + kvh * 64; KP = 128;
                    Op = YB + (size_t)(b * SEQ + qb * 256) * 512 + hq * 64; nwin = 128; nt = 132;
                } else if (idx < 1024) {
                    const int un = idx - 512, b = un >> 8, h = (un >> 5) & 7, R = un & 31;
                    kr0 = min(max(4 * R - 4, 0), 120); const int kr1 = min(max(4 * R - 1, 0), 120) + 7; nwin = kr1 - kr0 + 1; nt = nwin + 4; na = true; qgr0 = 4 * R;
                    Qp = NAQ + (size_t)(b * SEQ + R * 256) * 512 + h * 64; Kp = NAK + (size_t)(b * 8448) * 512 + h * 64; Vp = NAV + (size_t)(b * 8448) * 512 + h * 64; KP = 512;
                    Op = YA + (size_t)(b * SEQ + R * 256) * 512 + h * 64; rpbh = P.na_rpb + (size_t)(l * 8 + h) * 465;
                } else {
                    const int uc = idx - 1024, b = (uc >> 3) & 1, h = uc & 7;
                    if (uc < 16) { Qp = NAQ + (size_t)(NL + b * 256) * 512 + h * 64; Kp = NAK + (size_t)(b * 8448) * 512 + h * 64; Vp = NAV + (size_t)(b * 8448) * 512 + h * 64; KP = 512;
                        Op = YA + (size_t)(NL + b * 256) * 512 + h * 64; }
                    else { Qp = GQ + (size_t)(NL + b * 256) * 512 + h * 64; Kp = GK + (size_t)(b * 8448) * 128 + (h >> 2) * 64; Vp = GV + (size_t)(b * 8448) * 128 + (h >> 2) * 64; KP = 128;
                        Op = YB + (size_t)(NL + b * 256) * 512 + h * 64; }
                }
                att::unit(Qp, Kp, Vp, KP, Op, kr0, nwin, nt, na, qgr0, rpbh, shm);
            }
        }
        grid.sync();
        for (int pass = 0; pass < 2; ++pass) {
            pg8::Gemm g{pass ? YB : YA, (const bf16*)(ws + (pass ? WS_WPB : WS_WPA)), MG, DM, 512}; pg8::StaticOrder S; S.init(MG, DM, G, bx);
            EpiMerge E{pass ? SB : SA, H, pass};
            pg8::gemm_phase<EpiMerge, pg8::StaticOrder, true, true>(ldsl, g, S, E);
        }
        grid.sync();
        {
            pg8::Gemm g{H, (const bf16*)(ws + WS_WO), MG, DM, DM}; pg8::StaticOrder S; S.init(MG, DM, G, bx);
            EpiRes E{X, mods + 2048};
            pg8::gemm_phase<EpiRes, pg8::StaticOrder, true, true>(ldsl, g, S, E);
        }
        grid.sync();
        { const int ln = launder(lane);
        for (int row = gw; row < MG; row += NGW) {
            const int v = row < NL ? (row >> 13) : 2;
            norm_row(X + (size_t)row * DM, nullptr, P.norm2 + l * DM, mods + v * 6144 + 3072, mods + v * 6144 + 4096, H + (size_t)row * DM, ln);
        } }
        grid.sync();
        {
            pg8::Gemm g{H, (const bf16*)(ws + WS_WFI), MG, FF2, DM}; pg8::StaticOrder S; S.init(MG, FF2, G, bx);
            EpiSwiglu E{ACT};
            pg8::gemm_phase<EpiSwiglu, pg8::StaticOrder, true, true>(ldsl, g, S, E);
        }
        grid.sync();
        {
            pg8::Gemm g{ACT, (const bf16*)(ws + WS_WFO), MG, DM, FF}; pg8::StaticOrder S; S.init(MG, DM, G, bx);
            EpiRes E{X, mods + 5120};
            pg8::gemm_phase<EpiRes, pg8::StaticOrder, true, true>(ldsl, g, S, E);
        }
        grid.sync();
    }
    for (int row = gw; row < NL; row += NGW) {
        const f32x4* xr = (const f32x4*)(X + (size_t)row * DM) + lane;
        f32x4 v[4]; float s = 0.f;
#pragma unroll
        for (int j = 0; j < 4; ++j) { v[j] = xr[64 * j]; s += (v[j].x * v[j].x + v[j].y * v[j].y) + (v[j].z * v[j].z + v[j].w * v[j].w); }
        const float r = rsqrtf(wave_sum(s) * (1.0f / DM) + EPS);
        f32x4* o = (f32x4*)(P.out + (size_t)row * DM) + lane;
#pragma unroll
        for (int j = 0; j < 4; ++j) o[64 * j] = (v[j] * r) * ((const f32x4*)P.final_norm + lane)[64 * j];
    }
}

extern "C" void kernel_launch(void* const* d_in, const int* in_sizes, int n_in, void* d_out, int out_size, void* d_ws, size_t ws_size, hipStream_t stream) {
    static int grid = 0;
    if (grid == 0) {
        if (n_in != 18 || ws_size < WS_END) { fprintf(stderr, "kernel_launch: need 18 inputs and >= %zu bytes of workspace; got n_in %d ws %zu\n", (size_t)WS_END, n_in, ws_size); grid = -1; return; }
        int dev = 0, cus = 0, per_cu = 0;
        hipGetDevice(&dev);
        hipDeviceGetAttribute(&cus, hipDeviceAttributeMultiprocessorCount, dev);
        if (hipFuncSetAttribute((const void*)mega_fwd, hipFuncAttributeMaxDynamicSharedMemorySize, LDS_BYTES) != hipSuccess) { fprintf(stderr, "kernel_launch: hipFuncSetAttribute failed\n"); grid = -1; return; }
        if (hipOccupancyMaxActiveBlocksPerMultiprocessor(&per_cu, (const void*)mega_fwd, NTHREADS, LDS_BYTES) != hipSuccess || per_cu < 1) { fprintf(stderr, "kernel_launch: occupancy query says %d\n", per_cu); per_cu = 1; }
        (void)hipGetLastError();
        grid = cus * (per_cu > 1 ? 1 : per_cu);
    }
    if (grid < 0) return;
    Params p{};
    const float** pp = (const float**)&p;
    for (int i = 0; i < 18; ++i) pp[i] = (const float*)d_in[i];
    p.out = (float*)d_out; p.ws = (unsigned char*)d_ws;
    void* args[] = {&p};
    hipError_t e = hipLaunchCooperativeKernel((const void*)mega_fwd, dim3(grid), dim3(NTHREADS), args, LDS_BYTES, stream);
    if (e != hipSuccess) fprintf(stderr, "cooperative launch failed: %s (grid %d)\n", hipGetErrorString(e), grid);
}
```

```cpp
#include <hip/hip_runtime.h>
#include <hip/hip_cooperative_groups.h>
#include <cstdio>
#include <cstdint>
#include <hip/hip_bf16.h>
#include <cmath>
namespace cg = cooperative_groups;
__device__ const float ROPE_TAB[128*16*2] = {
1.000000000e+00f, 0.000000000e+00f, 1.000000000e+00f, 0.000000000e+00f, 1.000000000e+00f, 0.000000000e+00f, 1.000000000e+00f, 0.000000000e+00f, 1.000000000e+00f, 0.000000000e+00f, 1.000000000e+00f, 0.000000000e+00f, 1.000000000e+00f, 0.000000000e+00f, 1.000000000e+00f, 0.000000000e+00f, 1.000000000e+00f, 0.000000000e+00f, 1.000000000e+00f, 0.000000000e+00f, 1.000000000e+00f, 0.000000000e+00f, 1.000000000e+00f, 0.000000000e+00f, 1.000000000e+00f, 0.000000000e+00f, 1.000000000e+00f, 0.000000000e+00f, 1.000000000e+00f, 0.000000000e+00f, 1.000000000e+00f, 0.000000000e+00f,
5.403022766e-01f, 8.414710164e-01f, 8.460091352e-01f, 5.331684351e-01f, 9.504152536e-01f, 3.109835982e-01f, 9.842302203e-01f, 1.768921912e-01f, 9.950041771e-01f, 9.983342141e-02f, 9.984192848e-01f, 5.620449781e-02f, 9.995000362e-01f, 3.161750361e-02f, 9.998418689e-01f, 1.778185740e-02f, 9.999499917e-01f, 9.999833070e-03f, 9.999842048e-01f, 5.623383448e-03f, 9.999949932e-01f, 3.162272274e-03f, 9.999983907e-01f, 1.778278500e-03f, 9.999995232e-01f, 9.999999311e-04f, 9.999998212e-01f, 5.623412435e-04f, 9.999999404e-01f, 3.162277571e-04f, 1.000000000e+00f, 1.778279402e-04f,
-4.161468148e-01f, 9.092974067e-01f, 4.314628243e-01f, 9.021307230e-01f, 8.065783978e-01f, 5.911270976e-01f, 9.374182820e-01f, 3.482052684e-01f, 9.800665975e-01f, 1.986693293e-01f, 9.936820865e-01f, 1.122313142e-01f, 9.980006814e-01f, 6.320339441e-02f, 9.993675947e-01f, 3.555808961e-02f, 9.998000264e-01f, 1.999866590e-02f, 9.999367595e-01f, 1.124658901e-02f, 9.999799728e-01f, 6.324512884e-03f, 9.999936819e-01f, 3.556551412e-03f, 9.999979734e-01f, 1.999998698e-03f, 9.999993443e-01f, 1.124682371e-03f, 9.999998212e-01f, 6.324554561e-04f, 9.999999404e-01f, 3.556558804e-04f,
-9.899924994e-01f, 1.411200017e-01f, -1.159661636e-01f, 9.932531714e-01f, 5.827535987e-01f, 8.126488924e-01f, 8.610406518e-01f, 5.085361004e-01f, 9.553365111e-01f, 2.955202162e-01f, 9.858034849e-01f, 1.679033041e-01f, 9.955033660e-01f, 9.472608566e-02f, 9.985772967e-01f, 5.332308263e-02f, 9.995500445e-01f, 2.999549918e-02f, 9.998577237e-01f, 1.686943881e-02f, 9.999549985e-01f, 9.486690164e-03f, 9.999857545e-01f, 5.334813148e-03f, 9.999955297e-01f, 2.999995602e-03f, 9.999985695e-01f, 1.687023090e-03f, 9.999995232e-01f, 9.486831259e-04f, 9.999998808e-01f, 5.334838061e-04f,
-6.536436081e-01f, -7.568024993e-01f, -6.276797056e-01f, 7.784717083e-01f, 3.011374772e-01f, 9.535807371e-01f, 7.575061917e-01f, 6.528279781e-01f, 9.210609794e-01f, 3.894183338e-01f, 9.748082757e-01f, 2.230444849e-01f, 9.920106530e-01f, 1.261540651e-01f, 9.974712729e-01f, 7.107120752e-02f, 9.992001057e-01f, 3.998933360e-02f, 9.997470379e-01f, 2.249175683e-02f, 9.999200106e-01f, 1.264877338e-02f, 9.999747276e-01f, 7.113057654e-03f, 9.999920130e-01f, 3.999989480e-03f, 9.999974966e-01f, 2.249363344e-03f, 9.999992251e-01f, 1.264910679e-03f, 9.999997616e-01f, 7.113117026e-04f,
2.836621702e-01f, -9.589242935e-01f, -9.460792542e-01f, 3.239352703e-01f, -1.034233812e-02f, 9.999465346e-01f, 6.300802827e-01f, 7.765299678e-01f, 8.775825500e-01f, 4.794255495e-01f, 9.607312679e-01f, 2.774805427e-01f, 9.875259995e-01f, 1.574558765e-01f, 9.960497618e-01f, 8.879686147e-02f, 9.987502694e-01f, 4.997916520e-02f, 9.996047616e-01f, 2.811336145e-02f, 9.998750091e-01f, 1.581072807e-02f, 9.999604821e-01f, 8.891279809e-03f, 9.999874830e-01f, 4.999979399e-03f, 9.999960661e-01f, 2.811702900e-03f, 9.999987483e-01f, 1.581138116e-03f, 9.999995828e-01f, 8.891395992e-04f,
9.601702690e-01f, -2.794154882e-01f, -9.731037021e-01f, -2.303675264e-01f, -3.207963705e-01f, 9.471482038e-01f, 4.827820063e-01f, 8.757405281e-01f, 8.253356218e-01f, 5.646424890e-01f, 9.436169863e-01f, 3.310393095e-01f, 9.820539355e-01f, 1.886002719e-01f, 9.943132997e-01f, 1.064944416e-01f, 9.982005358e-01f, 5.996400490e-02f, 9.994308352e-01f, 3.373407945e-02f, 9.998199940e-01f, 1.897252724e-02f, 9.999430776e-01f, 1.066947449e-02f, 9.999819994e-01f, 5.999964196e-03f, 9.999943376e-01f, 3.374041524e-03f, 9.999982119e-01f, 1.897365320e-03f, 9.999994040e-01f, 1.066967379e-03f,
7.539022565e-01f, 6.569865942e-01f, -7.004297972e-01f, -7.137212753e-01f, -5.994374752e-01f, 8.004215956e-01f, 3.202570081e-01f, 9.473307133e-01f, 7.648422122e-01f, 6.442176700e-01f, 9.235194325e-01f, 3.835515678e-01f, 9.755998850e-01f, 2.195560932e-01f, 9.922624230e-01f, 1.241583377e-01f, 9.975510240e-01f, 6.994284689e-02f, 9.992253184e-01f, 3.935372457e-02f, 9.997550249e-01f, 2.213413455e-02f, 9.999225140e-01f, 1.244763471e-02f, 9.999755025e-01f, 6.999942940e-03f, 9.999922514e-01f, 3.936378751e-03f, 9.999975562e-01f, 2.213592408e-03f, 9.999992251e-01f, 1.244795276e-03f,
-1.455000341e-01f, 9.893582463e-01f, -2.120364457e-01f, -9.772617817e-01f, -8.186324239e-01f, 5.743178129e-01f, 1.476312131e-01f, 9.890424609e-01f, 6.967067122e-01f, 7.173560858e-01f, 9.005023241e-01f, 4.348512292e-01f, 9.681702852e-01f, 2.502923310e-01f, 9.898977876e-01f, 1.417829692e-01f, 9.968017340e-01f, 7.991468906e-02f, 9.989882708e-01f, 4.497213289e-02f, 9.996800423e-01f, 2.529552206e-02f, 9.998987913e-01f, 1.422575582e-02f, 9.999679923e-01f, 7.999914698e-03f, 9.999898672e-01f, 4.498715047e-03f, 9.999967813e-01f, 2.529819263e-03f, 9.999989867e-01f, 1.422623056e-03f,
-9.111302495e-01f, 4.121184647e-01f, 3.416602314e-01f, -9.398235083e-01f, -9.566441774e-01f, 2.912592292e-01f, -2.965079620e-02f, 9.995602965e-01f, 6.216099262e-01f, 7.833269238e-01f, 8.746382594e-01f, 4.847761393e-01f, 9.597726464e-01f, 2.807783186e-01f, 9.872201085e-01f, 1.593627781e-01f, 9.959527254e-01f, 8.987854421e-02f, 9.987195730e-01f, 5.058911815e-02f, 9.995950460e-01f, 2.845665626e-02f, 9.998719096e-01f, 1.600383036e-02f, 9.999595284e-01f, 8.999879472e-03f, 9.999871850e-01f, 5.061050411e-03f, 9.999959469e-01f, 2.846045885e-03f, 9.999987483e-01f, 1.600450720e-03f,
-8.390715122e-01f, -5.440210700e-01f, 7.901318669e-01f, -6.129369140e-01f, -9.997860789e-01f, -2.068356983e-02f, -2.059976310e-01f, 9.785524607e-01f, 5.403022766e-01f, 8.414710164e-01f, 8.460091352e-01f, 5.331684351e-01f, 9.504153132e-01f, 3.109835684e-01f, 9.842302203e-01f, 1.768921912e-01f, 9.950041771e-01f, 9.983341396e-02f, 9.984192848e-01f, 5.620449781e-02f, 9.995000362e-01f, 3.161750361e-02f, 9.998418689e-01f, 1.778185740e-02f, 9.999499917e-01f, 9.999834001e-03f, 9.999842048e-01f, 5.623383448e-03f, 9.999949932e-01f, 3.162272274e-03f, 9.999983907e-01f, 1.778278500e-03f,
4.425697960e-03f, -9.999902248e-01f, 9.952573776e-01f, -9.727646410e-02f, -9.437797070e-01f, -3.305749595e-01f, -3.758473992e-01f, 9.266815782e-01f, 4.535961151e-01f, 8.912073374e-01f, 8.147053123e-01f, 5.798751712e-01f, 9.401075840e-01f, 3.408778608e-01f, 9.809291363e-01f, 1.943656504e-01f, 9.939560890e-01f, 1.097782999e-01f, 9.980874062e-01f, 6.181810424e-02f, 9.993950725e-01f, 3.477803990e-02f, 9.998086691e-01f, 1.955982670e-02f, 9.999395013e-01f, 1.099977922e-02f, 9.999808669e-01f, 6.185714621e-03f, 9.999939203e-01f, 3.478498431e-03f, 9.999980927e-01f, 1.956106164e-03f,
8.438539505e-01f, -5.365729332e-01f, 8.938615918e-01f, 4.483429790e-01f, -7.941793799e-01f, -6.076834202e-01f, -5.338430405e-01f, 8.455836177e-01f, 3.623577356e-01f, 9.320390821e-01f, 7.808259130e-01f, 6.247486472e-01f, 9.288598895e-01f, 3.704312742e-01f, 9.773178697e-01f, 2.117776722e-01f, 9.928086400e-01f, 1.197122037e-01f, 9.977239966e-01f, 6.742975861e-02f, 9.992800951e-01f, 3.793822229e-02f, 9.997723103e-01f, 2.133773454e-02f, 9.999279976e-01f, 1.199971233e-02f, 9.999772310e-01f, 6.748044398e-03f, 9.999927878e-01f, 3.794723889e-03f, 9.999977350e-01f, 2.133933594e-03f,
9.074468017e-01f, 4.201670587e-01f, 5.171728134e-01f, 8.558809757e-01f, -5.658205152e-01f, -8.245284557e-01f, -6.750016809e-01f, 7.378162146e-01f, 2.674987614e-01f, 9.635581970e-01f, 7.444779873e-01f, 6.676470041e-01f, 9.166833758e-01f, 3.996143043e-01f, 9.733975530e-01f, 2.291227132e-01f, 9.915618896e-01f, 1.296341419e-01f, 9.973290563e-01f, 7.303927839e-02f, 9.991551042e-01f, 4.109803215e-02f, 9.997327924e-01f, 2.311557345e-02f, 9.999154806e-01f, 1.299963426e-02f, 9.999732971e-01f, 7.310371846e-03f, 9.999915361e-01f, 4.110949114e-03f, 9.999973178e-01f, 2.311761025e-03f,
1.367372274e-01f, 9.906073809e-01f, -1.879615150e-02f, 9.998233318e-01f, -2.813494802e-01f, -9.596053958e-01f, -7.948708534e-01f, 6.067786217e-01f, 1.699671596e-01f, 9.854497313e-01f, 7.057763338e-01f, 7.084347010e-01f, 9.035902619e-01f, 4.283977747e-01f, 9.691694379e-01f, 2.463953048e-01f, 9.902160168e-01f, 1.395431161e-01f, 9.969025850e-01f, 7.864648104e-02f, 9.990201592e-01f, 4.425742477e-02f, 9.996901155e-01f, 2.489333972e-02f, 9.999020100e-01f, 1.399954315e-02f, 9.999690056e-01f, 7.872696966e-03f, 9.999902248e-01f, 4.427174106e-03f, 9.999969006e-01f, 2.489588689e-03f,
-7.596879005e-01f, 6.502878666e-01f, -5.489754677e-01f, 8.358384371e-01f, 3.102234937e-02f, -9.995186925e-01f, -8.896704316e-01f, 4.566032588e-01f, 7.073719800e-02f, 9.974949956e-01f, 6.648434997e-01f, 7.469826937e-01f, 8.895936012e-01f, 4.567528665e-01f, 9.646348357e-01f, 2.635899782e-01f, 9.887710810e-01f, 1.494381279e-01f, 9.964445233e-01f, 8.425120264e-02f, 9.988752007e-01f, 4.741638154e-02f, 9.996442795e-01f, 2.667102963e-02f, 9.998875260e-01f, 1.499943808e-02f, 9.999644160e-01f, 8.435020223e-03f, 9.999887347e-01f, 4.743398633e-03f, 9.999964237e-01f, 2.667415887e-03f,
-9.576594830e-01f, -2.879033387e-01f, -9.100810885e-01f, 4.144302309e-01f, 3.403181434e-01f, -9.403103590e-01f, -9.564100504e-01f, 2.920270860e-01f, -2.919954434e-02f, 9.995735884e-01f, 6.218088269e-01f, 7.831690907e-01f, 8.747074604e-01f, 4.846512377e-01f, 9.597951770e-01f, 2.807013094e-01f, 9.872272611e-01f, 1.593182087e-01f, 9.959549904e-01f, 8.985326439e-02f, 9.987202883e-01f, 5.057485774e-02f, 9.995952845e-01f, 2.844863199e-02f, 9.998720288e-01f, 1.599931903e-02f, 9.999595284e-01f, 8.997339755e-03f, 9.999871850e-01f, 5.059622694e-03f, 9.999959469e-01f, 2.845243318e-03f,
-2.751633525e-01f, -9.613974690e-01f, -9.908979535e-01f, -1.346151382e-01f, 6.158647537e-01f, -7.878518701e-01f, -9.929850101e-01f, 1.182405204e-01f, -1.288445443e-01f, 9.916648269e-01f, 5.768082738e-01f, 8.168795705e-01f, 8.589466810e-01f, 5.120649934e-01f, 9.546520114e-01f, 2.977238595e-01f, 9.855847955e-01f, 1.691823453e-01f, 9.954339862e-01f, 9.545248002e-02f, 9.985553622e-01f, 5.373282731e-02f, 9.995430708e-01f, 3.022614494e-02f, 9.998555183e-01f, 1.699918136e-02f, 9.999542832e-01f, 9.559656493e-03f, 9.999855757e-01f, 5.375845823e-03f, 9.999954104e-01f, 3.023070283e-03f,
6.603167057e-01f, -7.509872317e-01f, -7.665365338e-01f, -6.422007084e-01f, 8.303361535e-01f, -5.572628975e-01f, -9.982416630e-01f, -5.927551538e-02f, -2.272021621e-01f, 9.738476276e-01f, 5.299841762e-01f, 8.480075598e-01f, 8.423270583e-01f, 5.389667153e-01f, 9.492070079e-01f, 3.146522641e-01f, 9.838436842e-01f, 1.790295690e-01f, 9.948815107e-01f, 1.010486856e-01f, 9.983804226e-01f, 5.689026415e-02f, 9.994877577e-01f, 3.200356290e-02f, 9.998379946e-01f, 1.799902879e-02f, 9.999487996e-01f, 1.012197044e-02f, 9.999837875e-01f, 5.692068953e-03f, 9.999948740e-01f, 3.200897481e-03f,
9.887046218e-01f, 1.498772055e-01f, -3.060954213e-01f, -9.520008564e-01f, 9.624637961e-01f, -2.714101076e-01f, -9.720142484e-01f, -2.349218130e-01f, -3.232895434e-01f, 9.463000894e-01f, 4.814845622e-01f, 8.764545918e-01f, 8.248651624e-01f, 5.653295517e-01f, 9.434618354e-01f, 3.314811885e-01f, 9.820042253e-01f, 1.888588965e-01f, 9.942975044e-01f, 1.066416800e-01f, 9.981955290e-01f, 6.004713103e-02f, 9.994292855e-01f, 3.378088027e-02f, 9.998195171e-01f, 1.899885759e-02f, 9.999428988e-01f, 1.068428159e-02f, 9.999819398e-01f, 6.008291151e-03f, 9.999942780e-01f, 3.378724447e-03f,
4.080820680e-01f, 9.129452705e-01f, 2.486167252e-01f, -9.686019421e-01f, 9.991443753e-01f, 4.135829210e-02f, -9.151299596e-01f, -4.031589925e-01f, -4.161468148e-01f, 9.092974067e-01f, 4.314628243e-01f, 9.021307230e-01f, 8.065784574e-01f, 5.911270380e-01f, 9.374182820e-01f, 3.482052684e-01f, 9.800665975e-01f, 1.986693144e-01f, 9.936820865e-01f, 1.122313142e-01f, 9.980006814e-01f, 6.320339441e-02f, 9.993675947e-01f, 3.555808961e-02f, 9.998000264e-01f, 1.999866776e-02f, 9.999367595e-01f, 1.124658901e-02f, 9.999799728e-01f, 6.324512884e-03f, 9.999936819e-01f, 3.556551412e-03f,
-5.477292538e-01f, 8.366556168e-01f, 7.267602682e-01f, -6.868911982e-01f, 9.367404580e-01f, 3.500247598e-01f, -8.293829560e-01f, -5.586804748e-01f, -5.048462152e-01f, 8.632093072e-01f, 3.800770044e-01f, 9.249548316e-01f, 7.874851823e-01f, 6.163335443e-01f, 9.310783744e-01f, 3.648192585e-01f, 9.780309200e-01f, 2.084598988e-01f, 9.930352569e-01f, 1.178173944e-01f, 9.977958202e-01f, 6.635902822e-02f, 9.993028045e-01f, 3.733518720e-02f, 9.997795224e-01f, 2.099845745e-02f, 9.999302626e-01f, 1.180889271e-02f, 9.999779463e-01f, 6.640734151e-03f, 9.999930263e-01f, 3.734378144e-03f,
-9.999608397e-01f, -8.851309307e-03f, 9.810745716e-01f, -1.936302334e-01f, 7.814403772e-01f, 6.239799261e-01f, -7.174775004e-01f, -6.965817213e-01f, -5.885011554e-01f, 8.084963560e-01f, 3.274896145e-01f, 9.448547959e-01f, 7.676045895e-01f, 6.409237385e-01f, 9.244439602e-01f, 3.813178837e-01f, 9.758974314e-01f, 2.182296216e-01f, 9.923570156e-01f, 1.233997419e-01f, 9.975810051e-01f, 6.951400638e-02f, 9.992348552e-01f, 3.911216930e-02f, 9.997580051e-01f, 2.199822664e-02f, 9.999234676e-01f, 1.237119269e-02f, 9.999758005e-01f, 6.956954487e-03f, 9.999923706e-01f, 3.912204877e-03f,
-5.328330398e-01f, -8.462203741e-01f, 9.332357645e-01f, 3.592645228e-01f, 5.486452579e-01f, 8.360552788e-01f, -5.829432607e-01f, -8.125128746e-01f, -6.662759781e-01f, 7.457052469e-01f, 2.738668621e-01f, 9.617676139e-01f, 7.469564080e-01f, 6.648730636e-01f, 9.175173044e-01f, 3.976959288e-01f, 9.736663699e-01f, 2.279775143e-01f, 9.916474223e-01f, 1.289781928e-01f, 9.973561764e-01f, 7.266827673e-02f, 9.991636872e-01f, 4.088902473e-02f, 9.997355342e-01f, 2.299797349e-02f, 9.999163747e-01f, 1.293348987e-02f, 9.999735355e-01f, 7.273174357e-03f, 9.999916553e-01f, 4.090031609e-03f,
4.241790175e-01f, -9.055783749e-01f, 5.979771614e-01f, 8.015131354e-01f, 2.614417076e-01f, 9.652192593e-01f, -4.300232828e-01f, -9.028177857e-01f, -7.373937964e-01f, 6.754631400e-01f, 2.193782777e-01f, 9.756398797e-01f, 7.255613208e-01f, 6.881574988e-01f, 9.103004336e-01f, 4.139482081e-01f, 9.713379741e-01f, 2.377026230e-01f, 9.909064770e-01f, 1.345525682e-01f, 9.971213937e-01f, 7.582182437e-02f, 9.990894198e-01f, 4.266574979e-02f, 9.997119904e-01f, 2.399769612e-02f, 9.999089241e-01f, 1.349578146e-02f, 9.999712110e-01f, 7.589393295e-03f, 9.999908805e-01f, 4.267857410e-03f,
9.912028313e-01f, -1.323517561e-01f, 7.855226099e-02f, 9.969099760e-01f, -5.168933049e-02f, 9.986631870e-01f, -2.635405958e-01f, -9.646483064e-01f, -8.011435866e-01f, 5.984721780e-01f, 1.641961634e-01f, 9.864277244e-01f, 7.034407258e-01f, 7.107539177e-01f, 9.027957320e-01f, 4.300695956e-01f, 9.689124227e-01f, 2.474039644e-01f, 9.901341200e-01f, 1.401226968e-01f, 9.968765974e-01f, 7.897461206e-02f, 9.990119338e-01f, 4.444234073e-02f, 9.996874928e-01f, 2.499739639e-02f, 9.999011755e-01f, 1.405806933e-02f, 9.999687672e-01f, 7.905611768e-03f, 9.999901056e-01f, 4.445684142e-03f,
6.469193697e-01f, 7.625584006e-01f, -4.650644958e-01f, 8.852767944e-01f, -3.596943319e-01f, 9.330701828e-01f, -8.874549717e-02f, -9.960543513e-01f, -8.568888307e-01f, 5.155012608e-01f, 1.084949449e-01f, 9.940969944e-01f, 6.806167960e-01f, 7.326396108e-01f, 8.950055242e-01f, 4.460549951e-01f, 9.663899541e-01f, 2.570805550e-01f, 9.893305302e-01f, 1.456883848e-01f, 9.966219068e-01f, 8.212661743e-02f, 9.989313483e-01f, 4.621879384e-02f, 9.996620417e-01f, 2.599707060e-02f, 9.998931289e-01f, 1.462035347e-02f, 9.999662042e-01f, 8.221829310e-03f, 9.999893308e-01f, 4.623509943e-03f,
-2.921388149e-01f, 9.563759565e-01f, -8.654506207e-01f, 5.009942055e-01f, -6.320286393e-01f, 7.749450207e-01f, 8.884812146e-02f, -9.960451722e-01f, -9.040721655e-01f, 4.273798466e-01f, 5.245061219e-02f, 9.986234903e-01f, 6.571123004e-01f, 7.537927032e-01f, 8.869323730e-01f, 4.618993104e-01f, 9.637709260e-01f, 2.667314112e-01f, 9.884956479e-01f, 1.512494683e-01f, 9.963572025e-01f, 8.527779579e-02f, 9.988475442e-01f, 4.799510166e-02f, 9.996355176e-01f, 2.699672058e-02f, 9.998847246e-01f, 1.518263202e-02f, 9.999635220e-01f, 8.538045920e-03f, 9.999884963e-01f, 4.801335745e-03f,
-9.626058936e-01f, 2.709057927e-01f, -9.992933869e-01f, -3.758566082e-02f, -8.416849375e-01f, 5.399689674e-01f, 2.636395097e-01f, -9.646213055e-01f, -9.422222972e-01f, 3.349882066e-01f, -3.759419080e-03f, 9.999929070e-01f, 6.329506636e-01f, 7.741921544e-01f, 8.785787225e-01f, 4.775975943e-01f, 9.610554576e-01f, 2.763556540e-01f, 9.876294732e-01f, 1.568057537e-01f, 9.960825443e-01f, 8.842811733e-02f, 9.987606406e-01f, 4.977125302e-02f, 9.996080399e-01f, 2.799634263e-02f, 9.998760223e-01f, 1.574490592e-02f, 9.999607801e-01f, 8.854261599e-03f, 9.999876022e-01f, 4.979162011e-03f,
-7.480575442e-01f, -6.636338830e-01f, -8.253716230e-01f, -5.645897985e-01f, -9.678714871e-01f, 2.514452934e-01f, 4.301158488e-01f, -9.027737379e-01f, -9.709581733e-01f, 2.392492294e-01f, -5.995756760e-02f, 9.982009530e-01f, 6.081562042e-01f, 7.938174009e-01f, 8.699471951e-01f, 4.931448400e-01f, 9.582439065e-01f, 2.859522104e-01f, 9.867320657e-01f, 1.623570919e-01f, 9.957979321e-01f, 9.157756716e-02f, 9.986705780e-01f, 5.154724792e-02f, 9.995795488e-01f, 2.899593674e-02f, 9.998670220e-01f, 1.630717516e-02f, 9.999579787e-01f, 9.170476347e-03f, 9.999867082e-01f, 5.156987347e-03f,
1.542514563e-01f, -9.880316257e-01f, -3.972518742e-01f, -9.177096486e-01f, -9.980752468e-01f, -6.201483682e-02f, 5.830269456e-01f, -8.124528527e-01f, -9.899924994e-01f, 1.411200017e-01f, -1.159661636e-01f, 9.932531714e-01f, 5.827535987e-01f, 8.126488924e-01f, 8.610406518e-01f, 5.085361004e-01f, 9.553365111e-01f, 2.955201864e-01f, 9.858034849e-01f, 1.679033041e-01f, 9.955033660e-01f, 9.472609311e-02f, 9.985772967e-01f, 5.332308263e-02f, 9.995500445e-01f, 2.999550104e-02f, 9.998577237e-01f, 1.686943881e-02f, 9.999549985e-01f, 9.486690164e-03f, 9.999857545e-01f, 5.334813148e-03f,
9.147423506e-01f, -4.040376544e-01f, 1.532154679e-01f, -9.881927967e-01f, -9.293003082e-01f, -3.693250120e-01f, 7.175492644e-01f, -6.965078115e-01f, -9.991351366e-01f, 4.158052057e-02f, -1.716081351e-01f, 9.851652980e-01f, 5.567683578e-01f, 8.306677938e-01f, 8.518617749e-01f, 5.237666368e-01f, 9.523335695e-01f, 3.050586283e-01f, 9.848436713e-01f, 1.734442115e-01f, 9.951988459e-01f, 9.787366539e-02f, 9.984809160e-01f, 5.509874597e-02f, 9.995195270e-01f, 3.099503554e-02f, 9.998480678e-01f, 1.743169688e-02f, 9.999519587e-01f, 9.802903049e-03f, 9.999848008e-01f, 5.512638018e-03f,
8.342233300e-01f, 5.514267087e-01f, 6.564951539e-01f, -7.543302178e-01f, -7.683671117e-01f, -6.400093436e-01f, 8.294403553e-01f, -5.585952401e-01f, -9.982947707e-01f, -5.837418884e-02f, -2.267075926e-01f, 9.739628434e-01f, 5.302263498e-01f, 8.478561044e-01f, 8.424135447e-01f, 5.388315320e-01f, 9.492354393e-01f, 3.145665526e-01f, 9.838528037e-01f, 1.789796203e-01f, 9.948843718e-01f, 1.010202691e-01f, 9.983813763e-01f, 5.687423423e-02f, 9.994880557e-01f, 3.199454024e-02f, 9.998381138e-01f, 1.799395122e-02f, 9.999487996e-01f, 1.011911593e-02f, 9.999837875e-01f, 5.690463353e-03f,
-1.327674743e-02f, 9.999118447e-01f, 9.575860500e-01f, -2.881473601e-01f, -5.312352777e-01f, -8.472243547e-01f, 9.151713848e-01f, -4.030649364e-01f, -9.874798059e-01f, -1.577456445e-01f, -2.810902894e-01f, 9.596813321e-01f, 5.031541586e-01f, 8.641966581e-01f, 8.326989412e-01f, 5.537260175e-01f, 9.460423589e-01f, 3.240430057e-01f, 9.828307629e-01f, 1.845093668e-01f, 9.945599437e-01f, 1.041658595e-01f, 9.982786179e-01f, 5.864954367e-02f, 9.994555712e-01f, 3.299400955e-02f, 9.998278022e-01f, 1.855619811e-02f, 9.999455214e-01f, 1.043532696e-02f, 9.999827743e-01f, 5.868288688e-03f,
-8.485702872e-01f, 5.290827155e-01f, 9.637575150e-01f, 2.667797208e-01f, -2.414211035e-01f, -9.704204202e-01f, 9.720383286e-01f, -2.348221242e-01f, -9.667981863e-01f, -2.555412054e-01f, -3.345843554e-01f, 9.423658252e-01f, 4.755789042e-01f, 8.796730638e-01f, 8.227210045e-01f, 5.684453845e-01f, 9.427546859e-01f, 3.334870934e-01f, 9.817776680e-01f, 1.900332868e-01f, 9.942255616e-01f, 1.073104069e-01f, 9.981727600e-01f, 6.042466685e-02f, 9.994220734e-01f, 3.399345279e-02f, 9.998172522e-01f, 1.911843941e-02f, 9.999421835e-01f, 1.075153705e-02f, 9.999817014e-01f, 6.046113092e-03f,
-9.036921859e-01f, -4.281826615e-01f, 6.731102467e-01f, 7.395421863e-01f, 7.233466953e-02f, -9.973804355e-01f, 9.982477427e-01f, -5.917267874e-02f, -9.364566803e-01f, -3.507832289e-01f, -3.870206773e-01f, 9.220710397e-01f, 4.475280643e-01f, 8.942698836e-01f, 8.124829531e-01f, 5.829849839e-01f, 9.393727183e-01f, 3.428978026e-01f, 9.806935191e-01f, 1.955512017e-01f, 9.938812256e-01f, 1.104538813e-01f, 9.980637431e-01f, 6.219960377e-02f, 9.993875623e-01f, 3.499285504e-02f, 9.998063445e-01f, 1.968067512e-02f, 9.999387264e-01f, 1.106774528e-02f, 9.999806285e-01f, 6.223937962e-03f,
-1.279636919e-01f, -9.917788506e-01f, 1.751565337e-01f, 9.845405817e-01f, 3.789161742e-01f, -9.254310131e-01f, 9.929728508e-01f, 1.183425784e-01f, -8.967583776e-01f, -4.425205886e-01f, -4.382335246e-01f, 8.988611698e-01f, 4.190297425e-01f, 9.079725146e-01f, 8.019878864e-01f, 5.973402858e-01f, 9.358968139e-01f, 3.522742093e-01f, 9.795783162e-01f, 2.010629177e-01f, 9.935269952e-01f, 1.135962531e-01f, 9.979515672e-01f, 6.397433579e-02f, 9.993520975e-01f, 3.599222749e-02f, 9.997950792e-01f, 2.024290524e-02f, 9.999352098e-01f, 1.138395350e-02f, 9.999794960e-01f, 6.401761901e-03f,
7.654140592e-01f, -6.435381174e-01f, -3.767422736e-01f, 9.263181090e-01f, 6.479216814e-01f, -7.617069483e-01f, 9.563800097e-01f, 2.921253741e-01f, -8.481000066e-01f, -5.298361778e-01f, -4.880608618e-01f, 8.728095889e-01f, 3.901124299e-01f, 9.207672477e-01f, 7.912392616e-01f, 6.115067005e-01f, 9.323273301e-01f, 3.616154492e-01f, 9.784321785e-01f, 2.065682709e-01f, 9.931628108e-01f, 1.167374924e-01f, 9.978361726e-01f, 6.574887782e-02f, 9.993155599e-01f, 3.699155897e-02f, 9.997835755e-01f, 2.080512606e-02f, 9.999315739e-01f, 1.170015987e-02f, 9.999783635e-01f, 6.579586305e-03f,
9.550736547e-01f, 2.963685691e-01f, -8.126112223e-01f, 5.828061700e-01f, 8.526731133e-01f, -5.224447846e-01f, 8.896234632e-01f, 4.566946924e-01f, -7.909677625e-01f, -6.118578315e-01f, -5.363451838e-01f, 8.439987302e-01f, 3.608050346e-01f, 9.326412678e-01f, 7.802404165e-01f, 6.254796982e-01f, 9.286646247e-01f, 3.709204793e-01f, 9.772551060e-01f, 2.120671123e-01f, 9.927886724e-01f, 1.198775545e-01f, 9.977176785e-01f, 6.752320379e-02f, 9.992780685e-01f, 3.799085692e-02f, 9.997717142e-01f, 2.136734314e-02f, 9.999278188e-01f, 1.201636530e-02f, 9.999771714e-01f, 6.757410709e-03f,
2.666429281e-01f, 9.637953639e-01f, -9.982103705e-01f, 5.980031565e-02f, 9.728653431e-01f, -2.313720286e-01f, 7.948083878e-01f, 6.068604589e-01f, -7.259323001e-01f, -6.877661943e-01f, -5.829339027e-01f, 8.125195503e-01f, 3.311368823e-01f, 9.435827136e-01f, 7.689949274e-01f, 6.392549276e-01f, 9.249090552e-01f, 3.801884055e-01f, 9.760470986e-01f, 2.175592482e-01f, 9.924046397e-01f, 1.230164245e-01f, 9.975960255e-01f, 6.929731369e-02f, 9.992396235e-01f, 3.899011388e-02f, 9.997594953e-01f, 2.192955278e-02f, 9.999239445e-01f, 1.233256981e-02f, 9.999759793e-01f, 6.935234182e-03f,
-6.669380665e-01f, 7.451131940e-01f, -8.763794303e-01f, -4.816212952e-01f, 9.965789914e-01f, 8.264580369e-02f, 6.749256253e-01f, 7.378857732e-01f, -6.536436081e-01f, -7.568024993e-01f, -6.276797056e-01f, 7.784717083e-01f, 3.011375964e-01f, 9.535806775e-01f, 7.575061917e-01f, 6.528279781e-01f, 9.210609794e-01f, 3.894183338e-01f, 9.748082757e-01f, 2.230444849e-01f, 9.920106530e-01f, 1.261540651e-01f, 9.974712729e-01f, 7.107120752e-02f, 9.992001057e-01f, 3.998933733e-02f, 9.997470379e-01f, 2.249175683e-02f, 9.999200106e-01f, 1.264877338e-02f, 9.999747276e-01f, 7.113057654e-03f,
-9.873392582e-01f, -1.586226672e-01f, -4.846394062e-01f, -8.747140765e-01f, 9.214623570e-01f, 3.884676993e-01f, 5.337560773e-01f, 8.456385136e-01f, -5.748240352e-01f, -8.182770610e-01f, -6.704410911e-01f, 7.419627309e-01f, 2.708370984e-01f, 9.626252055e-01f, 7.457779050e-01f, 6.661946774e-01f, 9.171208143e-01f, 3.986093104e-01f, 9.735385776e-01f, 2.285226882e-01f, 9.916067719e-01f, 1.292904317e-01f, 9.973433018e-01f, 7.284487784e-02f, 9.991596341e-01f, 4.098851606e-02f, 9.997342229e-01f, 2.305394970e-02f, 9.999159575e-01f, 1.296497509e-02f, 9.999734163e-01f, 7.290880661e-03f,
-3.999853134e-01f, -9.165215492e-01f, 5.636094138e-02f, -9.984104633e-01f, 7.549653053e-01f, 6.557646990e-01f, 3.757521510e-01f, 9.267202020e-01f, -4.902605712e-01f, -8.715758920e-01f, -7.110829353e-01f, 7.031081319e-01f, 2.402658761e-01f, 9.707071185e-01f, 7.338138223e-01f, 6.793506742e-01f, 9.130889177e-01f, 4.077604413e-01f, 9.722381234e-01f, 2.339936644e-01f, 9.911929369e-01f, 1.324255317e-01f, 9.972121716e-01f, 7.461831719e-02f, 9.991181493e-01f, 4.198765755e-02f, 9.997211099e-01f, 2.361613885e-02f, 9.999117851e-01f, 1.328117587e-02f, 9.999721050e-01f, 7.468704134e-03f,
5.551133156e-01f, -8.317747116e-01f, 5.800030828e-01f, -8.146142364e-01f, 5.135983825e-01f, 8.580306768e-01f, 2.058971673e-01f, 9.785736203e-01f, -4.007990062e-01f, -9.161660075e-01f, -7.494767308e-01f, 6.620306969e-01f, 2.094544172e-01f, 9.778184295e-01f, 7.216176391e-01f, 6.922917962e-01f, 9.089657664e-01f, 4.168707728e-01f, 9.709069133e-01f, 2.394572198e-01f, 9.907692075e-01f, 1.355592906e-01f, 9.970778823e-01f, 7.639151812e-02f, 9.990756512e-01f, 4.298675060e-02f, 9.997076392e-01f, 2.417832054e-02f, 9.999075532e-01f, 1.359737478e-02f, 9.999707937e-01f, 7.646527141e-03f,
9.998432994e-01f, 1.770192571e-02f, 9.250146747e-01f, -3.799313903e-01f, 2.212981731e-01f, 9.752061963e-01f, 2.954782173e-02f, 9.995633960e-01f, -3.073327839e-01f, -9.516021013e-01f, -7.855011225e-01f, 6.188602448e-01f, 1.784335226e-01f, 9.839519858e-01f, 7.091933489e-01f, 7.050140500e-01f, 9.047516584e-01f, 4.259394705e-01f, 9.695450068e-01f, 2.449132055e-01f, 9.903355837e-01f, 1.386916935e-01f, 9.969404936e-01f, 7.816448808e-02f, 9.990321398e-01f, 4.398580641e-02f, 9.996939301e-01f, 2.474049293e-02f, 9.999032021e-01f, 1.391357277e-02f, 9.999693632e-01f, 7.824349217e-03f,
5.253220201e-01f, 8.509035110e-01f, 9.851381779e-01f, 1.717635691e-01f, -9.294810891e-02f, 9.956709743e-01f, -1.477329880e-01f, 9.890272617e-01f, -2.107957900e-01f, -9.775301218e-01f, -8.190422058e-01f, 5.737333298e-01f, 1.472342163e-01f, 9.891016483e-01f, 6.965447664e-01f, 7.175133228e-01f, 9.004471302e-01f, 4.349655211e-01f, 9.681524038e-01f, 2.503614724e-01f, 9.898920655e-01f, 1.418227106e-01f, 9.967998862e-01f, 7.993719727e-02f, 9.989876747e-01f, 4.498481750e-02f, 9.996798635e-01f, 2.530265786e-02f, 9.998987317e-01f, 1.422976889e-02f, 9.999679923e-01f, 8.002171293e-03f,
-4.321779609e-01f, 9.017883539e-01f, 7.418580055e-01f, 6.705570221e-01f, -3.979767561e-01f, 9.173954725e-01f, -3.203543723e-01f, 9.472977519e-01f, -1.121526212e-01f, -9.936909676e-01f, -8.499938846e-01f, 5.267925262e-01f, 1.158876941e-01f, 9.932623506e-01f, 6.836758852e-01f, 7.297858000e-01f, 8.960524797e-01f, 4.439480901e-01f, 9.667292237e-01f, 2.558017969e-01f, 9.894386530e-01f, 1.449523121e-01f, 9.966561794e-01f, 8.170966059e-02f, 9.989421964e-01f, 4.598378390e-02f, 9.996654391e-01f, 2.586481534e-02f, 9.998942018e-01f, 1.454596408e-02f, 9.999665618e-01f, 8.179994300e-03f,
-9.923354983e-01f, 1.235731244e-01f, 2.700984478e-01f, 9.628326893e-01f, -6.635382771e-01f, 7.481423020e-01f, -4.828719497e-01f, 8.756909966e-01f, -1.238837745e-02f, -9.999232888e-01f, -8.782584071e-01f, 4.781863391e-01f, 8.442528546e-02f, 9.964298010e-01f, 6.705908179e-01f, 7.418274283e-01f, 8.915683031e-01f, 4.528862834e-01f, 9.652754664e-01f, 2.612340748e-01f, 9.889753461e-01f, 1.480804533e-01f, 9.965093136e-01f, 8.348185569e-02f, 9.988957047e-01f, 4.698270187e-02f, 9.996507764e-01f, 2.642696351e-02f, 9.998895526e-01f, 1.486215740e-02f, 9.999650717e-01f, 8.357816376e-03f,
-6.401443481e-01f, -7.682546377e-01f, -2.848466039e-01f, 9.585731030e-01f, -8.632964492e-01f, 5.046971440e-01f, -6.301599741e-01f, 7.764653563e-01f, 8.749917895e-02f, -9.961646199e-01f, -9.037463665e-01f, 4.280683994e-01f, 5.287845805e-02f, 9.986009598e-01f, 6.572937369e-01f, 7.536345124e-01f, 8.869948983e-01f, 4.617791772e-01f, 9.637911916e-01f, 2.666580379e-01f, 9.885020852e-01f, 1.512071192e-01f, 9.963592887e-01f, 8.525379747e-02f, 9.988481998e-01f, 4.798157141e-02f, 9.996357560e-01f, 2.698910423e-02f, 9.998847842e-01f, 1.517834887e-02f, 9.999635816e-01f, 8.535637520e-03f,
3.005925417e-01f, -9.537526369e-01f, -7.520639896e-01f, 6.590901017e-01f, -9.774427414e-01f, 2.112006694e-01f, -7.575730681e-01f, 6.527503729e-01f, 1.865124702e-01f, -9.824525714e-01f, -9.263771176e-01f, 3.765971363e-01f, 2.127875946e-02f, 9.997735620e-01f, 6.437888145e-01f, 7.652031779e-01f, 8.823328614e-01f, 4.706258774e-01f, 9.622764587e-01f, 2.720735669e-01f, 9.880189896e-01f, 1.543322802e-01f, 9.962061048e-01f, 8.702547103e-02f, 9.987997413e-01f, 4.898039624e-02f, 9.996203780e-01f, 2.755123749e-02f, 9.998799562e-01f, 1.549453940e-02f, 9.999620318e-01f, 8.713459596e-03f,
9.649659991e-01f, -2.623748481e-01f, -9.876590967e-01f, 1.566190720e-01f, -9.946564436e-01f, -1.032404676e-01f, -8.610926867e-01f, 5.084480047e-01f, 2.836621702e-01f, -9.589242935e-01f, -9.460792542e-01f, 3.239352703e-01f, -1.034221891e-02f, 9.999465346e-01f, 6.300802827e-01f, 7.765299678e-01f, 8.775825500e-01f, 4.794255495e-01f, 9.607312679e-01f, 2.774805427e-01f, 9.875259995e-01f, 1.574558914e-01f, 9.960497618e-01f, 8.879686147e-02f, 9.987502694e-01f, 4.997916892e-02f, 9.996047616e-01f, 2.811335959e-02f, 9.998750091e-01f, 1.581072807e-02f, 9.999604821e-01f, 8.891279809e-03f,
7.421542406e-01f, 6.702291369e-01f, -9.190735221e-01f, -3.940860629e-01f, -9.132301211e-01f, -4.074441493e-01f, -9.374542832e-01f, 3.481085002e-01f, 3.779776394e-01f, -9.258147478e-01f, -9.627903700e-01f, 2.702493370e-01f, -4.195285589e-02f, 9.991195798e-01f, 6.161724925e-01f, 7.876112461e-01f, 8.727445006e-01f, 4.881772399e-01f, 9.591556787e-01f, 2.828786969e-01f, 9.870231748e-01f, 1.605779380e-01f, 9.958902597e-01f, 9.056797624e-02f, 9.986997843e-01f, 5.097789690e-02f, 9.995887876e-01f, 2.867547423e-02f, 9.998699427e-01f, 1.612691768e-02f, 9.999588728e-01f, 9.069100954e-03f,
-1.629907787e-01f, 9.866275787e-01f, -5.674300194e-01f, -8.234215975e-01f, -7.412399650e-01f, -6.712400913e-01f, -9.842484593e-01f, 1.767906845e-01f, 4.685169160e-01f, -8.834545016e-01f, -9.764577150e-01f, 2.157090008e-01f, -7.352153957e-02f, 9.972936511e-01f, 6.020698547e-01f, 7.984433770e-01f, 8.678191900e-01f, 4.968801141e-01f, 9.575498104e-01f, 2.882679403e-01f, 9.865104556e-01f, 1.636983752e-01f, 9.957276583e-01f, 9.233880043e-02f, 9.986482859e-01f, 5.197656900e-02f, 9.995725155e-01f, 2.923758142e-02f, 9.998648167e-01f, 1.644310169e-02f, 9.999572635e-01f, 9.246920235e-03f,
-9.182828069e-01f, 3.959251344e-01f, -4.102819040e-02f, -9.991579652e-01f, -4.957418144e-01f, -8.684699535e-01f, -1.000000000e+00f, -1.030206768e-04f, 5.543745160e-01f, -8.322673440e-01f, -9.870380163e-01f, 1.604867131e-01f, -1.050167158e-01f, 9.944704771e-01f, 5.877768993e-01f, 8.090230227e-01f, 8.628070951e-01f, 5.055333376e-01f, 9.559136033e-01f, 2.936480343e-01f, 9.859878421e-01f, 1.668171734e-01f, 9.955618382e-01f, 9.410934150e-02f, 9.985958338e-01f, 5.297519267e-02f, 9.995558858e-01f, 2.979967557e-02f, 9.998595715e-01f, 1.675928757e-02f, 9.999555945e-01f, 9.424741380e-03f,
-8.293098211e-01f, -5.587890744e-01f, 4.980095923e-01f, -8.671715260e-01f, -2.010796219e-01f, -9.795749187e-01f, -9.842120409e-01f, -1.769934893e-01f, 6.346929669e-01f, -7.727644444e-01f, -9.944978952e-01f, 1.047568321e-01f, -1.364068687e-01f, 9.906529188e-01f, 5.732980371e-01f, 8.193469048e-01f, 8.577086926e-01f, 5.141359568e-01f, 9.542471766e-01f, 2.990188897e-01f, 9.854553938e-01f, 1.699342877e-01f, 9.953929186e-01f, 9.587957710e-02f, 9.985423684e-01f, 5.397376046e-02f, 9.995389581e-01f, 3.036176413e-02f, 9.998542070e-01f, 1.707546785e-02f, 9.999538660e-01f, 9.602561593e-03f,
2.212675475e-02f, -9.997551441e-01f, 8.836693168e-01f, -4.681116939e-01f, 1.135217771e-01f, -9.935355186e-01f, -9.373825192e-01f, -3.483016491e-01f, 7.086697817e-01f, -7.055402994e-01f, -9.988136292e-01f, 4.869600013e-02f, -1.676606387e-01f, 9.858447909e-01f, 5.586378574e-01f, 8.294116855e-01f, 8.525245190e-01f, 5.226872563e-01f, 9.525505900e-01f, 3.043802381e-01f, 9.849131107e-01f, 1.730497181e-01f, 9.952208400e-01f, 9.764950722e-02f, 9.984878898e-01f, 5.497227982e-02f, 9.995217323e-01f, 3.092384152e-02f, 9.998487830e-01f, 1.739165001e-02f, 9.999521971e-01f, 9.780380875e-03f,
8.532201052e-01f, -5.215510130e-01f, 9.971746206e-01f, 7.511820644e-02f, 4.168670774e-01f, -9.089674354e-01f, -8.609884381e-01f, -5.086245537e-01f, 7.755658031e-01f, -6.312667131e-01f, -9.999717474e-01f, -7.518785074e-03f, -1.987468749e-01f, 9.800508618e-01f, 5.438010693e-01f, 8.392141461e-01f, 8.472551107e-01f, 5.311862230e-01f, 9.508239031e-01f, 3.097319603e-01f, 9.843609333e-01f, 1.761634201e-01f, 9.950456619e-01f, 9.941913933e-02f, 9.984323978e-01f, 5.597073585e-02f, 9.995042086e-01f, 3.148590773e-02f, 9.998431802e-01f, 1.770782843e-02f, 9.999504089e-01f, 9.958200157e-03f,
8.998668194e-01f, 4.361647666e-01f, 8.035690784e-01f, 5.952115059e-01f, 6.788702011e-01f, -7.342582941e-01f, -7.574391961e-01f, -6.529057026e-01f, 8.347129226e-01f, -5.506852865e-01f, -9.979684949e-01f, -6.370980293e-02f, -2.296342701e-01f, 9.732769728e-01f, 5.287922621e-01f, 8.487513065e-01f, 8.419009447e-01f, 5.396320224e-01f, 9.490671158e-01f, 3.150739372e-01f, 9.837989211e-01f, 1.792753637e-01f, 9.948672652e-01f, 1.011884511e-01f, 9.983759522e-01f, 5.696914345e-02f, 9.994863272e-01f, 3.204796836e-02f, 9.998375773e-01f, 1.802400686e-02f, 9.999486208e-01f, 1.013601944e-02f,
1.191801354e-01f, 9.928726554e-01f, 3.624766469e-01f, 9.319928288e-01f, 8.735505342e-01f, -4.867334962e-01f, -6.300007105e-01f, -7.765945792e-01f, 8.855196238e-01f, -4.646020234e-01f, -9.928101897e-01f, -1.196994036e-01f, -2.602920234e-01f, 9.655299187e-01f, 5.136163235e-01f, 8.580200076e-01f, 8.364626765e-01f, 5.480239391e-01f, 9.472803473e-01f, 3.204059005e-01f, 9.832270741e-01f, 1.823855042e-01f, 9.946857691e-01f, 1.029574350e-01f, 9.983184934e-01f, 5.796748772e-02f, 9.994681478e-01f, 3.261001408e-02f, 9.998317957e-01f, 1.834018156e-02f, 9.999468327e-01f, 1.031383779e-02f,
-7.710802555e-01f, 6.367380023e-01f, -1.902491003e-01f, 9.817358255e-01f, 9.816020727e-01f, -1.909380108e-01f, -4.826923311e-01f, -8.757900000e-01f, 9.274784923e-01f, -3.738765717e-01f, -9.845131636e-01f, -1.753105819e-01f, -2.906895280e-01f, 9.568174481e-01f, 4.982779026e-01f, 8.670173883e-01f, 8.309406638e-01f, 5.563610196e-01f, 9.454635978e-01f, 3.257277906e-01f, 9.826454520e-01f, 1.854938269e-01f, 9.945011139e-01f, 1.047261059e-01f, 9.982600212e-01f, 5.896577984e-02f, 9.994496703e-01f, 3.317204863e-02f, 9.998259544e-01f, 1.865635626e-02f, 9.999449849e-01f, 1.049165614e-02f,
-9.524129629e-01f, -3.048106432e-01f, -6.843819022e-01f, 7.291237116e-01f, 9.923083186e-01f, 1.237909496e-01f, -3.201591969e-01f, -9.473637342e-01f, 9.601702690e-01f, -2.794154882e-01f, -9.731037021e-01f, -2.303675264e-01f, -3.207963705e-01f, 9.471482038e-01f, 4.827820063e-01f, 8.757405281e-01f, 8.253356218e-01f, 5.646424294e-01f, 9.436169863e-01f, 3.310393095e-01f, 9.820539355e-01f, 1.886002868e-01f, 9.943132997e-01f, 1.064944416e-01f, 9.982005358e-01f, 5.996400863e-02f, 9.994308352e-01f, 3.373407945e-02f, 9.998199940e-01f, 1.897252724e-02f, 9.999430776e-01f, 1.066947449e-02f,
-2.581016421e-01f, -9.661177397e-01f, -9.677396417e-01f, 2.519522905e-01f, 9.046075344e-01f, 4.262454212e-01f, -1.475291997e-01f, -9.890577197e-01f, 9.832684398e-01f, -1.821625978e-01f, -9.586178064e-01f, -2.846961617e-01f, -3.505824506e-01f, 9.365319014e-01f, 4.671334028e-01f, 8.841868639e-01f, 8.196480274e-01f, 5.728674531e-01f, 9.417404532e-01f, 3.363404274e-01f, 9.814526439e-01f, 1.917048544e-01f, 9.941223264e-01f, 1.082624346e-01f, 9.981400967e-01f, 6.096218154e-02f, 9.994117022e-01f, 3.429609165e-02f, 9.998139739e-01f, 1.928869821e-02f, 9.999411702e-01f, 1.084729191e-02f,
6.735071540e-01f, -7.391806841e-01f, -9.530500174e-01f, -3.028128445e-01f, 7.271980643e-01f, 6.864277124e-01f, 2.975377068e-02f, -9.995572567e-01f, 9.965420961e-01f, -8.308912069e-02f, -9.411013126e-01f, -3.381247520e-01f, -3.800179660e-01f, 9.249790907e-01f, 4.513370693e-01f, 8.923535347e-01f, 8.138784766e-01f, 5.810351968e-01f, 9.398342371e-01f, 3.416308761e-01f, 9.808415174e-01f, 1.948075294e-01f, 9.939282537e-01f, 1.100300923e-01f, 9.980786443e-01f, 6.196028739e-02f, 9.993922710e-01f, 3.485809639e-02f, 9.998078346e-01f, 1.960486546e-02f, 9.999392033e-01f, 1.102510840e-02f,
9.858965874e-01f, 1.673557013e-01f, -6.448370218e-01f, -7.643201351e-01f, 4.776714444e-01f, 8.785385489e-01f, 2.060983330e-01f, -9.785313010e-01f, 9.998586178e-01f, 1.681409217e-02f, -9.206095338e-01f, -3.904843926e-01f, -4.090735018e-01f, 9.125014544e-01f, 4.353979826e-01f, 9.002380967e-01f, 8.080275059e-01f, 5.891447663e-01f, 9.378982186e-01f, 3.469105363e-01f, 9.802205563e-01f, 1.979082376e-01f, 9.937310219e-01f, 1.117973924e-01f, 9.980161786e-01f, 6.295833737e-02f, 9.993724823e-01f, 3.542009369e-02f, 9.998015761e-01f, 1.992103085e-02f, 9.999372363e-01f, 1.120292582e-02f,
3.918572366e-01f, 9.200260639e-01f, -1.380281597e-01f, -9.904283285e-01f, 1.807759702e-01f, 9.835243225e-01f, 3.759426475e-01f, -9.266429543e-01f, 9.931849241e-01f, 1.165492982e-01f, -8.972073197e-01f, -4.416095316e-01f, -4.377200007e-01f, 8.991113305e-01f, 4.193212092e-01f, 9.078379273e-01f, 8.020957708e-01f, 5.971954465e-01f, 9.359325767e-01f, 3.521791995e-01f, 9.795898199e-01f, 2.010069788e-01f, 9.935306311e-01f, 1.135643497e-01f, 9.979526997e-01f, 6.395632029e-02f, 9.993524551e-01f, 3.598207608e-02f, 9.997951984e-01f, 2.023719437e-02f, 9.999352098e-01f, 1.138074230e-02f,
-5.624538660e-01f, 8.268286586e-01f, 4.112906456e-01f, -9.115042686e-01f, -1.340468824e-01f, 9.909749627e-01f, 5.339299440e-01f, -8.455287218e-01f, 9.765876532e-01f, 2.151199877e-01f, -8.709686995e-01f, -4.913385212e-01f, -4.659289122e-01f, 8.848221898e-01f, 4.031118751e-01f, 9.151507020e-01f, 7.960838079e-01f, 6.051864028e-01f, 9.339373708e-01f, 3.574367166e-01f, 9.789492488e-01f, 2.041037083e-01f, 9.933271408e-01f, 1.153309494e-01f, 9.978882670e-01f, 6.495424360e-02f, 9.993320704e-01f, 3.654404357e-02f, 9.997887611e-01f, 2.055335604e-02f, 9.999331832e-01f, 1.155855879e-02f,
-9.996474385e-01f, -2.655115537e-02f, 8.339421749e-01f, -5.518518090e-01f, -4.355781674e-01f, 9.001508951e-01f, 6.750773191e-01f, -7.377469540e-01f, 9.502326250e-01f, 3.115412891e-01f, -8.419764638e-01f, -5.395141840e-01f, -4.936717451e-01f, 8.696483374e-01f, 3.867750466e-01f, 9.221740961e-01f, 7.899922729e-01f, 6.131168008e-01f, 9.319126010e-01f, 3.626829684e-01f, 9.782989621e-01f, 2.071983814e-01f, 9.931204915e-01f, 1.170971766e-01f, 9.978227615e-01f, 6.595209241e-02f, 9.993113279e-01f, 3.710600734e-02f, 9.997822046e-01f, 2.086951770e-02f, 9.999310970e-01f, 1.173637528e-02f,
-5.177697539e-01f, -8.555200100e-01f, 9.997526407e-01f, -2.224157006e-02f, -6.939117312e-01f, 7.200600505e-01f, 7.949331403e-01f, -6.066970825e-01f, 9.143830538e-01f, 4.048501849e-01f, -8.103224635e-01f, -5.859842300e-01f, -5.209211111e-01f, 8.536047935e-01f, 3.703159094e-01f, 9.289059043e-01f, 7.838217020e-01f, 6.209859252e-01f, 9.298583269e-01f, 3.679177165e-01f, 9.776388407e-01f, 2.102909982e-01f, 9.929106832e-01f, 1.188630387e-01f, 9.977563620e-01f, 6.694988906e-02f, 9.992902875e-01f, 3.766795248e-02f, 9.997755289e-01f, 2.118567377e-02f, 9.999290109e-01f, 1.191418990e-02f,
4.401430190e-01f, -8.979277015e-01f, 8.576571345e-01f, 5.142219663e-01f, -8.834316730e-01f, 4.685599506e-01f, 8.897171617e-01f, -4.565122128e-01f, 8.693974018e-01f, 4.941135347e-01f, -7.761065960e-01f, -6.306017041e-01f, -5.476494431e-01f, 8.367078900e-01f, 3.537396789e-01f, 9.353439212e-01f, 7.775726914e-01f, 6.287930012e-01f, 9.277747273e-01f, 3.731408715e-01f, 9.769689441e-01f, 2.133814991e-01f, 9.926977158e-01f, 1.206285134e-01f, 9.976888895e-01f, 6.794761121e-02f, 9.992689490e-01f, 3.822989017e-02f, 9.997687936e-01f, 2.150182985e-02f, 9.999268651e-01f, 1.209200546e-02f,
9.933903813e-01f, -1.147848144e-01f, 4.514202476e-01f, 8.923114538e-01f, -9.853413105e-01f, 1.705945879e-01f, 9.564402103e-01f, -2.919283211e-01f, 8.157250285e-01f, 5.784398317e-01f, -7.394371629e-01f, -6.732255816e-01f, -5.738303661e-01f, 8.189741969e-01f, 3.370516896e-01f, 9.414861202e-01f, 7.712460160e-01f, 6.365371943e-01f, 9.256617427e-01f, 3.783521950e-01f, 9.762892723e-01f, 2.164698690e-01f, 9.924816489e-01f, 1.223936230e-01f, 9.976204634e-01f, 6.894526631e-02f, 9.992473125e-01f, 3.879181668e-02f, 9.997619390e-01f, 2.181798220e-02f, 9.999247193e-01f, 1.226981916e-02f,
6.333191991e-01f, 7.738906741e-01f, -9.384513646e-02f, 9.955868125e-01f, -9.895353913e-01f, -1.442903578e-01f, 9.929971695e-01f, -1.181379855e-01f, 7.539022565e-01f, 6.569865942e-01f, -7.004299760e-01f, -7.137210965e-01f, -5.994372964e-01f, 8.004217148e-01f, 3.202570081e-01f, 9.473307133e-01f, 7.648422122e-01f, 6.442176700e-01f, 9.235194325e-01f, 3.835515678e-01f, 9.755998850e-01f, 2.195560932e-01f, 9.922624230e-01f, 1.241583377e-01f, 9.975510240e-01f, 6.994284689e-02f, 9.992253184e-01f, 3.935372457e-02f, 9.997550249e-01f, 2.213413455e-02f, 9.999225140e-01f, 1.244763471e-02f,
-3.090227246e-01f, 9.510546327e-01f, -6.102110744e-01f, 7.922388911e-01f, -8.955979943e-01f, -4.448643327e-01f, 9.982355237e-01f, 5.937835947e-02f, 6.845467091e-01f, 7.289689779e-01f, -6.592084765e-01f, -7.519602180e-01f, -6.244450212e-01f, 7.810688019e-01f, 3.033610582e-01f, 9.528756738e-01f, 7.583618760e-01f, 6.518337727e-01f, 9.213479757e-01f, 3.887388110e-01f, 9.749007225e-01f, 2.226400971e-01f, 9.920400381e-01f, 1.259226501e-01f, 9.974805713e-01f, 7.094036788e-02f, 9.992030263e-01f, 3.991562501e-02f, 9.997479320e-01f, 2.245028317e-02f, 9.999203086e-01f, 1.262544841e-02f,
-9.672505856e-01f, 2.538233697e-01f, -9.386403561e-01f, 3.448974490e-01f, -7.128450871e-01f, -7.013215423e-01f, 9.719900489e-01f, 2.350219339e-01f, 6.083510518e-01f, 7.936680317e-01f, -6.159027219e-01f, -7.878221869e-01f, -6.488281488e-01f, 7.609349489e-01f, 2.863692045e-01f, 9.581193328e-01f, 7.518057823e-01f, 6.593846679e-01f, 9.191473722e-01f, 3.939137757e-01f, 9.741917849e-01f, 2.257218957e-01f, 9.918145537e-01f, 1.276865751e-01f, 9.974091053e-01f, 7.193781435e-02f, 9.991804361e-01f, 4.047751427e-02f, 9.997408390e-01f, 2.276643179e-02f, 9.999180436e-01f, 1.280326117e-02f,
-7.361927032e-01f, -6.767719388e-01f, -9.779862761e-01f, -2.086692750e-01f, -4.593983889e-01f, -8.882303238e-01f, 9.150884748e-01f, 4.032530487e-01f, 5.260773301e-01f, 8.504367471e-01f, -5.706502199e-01f, -8.211932182e-01f, -6.725627184e-01f, 7.400401235e-01f, 2.692867517e-01f, 9.630600214e-01f, 7.451744676e-01f, 6.668695807e-01f, 9.169177413e-01f, 3.990762532e-01f, 9.734731317e-01f, 2.288014293e-01f, 9.915859103e-01f, 1.294501126e-01f, 9.973366857e-01f, 7.293518633e-02f, 9.991575480e-01f, 4.103938490e-02f, 9.997335672e-01f, 2.308257483e-02f, 9.999157190e-01f, 1.298107579e-02f,
1.717173457e-01f, -9.851462841e-01f, -7.161304951e-01f, -6.979663968e-01f, -1.603949666e-01f, -9.870529175e-01f, 8.293254972e-01f, 5.587657690e-01f, 4.385472536e-01f, 8.987081051e-01f, -5.235932469e-01f, -8.519684076e-01f, -6.956245899e-01f, 7.184054852e-01f, 2.521191835e-01f, 9.676961899e-01f, 7.384685278e-01f, 6.742879152e-01f, 9.146590829e-01f, 4.042260945e-01f, 9.727447033e-01f, 2.318786681e-01f, 9.913541675e-01f, 1.312132180e-01f, 9.972632527e-01f, 7.393248379e-02f, 9.991343021e-01f, 4.160124436e-02f, 9.997262359e-01f, 2.339871787e-02f, 9.999133945e-01f, 1.315888762e-02f,
9.217512608e-01f, -3.877816498e-01f, -2.337207645e-01f, -9.723037481e-01f, 1.545165181e-01f, -9.879902005e-01f, 7.174060345e-01f, 6.966552734e-01f, 3.466353416e-01f, 9.379999638e-01f, -4.748813212e-01f, -8.800498247e-01f, -7.179910541e-01f, 6.960523129e-01f, 2.348718494e-01f, 9.720263481e-01f, 7.316888571e-01f, 6.816387773e-01f, 9.123715162e-01f, 4.093632102e-01f, 9.720066190e-01f, 2.349535823e-01f, 9.911192656e-01f, 1.329759061e-01f, 9.971888065e-01f, 7.492970675e-02f, 9.991107583e-01f, 4.216309637e-02f, 9.997187853e-01f, 2.371485718e-02f, 9.999110699e-01f, 1.333669946e-02f,
8.243313432e-01f, 5.661076307e-01f, 3.206739426e-01f, -9.471896291e-01f, 4.541028738e-01f, -8.909492493e-01f, 5.828598738e-01f, 8.125726581e-01f, 2.512599528e-01f, 9.679196477e-01f, -4.246677160e-01f, -9.053493142e-01f, -7.396394610e-01f, 6.730033755e-01f, 2.175502628e-01f, 9.760491252e-01f, 7.248359919e-01f, 6.889214516e-01f, 9.100551009e-01f, 4.144873321e-01f, 9.712587595e-01f, 2.380261570e-01f, 9.908812046e-01f, 1.347381920e-01f, 9.971134067e-01f, 7.592686266e-02f, 9.990868568e-01f, 4.272492975e-02f, 9.997112155e-01f, 2.403099649e-02f, 9.999086857e-01f, 1.351451222e-02f,
-3.097503260e-02f, 9.995201826e-01f, 7.763037086e-01f, -6.303589940e-01f, 7.086563706e-01f, -7.055538297e-01f, 4.299306870e-01f, 9.028618932e-01f, 1.533735693e-01f, 9.881682992e-01f, -3.731119633e-01f, -9.277863503e-01f, -7.605484128e-01f, 6.492812634e-01f, 2.001598924e-01f, 9.797632694e-01f, 7.179107070e-01f, 6.961352229e-01f, 9.077098370e-01f, 4.195984006e-01f, 9.705011845e-01f, 2.410963625e-01f, 9.906400442e-01f, 1.365000308e-01f, 9.970369935e-01f, 7.692394406e-02f, 9.990627170e-01f, 4.328674823e-02f, 9.997035861e-01f, 2.434713021e-02f, 9.999062419e-01f, 1.369232405e-02f,
-8.578031063e-01f, 5.139784217e-01f, 9.928478599e-01f, -1.193865910e-01f, 8.929339647e-01f, -4.501876533e-01f, 2.634407580e-01f, 9.646756053e-01f, 5.395522714e-02f, 9.985433817e-01f, -3.203761876e-01f, -9.472904205e-01f, -7.806967497e-01f, 6.249100566e-01f, 1.827063411e-01f, 9.831675291e-01f, 7.109135985e-01f, 7.032793760e-01f, 9.053359628e-01f, 4.246961474e-01f, 9.697338939e-01f, 2.441641390e-01f, 9.903957844e-01f, 1.382614523e-01f, 9.969595671e-01f, 7.792093605e-02f, 9.990381598e-01f, 4.384855926e-02f, 9.996958375e-01f, 2.466326393e-02f, 9.999037981e-01f, 1.387013402e-02f,
-8.959709406e-01f, -4.441126585e-01f, 9.036121368e-01f, 4.283516109e-01f, 9.886589646e-01f, -1.501781940e-01f, 8.864288777e-02f, 9.960634708e-01f, -4.600222036e-02f, 9.989413619e-01f, -2.666280270e-01f, -9.637995362e-01f, -8.000645638e-01f, 5.999138951e-01f, 1.651948988e-01f, 9.862609506e-01f, 7.038453221e-01f, 7.103532553e-01f, 9.029334188e-01f, 4.297804832e-01f, 9.689569473e-01f, 2.472294867e-01f, 9.901483059e-01f, 1.400224417e-01f, 9.968811274e-01f, 7.891785353e-02f, 9.990133643e-01f, 4.441035166e-02f, 9.996879697e-01f, 2.497939393e-02f, 9.999012947e-01f, 1.404794492e-02f,
-1.103872433e-01f, -9.938886762e-01f, 5.360818505e-01f, 8.441659808e-01f, 9.863393307e-01f, 1.647261530e-01f, -8.895073086e-02f, 9.960360527e-01f, -1.455000341e-01f, 9.893582463e-01f, -2.120364457e-01f, -9.772617817e-01f, -8.186323047e-01f, 5.743179917e-01f, 1.476312131e-01f, 9.890424609e-01f, 6.967067122e-01f, 7.173560858e-01f, 9.005023241e-01f, 4.348512292e-01f, 9.681702852e-01f, 2.502923310e-01f, 9.898977876e-01f, 1.417829692e-01f, 9.968017340e-01f, 7.991469651e-02f, 9.989882708e-01f, 4.497213289e-02f, 9.996800423e-01f, 2.529552206e-02f, 9.998987913e-01f, 1.422575582e-02f,
7.766859531e-01f, -6.298879981e-01f, 3.445185488e-03f, 9.999940395e-01f, 8.862052560e-01f, 4.632928669e-01f, -2.637388706e-01f, 9.645941257e-01f, -2.435445338e-01f, 9.698897004e-01f, -1.567750126e-01f, -9.876343608e-01f, -8.363815546e-01f, 5.481476784e-01f, 1.300208420e-01f, 9.915112853e-01f, 6.894984245e-01f, 7.242871523e-01f, 8.980427384e-01f, 4.399082065e-01f, 9.673739672e-01f, 2.533527315e-01f, 9.896440506e-01f, 1.435430646e-01f, 9.967212677e-01f, 8.091145754e-02f, 9.989628196e-01f, 4.553389549e-02f, 9.996719956e-01f, 2.561164647e-02f, 9.998962879e-01f, 1.440356486e-02f,
9.496777058e-01f, 3.132287860e-01f, -5.302492976e-01f, 8.478417993e-01f, 6.981857419e-01f, 7.159166336e-01f, -4.302088320e-01f, 9.027293921e-01f, -3.391546607e-01f, 9.407306314e-01f, -1.010174751e-01f, -9.948846698e-01f, -8.532945514e-01f, 5.214292407e-01f, 1.123693660e-01f, 9.936665297e-01f, 6.822211742e-01f, 7.311458588e-01f, 8.955547810e-01f, 4.449512959e-01f, 9.665679932e-01f, 2.564105392e-01f, 9.893872738e-01f, 1.453027129e-01f, 9.966399074e-01f, 8.190813661e-02f, 9.989370108e-01f, 4.609564692e-02f, 9.996638298e-01f, 2.592777088e-02f, 9.998936653e-01f, 1.458137389e-02f,
2.495401055e-01f, 9.683644772e-01f, -9.006391764e-01f, 4.345676303e-01f, 4.409287572e-01f, 8.975421190e-01f, -5.831102729e-01f, 8.123930097e-01f, -4.313769937e-01f, 9.021717310e-01f, -4.494105279e-02f, -9.989896417e-01f, -8.693541884e-01f, 4.941895902e-01f, 9.468235075e-02f, 9.955075383e-01f, 6.748757362e-01f, 7.379313707e-01f, 8.930384517e-01f, 4.499803185e-01f, 9.657523036e-01f, 2.594658434e-01f, 9.891272783e-01f, 1.470618844e-01f, 9.965574741e-01f, 8.290474117e-02f, 9.989109635e-01f, 4.665738344e-02f, 9.996555448e-01f, 2.624388970e-02f, 9.998911023e-01f, 1.475918386e-02f,
-6.800234914e-01f, 7.331902981e-01f, -9.936468601e-01f, -1.125427037e-01f, 1.399453431e-01f, 9.901592135e-01f, -7.176206112e-01f, 6.964342594e-01f, -5.192891359e-01f, 8.545985818e-01f, 1.127792522e-02f, -9.999364018e-01f, -8.845446110e-01f, 4.664555788e-01f, 7.696539164e-02f, 9.970337749e-01f, 6.674628258e-01f, 7.446430922e-01f, 8.904939294e-01f, 4.549950957e-01f, 9.649269581e-01f, 2.625184953e-01f, 9.888642430e-01f, 1.488205791e-01f, 9.964740872e-01f, 8.390125632e-02f, 9.988845587e-01f, 4.721910506e-02f, 9.996472001e-01f, 2.656000853e-02f, 9.998884201e-01f, 1.493699197e-02f,
-9.843766689e-01f, -1.760756075e-01f, -7.806286812e-01f, -6.249951124e-01f, -1.749181598e-01f, 9.845829606e-01f, -8.294976354e-01f, 5.585102439e-01f, -6.020119190e-01f, 7.984871268e-01f, 6.746077538e-02f, -9.977219105e-01f, -8.988505006e-01f, 4.382553995e-01f, 5.922409892e-02f, 9.982447028e-01f, 6.599831581e-01f, 7.512803674e-01f, 8.879212737e-01f, 4.599954784e-01f, 9.640919566e-01f, 2.655685544e-01f, 9.885979891e-01f, 1.505788416e-01f, 9.963896871e-01f, 8.489768207e-02f, 9.988578558e-01f, 4.778081179e-02f, 9.996387959e-01f, 2.687612176e-02f, 9.998857379e-01f, 1.511479914e-02f,
-3.836984336e-01f, -9.234584570e-01f, -3.271927834e-01f, -9.449576139e-01f, -4.724333286e-01f, 8.813664317e-01f, -9.152126908e-01f, 4.029710889e-01f, -6.787203550e-01f, 7.343968153e-01f, 1.234308258e-01f, -9.923532009e-01f, -9.122576714e-01f, 4.096167684e-01f, 4.146407545e-02f, 9.991400242e-01f, 6.524375081e-01f, 7.578425407e-01f, 8.853204846e-01f, 4.649813473e-01f, 9.632473588e-01f, 2.686159313e-01f, 9.883286953e-01f, 1.523365974e-01f, 9.963042736e-01f, 8.589403331e-02f, 9.988307953e-01f, 4.834250361e-02f, 9.996302128e-01f, 2.719223499e-02f, 9.998830557e-01f, 1.529260725e-02f,
5.697503090e-01f, -8.218178153e-01f, 2.270120084e-01f, -9.738919735e-01f, -7.230991125e-01f, 6.907442808e-01f, -9.720626473e-01f, 2.347215265e-01f, -7.486464977e-01f, 6.629694104e-01f, 1.790106595e-01f, -9.838471413e-01f, -9.247525930e-01f, 3.805688024e-01f, 2.369106375e-02f, 9.997193217e-01f, 6.448265314e-01f, 7.643289566e-01f, 8.826917410e-01f, 4.699524939e-01f, 9.623931050e-01f, 2.716606259e-01f, 9.880561829e-01f, 1.540938765e-01f, 9.962179065e-01f, 8.689029515e-02f, 9.988034964e-01f, 4.890418053e-02f, 9.996215701e-01f, 2.750834450e-02f, 9.998803139e-01f, 1.547041349e-02f,
9.993732572e-01f, 3.539830074e-02f, 7.113042474e-01f, -7.028842568e-01f, -9.020542502e-01f, 4.316227138e-01f, -9.982538819e-01f, 5.906983837e-02f, -8.110930920e-01f, 5.849170685e-01f, 2.340240777e-01f, -9.722307920e-01f, -9.363229275e-01f, 3.511400521e-01f, 5.910437554e-03f, 9.999825358e-01f, 6.371511221e-01f, 7.707388997e-01f, 8.800350428e-01f, 4.749087691e-01f, 9.615292549e-01f, 2.747026384e-01f, 9.877806306e-01f, 1.558506787e-01f, 9.961305261e-01f, 8.788647503e-02f, 9.987758398e-01f, 4.946583882e-02f, 9.996128082e-01f, 2.782445215e-02f, 9.998775721e-01f, 1.564821973e-02f,
5.101770163e-01f, 8.600693941e-01f, 9.765252471e-01f, -2.154029608e-01f, -9.915538430e-01f, 1.296956539e-01f, -9.929606318e-01f, -1.184448823e-01f, -8.654354811e-01f, 5.010203719e-01f, 2.882981002e-01f, -9.575406909e-01f, -9.469569325e-01f, 3.213604093e-01f, -1.187205687e-02f, 9.999295473e-01f, 6.294120550e-01f, 7.770717740e-01f, 8.773505092e-01f, 4.798500240e-01f, 9.606557488e-01f, 2.777418792e-01f, 9.875019193e-01f, 1.576069742e-01f, 9.960421324e-01f, 8.888255060e-02f, 9.987478256e-01f, 5.002748594e-02f, 9.996039867e-01f, 2.814055420e-02f, 9.998747706e-01f, 1.582602598e-02f,
-4.480736256e-01f, 8.939966559e-01f, 9.409945607e-01f, 3.384217024e-01f, -9.827213287e-01f, -1.850914657e-01f, -9.563499093e-01f, -2.922239304e-01f, -9.111302495e-01f, 4.121184647e-01f, 3.416602314e-01f, -9.398235083e-01f, -9.566441774e-01f, 2.912592292e-01f, -2.965079620e-02f, 9.995602965e-01f, 6.216099858e-01f, 7.833269238e-01f, 8.746382594e-01f, 4.847761393e-01f, 9.597726464e-01f, 2.807783484e-01f, 9.872201085e-01f, 1.593627781e-01f, 9.959527254e-01f, 8.987855166e-02f, 9.987195730e-01f, 5.058911443e-02f, 9.995950460e-01f, 2.845665626e-02f, 9.998719096e-01f, 1.600383036e-02f,
-9.943674803e-01f, 1.059875116e-01f, 6.156554222e-01f, 7.880154848e-01f, -8.764333129e-01f, -4.815232456e-01f, -8.895764351e-01f, -4.567863345e-01f, -9.477217197e-01f, 3.190979958e-01f, 3.939426839e-01f, -9.191350341e-01f, -9.653747678e-01f, 2.608670294e-01f, -4.742016271e-02f, 9.988750219e-01f, 6.137457490e-01f, 7.895037532e-01f, 8.718983531e-01f, 4.896869063e-01f, 9.588799477e-01f, 2.838120162e-01f, 9.869351387e-01f, 1.611180753e-01f, 9.958623648e-01f, 9.087446332e-02f, 9.986909628e-01f, 5.115072429e-02f, 9.995859861e-01f, 2.877275459e-02f, 9.998690486e-01f, 1.618163660e-02f,
-6.264444590e-01f, -7.794660926e-01f, 1.007066220e-01f, 9.949161410e-01f, -6.832289696e-01f, -7.302041650e-01f, -7.947461605e-01f, -6.069419384e-01f, -9.748435616e-01f, 2.228900939e-01f, 4.449792802e-01f, -8.955408931e-01f, -9.731400609e-01f, 2.302137464e-01f, -6.517452747e-02f, 9.978739023e-01f, 6.058201790e-01f, 7.956016064e-01f, 8.691309094e-01f, 4.945821762e-01f, 9.579776525e-01f, 2.868428528e-01f, 9.866470695e-01f, 1.628728807e-01f, 9.957709908e-01f, 9.187027812e-02f, 9.986619949e-01f, 5.171232671e-02f, 9.995768070e-01f, 2.908885106e-02f, 9.998661876e-01f, 1.635944098e-02f,
3.174287081e-01f, -9.482821226e-01f, -4.452612102e-01f, 8.954007030e-01f, -4.222704768e-01f, -9.064698815e-01f, -6.748499870e-01f, -7.379549146e-01f, -9.922253489e-01f, 1.244542375e-01f, 4.946095049e-01f, -8.691152930e-01f, -9.799323082e-01f, 1.993305236e-01f, -8.290828764e-02f, 9.965571761e-01f, 5.978339314e-01f, 8.016199470e-01f, 8.663359284e-01f, 4.994617999e-01f, 9.570658207e-01f, 2.898707688e-01f, 9.863558412e-01f, 1.646271497e-01f, 9.956786036e-01f, 9.286600351e-02f, 9.986327887e-01f, 5.227390677e-02f, 9.995675683e-01f, 2.940494195e-02f, 9.998632669e-01f, 1.653724350e-02f,
9.694593549e-01f, -2.452519834e-01f, -8.540936708e-01f, 5.201192498e-01f, -1.194339693e-01f, -9.928421378e-01f, -5.336694121e-01f, -8.456931710e-01f, -9.996930361e-01f, 2.477485314e-02f, 5.426756740e-01f, -8.399423361e-01f, -9.857447147e-01f, 1.682477444e-01f, -1.006158292e-01f, 9.949253798e-01f, 5.897880197e-01f, 8.075581193e-01f, 8.635135293e-01f, 5.043256879e-01f, 9.561443329e-01f, 2.928958237e-01f, 9.860615730e-01f, 1.663808972e-01f, 9.955852628e-01f, 9.386163205e-02f, 9.986032248e-01f, 5.283546820e-02f, 9.995582104e-01f, 2.972103283e-02f, 9.998602867e-01f, 1.671504788e-02f,
7.301735282e-01f, 6.832616925e-01f, -9.998821616e-01f, -1.535241678e-02f, 1.952449679e-01f, -9.807544947e-01f, -3.756571114e-01f, -9.267587066e-01f, -9.971721768e-01f, -7.515111566e-02f, 5.890265703e-01f, -8.081136942e-01f, -9.905714393e-01f, 1.369969547e-01f, -1.182915568e-01f, 9.929789305e-01f, 5.816830993e-01f, 8.134155273e-01f, 8.606638908e-01f, 5.091735721e-01f, 9.552133679e-01f, 2.959179580e-01f, 9.857641459e-01f, 1.681341380e-01f, 9.954909086e-01f, 9.485717118e-02f, 9.985733628e-01f, 5.339701846e-02f, 9.995487928e-01f, 3.003711812e-02f, 9.998573065e-01f, 1.689285226e-02f,
-1.804304570e-01f, 9.835877419e-01f, -8.377248049e-01f, -5.460926294e-01f, 4.905616641e-01f, -8.714064956e-01f, -2.057968229e-01f, -9.785947204e-01f, -9.846878052e-01f, -1.743271649e-01f, 6.335148811e-01f, -7.737304568e-01f, -9.944077134e-01f, 1.056089550e-01f, -1.359298676e-01f, 9.907184839e-01f, 5.735200047e-01f, 8.191915751e-01f, 8.577870131e-01f, 5.140053630e-01f, 9.542728066e-01f, 2.989371121e-01f, 9.854635596e-01f, 1.698868275e-01f, 9.953955412e-01f, 9.585261345e-02f, 9.985432029e-01f, 5.395854637e-02f, 9.995392561e-01f, 3.035320155e-02f, 9.998542666e-01f, 1.707065292e-02f,
-9.251475334e-01f, 3.796077371e-01f, -4.175648987e-01f, -9.086471200e-01f, 7.372311950e-01f, -6.756405830e-01f, -2.944579907e-02f, -9.995663762e-01f, -9.623649120e-01f, -2.717604339e-01f, 6.760007739e-01f, -7.369009256e-01f, -9.972496629e-01f, 7.411535084e-02f, -1.535250843e-01f, 9.881447554e-01f, 5.652995706e-01f, 8.248857260e-01f, 8.548829556e-01f, 5.188208818e-01f, 9.533227086e-01f, 3.019533157e-01f, 9.851599336e-01f, 1.716389805e-01f, 9.952991605e-01f, 9.684795886e-02f, 9.985126853e-01f, 5.452005938e-02f, 9.995296001e-01f, 3.066928312e-02f, 9.998512268e-01f, 1.724845544e-02f,
-8.192882538e-01f, -5.733818412e-01f, 1.312005073e-01f, -9.913558364e-01f, 9.107885361e-01f, -4.128731191e-01f, 1.478339285e-01f, -9.890121818e-01f, -9.304261804e-01f, -3.664793074e-01f, 7.163491845e-01f, -6.977419257e-01f, -9.990944266e-01f, 4.254788160e-02f, -1.710718721e-01f, 9.852585793e-01f, 5.570225716e-01f, 8.304973245e-01f, 8.519519567e-01f, 5.236200094e-01f, 9.523630738e-01f, 3.049664497e-01f, 9.848531485e-01f, 1.733906120e-01f, 9.952018261e-01f, 9.784321487e-02f, 9.984818697e-01f, 5.508155748e-02f, 9.995198250e-01f, 3.098535910e-02f, 9.998481274e-01f, 1.742625609e-02f,
3.982087970e-02f, -9.992068410e-01f, 6.395553350e-01f, -7.687450647e-01f, 9.940242171e-01f, -1.091595069e-01f, 3.204510510e-01f, -9.472650886e-01f, -8.891909122e-01f, -4.575363994e-01f, 7.544332147e-01f, -6.563767791e-01f, -9.999401569e-01f, 1.093762368e-02f, -1.885645688e-01f, 9.820607901e-01f, 5.486899018e-01f, 8.360259533e-01f, 8.489939570e-01f, 5.284025669e-01f, 9.513939619e-01f, 3.079765737e-01f, 9.845432639e-01f, 1.751416773e-01f, 9.951034784e-01f, 9.883836657e-02f, 9.984506965e-01f, 5.564303696e-02f, 9.995099902e-01f, 3.130143136e-02f, 9.998450279e-01f, 1.760405675e-02f,
8.623188734e-01f, -5.063656569e-01f, 9.509409070e-01f, -3.093724847e-01f, 9.786828160e-01f, 2.053775787e-01f, 4.829612970e-01f, -8.756417036e-01f, -8.390715122e-01f, -5.440210700e-01f, 7.901318669e-01f, -6.129369140e-01f, -9.997860789e-01f, -2.068333142e-02f, -2.059976310e-01f, 9.785524607e-01f, 5.403022766e-01f, 8.414710164e-01f, 8.460091352e-01f, 5.331684351e-01f, 9.504152536e-01f, 3.109835982e-01f, 9.842302203e-01f, 1.768921912e-01f, 9.950041771e-01f, 9.983342141e-02f, 9.984192848e-01f, 5.620449409e-02f, 9.995000362e-01f, 3.161750361e-02f, 9.998418689e-01f, 1.778185740e-02f,
8.920048475e-01f, 4.520258009e-01f, 9.694527388e-01f, 2.452782542e-01f, 8.662855029e-01f, 4.995492697e-01f, 6.302406788e-01f, -7.763997912e-01f, -7.805679440e-01f, -6.250709295e-01f, 8.233328462e-01f, -5.675588250e-01f, -9.986322522e-01f, -5.228384212e-02f, -2.233655602e-01f, 9.747347236e-01f, 5.318607092e-01f, 8.468318582e-01f, 8.429974914e-01f, 5.379174352e-01f, 9.494271278e-01f, 3.139874935e-01f, 9.839141369e-01f, 1.786421537e-01f, 9.949038625e-01f, 1.008283719e-01f, 9.983875155e-01f, 5.676594004e-02f, 9.994900227e-01f, 3.193357214e-02f, 9.998387098e-01f, 1.795965619e-02f,
1.015857086e-01f, 9.948267937e-01f, 6.893923283e-01f, 7.243881822e-01f, 6.679785848e-01f, 7.441805601e-01f, 7.576409578e-01f, -6.526715755e-01f, -7.142657638e-01f, -6.998745203e-01f, 8.539305925e-01f, -5.203868747e-01f, -9.964799285e-01f, -8.383183926e-02f, -2.406628430e-01f, 9.706087708e-01f, 5.233659744e-01f, 8.521080017e-01f, 8.399593234e-01f, 5.426494479e-01f, 9.484294653e-01f, 3.169882894e-01f, 9.835948944e-01f, 1.803915352e-01f, 9.948025346e-01f, 1.018232331e-01f, 9.983554482e-01f, 5.732736737e-02f, 9.994798303e-01f, 3.224964067e-02f, 9.998354912e-01f, 1.813745499e-02f,
-7.822308540e-01f, 6.229886413e-01f, 1.970090568e-01f, 9.804016948e-01f, 4.034298062e-01f, 9.150105715e-01f, 8.611455560e-01f, -5.083584189e-01f, -6.408262849e-01f, -7.676859498e-01f, 8.818289638e-01f, -4.715693891e-01f, -9.933311343e-01f, -1.152962446e-01f, -2.578840256e-01f, 9.661758542e-01f, 5.148188472e-01f, 8.572989702e-01f, 8.368944526e-01f, 5.473642945e-01f, 9.474223256e-01f, 3.199858963e-01f, 9.832725525e-01f, 1.821403503e-01f, 9.947001934e-01f, 1.028179824e-01f, 9.983230233e-01f, 5.788877234e-02f, 9.994695783e-01f, 3.256569803e-02f, 9.998322725e-01f, 1.831525378e-02f,
-9.468680024e-01f, -3.216224015e-01f, -3.560463190e-01f, 9.344683290e-01f, 9.887336940e-02f, 9.951000214e-01f, 9.374901056e-01f, -3.480119109e-01f, -5.609837770e-01f, -8.278267980e-01f, 9.069392681e-01f, -4.212614298e-01f, -9.891891479e-01f, -1.466451287e-01f, -2.750236690e-01f, 9.614374638e-01f, 5.062202811e-01f, 8.624042273e-01f, 8.338031769e-01f, 5.520617962e-01f, 9.464057088e-01f, 3.229803145e-01f, 9.829471111e-01f, 1.838885993e-01f, 9.945968986e-01f, 1.038126275e-01f, 9.982903004e-01f, 5.845016241e-02f, 9.994592667e-01f, 3.288175911e-02f, 9.998289943e-01f, 1.849305071e-02f,
-2.409590483e-01f, -9.705352783e-01f, -7.994487882e-01f, 6.007342339e-01f, -2.154882401e-01f, 9.765064120e-01f, 9.842666984e-01f, -1.766892821e-01f, -4.755369425e-01f, -8.796957731e-01f, 9.291825294e-01f, -3.696212471e-01f, -9.840580225e-01f, -1.778476238e-01f, -2.920763195e-01f, 9.563950300e-01f, 4.975710809e-01f, 8.674232364e-01f, 8.306855559e-01f, 5.567418337e-01f, 9.453796148e-01f, 3.259714842e-01f, 9.826185107e-01f, 1.856362671e-01f, 9.944925904e-01f, 1.048071757e-01f, 9.982572794e-01f, 5.901153386e-02f, 9.994487762e-01f, 3.319781274e-02f, 9.998256564e-01f, 1.867084950e-02f,
6.864865422e-01f, -7.271425128e-01f, -9.966333508e-01f, 8.198728412e-02f, -5.084800720e-01f, 8.610737324e-01f, 1.000000000e+00f, 2.060413535e-04f, -3.853378594e-01f, -9.227755666e-01f, 9.484879971e-01f, -3.168129921e-01f, -9.779430032e-01f, -2.088720351e-01f, -3.090365231e-01f, 9.510501623e-01f, 4.888721108e-01f, 8.723554611e-01f, 8.275416493e-01f, 5.614042878e-01f, 9.443440437e-01f, 3.289594054e-01f, 9.822868705e-01f, 1.873833388e-01f, 9.943872690e-01f, 1.058016121e-01f, 9.982239604e-01f, 5.957288295e-02f, 9.994382262e-01f, 3.351386636e-02f, 9.998223782e-01f, 1.884864643e-02f,
9.827795625e-01f, 1.847817302e-01f, -8.868746758e-01f, -4.620101154e-01f, -7.510490417e-01f, 6.602464318e-01f, 9.841938019e-01f, 1.770948619e-01f, -2.912894785e-01f, -9.566349387e-01f, 9.647951126e-01f, -2.630026639e-01f, -9.708499908e-01f, -2.396878302e-01f, -3.258991241e-01f, 9.454045296e-01f, 4.801242650e-01f, 8.772004843e-01f, 8.243715763e-01f, 5.660489798e-01f, 9.432991147e-01f, 3.319440186e-01f, 9.819520712e-01f, 1.891298145e-01f, 9.942809343e-01f, 1.067959517e-01f, 9.981902838e-01f, 6.013421714e-02f, 9.994276166e-01f, 3.382991254e-02f, 9.998189807e-01f, 1.902644150e-02f,
3.755095899e-01f, 9.268184900e-01f, -5.039728284e-01f, -8.637195230e-01f, -9.191339612e-01f, 3.939450979e-01f, 9.373466372e-01f, 3.483982384e-01f, -1.943297088e-01f, -9.809362888e-01f, 9.780520201e-01f, -2.083608955e-01f, -9.627863169e-01f, -2.702637315e-01f, -3.426586390e-01f, 9.394599795e-01f, 4.713284373e-01f, 8.819577694e-01f, 8.211753964e-01f, 5.706758499e-01f, 9.422446489e-01f, 3.349253237e-01f, 9.816142321e-01f, 1.908757091e-01f, 9.941736460e-01f, 1.077901721e-01f, 9.981563091e-01f, 6.069553271e-02f, 9.994168282e-01f, 3.414595872e-02f, 9.998155832e-01f, 1.920423657e-02f,
-5.770022273e-01f, 8.167425990e-01f, 3.414078429e-02f, -9.994170070e-01f, -9.960693717e-01f, 8.857665956e-02f, 8.609359860e-01f, 5.087132454e-01f, -9.542828053e-02f, -9.954363108e-01f, 9.882167578e-01f, -1.530608535e-01f, -9.537598491e-01f, -3.005696237e-01f, -3.593098223e-01f, 9.332183003e-01f, 4.624853432e-01f, 8.866268992e-01f, 8.179532886e-01f, 5.752846003e-01f, 9.411808252e-01f, 3.379032910e-01f, 9.812732339e-01f, 1.926209927e-01f, 9.940654039e-01f, 1.087842956e-01f, 9.981220365e-01f, 6.125682592e-02f, 9.994059801e-01f, 3.446200117e-02f, 9.998121262e-01f, 1.938203163e-02f,
-9.990208149e-01f, -4.424267635e-02f, 5.617429614e-01f, -8.273118138e-01f, -9.742255807e-01f, -2.255758345e-01f, 7.573719025e-01f, 6.529837251e-01f, 4.425697960e-03f, -9.999902248e-01f, 9.952573776e-01f, -9.727646410e-02f, -9.437798262e-01f, -3.305747509e-01f, -3.758473992e-01f, 9.266815782e-01f, 4.535961151e-01f, 8.912073374e-01f, 8.147053123e-01f, 5.798751712e-01f, 9.401075840e-01f, 3.408778608e-01f, 9.809291363e-01f, 1.943656504e-01f, 9.939560890e-01f, 1.097783074e-01f, 9.980874062e-01f, 6.181810424e-02f, 9.993950725e-01f, 3.477803990e-02f, 9.998086691e-01f, 1.955982484e-02f,
-5.025443435e-01f, -8.645514250e-01f, 9.163355827e-01f, -4.004111886e-01f, -8.557689190e-01f, -5.173581839e-01f, 6.299206614e-01f, 7.766594887e-01f, 1.042364091e-01f, -9.945525527e-01f, 9.991515279e-01f, -4.118499532e-02f, -9.328559637e-01f, -3.602495193e-01f, -3.922660947e-01f, 9.198517799e-01f, 4.446615279e-01f, 8.956986666e-01f, 8.114315867e-01f, 5.844473839e-01f, 9.390249252e-01f, 3.438490629e-01f, 9.805819392e-01f, 1.961097270e-01f, 9.938458204e-01f, 1.107722074e-01f, 9.980525374e-01f, 6.237935647e-02f, 9.993839860e-01f, 3.509407118e-02f, 9.998052120e-01f, 1.973761991e-02f,
4.559690952e-01f, -8.899955750e-01f, 9.887145162e-01f, 1.498119384e-01f, -6.524437070e-01f, -7.578372359e-01f, 4.826020896e-01f, 8.758397102e-01f, 2.030046880e-01f, -9.791777730e-01f, 9.998869300e-01f, 1.503714453e-02f, -9.209993482e-01f, -3.895640969e-01f, -4.085607529e-01f, 9.127311110e-01f, 4.356824458e-01f, 9.001004100e-01f, 8.081322312e-01f, 5.890011191e-01f, 9.379329085e-01f, 3.468167782e-01f, 9.802316427e-01f, 1.978531629e-01f, 9.937345386e-01f, 1.117659956e-01f, 9.980172515e-01f, 6.294059008e-02f, 9.993728399e-01f, 3.541010246e-02f, 9.998016953e-01f, 1.991541311e-02f,
9.952666163e-01f, -9.718190879e-02f, 7.565875053e-01f, 6.538924575e-01f, -3.844182491e-01f, -9.231590629e-01f, 3.200624883e-01f, 9.473964572e-01f, 2.997455299e-01f, -9.540191889e-01f, 9.974612594e-01f, 7.121126354e-02f, -9.082219005e-01f, -4.184889197e-01f, -4.247261286e-01f, 9.053218961e-01f, 4.266598225e-01f, 9.044122100e-01f, 8.048072457e-01f, 5.935363173e-01f, 9.368314743e-01f, 3.497810662e-01f, 9.798783064e-01f, 1.995959580e-01f, 9.936223030e-01f, 1.127596796e-01f, 9.979817271e-01f, 6.350180507e-02f, 9.993616343e-01f, 3.572613373e-02f, 9.997981191e-01f, 2.009320445e-02f,
6.195206046e-01f, 7.849804163e-01f, 2.914465666e-01f, 9.565871358e-01f, -7.827047259e-02f, -9.969321489e-01f, 1.474282593e-01f, 9.890727401e-01f, 3.934913874e-01f, -9.193283319e-01f, 9.918821454e-01f, 1.271607429e-01f, -8.945361972e-01f, -4.469954967e-01f, -4.407573938e-01f, 8.976262808e-01f, 4.175945222e-01f, 9.086334705e-01f, 8.014568090e-01f, 5.980526209e-01f, 9.357206821e-01f, 3.527418077e-01f, 9.795218110e-01f, 2.013381571e-01f, 9.935090542e-01f, 1.137532443e-01f, 9.979458451e-01f, 6.406301260e-02f, 9.993502498e-01f, 3.604215756e-02f, 9.997945428e-01f, 2.027099766e-02f,
-3.258098066e-01f, 9.454353452e-01f, -2.634541392e-01f, 9.646719098e-01f, 2.356393039e-01f, -9.718405604e-01f, -2.985579334e-02f, 9.995542169e-01f, 4.833047390e-01f, -8.754521608e-01f, 9.831672907e-01f, 1.827077270e-01f, -8.799561262e-01f, -4.750549197e-01f, -4.566490650e-01f, 8.896468878e-01f, 4.084874690e-01f, 9.127639532e-01f, 7.980811000e-01f, 6.025500894e-01f, 9.346005321e-01f, 3.556990325e-01f, 9.791622162e-01f, 2.030797005e-01f, 9.933947921e-01f, 1.147466898e-01f, 9.979096651e-01f, 6.462418288e-02f, 9.993388057e-01f, 3.635817394e-02f, 9.997909069e-01f, 2.044878900e-02f,
-9.715921879e-01f, 2.366613895e-01f, -7.372213602e-01f, 6.756513119e-01f, 5.261809826e-01f, -8.503726125e-01f, -2.061982006e-01f, 9.785102606e-01f, 5.682899356e-01f, -8.228283525e-01f, 9.713441133e-01f, 2.376775593e-01f, -8.644961119e-01f, -5.026394725e-01f, -4.723965526e-01f, 8.813861012e-01f, 3.993395865e-01f, 9.168030620e-01f, 7.946801186e-01f, 6.070284247e-01f, 9.334710836e-01f, 3.586527407e-01f, 9.787995219e-01f, 2.048205882e-01f, 9.932795167e-01f, 1.157400310e-01f, 9.978731871e-01f, 6.518533826e-02f, 9.993273020e-01f, 3.667419404e-02f, 9.997872710e-01f, 2.062657848e-02f,
-7.240971923e-01f, -6.896979213e-01f, -9.839316607e-01f, 1.785455495e-01f, 7.645443082e-01f, -6.445711255e-01f, -3.760372102e-01f, 9.266045690e-01f, 6.475961804e-01f, -7.619836926e-01f, 9.564502239e-01f, 2.918955386e-01f, -8.481717706e-01f, -5.297213197e-01f, -4.879944921e-01f, 8.728467226e-01f, 3.901517391e-01f, 9.207505584e-01f, 7.912539840e-01f, 6.114876866e-01f, 9.323322177e-01f, 3.616028130e-01f, 9.784337282e-01f, 2.065608501e-01f, 9.931632876e-01f, 1.167332530e-01f, 9.978363514e-01f, 6.574647129e-02f, 9.993156195e-01f, 3.699020669e-02f, 9.997835755e-01f, 2.080436796e-02f,
1.891294271e-01f, -9.819521904e-01f, -9.276105762e-01f, -3.735487163e-01f, 9.270853400e-01f, -3.748503029e-01f, -5.340162516e-01f, 8.454742432e-01f, 7.204326391e-01f, -6.935249567e-01f, 9.385324121e-01f, 3.451911509e-01f, -8.309991956e-01f, -5.562736392e-01f, -5.034382939e-01f, 8.640311956e-01f, 3.809248805e-01f, 9.246059656e-01f, 7.878028154e-01f, 6.159275174e-01f, 9.311841130e-01f, 3.645493090e-01f, 9.780648947e-01f, 2.083004564e-01f, 9.930460453e-01f, 1.177263632e-01f, 9.977992177e-01f, 6.630758941e-02f, 9.993038774e-01f, 3.730621934e-02f, 9.997798800e-01f, 2.098215744e-02f,
9.284713268e-01f, -3.714041114e-01f, -5.856038332e-01f, -8.105974197e-01f, 9.976883531e-01f, -6.795591116e-02f, -6.751540303e-01f, 7.376767993e-01f, 7.860706449e-01f, -6.181366444e-01f, 9.176476598e-01f, 3.973950148e-01f, -8.129957914e-01f, -5.822695494e-01f, -5.187226534e-01f, 8.549425602e-01f, 3.716599345e-01f, 9.283689260e-01f, 7.843267918e-01f, 6.203478575e-01f, 9.300266504e-01f, 3.674921393e-01f, 9.776929021e-01f, 2.100393921e-01f, 9.929278493e-01f, 1.187193394e-01f, 9.977617860e-01f, 6.686867774e-02f, 9.992920160e-01f, 3.762222081e-02f, 9.997761250e-01f, 2.115994506e-02f,
8.141809702e-01f, 5.806111693e-01f, -6.324278563e-02f, -9.979981780e-01f, 9.693515897e-01f, 2.456775755e-01f, -7.949962020e-01f, 6.066144109e-01f, 8.438539505e-01f, -5.365729332e-01f, 8.938615918e-01f, 4.483429790e-01f, -7.941793799e-01f, -6.076834202e-01f, -5.338430405e-01f, 8.455836177e-01f, 3.623578250e-01f, 9.320390821e-01f, 7.808259130e-01f, 6.247486472e-01f, 9.288598895e-01f, 3.704313040e-01f, 9.773178697e-01f, 2.117776722e-01f, 9.928086400e-01f, 1.197122112e-01f, 9.977239966e-01f, 6.742975861e-02f, 9.992800951e-01f, 3.793822229e-02f, 9.997723103e-01f, 2.133773454e-02f,
-4.866360873e-02f, 9.988152385e-01f, 4.786024988e-01f, -8.780316710e-01f, 8.448832631e-01f, 5.349507332e-01f, -8.897646070e-01f, 4.564197063e-01f, 8.932062984e-01f, -4.496471286e-01f, 8.672499061e-01f, 4.978730977e-01f, -7.745689750e-01f, -6.324894428e-01f, -5.487948060e-01f, 8.359571099e-01f, 3.530194759e-01f, 9.356159568e-01f, 7.773004174e-01f, 6.291296482e-01f, 9.276838303e-01f, 3.733667731e-01f, 9.769397378e-01f, 2.135152817e-01f, 9.926884174e-01f, 1.207049638e-01f, 9.976859689e-01f, 6.799080223e-02f, 9.992680550e-01f, 3.825422376e-02f, 9.997684956e-01f, 2.151552029e-02f,
-8.667671084e-01f, 4.987131655e-01f, 8.730400801e-01f, -4.876484275e-01f, 6.366297007e-01f, 7.711696625e-01f, -9.564702511e-01f, 2.918297648e-01f, 9.336335659e-01f, -3.582294583e-01f, 8.378961682e-01f, 5.458296537e-01f, -7.541838884e-01f, -6.566632986e-01f, -5.635727644e-01f, 8.260664344e-01f, 3.436457217e-01f, 9.390993714e-01f, 7.737502456e-01f, 6.334908009e-01f, 9.264984727e-01f, 3.762984574e-01f, 9.765585065e-01f, 2.152522057e-01f, 9.925672412e-01f, 1.216975898e-01f, 9.976475835e-01f, 6.855183095e-02f, 9.992558956e-01f, 3.857021779e-02f, 9.997646809e-01f, 2.169330604e-02f,
-8.879688978e-01f, -4.599034786e-01f, 9.985986948e-01f, 5.292089656e-02f, 3.652422130e-01f, 9.309124947e-01f, -9.930093288e-01f, 1.180356890e-01f, 9.647326469e-01f, -2.632316053e-01f, 8.058937788e-01f, 5.920601487e-01f, -7.330448627e-01f, -6.801803112e-01f, -5.781728029e-01f, 8.159143329e-01f, 3.342377245e-01f, 9.424887896e-01f, 7.701756358e-01f, 6.378318667e-01f, 9.253038764e-01f, 3.792264462e-01f, 9.761741757e-01f, 2.169884592e-01f, 9.924450517e-01f, 1.226900965e-01f, 9.976088405e-01f, 6.911283731e-02f, 9.992436171e-01f, 3.888620436e-02f, 9.997608066e-01f, 2.187109366e-02f,
-9.277620912e-02f, -9.956870079e-01f, 8.166087270e-01f, 5.771915913e-01f, 5.763408914e-02f, 9.983377457e-01f, -9.982294440e-01f, -5.948119611e-02f, 9.861924052e-01f, -1.656036228e-01f, 7.713432908e-01f, 6.364192963e-01f, -7.111726999e-01f, -7.030173540e-01f, -5.925897360e-01f, 8.055044413e-01f, 3.247962892e-01f, 9.457839727e-01f, 7.665767074e-01f, 6.421527267e-01f, 9.241000414e-01f, 3.821505904e-01f, 9.757867455e-01f, 2.187240422e-01f, 9.923218489e-01f, 1.236824766e-01f, 9.975697994e-01f, 6.967382133e-02f, 9.992312789e-01f, 3.920219466e-02f, 9.997568727e-01f, 2.204887755e-02f,
7.877145410e-01f, -6.160404682e-01f, 3.831194937e-01f, 9.236987829e-01f, -2.556895912e-01f, 9.667589068e-01f, -9.719658494e-01f, -2.351220697e-01f, 9.977982640e-01f, -6.632189453e-02f, 7.343545556e-01f, 6.787660718e-01f, -6.885895729e-01f, -7.251513004e-01f, -6.068195105e-01f, 7.948396206e-01f, 3.153223693e-01f, 9.489846230e-01f, 7.629535198e-01f, 6.464533210e-01f, 9.228869677e-01f, 3.850709498e-01f, 9.753962755e-01f, 2.204589099e-01f, 9.921976924e-01f, 1.246747300e-01f, 9.975304604e-01f, 7.023479044e-02f, 9.992188811e-01f, 3.951817751e-02f, 9.997529387e-01f, 2.222666144e-02f,
9.439841509e-01f, 3.299908042e-01f, -1.683704406e-01f, 9.857237935e-01f, -5.436599255e-01f, 8.393055797e-01f, -9.150469303e-01f, -4.033473432e-01f, 9.994345903e-01f, 3.362342715e-02f, 6.950438619e-01f, 7.189673185e-01f, -6.653177142e-01f, -7.465603352e-01f, -6.208572388e-01f, 7.839236856e-01f, 3.058169186e-01f, 9.520903230e-01f, 7.593061924e-01f, 6.507335305e-01f, 9.216646552e-01f, 3.879874349e-01f, 9.750027061e-01f, 2.221930772e-01f, 9.920725226e-01f, 1.256668717e-01f, 9.974908233e-01f, 7.079573721e-02f, 9.992063046e-01f, 3.983415663e-02f, 9.997490048e-01f, 2.240444534e-02f,
2.323590964e-01f, 9.726300836e-01f, -6.679986119e-01f, 7.441624999e-01f, -7.777124643e-01f, 6.286201477e-01f, -8.292679787e-01f, -5.588511825e-01f, 9.910848737e-01f, 1.332318485e-01f, 6.535362005e-01f, 7.568953037e-01f, -6.413808465e-01f, -7.672226429e-01f, -6.346988082e-01f, 7.727596164e-01f, 2.962808907e-01f, 9.551008344e-01f, 7.556348443e-01f, 6.549931169e-01f, 9.204331040e-01f, 3.909000754e-01f, 9.746060371e-01f, 2.239265591e-01f, 9.919463396e-01f, 1.266588867e-01f, 9.974508882e-01f, 7.135665417e-02f, 9.991936684e-01f, 4.015012830e-02f, 9.997450113e-01f, 2.258222736e-02f
};
namespace pg8 {
#define PG8_LAS __attribute__((address_space(3)))
typedef unsigned short bf16_t;
typedef short bf16x8 __attribute__((ext_vector_type(8)));
typedef float f32x4 __attribute__((ext_vector_type(4)));
typedef unsigned u32x4 __attribute__((ext_vector_type(4)));
constexpr int BM = 256, BK = 64, HALF = 128, HTB = HALF * BK * 2  , STAGE_BYTES = 8 * HTB, NXCD = 8, WGM = 8;

__host__ __device__ __forceinline__ int lds_byte(int r, int c) { const int st = (r >> 4) * 2 + (c >> 5), rr = r & 15, cc = c & 31, ob = rr * 64 + cc * 2; return st * 1024 + (ob ^ (((ob >> 9) & 1) << 5)); }
__host__ __device__ __forceinline__ void stage_rc(int b, int& R, int& C) { const int st = b / 1024, sb = b % 1024, swz = sb ^ (((sb >> 9) & 1) << 5); R = (st >> 1) * 16 + swz / 64; C = (st & 1) * 32 + (swz % 64) / 2; }
__host__ __device__ __forceinline__ int perm32(int rho) { const int n = rho >> 4, i = rho & 15; return 8 * (i >> 2) + 4 * n + (i & 3); }

struct Unit { int pm, pn; };
struct Gemm { const bf16_t* A; const bf16_t* Bt; int M, N, K; };

struct StaticOrder {
    int nM, nN, nwg, G, c;
    __host__ __device__ void init(int M, int N, int G_, int c_) { nM = M / BM; nN = N / BM; nwg = nM * nN; G = G_; c = c_; }
    __host__ __device__ bool next(int i, Unit& u) const {
        const long L = (long)i * G + c; if (L >= nwg) return false;
        int wgid = (int)L; { const int q = nwg / NXCD, r = nwg % NXCD, xcd = wgid % NXCD, off = wgid / NXCD; wgid = (xcd < r ? xcd * (q + 1) : r * (q + 1) + (xcd - r) * q) + off; }
        const int nig = WGM * nN, gid = wgid / nig, fm = gid * WGM, gsz = (nM - fm) < WGM ? (nM - fm) : WGM;
        u.pm = fm + ((wgid % nig) % gsz); u.pn = (wgid % nig) / gsz; return true;
    }
    __device__ __forceinline__ void a_ready(const Unit&) const {}
    __device__ __forceinline__ void done(const Unit&) const {}
};

__device__ __forceinline__ unsigned cvt_pk_bf16(float lo, float hi) { unsigned r; asm volatile("v_cvt_pk_bf16_f32 %0, %1, %2" : "=v"(r) : "v"(lo), "v"(hi)); return r; }
template <class Epi, class Sched, bool ALIGN_EPI = false, bool SP2 = false>
__device__ __forceinline__ void gemm_phase(PG8_LAS unsigned char* lds, const Gemm g, const Sched& S, const Epi& E) {
    int tid_ = threadIdx.x; asm volatile("" : "+v"(tid_));
    const int tid = tid_, wid = __builtin_amdgcn_readfirstlane(tid >> 6), lane = tid & 63, wr = wid >> 2, wc = wid & 3, fr = lane & 15, fq = lane >> 4;
    const int K = g.K, nt = K / BK;
    unsigned voffA[2], voffB[2];
#pragma unroll
    for (int i = 0; i < 2; ++i) { int R, C; stage_rc(tid * 16 + i * 8192, R, C); const int Rb = Epi::PERM ? ((R & ~31) + perm32(R & 31)) : R;
        voffA[i] = (unsigned)(R * K + C) * 2u; voffB[i] = (unsigned)(Rb * K + C) * 2u; }
    const size_t kstep = (size_t)(BK * 2);
    const size_t hstep = (size_t)HALF * K * 2;
    const size_t tstep = 2 * hstep;
    const unsigned ldsw = (unsigned)wid * 1024u;
    const int aoff = lds_byte(wr * 64 + fr, fq * 8), boff = lds_byte(wc * 32 + fr, fq * 8);
#define PG8_SA(b, h) (((b) * 2 + (h)) * HTB)
#define PG8_SB(b, h) ((4 + (b) * 2 + (h)) * HTB)
#define PG8_STAGE(bufoff, gbase, voff) do { _Pragma("unroll") for (int _i = 0; _i < 2; ++_i) \
        __builtin_amdgcn_global_load_lds((const unsigned*)((const char*)(gbase) + (voff)[_i]), (PG8_LAS unsigned*)(lds + (bufoff) + ldsw + _i * 8192), 16, 0, 0); } while (0)
#define PG8_LDA(dst, b, h) do { _Pragma("unroll") for (int m = 0; m < 4; ++m) _Pragma("unroll") for (int k = 0; k < 2; ++k) dst[m][k] = *(const PG8_LAS bf16x8*)(lds + PG8_SA(b, h) + aoff + m * 2048 + k * 1024); } while (0)
#define PG8_LDB(dst, b, h) do { _Pragma("unroll") for (int n = 0; n < 2; ++n) _Pragma("unroll") for (int k = 0; k < 2; ++k) dst[n][k] = *(const PG8_LAS bf16x8*)(lds + PG8_SB(b, h) + boff + n * 2048 + k * 1024); } while (0)
#define PG8_MMA(ai, bj, At, Bt) do { __builtin_amdgcn_s_setprio(1); _Pragma("unroll") for (int m = 0; m < 4; ++m) _Pragma("unroll") for (int n = 0; n < 2; ++n) _Pragma("unroll") for (int k = 0; k < 2; ++k) \
        acc[ai][bj][m][n] = __builtin_amdgcn_mfma_f32_16x16x32_bf16(Bt[n][k], At[m][k], acc[ai][bj][m][n], 0, 0, 0); __builtin_amdgcn_s_setprio(0); } while (0)
#define PG8_WAIT_V(n) asm volatile("s_waitcnt vmcnt(" #n ")" ::: "memory")
#define PG8_WAIT_L(n) asm volatile("s_waitcnt lgkmcnt(" #n ")" ::: "memory")
#define PG8_BAR __builtin_amdgcn_s_barrier()
#define PG8_SCHED __builtin_amdgcn_sched_barrier(0)
    Unit cur, nxt; int ui = 0;
    if (!S.next(0, cur)) return;
    f32x4 acc[2][2][4][2];
#pragma unroll
    for (int a = 0; a < 2; ++a)
#pragma unroll
        for (int b = 0; b < 2; ++b)
#pragma unroll
            for (int m = 0; m < 4; ++m)
#pragma unroll
                for (int n = 0; n < 2; ++n) acc[a][b][m][n] = (f32x4){0.f, 0.f, 0.f, 0.f};
    bf16x8 At[4][2], B0[2][2], B1[2][2];
    const char* cA = (const char*)g.A + (size_t)cur.pm * tstep; const char* cB = (const char*)g.Bt + (size_t)cur.pn * tstep;
    S.a_ready(cur);
    if constexpr (SP2) {
        PG8_STAGE(PG8_SB(0, 0), cB, voffB); PG8_STAGE(PG8_SB(0, 1), cB + hstep, voffB); PG8_STAGE(PG8_SA(0, 0), cA, voffA); PG8_STAGE(PG8_SA(0, 1), cA + hstep, voffA);
        if (wr == 1) PG8_BAR;
        PG8_WAIT_V(2); PG8_BAR;
        PG8_STAGE(PG8_SB(1, 0), cB + kstep, voffB); PG8_STAGE(PG8_SA(1, 0), cA + kstep, voffA); PG8_STAGE(PG8_SB(1, 1), cB + hstep + kstep, voffB);
        PG8_WAIT_V(6); PG8_BAR;
    } else {
        PG8_STAGE(PG8_SB(0, 0), cB, voffB); PG8_STAGE(PG8_SA(0, 0), cA, voffA); PG8_STAGE(PG8_SB(0, 1), cB + hstep, voffB); PG8_STAGE(PG8_SA(0, 1), cA + hstep, voffA);
        if (wr == 1) PG8_BAR;
        PG8_WAIT_V(4); PG8_BAR;
        PG8_STAGE(PG8_SB(1, 0), cB + kstep, voffB); PG8_STAGE(PG8_SA(1, 0), cA + kstep, voffA); PG8_STAGE(PG8_SB(1, 1), cB + hstep + kstep, voffB);
        PG8_WAIT_V(6); PG8_BAR;
    }
    for (;;) {
        const bool has_next = S.next(ui + 1, nxt);
        const char* nA = has_next ? (const char*)g.A + (size_t)nxt.pm * tstep : cA; const char* nB = has_next ? (const char*)g.Bt + (size_t)nxt.pn * tstep : cB;
        for (int t = 0; t < nt; t += 2) {
            const bool last = (t == nt - 2);
            const char* a1 = cA + (size_t)(t + 1) * kstep;
            const char* a2 = last ? nA : cA + (size_t)(t + 2) * kstep; const char* b2 = last ? nB : cB + (size_t)(t + 2) * kstep;
            const char* a3 = a2 + kstep; const char* b3 = b2 + kstep;
            if (last && has_next) S.a_ready(nxt);
            if constexpr (SP2) {
            PG8_LDB(B0, 0, 0); PG8_LDB(B1, 0, 1); PG8_SCHED; PG8_LDA(At, 0, 0); PG8_STAGE(PG8_SA(1, 1), a1 + hstep, voffA);
            PG8_WAIT_V(8); PG8_WAIT_L(0); PG8_BAR; PG8_MMA(0, 0, At, B0); PG8_MMA(0, 1, At, B1); PG8_BAR; PG8_SCHED;
            PG8_LDA(At, 0, 1); PG8_STAGE(PG8_SB(0, 0), b2, voffB); PG8_STAGE(PG8_SB(0, 1), b2 + hstep, voffB); PG8_STAGE(PG8_SA(0, 0), a2, voffA);
            PG8_WAIT_V(8); PG8_WAIT_L(0); PG8_BAR; PG8_MMA(1, 0, At, B0); PG8_MMA(1, 1, At, B1); PG8_BAR; PG8_SCHED;
            PG8_LDB(B0, 1, 0); PG8_LDB(B1, 1, 1); PG8_SCHED; PG8_LDA(At, 1, 0); PG8_STAGE(PG8_SA(0, 1), a2 + hstep, voffA);
            PG8_WAIT_V(8); PG8_WAIT_L(0); PG8_BAR; PG8_MMA(0, 0, At, B0); PG8_MMA(0, 1, At, B1); PG8_BAR; PG8_SCHED;
            PG8_LDA(At, 1, 1); PG8_STAGE(PG8_SB(1, 0), b3, voffB); PG8_STAGE(PG8_SB(1, 1), b3 + hstep, voffB); PG8_STAGE(PG8_SA(1, 0), a3, voffA);
            PG8_WAIT_V(8); PG8_WAIT_L(0); PG8_BAR; PG8_MMA(1, 0, At, B0); PG8_MMA(1, 1, At, B1); PG8_BAR; PG8_SCHED;
            } else {
            PG8_LDB(B0, 0, 0); PG8_SCHED; PG8_LDA(At, 0, 0); PG8_STAGE(PG8_SA(1, 1), a1 + hstep, voffA);
            PG8_WAIT_L(8); PG8_BAR; PG8_WAIT_L(0); PG8_MMA(0, 0, At, B0); PG8_BAR; PG8_SCHED;
            PG8_LDB(B1, 0, 1); PG8_STAGE(PG8_SB(0, 0), b2, voffB);
            PG8_BAR; PG8_WAIT_L(0); PG8_MMA(0, 1, At, B1); PG8_BAR;
            PG8_LDA(At, 0, 1); PG8_STAGE(PG8_SA(0, 0), a2, voffA);
            PG8_BAR; PG8_WAIT_L(0); PG8_MMA(1, 0, At, B0); PG8_BAR; PG8_SCHED;
            PG8_STAGE(PG8_SB(0, 1), b2 + hstep, voffB);
            PG8_WAIT_V(6); PG8_BAR; PG8_MMA(1, 1, At, B1); PG8_BAR;
            PG8_LDB(B0, 1, 0); PG8_SCHED; PG8_LDA(At, 1, 0); PG8_STAGE(PG8_SA(0, 1), a2 + hstep, voffA);
            PG8_WAIT_L(8); PG8_BAR; PG8_WAIT_L(0); PG8_MMA(0, 0, At, B0); PG8_BAR; PG8_SCHED;
            PG8_LDB(B1, 1, 1); PG8_STAGE(PG8_SB(1, 0), b3, voffB);
            PG8_BAR; PG8_WAIT_L(0); PG8_MMA(0, 1, At, B1); PG8_BAR;
            PG8_LDA(At, 1, 1); PG8_STAGE(PG8_SA(1, 0), a3, voffA);
            PG8_BAR; PG8_WAIT_L(0); PG8_MMA(1, 0, At, B0); PG8_BAR; PG8_SCHED;
            PG8_STAGE(PG8_SB(1, 1), b3 + hstep, voffB);
            PG8_WAIT_V(6); PG8_BAR; PG8_MMA(1, 1, At, B1); PG8_BAR;
            }
        }
        if constexpr (ALIGN_EPI) { if (wr == 0) PG8_BAR; }
        if constexpr (!Epi::AFTER_DRAIN) { E(acc, cur, wr, wc, fr, fq); S.done(cur); }
        if (!has_next) break;
#pragma unroll
        for (int a = 0; a < 2; ++a)
#pragma unroll
            for (int b = 0; b < 2; ++b)
#pragma unroll
                for (int m = 0; m < 4; ++m)
#pragma unroll
                    for (int n = 0; n < 2; ++n) acc[a][b][m][n] = (f32x4){0.f, 0.f, 0.f, 0.f};
        cur = nxt; cA = nA; cB = nB; ++ui;
        if constexpr (ALIGN_EPI) { if (wr == 1) PG8_BAR; }
    }
    PG8_WAIT_V(0);
    if constexpr (!ALIGN_EPI) { if (wr == 0) PG8_BAR; }
    PG8_BAR;
    if constexpr (Epi::AFTER_DRAIN) { E.fused(acc, cur, wr, wc, fr, fq, lds, wid, lane); S.done(cur); }
#undef PG8_SA
#undef PG8_SB
#undef PG8_STAGE
#undef PG8_LDA
#undef PG8_LDB
#undef PG8_MMA
#undef PG8_WAIT_V
#undef PG8_WAIT_L
#undef PG8_BAR
#undef PG8_SCHED
}
}
namespace attn_body {
constexpr int QP=512,KP=128,OP=512;
using bf16=__hip_bfloat16;
using bf16x8=__attribute__((ext_vector_type(8)))short;
using s16x4=__attribute__((ext_vector_type(4)))short;
using f32x16=__attribute__((ext_vector_type(16)))float;
using u32x4=__attribute__((ext_vector_type(4)))unsigned;
constexpr int D=64;
constexpr int NW=8,QBLK=32,QB=QBLK*NW,KVBLK=64;
__device__ __forceinline__ int crow(int r,int hi){return (r&3)+8*(r>>2)+4*hi;}
#define SBAR() __builtin_amdgcn_sched_barrier(0)
__device__ __forceinline__ void cmask(f32x16&p0,f32x16&p1,int jb,int qrel,int hi){
  const float NEG=-INFINITY; int kb=64*jb+4*hi;
  #pragma unroll
  for(int r=0;r<16;++r){int kv=kb+(r&3)+8*(r>>2); if(kv>qrel)p0[r]=NEG; if(kv+32>qrel)p1[r]=NEG;}
}

constexpr int NSLOT=3, SLOTB=8192;
constexpr int LDS_K=0, LDS_V=NSLOT*SLOTB, LDS_WS=2*NSLOT*SLOTB, LDS_OST=LDS_WS+NW*64*4, LDS_BYTES=LDS_OST+NW*4096;
constexpr float C2=0.125f*1.4426950408889634f;
__device__ __forceinline__ void glds16(const void*gsrc,unsigned lds_dst){unsigned keep;
  asm volatile("s_mov_b32 %0, m0\n\ts_mov_b32 m0, %2\n\ts_nop 0\n\tglobal_load_lds_dwordx4 %1, off\n\ts_mov_b32 m0, %0":"=&s"(keep):"v"(gsrc),"s"(lds_dst):"memory");}
__device__ __forceinline__ float max3f(float a,float b,float c){float r;asm("v_max3_f32 %0, %1, %2, %3":"=v"(r):"v"(a),"v"(b),"v"(c));return r;}
__device__ __forceinline__ float max2f(float a,float b){float r;asm("v_max_f32_e32 %0, %1, %2":"=v"(r):"v"(a),"v"(b));return r;}
__device__ __forceinline__ float fadd_s(float a,float b){float r;asm("v_add_f32_e32 %0, %1, %2":"=v"(r):"v"(a),"v"(b));return r;}
__device__ __forceinline__ float fsub_s(float a,float b){float r;asm("v_sub_f32_e32 %0, %1, %2":"=v"(r):"v"(a),"v"(b));return r;}
typedef float f32x2_t __attribute__((ext_vector_type(2))); typedef __bf16 bf16x2_t __attribute__((ext_vector_type(2)));
__device__ __forceinline__ unsigned cvtpk_s(float lo,float hi){f32x2_t v={lo,hi};bf16x2_t b=__builtin_convertvector(v,bf16x2_t);return __builtin_bit_cast(unsigned,b);}
#define WAIT_BAR(N) asm volatile("s_waitcnt vmcnt(" #N ") lgkmcnt(0)\n\ts_barrier":::"memory")

__device__ __forceinline__ void qkt(f32x16&p0,f32x16&p1,const char*Kslot,const bf16x8*qr,const f32x16&negm,int r32,int hi){
  const char*kb=Kslot+hi*1024+r32*16;
  #pragma unroll
  for(int d0=0;d0<4;++d0){
    const bf16x8 b0=*reinterpret_cast<const bf16x8*>(kb+d0*2048);
    const bf16x8 b1=*reinterpret_cast<const bf16x8*>(kb+d0*2048+512);
    if(d0==0){p0=__builtin_amdgcn_mfma_f32_32x32x16_bf16(b0,qr[0],negm,0,0,0);p1=__builtin_amdgcn_mfma_f32_32x32x16_bf16(b1,qr[0],negm,0,0,0);}
    else{p0=__builtin_amdgcn_mfma_f32_32x32x16_bf16(b0,qr[d0],p0,0,0,0);p1=__builtin_amdgcn_mfma_f32_32x32x16_bf16(b1,qr[d0],p1,0,0,0);}}
}
typedef __attribute__((address_space(3))) const char* lds_cptr;
typedef short v4i16_t __attribute__((ext_vector_type(4)));
__device__ __forceinline__ void kload8(bf16x8*kf,lds_cptr kp){
  kf[0]=*(const __attribute__((address_space(3))) bf16x8*)(kp);      kf[1]=*(const __attribute__((address_space(3))) bf16x8*)(kp+512);
  kf[2]=*(const __attribute__((address_space(3))) bf16x8*)(kp+2048); kf[3]=*(const __attribute__((address_space(3))) bf16x8*)(kp+2560);
  kf[4]=*(const __attribute__((address_space(3))) bf16x8*)(kp+4096); kf[5]=*(const __attribute__((address_space(3))) bf16x8*)(kp+4608);
  kf[6]=*(const __attribute__((address_space(3))) bf16x8*)(kp+6144); kf[7]=*(const __attribute__((address_space(3))) bf16x8*)(kp+6656);
}
__device__ __forceinline__ void kload2(bf16x8*kf,lds_cptr kp,int j){ kf[2*j]=*(const __attribute__((address_space(3))) bf16x8*)(kp+j*2048); kf[2*j+1]=*(const __attribute__((address_space(3))) bf16x8*)(kp+j*2048+512); }
__device__ __forceinline__ s16x4 vtr(lds_cptr p){ return __builtin_bit_cast(s16x4,__builtin_amdgcn_ds_read_tr16_b64_v4i16((__attribute__((address_space(3))) v4i16_t*)p)); }
__device__ __forceinline__ float rowmax(const f32x16&p0,const f32x16&p1){
  float a=max3f(p0[0],p0[1],p1[0]),b=max3f(p0[2],p0[3],p1[1]);a=max3f(a,p1[2],p1[3]);
  #pragma unroll
  for(int r=4;r<16;r+=4){a=max3f(a,p0[r],p0[r+1]);b=max3f(b,p0[r+2],p0[r+3]);a=max3f(a,p1[r],p1[r+1]);b=max3f(b,p1[r+2],p1[r+3]);}
  const float m=max2f(a,b);
  auto rr=__builtin_amdgcn_permlane32_swap(__float_as_uint(m),__float_as_uint(m),false,false);
  return max2f(__uint_as_float(rr[0]),__uint_as_float(rr[1]));
}
__device__ __forceinline__ void pv(f32x16*o,int vb,bf16x8 pa0,bf16x8 pa1,bf16x8 pa2,bf16x8 pa3){
  #pragma unroll
  for(int d0=0;d0<2;++d0){s16x4 lo[4],hi[4];
    #pragma unroll
    for(int ks=0;ks<4;++ks){
      asm volatile("ds_read_b64_tr_b16 %0,%1 offset:%c2":"=&v"(lo[ks]):"v"(vb),"i"(d0*4096+ks*1024):"memory");
      asm volatile("ds_read_b64_tr_b16 %0,%1 offset:%c2":"=&v"(hi[ks]):"v"(vb),"i"(d0*4096+ks*1024+512):"memory");}
    asm volatile("s_waitcnt lgkmcnt(0)":::"memory");SBAR();
    #define PK(k) (bf16x8){lo[k][0],lo[k][1],lo[k][2],lo[k][3],hi[k][0],hi[k][1],hi[k][2],hi[k][3]}
    o[d0]=__builtin_amdgcn_mfma_f32_32x32x16_bf16(pa0,PK(0),o[d0],0,0,0);
    o[d0]=__builtin_amdgcn_mfma_f32_32x32x16_bf16(pa1,PK(1),o[d0],0,0,0);
    o[d0]=__builtin_amdgcn_mfma_f32_32x32x16_bf16(pa2,PK(2),o[d0],0,0,0);
    o[d0]=__builtin_amdgcn_mfma_f32_32x32x16_bf16(pa3,PK(3),o[d0],0,0,0);
    #undef PK
  }
}

#ifndef ATTN_STORE16
#define ATTN_STORE16(p,v) (*(u32x4*)(p)=(v))
#endif
template<int THRL> __device__ __forceinline__ void attn_unit(const bf16*Qp,const bf16*__restrict__ Kh,const bf16*__restrict__ Vh,bf16*Op,const int NT,char*shm){
  int tid_=threadIdx.x; asm volatile("":"+v"(tid_)); const int tid=tid_,lane=tid&63,r32=lane&31,hi=lane>>5; const int wid=__builtin_amdgcn_readfirstlane(tid>>6);
  const bf16*Qw=Qp+(long)(wid*QBLK)*QP;
  const unsigned lds0=(unsigned)(uintptr_t)shm;
  float*wsf=(float*)(shm+LDS_WS)+wid*64;
  const bf16*ksrc=Kh+(long)lane*KP+wid*8;
  const bf16*vsrc=Vh+(long)(16*(wid&3)+(lane>>2))*KP+(wid>>2)*32+(lane&3)*8;
  const unsigned kdst=lds0+LDS_K+wid*1024, vdst=lds0+LDS_V+wid*1024;
  #define DMA_K(t,slot) glds16(ksrc+(long)(t)*KVBLK*KP,(unsigned)__builtin_amdgcn_readfirstlane(kdst+(slot)))
  #define DMA_V(t,slot) glds16(vsrc+(long)(t)*KVBLK*KP,(unsigned)__builtin_amdgcn_readfirstlane(vdst+(slot)))
  const int vb0=(int)(lds0+LDS_V)+((lane>>4)&1)*32+(lane&3)*8+(4*hi+((lane&15)>>2))*64;
  const char*Kbase=shm+LDS_K; bf16x8 kf[8];
  const lds_cptr shm3=(lds_cptr)shm; const lds_cptr kp0=shm3+LDS_K+hi*1024+r32*16; const lds_cptr vp0=shm3+LDS_V+((lane>>4)&1)*32+(lane&3)*8+(4*hi+((lane&15)>>2))*64;
  DMA_K(0,0);DMA_V(0,0);DMA_K(1,SLOTB);
  bf16x8 qr[4];
  #pragma unroll
  for(int d0=0;d0<4;++d0)qr[d0]=*reinterpret_cast<const bf16x8*>(&Qw[(long)r32*QP+d0*16+hi*8]);
  float mhat=0.f,l_reg=0.f;f32x16 o[2];o[0]=f32x16{};o[1]=f32x16{};f32x16 negm=f32x16{};asm volatile("":"+v"(negm));
  #define CMASK(P0,P1,t) do{}while(0)
  bool resc=false;
  #define START(P0,P1) do{ const float rm=rowmax(P0,P1); resc=false; \
    { const float dl=rm; mhat=fadd_s(mhat,dl); \
      _Pragma("unroll") for(int r=0;r<16;++r){P0[r]=fsub_s(P0[r],dl);P1[r]=fsub_s(P1[r],dl);} \
      _Pragma("unroll") for(int r=0;r<16;++r)negm[r]=-mhat; asm volatile("":"+v"(negm)); } \
    _Pragma("unroll") for(int r=0;r<16;++r)P0[r]=__builtin_amdgcn_exp2f(P0[r]); }while(0)
  #define RESC() do{ if(resc){ asm volatile("s_waitcnt lgkmcnt(0)":::"memory"); \
      _Pragma("unroll") for(int d_=0;d_<2;++d_) _Pragma("unroll") for(int r=0;r<16;++r)o[d_][r]*=wsf[crow(r,hi)]; } }while(0)
  f32x16 pA0,pA1,pB0,pB1;
  int sl_prev=0,sl_cur=0,sl_next=SLOTB;
  #define ROT() do{sl_prev=sl_cur;sl_cur=sl_next;sl_next=(sl_next==(NSLOT-1)*SLOTB)?0:sl_next+SLOTB;}while(0)
  DMA_K(2,2*SLOTB);
  WAIT_BAR(3);
  qkt(pA0,pA1,Kbase,qr,negm,r32,hi);asm volatile("s_nop 15\n\ts_nop 7":"+v"(pA0),"+v"(pA1));CMASK(pA0,pA1,0);
  START(pA0,pA1);
  _Pragma("unroll") for(int r=0;r<16;++r)pA1[r]=__builtin_amdgcn_exp2f(pA1[r]);
  WAIT_BAR(0);
  DMA_K(3,0);DMA_V(1,SLOTB);
  ROT();
  kload8(kf,kp0+sl_cur);
  WAIT_BAR(2);
  s16x4 vlo[8],vhi[8]; u32x4 pw0,pw1,pw2,pw3;
  #define PKW(P,B) cvtpk_s(P[B],P[B+1])
  #define PAF(k) __builtin_bit_cast(bf16x8,pw##k)
  #define VFR(i) (bf16x8){vlo[i][0],vlo[i][1],vlo[i][2],vlo[i][3],vhi[i][0],vhi[i][1],vhi[i][2],vhi[i][3]}
  #define PIN(x) asm volatile("":"+v"(x))
  #define MX3(a,b,c) __builtin_fmaxf(__builtin_fmaxf((a),(b)),(c))
  #define GAPA(MF,A0,A1,A2,A3,W0,W1,PW) do{ MF; sacc+=A0; sacc+=A1; sacc+=A2; sacc+=A3; PIN(sacc); W0; W1; PIN(PW); SBAR(); }while(0)
  #define EX(v) __builtin_amdgcn_exp2f(v)
  #define GAPB(MF,X,B) do{ MF; X[B]=EX(X[B]); X[B+1]=EX(X[B+1]); X[B+2]=EX(X[B+2]); X[B+3]=EX(X[B+3]); PIN(X); SBAR(); }while(0)
  #define VRD(i) do{ vlo[i]=vtr(vp_+(((i)>>2)*4096+((i)&3)*1024)); vhi[i]=vtr(vp_+(((i)>>2)*4096+((i)&3)*1024+512)); }while(0)
  #define KRD(G,j) do{ if(G){ kload2(kf,kp0+sl_next,j); SBAR(); } }while(0)
  #define STEP(C0,C1,P0,P1,t,GK,GV,GL) do{ SBAR(); \
    const lds_cptr vp_=vp0+sl_prev; \
    VRD(0); SBAR(); float sacc=(P0[0]+P0[1]); \
    GAPA(C0=__builtin_amdgcn_mfma_f32_32x32x16_bf16(kf[0],qr[0],negm,0,0,0), P0[2],P0[3],P0[4],P0[5],     pw0[0]=PKW(P0,0), pw0[1]=PKW(P0,2), pw0); \
    VRD(4); SBAR(); GAPA(C1=__builtin_amdgcn_mfma_f32_32x32x16_bf16(kf[1],qr[0],negm,0,0,0), P0[6],P0[7],P0[8],P0[9],     pw0[2]=PKW(P0,4), pw0[3]=PKW(P0,6), pw0); \
    VRD(1); SBAR(); GAPA(C0=__builtin_amdgcn_mfma_f32_32x32x16_bf16(kf[2],qr[1],C0,0,0,0),   P0[10],P0[11],P0[12],P0[13], pw1[0]=PKW(P0,8), pw1[1]=PKW(P0,10), pw1); \
    VRD(5); SBAR(); GAPA(C1=__builtin_amdgcn_mfma_f32_32x32x16_bf16(kf[3],qr[1],C1,0,0,0),   P0[14],P0[15],P1[0],P1[1],   pw1[2]=PKW(P0,12),pw1[3]=PKW(P0,14), pw1); \
    VRD(2); SBAR(); GAPA(C0=__builtin_amdgcn_mfma_f32_32x32x16_bf16(kf[4],qr[2],C0,0,0,0),   P1[2],P1[3],P1[4],P1[5],     pw2[0]=PKW(P1,0), pw2[1]=PKW(P1,2), pw2); \
    VRD(6); SBAR(); GAPA(C1=__builtin_amdgcn_mfma_f32_32x32x16_bf16(kf[5],qr[2],C1,0,0,0),   P1[6],P1[7],P1[8],P1[9],     pw2[2]=PKW(P1,4), pw2[3]=PKW(P1,6), pw2); \
    VRD(3); SBAR(); GAPA(C0=__builtin_amdgcn_mfma_f32_32x32x16_bf16(kf[6],qr[3],C0,0,0,0),   P1[10],P1[11],P1[12],P1[13], pw3[0]=PKW(P1,8), pw3[1]=PKW(P1,10), pw3); \
    VRD(7); SBAR(); GAPA(C1=__builtin_amdgcn_mfma_f32_32x32x16_bf16(kf[7],qr[3],C1,0,0,0),   P1[14],P1[15],0.f,0.f,       pw3[2]=PKW(P1,12),pw3[3]=PKW(P1,14), pw3); \
    l_reg+=sacc; \
    if(GK){DMA_K((t)+3,sl_cur);} if(GV){DMA_V((t)+1,sl_next);} \
    CMASK(C0,C1,t); \
    { float a=MX3(C0[0],C0[1],C1[0]),b=MX3(C0[2],C0[3],C1[1]); a=MX3(a,C1[2],C1[3]); \
      _Pragma("unroll") for(int r=4;r<16;r+=4){a=MX3(a,C0[r],C0[r+1]);b=MX3(b,C0[r+2],C0[r+3]);a=MX3(a,C1[r],C1[r+1]);b=MX3(b,C1[r+2],C1[r+3]);} \
      float rm=__builtin_fmaxf(a,b); { auto rr=__builtin_amdgcn_permlane32_swap(__float_as_uint(rm),__float_as_uint(rm),false,false); rm=__builtin_fmaxf(__uint_as_float(rr[0]),__uint_as_float(rr[1])); } \
      resc=false; \
      if(__builtin_expect(__any(rm>(float)THRL),0)){ const float dl=__builtin_fmaxf(rm,0.f); mhat+=dl; \
        _Pragma("unroll") for(int r=0;r<16;++r){C0[r]-=dl;C1[r]-=dl;} \
        _Pragma("unroll") for(int r=0;r<16;++r)negm[r]=-mhat; asm volatile("":"+v"(negm)); \
        const float f=__builtin_amdgcn_exp2f(-dl); l_reg*=f; if(hi==0)wsf[r32]=f; resc=true; } } \
    SBAR(); \
    GAPB(o[0]=__builtin_amdgcn_mfma_f32_32x32x16_bf16(PAF(0),VFR(0),o[0],0,0,0), C0,0); \
    GAPB(o[1]=__builtin_amdgcn_mfma_f32_32x32x16_bf16(PAF(0),VFR(4),o[1],0,0,0), C0,4); \
    KRD(GL,0); GAPB(o[0]=__builtin_amdgcn_mfma_f32_32x32x16_bf16(PAF(1),VFR(1),o[0],0,0,0), C0,8); \
    KRD(GL,1); GAPB(o[1]=__builtin_amdgcn_mfma_f32_32x32x16_bf16(PAF(1),VFR(5),o[1],0,0,0), C0,12); \
    KRD(GL,2); GAPB(o[0]=__builtin_amdgcn_mfma_f32_32x32x16_bf16(PAF(2),VFR(2),o[0],0,0,0), C1,0); \
    KRD(GL,3); GAPB(o[1]=__builtin_amdgcn_mfma_f32_32x32x16_bf16(PAF(2),VFR(6),o[1],0,0,0), C1,4); \
    GAPB(o[0]=__builtin_amdgcn_mfma_f32_32x32x16_bf16(PAF(3),VFR(3),o[0],0,0,0), C1,8); \
    GAPB(o[1]=__builtin_amdgcn_mfma_f32_32x32x16_bf16(PAF(3),VFR(7),o[1],0,0,0), C1,12); \
    }while(0)
  int t=1;
  for(;t+5<NT;t+=2){
    STEP(pB0,pB1,pA0,pA1,t,true,true,true);     WAIT_BAR(2); RESC(); ROT();
    STEP(pA0,pA1,pB0,pB1,t+1,true,true,true);   WAIT_BAR(2); RESC(); ROT();
  }
  #define ENDW(tt) do{ if((tt)+3<NT){WAIT_BAR(2);} else if((tt)+2<NT){WAIT_BAR(1);} else {WAIT_BAR(0);} }while(0)
  for(;t+1<NT;t+=2){
    STEP(pB0,pB1,pA0,pA1,t,(t+3<NT),(t+1<NT),(t+1<NT));       ENDW(t);   RESC(); ROT();
    STEP(pA0,pA1,pB0,pB1,t+1,(t+4<NT),(t+2<NT),(t+2<NT));     ENDW(t+1); RESC(); ROT();
  }
  STEP(pB0,pB1,pA0,pA1,NT-1,false,false,false); RESC();
  { float sacc=pB0[0]+pB0[1]; _Pragma("unroll") for(int r=2;r<16;++r)sacc+=pB0[r]; _Pragma("unroll") for(int r=0;r<16;++r)sacc+=pB1[r]; l_reg+=sacc;
    pw0=(u32x4){PKW(pB0,0),PKW(pB0,2),PKW(pB0,4),PKW(pB0,6)};pw1=(u32x4){PKW(pB0,8),PKW(pB0,10),PKW(pB0,12),PKW(pB0,14)};pw2=(u32x4){PKW(pB1,0),PKW(pB1,2),PKW(pB1,4),PKW(pB1,6)};pw3=(u32x4){PKW(pB1,8),PKW(pB1,10),PKW(pB1,12),PKW(pB1,14)};
    SBAR(); pv(o,vb0+sl_cur,PAF(0),PAF(1),PAF(2),PAF(3)); }
  #undef PKW
  #undef PAF
  #undef VFR
  #undef PIN
  #undef MX3
  #undef GAPA
  #undef GAPB
  #undef EX
  #undef VRD
  #undef KRD
  #undef STEP
  #undef ENDW
  {auto rr=__builtin_amdgcn_permlane32_swap(__float_as_uint(l_reg),__float_as_uint(l_reg),false,false);l_reg=__uint_as_float(rr[0])+__uint_as_float(rr[1]);}
  if(hi==0)wsf[32+r32]=l_reg;asm volatile("s_waitcnt lgkmcnt(0)":::"memory");
  float rli[16];
  #pragma unroll
  for(int r=0;r<16;++r)rli[r]=__builtin_amdgcn_rcpf(wsf[32+crow(r,hi)]);
  bf16*Ow=Op+(long)(wid*QBLK)*OP;
  { bf16*stg=(bf16*)(shm+LDS_OST)+wid*2048;
    #pragma unroll
    for(int r=0;r<16;++r){const int orow=crow(r,hi);
      #pragma unroll
      for(int d0=0;d0<2;++d0)stg[orow*64+d0*32+r32]=__float2bfloat16(o[d0][r]*rli[r]);}
    asm volatile("s_waitcnt lgkmcnt(0)":::"memory");
    #pragma unroll
    for(int i=0;i<4;++i){const int row=i*8+(lane>>3),ch=lane&7; const u32x4 v=*(const u32x4*)(stg+row*64+ch*8); ATTN_STORE16(Ow+(long)row*OP+ch*8,v);} }
  asm volatile("s_waitcnt lgkmcnt(0)\n\ts_barrier":::"memory");
  #undef DMA_K
  #undef DMA_V
  #undef CMASK
  #undef START
  #undef RESC
  #undef ROT
}
constexpr int ATTN_LDS_BYTES=LDS_BYTES;
#undef SBAR
#undef WAIT_BAR
}

#define LAS __attribute__((address_space(3)))
typedef unsigned short bf16;
typedef unsigned u32x4 __attribute__((ext_vector_type(4)));
typedef unsigned u32x2 __attribute__((ext_vector_type(2)));
typedef float f32x4 __attribute__((ext_vector_type(4)));
typedef float f32x16 __attribute__((ext_vector_type(16)));
typedef short bf16x8 __attribute__((ext_vector_type(8)));
typedef short s16x4 __attribute__((ext_vector_type(4)));

constexpr int DM = 1024, NL = 16384, MT = 16896, SEQ = 8192;
constexpr int INC = 4352, FF = 2816, FF2 = 5632, DEPTH = 4;
constexpr float EPS = 1e-6f;
constexpr float LOG2E = 1.4426950408889634f;
constexpr float C2 = 0.125f * 1.4426950408889634f;
constexpr int NWAVES = 8, NTHREADS = 512;

constexpr size_t MiB = 1u << 20;
constexpr size_t WS_MODS = 1 * MiB;
constexpr size_t WS_WIN = 2 * MiB;
constexpr size_t WS_WPA = 11 * MiB, WS_WPB = 12 * MiB;
constexpr size_t WS_WO = 13 * MiB;
constexpr size_t WS_WFI = 15 * MiB;
constexpr size_t WS_WFO = 26 * MiB;
constexpr size_t WS_X = 32 * MiB;
constexpr size_t WS_H = 98 * MiB;
constexpr size_t SZ512 = (size_t)MT * 512 * 2, SZ128 = (size_t)MT * 128 * 2, SZ1024 = (size_t)MT * 1024 * 2;
constexpr size_t WS_NAQ = 131 * MiB, WS_NAK = WS_NAQ + SZ512, WS_NAV = WS_NAK + SZ512, WS_GQ = WS_NAV + SZ512, WS_GK = WS_GQ + SZ512, WS_GV = WS_GK + SZ128;
constexpr size_t WS_SA = WS_GV + SZ128, WS_SB = WS_SA + SZ1024, WS_YA = WS_SB + SZ1024, WS_YB = WS_YA + SZ512, WS_END = WS_YB + SZ512;
constexpr size_t WS_ACT = 131 * MiB;
static_assert(WS_ACT + (size_t)MT * FF * 2 <= WS_END, "act overlay");
static_assert(WS_WFO + (size_t)DM * FF * 2 <= WS_X && WS_WFI + (size_t)FF2 * DM * 2 <= WS_WFO && WS_WIN + (size_t)INC * DM * 2 <= WS_WPA, "weights map");

constexpr int RING_BYTES = 131072;
constexpr int LDS_BYTES = 147456;
constexpr int A_K = 0, A_V = 16384, A_WS = 32768, A_OST = 34816, A_RPB = 67584;

__device__ __forceinline__ unsigned f2bf(float f) { unsigned u = __builtin_bit_cast(unsigned, f); return (u + 0x7fffu + ((u >> 16) & 1u)) >> 16; }
__device__ __forceinline__ unsigned pk2(float lo, float hi) { return f2bf(lo) | (f2bf(hi) << 16); }
__device__ __forceinline__ float bflo(unsigned w) { return __builtin_bit_cast(float, w << 16); }
__device__ __forceinline__ float bfhi(unsigned w) { return __builtin_bit_cast(float, w & 0xffff0000u); }
__device__ __forceinline__ float wave_sum(float v) {
#pragma unroll
    for (int o = 1; o < 64; o <<= 1) v += __shfl_xor(v, o);
    return v;
}
__device__ __forceinline__ int launder(int v) { asm volatile("" : "+v"(v)); return v; }
__device__ __forceinline__ float sigmoidf_(float x) { return __builtin_amdgcn_rcpf(1.0f + __expf(-x)); }

using pg8::Unit; using pg8::cvt_pk_bf16;
typedef f32x4 Acc[2][2][4][2];

struct EpiIn {
    static constexpr bool PERM = true, AFTER_DRAIN = false;
    bf16 *NAQ, *NAK, *NAV, *GQ, *GK, *GV, *SA, *SB; const float* qgain; const float* kgain;
    __device__ __forceinline__ void operator()(const Acc& acc, const Unit& u, int wr, int wc, int fr, int fq) const {
        const int pm = u.pm, pn = u.pn;
        const int rbase = pm * 256 + wr * 64 + fr;
        const int kvd = pm < 32 ? 0 : (pm < 64 ? 256 : (pm == 64 ? -8192 : 0));
        if (pn < 6 || pn >= 9) {
            bf16* dst; int ld, colt, rowd = 0; float sc = 1.f; bool sig = false;
            if (pn < 2) { dst = NAQ; ld = 512; colt = pn * 256; sc = C2; }
            else if (pn < 4) { dst = NAK; ld = 512; colt = (pn - 2) * 256; rowd = kvd; }
            else if (pn < 6) { dst = NAV; ld = 512; colt = (pn - 4) * 256; rowd = kvd; }
            else if (pn < 13) { dst = SA; ld = 1024; colt = (pn - 9) * 256; sig = true; }
            else { dst = SB; ld = 1024; colt = (pn - 13) * 256; sig = true; }
            const int col0 = colt + wc * 32 + 8 * fq;
#pragma unroll
            for (int ai = 0; ai < 2; ++ai)
#pragma unroll
                for (int m = 0; m < 4; ++m) {
                    bf16* rowp = dst + (size_t)(rbase + ai * 128 + m * 16 + rowd) * ld + col0;
#pragma unroll
                    for (int bj = 0; bj < 2; ++bj) {
                        f32x4 v0 = acc[ai][bj][m][0], v1 = acc[ai][bj][m][1];
                        if (sig) {
#pragma unroll
                            for (int e = 0; e < 4; ++e) { v0[e] = sigmoidf_(v0[e]); v1[e] = sigmoidf_(v1[e]); }
                        } else { v0 = v0 * sc; v1 = v1 * sc; }
                        u32x4 w; w.x = cvt_pk_bf16(v0[0], v0[1]); w.y = cvt_pk_bf16(v0[2], v0[3]); w.z = cvt_pk_bf16(v1[0], v1[1]); w.w = cvt_pk_bf16(v1[2], v1[3]);
                        *(u32x4*)(rowp + bj * 128) = w;
                    }
                }
        } else {
            const int hidx = 4 * (pn - 6) + wc;
            const bool isv = hidx >= 10, isk = (hidx >= 8) && !isv;
            bf16* dst; int ld, hcol, rowd; float sc = 1.f;
            if (isv) { dst = GV; ld = 128; hcol = (hidx - 10) * 64; rowd = kvd; }
            else if (isk) { dst = GK; ld = 128; hcol = (hidx - 8) * 64; rowd = kvd; }
            else { dst = GQ; ld = 512; hcol = hidx * 64; rowd = 0; sc = C2; }
            const float* gain = isk ? kgain : qgain;
            f32x4 gv[2][2];
#pragma unroll
            for (int bj = 0; bj < 2; ++bj)
#pragma unroll
                for (int n = 0; n < 2; ++n) gv[bj][n] = *(const f32x4*)(gain + 32 * bj + 8 * fq + 4 * n);
            const bool latent = pm < 64;
#pragma unroll
            for (int ai = 0; ai < 2; ++ai)
#pragma unroll
                for (int m = 0; m < 4; ++m) {
                    const int row = rbase + ai * 128 + m * 16;
                    bf16* rowp = dst + (size_t)(row + rowd) * ld + hcol + 8 * fq;
                    if (isv) {
#pragma unroll
                        for (int bj = 0; bj < 2; ++bj) {
                            const f32x4 v0 = acc[ai][bj][m][0], v1 = acc[ai][bj][m][1];
                            u32x4 w; w.x = cvt_pk_bf16(v0[0], v0[1]); w.y = cvt_pk_bf16(v0[2], v0[3]); w.z = cvt_pk_bf16(v1[0], v1[1]); w.w = cvt_pk_bf16(v1[2], v1[3]);
                            *(u32x4*)(rowp + bj * 32) = w;
                        }
                    } else {
                        float ss = 0.f;
#pragma unroll
                        for (int bj = 0; bj < 2; ++bj)
#pragma unroll
                            for (int n = 0; n < 2; ++n) { const f32x4 x = acc[ai][bj][m][n]; ss += (x[0] * x[0] + x[1] * x[1]) + (x[2] * x[2] + x[3] * x[3]); }
                        ss += __shfl_xor(ss, 16); ss += __shfl_xor(ss, 32);
                        const float rinv = rsqrtf(ss * (1.0f / 64.0f) + EPS);
                        const int s = row & (SEQ - 1);
#pragma unroll
                        for (int bj = 0; bj < 2; ++bj) {
                            f32x4 v0 = acc[ai][bj][m][0] * rinv * gv[bj][0], v1 = acc[ai][bj][m][1] * rinv * gv[bj][1];
                            if (latent) {
                                const int pos = bj == 0 ? (s >> 6) : (s & 63);
                                const f32x4 t0 = *(const f32x4*)(ROPE_TAB + (pos * 16 + 4 * fq) * 2);
                                const f32x4 t1 = *(const f32x4*)(ROPE_TAB + (pos * 16 + 4 * fq) * 2 + 4);
                                f32x4 r0, r1;
                                r0[0] = v0[0] * t0[0] - v0[1] * t0[1]; r0[1] = v0[0] * t0[1] + v0[1] * t0[0];
                                r0[2] = v0[2] * t0[2] - v0[3] * t0[3]; r0[3] = v0[2] * t0[3] + v0[3] * t0[2];
                                r1[0] = v1[0] * t1[0] - v1[1] * t1[1]; r1[1] = v1[0] * t1[1] + v1[1] * t1[0];
                                r1[2] = v1[2] * t1[2] - v1[3] * t1[3]; r1[3] = v1[2] * t1[3] + v1[3] * t1[2];
                                v0 = r0; v1 = r1;
                            }
                            v0 = v0 * sc; v1 = v1 * sc;
                            u32x4 w; w.x = cvt_pk_bf16(v0[0], v0[1]); w.y = cvt_pk_bf16(v0[2], v0[3]); w.z = cvt_pk_bf16(v1[0], v1[1]); w.w = cvt_pk_bf16(v1[2], v1[3]);
                            *(u32x4*)(rowp + bj * 32) = w;
                        }
                    }
                }
        }
    }
};

struct EpiMerge {
    static constexpr bool PERM = true, AFTER_DRAIN = false;
    const bf16* S; bf16* O; int second;
    __device__ __forceinline__ void operator()(const Acc& acc, const Unit& u, int wr, int wc, int fr, int fq) const {
        const int rbase = u.pm * 256 + wr * 64 + fr, col0 = u.pn * 256 + wc * 32 + 8 * fq;
#pragma unroll
        for (int ai = 0; ai < 2; ++ai)
#pragma unroll
            for (int m = 0; m < 4; ++m)
#pragma unroll
                for (int bj = 0; bj < 2; ++bj) {
                    const size_t off = (size_t)(rbase + ai * 128 + m * 16) * 1024 + col0 + bj * 128;
                    const u32x4 b = *(const u32x4*)(S + off);
                    u32x4 p = {0u, 0u, 0u, 0u};
                    if (second) p = *(const u32x4*)(O + off);
                    const f32x4 v0 = acc[ai][bj][m][0], v1 = acc[ai][bj][m][1];
                    u32x4 w;
                    w.x = cvt_pk_bf16(bflo(p.x) + v0[0] * bflo(b.x), bfhi(p.x) + v0[1] * bfhi(b.x)); w.y = cvt_pk_bf16(bflo(p.y) + v0[2] * bflo(b.y), bfhi(p.y) + v0[3] * bfhi(b.y));
                    w.z = cvt_pk_bf16(bflo(p.z) + v1[0] * bflo(b.z), bfhi(p.z) + v1[1] * bfhi(b.z)); w.w = cvt_pk_bf16(bflo(p.w) + v1[2] * bflo(b.w), bfhi(p.w) + v1[3] * bfhi(b.w));
                    *(u32x4*)(O + off) = w;
                }
    }
};

struct EpiRes {
    static constexpr bool PERM = false, AFTER_DRAIN = false;
    float* X; const float* gate;
    __device__ __forceinline__ void operator()(const Acc& acc, const Unit& u, int wr, int wc, int fr, int fq) const {
        const int pm = u.pm, v = pm < 32 ? 0 : (pm < 64 ? 1 : 2);
        const int rbase = pm * 256 + wr * 64 + fr, col0 = u.pn * 256 + wc * 32 + 4 * fq;
        const float* g = gate + v * 6144 + col0;
        f32x4 gv[2][2];
#pragma unroll
        for (int bj = 0; bj < 2; ++bj)
#pragma unroll
            for (int n = 0; n < 2; ++n) gv[bj][n] = *(const f32x4*)(g + bj * 128 + 16 * n);
#pragma unroll
        for (int ai = 0; ai < 2; ++ai)
#pragma unroll
            for (int m = 0; m < 4; ++m) {
                float* rowp = X + (size_t)(rbase + ai * 128 + m * 16) * DM + col0;
#pragma unroll
                for (int bj = 0; bj < 2; ++bj)
#pragma unroll
                    for (int n = 0; n < 2; ++n) {
                        f32x4* p = (f32x4*)(rowp + bj * 128 + 16 * n);
                        *p = *p + gv[bj][n] * acc[ai][bj][m][n];
                    }
            }
    }
};

struct EpiSwiglu {
    static constexpr bool PERM = true, AFTER_DRAIN = false;
    bf16* O;
    __device__ __forceinline__ void operator()(const Acc& acc, const Unit& u, int wr, int wc, int fr, int fq) const {
        const int rbase = u.pm * 256 + wr * 64 + fr, col0 = u.pn * 128 + wc * 32 + 8 * fq;
#pragma unroll
        for (int ai = 0; ai < 2; ++ai)
#pragma unroll
            for (int m = 0; m < 4; ++m) {
                f32x4 r[2];
#pragma unroll
                for (int n = 0; n < 2; ++n) {
                    const f32x4 a = acc[ai][0][m][n], uu = acc[ai][1][m][n];
#pragma unroll
                    for (int e = 0; e < 4; ++e) r[n][e] = a[e] * sigmoidf_(a[e]) * uu[e];
                }
                u32x4 w; w.x = cvt_pk_bf16(r[0][0], r[0][1]); w.y = cvt_pk_bf16(r[0][2], r[0][3]); w.z = cvt_pk_bf16(r[1][0], r[1][1]); w.w = cvt_pk_bf16(r[1][2], r[1][3]);
                *(u32x4*)(O + (size_t)(rbase + ai * 128 + m * 16) * FF + col0) = w;
            }
    }
};

namespace att {
__device__ __forceinline__ int crow(int r, int hi) { return (r & 3) + 8 * (r >> 2) + 4 * hi; }
__device__ __forceinline__ void glds16(const void* gsrc, unsigned lds_dst) { unsigned keep;
    asm volatile("s_mov_b32 %0, m0\n\ts_mov_b32 m0, %2\n\ts_nop 0\n\tglobal_load_lds_dwordx4 %1, off\n\ts_mov_b32 m0, %0" : "=&s"(keep) : "v"(gsrc), "s"(lds_dst) : "memory"); }
typedef float f32x2_t __attribute__((ext_vector_type(2))); typedef __bf16 bf16x2_t __attribute__((ext_vector_type(2)));
__device__ __forceinline__ unsigned cvtpk_s(float lo, float hi) { f32x2_t v = {lo, hi}; bf16x2_t b = __builtin_convertvector(v, bf16x2_t); return __builtin_bit_cast(unsigned, b); }
__device__ __forceinline__ void qkt(f32x16& p0, f32x16& p1, const char* Kslot, const bf16x8* qr, int r32, int hi) {
    const char* kb = Kslot + hi * 1024 + r32 * 16; const f32x16 z = f32x16{};
#pragma unroll
    for (int d0 = 0; d0 < 4; ++d0) {
        const bf16x8 b0 = *reinterpret_cast<const bf16x8*>(kb + d0 * 2048);
        const bf16x8 b1 = *reinterpret_cast<const bf16x8*>(kb + d0 * 2048 + 512);
        if (d0 == 0) { p0 = __builtin_amdgcn_mfma_f32_32x32x16_bf16(b0, qr[0], z, 0, 0, 0); p1 = __builtin_amdgcn_mfma_f32_32x32x16_bf16(b1, qr[0], z, 0, 0, 0); }
        else { p0 = __builtin_amdgcn_mfma_f32_32x32x16_bf16(b0, qr[d0], p0, 0, 0, 0); p1 = __builtin_amdgcn_mfma_f32_32x32x16_bf16(b1, qr[d0], p1, 0, 0, 0); } }
}
__device__ __forceinline__ void pv(f32x16* o, int vb, bf16x8 pa0, bf16x8 pa1, bf16x8 pa2, bf16x8 pa3) {
#pragma unroll
    for (int d0 = 0; d0 < 2; ++d0) { s16x4 lo[4], hi[4];
#pragma unroll
        for (int ks = 0; ks < 4; ++ks) {
            asm volatile("ds_read_b64_tr_b16 %0,%1 offset:%c2" : "=&v"(lo[ks]) : "v"(vb), "i"(d0 * 4096 + ks * 1024) : "memory");
            asm volatile("ds_read_b64_tr_b16 %0,%1 offset:%c2" : "=&v"(hi[ks]) : "v"(vb), "i"(d0 * 4096 + ks * 1024 + 512) : "memory"); }
        asm volatile("s_waitcnt lgkmcnt(0)" ::: "memory"); __builtin_amdgcn_sched_barrier(0);
#define PK(k) (bf16x8){lo[k][0], lo[k][1], lo[k][2], lo[k][3], hi[k][0], hi[k][1], hi[k][2], hi[k][3]}
        o[d0] = __builtin_amdgcn_mfma_f32_32x32x16_bf16(pa0, PK(0), o[d0], 0, 0, 0);
        o[d0] = __builtin_amdgcn_mfma_f32_32x32x16_bf16(pa1, PK(1), o[d0], 0, 0, 0);
        o[d0] = __builtin_amdgcn_mfma_f32_32x32x16_bf16(pa2, PK(2), o[d0], 0, 0, 0);
        o[d0] = __builtin_amdgcn_mfma_f32_32x32x16_bf16(pa3, PK(3), o[d0], 0, 0, 0);
#undef PK
    }
}
__device__ __forceinline__ float rowmax(const f32x16& p0, const f32x16& p1) {
    float a = fmaxf(p0[0], p1[0]);
#pragma unroll
    for (int r = 1; r < 16; ++r) a = fmaxf(a, fmaxf(p0[r], p1[r]));
    auto rr = __builtin_amdgcn_permlane32_swap(__float_as_uint(a), __float_as_uint(a), false, false);
    return fmaxf(__uint_as_float(rr[0]), __uint_as_float(rr[1]));
}
#define WAIT_BAR0() asm volatile("s_waitcnt vmcnt(0) lgkmcnt(0)\n\ts_barrier" ::: "memory")

__device__ __forceinline__ void unit(const bf16* Qp, const bf16* Kp, const bf16* Vp, int KP, bf16* Op, int kr0, int nwin, int nt, bool na, int qgr0, const float* rpb_h, char* shm) {
    int tid_ = threadIdx.x; asm volatile("" : "+v"(tid_));
    const int tid = tid_, lane = tid & 63, r32 = lane & 31, hi = lane >> 5; const int wid = __builtin_amdgcn_readfirstlane(tid >> 6);
    const unsigned lds0 = (unsigned)(uintptr_t)shm;
    float* wsf = (float*)(shm + A_WS) + wid * 64;
    float* rpbL = (float*)(shm + A_RPB);
    if (na) { for (int i = tid; i < 465; i += NTHREADS) rpbL[i] = rpb_h[i] * LOG2E; }
    const bf16* Qw = Qp + (size_t)(wid * 32) * 512;
    bf16x8 qr[4];
#pragma unroll
    for (int d0 = 0; d0 < 4; ++d0) qr[d0] = *reinterpret_cast<const bf16x8*>(&Qw[(size_t)r32 * 512 + d0 * 16 + hi * 8]);
    const bf16* ksrc = Kp + (size_t)lane * KP + wid * 8;
    const bf16* vsrc = Vp + (size_t)(16 * (wid & 3) + (lane >> 2)) * KP + (wid >> 2) * 32 + (lane & 3) * 8;
    const unsigned kdst = lds0 + A_K + wid * 1024, vdst = lds0 + A_V + wid * 1024;
    const int vb0 = (int)(lds0 + A_V) + ((lane >> 4) & 1) * 32 + (lane & 3) * 8 + (4 * hi + ((lane & 15) >> 2)) * 64;
#define KROW(t) ((t) < nwin ? (kr0 + (t)) * 64 : 8192 + ((t) - nwin) * 64)
    float mrun = -1e30f, lrun = 0.f; f32x16 o[2]; o[0] = f32x16{}; o[1] = f32x16{};
    const int qgr = qgr0 + (wid >> 1), qc = (wid & 1) * 32 + r32;
    const int rs = min(max(qgr - 4, 0), 120), cs = min(max(qc - 8, 0), 48);
    { const size_t r = (size_t)KROW(0) * KP; glds16(ksrc + r, (unsigned)__builtin_amdgcn_readfirstlane(kdst)); glds16(vsrc + r, (unsigned)__builtin_amdgcn_readfirstlane(vdst)); }
    for (int t = 0; t < nt; ++t) {
        const int slot = (t & 1) * 8192;
        WAIT_BAR0();
        if (t + 1 < nt) { const size_t r = (size_t)KROW(t + 1) * KP; const int ns = ((t + 1) & 1) * 8192;
            glds16(ksrc + r, (unsigned)__builtin_amdgcn_readfirstlane(kdst + ns)); glds16(vsrc + r, (unsigned)__builtin_amdgcn_readfirstlane(vdst + ns)); }
        const bool win = na && (t < nwin);
        const int kr = kr0 + t;
        if (win && (kr < rs || kr >= rs + 8)) continue;
        f32x16 p0, p1;
        qkt(p0, p1, shm + A_K + slot, qr, r32, hi);
        if (win) {
            const int brow = (kr - qgr + 7) * 31 + 15 - qc;
#pragma unroll
            for (int r = 0; r < 16; ++r) {
                const int kc = crow(r, hi);
                { const bool ok = (kc >= cs) && (kc < cs + 16); const int idx = min(max(brow + kc, 0), 464); const float bv = rpbL[idx]; p0[r] = ok ? p0[r] + bv : -INFINITY; }
                { const int kc2 = kc + 32; const bool ok = (kc2 >= cs) && (kc2 < cs + 16); const int idx = min(max(brow + kc2, 0), 464); const float bv = rpbL[idx]; p1[r] = ok ? p1[r] + bv : -INFINITY; }
            }
        }
        const float rm = rowmax(p0, p1);
        const float mnew = fmaxf(mrun, rm);
        const float alpha = __builtin_amdgcn_exp2f(mrun - mnew);
        mrun = mnew;
        float ls = 0.f;
#pragma unroll
        for (int r = 0; r < 16; ++r) { p0[r] = __builtin_amdgcn_exp2f(p0[r] - mnew); p1[r] = __builtin_amdgcn_exp2f(p1[r] - mnew); ls += p0[r] + p1[r]; }
        lrun = lrun * alpha + ls;
        if (__any(alpha < 1.0f)) {
            if (hi == 0) wsf[r32] = alpha;
            asm volatile("s_waitcnt lgkmcnt(0)" ::: "memory");
#pragma unroll
            for (int d = 0; d < 2; ++d)
#pragma unroll
                for (int r = 0; r < 16; ++r) o[d][r] *= wsf[crow(r, hi)];
        }
        u32x4 pw0, pw1, pw2, pw3;
        pw0 = (u32x4){cvtpk_s(p0[0], p0[1]), cvtpk_s(p0[2], p0[3]), cvtpk_s(p0[4], p0[5]), cvtpk_s(p0[6], p0[7])};
        pw1 = (u32x4){cvtpk_s(p0[8], p0[9]), cvtpk_s(p0[10], p0[11]), cvtpk_s(p0[12], p0[13]), cvtpk_s(p0[14], p0[15])};
        pw2 = (u32x4){cvtpk_s(p1[0], p1[1]), cvtpk_s(p1[2], p1[3]), cvtpk_s(p1[4], p1[5]), cvtpk_s(p1[6], p1[7])};
        pw3 = (u32x4){cvtpk_s(p1[8], p1[9]), cvtpk_s(p1[10], p1[11]), cvtpk_s(p1[12], p1[13]), cvtpk_s(p1[14], p1[15])};
        pv(o, vb0 + slot, __builtin_bit_cast(bf16x8, pw0), __builtin_bit_cast(bf16x8, pw1), __builtin_bit_cast(bf16x8, pw2), __builtin_bit_cast(bf16x8, pw3));
    }
#undef KROW
    { auto rr = __builtin_amdgcn_permlane32_swap(__float_as_uint(lrun), __float_as_uint(lrun), false, false); lrun = __uint_as_float(rr[0]) + __uint_as_float(rr[1]); }
    if (hi == 0) wsf[32 + r32] = lrun;
    asm volatile("s_waitcnt lgkmcnt(0)" ::: "memory");
    float rli[16];
#pragma unroll
    for (int r = 0; r < 16; ++r) rli[r] = __builtin_amdgcn_rcpf(wsf[32 + crow(r, hi)]);
    bf16* Ow = Op + (size_t)(wid * 32) * 512;
    { bf16* stg = (bf16*)(shm + A_OST) + wid * 2048;
#pragma unroll
        for (int r = 0; r < 16; ++r) { const int orow = crow(r, hi);
#pragma unroll
            for (int d0 = 0; d0 < 2; ++d0) stg[orow * 64 + d0 * 32 + r32] = (bf16)f2bf(o[d0][r] * rli[r]); }
        asm volatile("s_waitcnt lgkmcnt(0)" ::: "memory");
#pragma unroll
        for (int i = 0; i < 4; ++i) { const int row = i * 8 + (lane >> 3), ch = lane & 7; const u32x4 v = *(const u32x4*)(stg + row * 64 + ch * 8); *(u32x4*)(Ow + (size_t)row * 512 + ch * 8) = v; } }
    asm volatile("s_waitcnt vmcnt(0) lgkmcnt(0)\n\ts_barrier" ::: "memory");
}
}

template <int MAP>
__device__ __forceinline__ void transpose_item(const float* W, int N, bf16* WT, int ldk, int koff, LAS float* scr, int item, int lane) {
    const int nblk = N / 32, kb = item / nblk, nb = item % nblk, k0 = 64 * kb, n0 = 32 * nb;
#pragma unroll 8
    for (int i = 0; i < 32; ++i) { const int kk = 2 * i + (lane >> 5); scr[kk * 33 + (lane & 31)] = W[(size_t)(k0 + kk) * N + n0 + (lane & 31)]; }
    asm volatile("s_waitcnt lgkmcnt(0)" ::: "memory");
    int r0 = n0;
    if (MAP == 1) { if (n0 >= 1536 && n0 < 2304) { const int tile = n0 >> 8, within = n0 & 255, hw = within >> 6, bj = (within & 63) >> 5; r0 = tile * 256 + 128 * bj + 32 * hw; } }
    if (MAP == 2) { if (n0 < FF) { r0 = (n0 >> 7) * 256 + (n0 & 127); } else { const int n1 = n0 - FF; r0 = (n1 >> 7) * 256 + 128 + (n1 & 127); } }
    const int c = lane & 7;
#pragma unroll
    for (int j = 0; j < 4; ++j) { const int n = (lane >> 3) + 8 * j; const LAS float* s = scr + (8 * c) * 33 + n;
        u32x4 o; o.x = pk2(s[0 * 33], s[1 * 33]); o.y = pk2(s[2 * 33], s[3 * 33]); o.z = pk2(s[4 * 33], s[5 * 33]); o.w = pk2(s[6 * 33], s[7 * 33]);
        *(u32x4*)(WT + (size_t)(r0 + n) * ldk + koff + k0 + 8 * c) = o; }
    asm volatile("s_waitcnt lgkmcnt(0)" ::: "memory");
}

struct Params {
    const float *x, *c, *ctx, *c_ctx, *w_mod, *b_mod, *norm1, *w_in, *na_rpb, *q_gain, *k_gain, *w_pa, *w_pb, *w_o, *norm2, *w_ffn_in, *w_ffn_out, *final_norm;
    float* out; unsigned char* ws;
};

__device__ __forceinline__ void phase_wconv(const Params& P, int l, unsigned char* ws, LAS unsigned char* lds, int gw, int NGW, int wave, int lane) {
    LAS float* scr = (LAS float*)(lds + wave * 16384);
    constexpr int I_IN = (DM / 64) * (INC / 32), I_PA = (512 / 64) * (DM / 32), I_O = (DM / 64) * (DM / 32), I_FI = (DM / 64) * (FF2 / 32), I_FO = (FF / 64) * (DM / 32);
    constexpr int NITEMS = I_IN + 2 * I_PA + I_O + I_FI + I_FO;
    for (int it = gw; it < NITEMS; it += NGW) {
        int r = it;
        if (r < I_IN) { transpose_item<1>(P.w_in + (size_t)l * DM * INC, INC, (bf16*)(ws + WS_WIN), DM, 0, scr, r, lane); continue; } r -= I_IN;
        if (r < I_PA) { transpose_item<0>(P.w_pa + (size_t)l * 512 * DM, DM, (bf16*)(ws + WS_WPA), 512, 0, scr, r, lane); continue; } r -= I_PA;
        if (r < I_PA) { transpose_item<0>(P.w_pb + (size_t)l * 512 * DM, DM, (bf16*)(ws + WS_WPB), 512, 0, scr, r, lane); continue; } r -= I_PA;
        if (r < I_O) { transpose_item<0>(P.w_o + (size_t)l * DM * DM, DM, (bf16*)(ws + WS_WO), DM, 0, scr, r, lane); continue; } r -= I_O;
        if (r < I_FI) { transpose_item<2>(P.w_ffn_in + (size_t)l * DM * FF2, FF2, (bf16*)(ws + WS_WFI), DM, 0, scr, r, lane); continue; } r -= I_FI;
        transpose_item<0>(P.w_ffn_out + (size_t)l * FF * DM, DM, (bf16*)(ws + WS_WFO), FF, 0, scr, r, lane);
    }
}

__device__ __forceinline__ void norm_row(const float* xrow, float* xcopy, const float* gamma, const float* sh, const float* sc, bf16* hrow, int lane) {
    const f32x4* xr = (const f32x4*)xrow + lane;
    f32x4 v[4]; float s = 0.f;
#pragma unroll
    for (int j = 0; j < 4; ++j) { v[j] = xr[64 * j]; s += (v[j].x * v[j].x + v[j].y * v[j].y) + (v[j].z * v[j].z + v[j].w * v[j].w); }
    const float r = rsqrtf(wave_sum(s) * (1.0f / DM) + EPS);
    if (xcopy) {
#pragma unroll
        for (int j = 0; j < 4; ++j) ((f32x4*)xcopy + lane)[64 * j] = v[j];
    }
    unsigned long long* o8 = (unsigned long long*)hrow + lane;
#pragma unroll
    for (int j = 0; j < 4; ++j) {
        const f32x4 g = ((const f32x4*)gamma + lane)[64 * j], a = ((const f32x4*)sc + lane)[64 * j], b = ((const f32x4*)sh + lane)[64 * j];
        const f32x4 y = (v[j] * r) * g * (a + 1.0f) + b;
        o8[64 * j] = (unsigned long long)pk2(y.x, y.y) | ((unsigned long long)pk2(y.z, y.w) << 32);
    }
}

__global__ void __launch_bounds__(NTHREADS, 2) mega_fwd(Params P) {
    extern __shared__ __attribute__((aligned(16))) unsigned char lds[];
    cg::grid_group grid = cg::this_grid();
    LAS unsigned char* ldsl = (LAS unsigned char*)lds;
    const int tid = threadIdx.x, lane = tid & 63, wave = __builtin_amdgcn_readfirstlane(tid >> 6);
    const int G = gridDim.x, bx = blockIdx.x;
    const int vcu = (G % 8 == 0) ? (bx % 8) * (G / 8) + bx / 8 : bx;
    const int gw = vcu * NWAVES + wave, NGW = G * NWAVES;
    unsigned char* ws = P.ws;
    float* MODS = (float*)(ws + WS_MODS);
    float* X = (float*)(ws + WS_X);
    bf16* H = (bf16*)(ws + WS_H);
    bf16 *NAQ = (bf16*)(ws + WS_NAQ), *NAK = (bf16*)(ws + WS_NAK), *NAV = (bf16*)(ws + WS_NAV), *GQ = (bf16*)(ws + WS_GQ), *GK = (bf16*)(ws + WS_GK), *GV = (bf16*)(ws + WS_GV);
    bf16 *SA = (bf16*)(ws + WS_SA), *SB = (bf16*)(ws + WS_SB), *YA = (bf16*)(ws + WS_YA), *YB = (bf16*)(ws + WS_YB), *ACT = (bf16*)(ws + WS_ACT);

    {
        float* sl = (float*)lds;
        f32x4* red = (f32x4*)(lds + 16384);
        for (int i = tid; i < 3072; i += NTHREADS) { const int v = i >> 10, k = i & 1023; const float xv = v < 2 ? P.c[v * 1024 + k] : P.c_ctx[k]; sl[i] = xv * sigmoidf_(xv); }
        __syncthreads();
        const int cgi = tid & 31, kc = tid >> 5;
        for (int item = bx; item < 192; item += G) {
            const int l = item / 48, jb = (item % 48) * 128;
            const float* w = P.w_mod + (size_t)l * DM * 6144 + jb + cgi * 4;
            f32x4 a0 = {0.f, 0.f, 0.f, 0.f}, a1 = a0, a2 = a0;
#pragma unroll 8
            for (int kk = 0; kk < 64; ++kk) { const int k = kc * 64 + kk; const f32x4 wv = *(const f32x4*)(w + (size_t)k * 6144);
                a0 = a0 + wv * sl[k]; a1 = a1 + wv * sl[1024 + k]; a2 = a2 + wv * sl[2048 + k]; }
            red[(kc * 3 + 0) * 32 + cgi] = a0; red[(kc * 3 + 1) * 32 + cgi] = a1; red[(kc * 3 + 2) * 32 + cgi] = a2;
            __syncthreads();
            if (tid < 384) { const int v = tid >> 7, cc = tid & 127; float s = 0.f;
#pragma unroll
                for (int q = 0; q < 16; ++q) s += ((const float*)&red[(q * 3 + v) * 32 + (cc >> 2)])[cc & 3];
                MODS[(size_t)(l * 3 + v) * 6144 + jb + cc] = s + P.b_mod[l * 6144 + jb + cc]; }
            __syncthreads();
        }
        __syncthreads();
        phase_wconv(P, 0, ws, ldsl, gw, NGW, wave, launder(lane));
    }
    grid.sync();

    for (int l = 0; l < DEPTH; ++l) {
        const bool last = (l == DEPTH - 1);
        const float* mods = MODS + (size_t)l * 3 * 6144;
        const int MG = last ? NL : MT;
        if (l > 0) phase_wconv(P, l, ws, ldsl, gw, NGW, wave, launder(lane));
        { const int ln = launder(lane);
        for (int row = gw; row < MT; row += NGW) {
            const int v = row < NL ? (row >> 13) : 2;
            const float* xr = (l == 0) ? (row < NL ? P.x + (size_t)row * DM : P.ctx + (size_t)(row - NL) * DM) : X + (size_t)row * DM;
            norm_row(xr, l == 0 ? X + (size_t)row * DM : nullptr, P.norm1 + l * DM, mods + v * 6144 + 0, mods + v * 6144 + 1024, H + (size_t)row * DM, ln);
        } }
        grid.sync();
        {
            pg8::Gemm g{H, (const bf16*)(ws + WS_WIN), MT, INC, DM}; pg8::StaticOrder S; S.init(MT, INC, G, bx);
            EpiIn E{NAQ, NAK, NAV, GQ, GK, GV, SA, SB, P.q_gain + l * 64, P.k_gain + l * 64};
            pg8::gemm_phase<EpiIn, pg8::StaticOrder, true, true>(ldsl, g, S, E);
        }
        grid.sync();
        {
            char* shm = (char*)lds;
            const int total = last ? 1024 : 1056;
            for (int idx = vcu; idx < total; idx += G) {
                const bf16 *Qp, *Kp, *Vp; bf16* Op; int KP, kr0 = 0, nwin = 0, nt = 4, qgr0 = 0; bool na = false; const float* rpbh = P.na_rpb;
                if (idx < 512) {
                    const int b = idx >> 8, hq = (idx >> 5) & 7, qb = idx & 31, kvh = hq >> 2;
                    Qp = GQ + (size_t)(b * SEQ + qb * 256) * 512 + hq * 64; Kp = GK + (size_t)(b * 8448) * 128 + kvh * 64; Vp = GV + (size_t)(b * 8448) * 128 + kvh * 64; KP = 128;
                    Op = YB + (size_t)(b * SEQ + qb * 256) * 512 + hq * 64; nwin = 128; nt = 132;
                } else if (idx < 1024) {
                    const int un = idx - 512, b = un >> 8, h = (un >> 5) & 7, R = un & 31;
                    kr0 = min(max(4 * R - 4, 0), 120); const int kr1 = min(max(4 * R - 1, 0), 120) + 7; nwin = kr1 - kr0 + 1; nt = nwin + 4; na = true; qgr0 = 4 * R;
                    Qp = NAQ + (size_t)(b * SEQ + R * 256) * 512 + h * 64; Kp = NAK + (size_t)(b * 8448) * 512 + h * 64; Vp = NAV + (size_t)(b * 8448) * 512 + h * 64; KP = 512;
                    Op = YA + (size_t)(b * SEQ + R * 256) * 512 + h * 64; rpbh = P.na_rpb + (size_t)(l * 8 + h) * 465;
                } else {
                    const int uc = idx - 1024, b = (uc >> 3) & 1, h = uc & 7;
                    if (uc < 16) { Qp = NAQ + (size_t)(NL + b * 256) * 512 + h * 64; Kp = NAK + (size_t)(b * 8448) * 512 + h * 64; Vp = NAV + (size_t)(b * 8448) * 512 + h * 64; KP = 512;
                        Op = YA + (size_t)(NL + b * 256) * 512 + h * 64; }
                    else { Qp = GQ + (size_t)(NL + b * 256) * 512 + h * 64; Kp = GK + (size_t)(b * 8448) * 128 + (h >> 2) * 64; Vp = GV + (size_t)(b * 8448) * 128 + (h >> 2) * 64; KP = 128;
                        Op = YB + (size_t)(NL + b * 256) * 512 + h * 64; }
                }
                if (idx < 512) attn_body::attn_unit<8>((const attn_body::bf16*)Qp, (const attn_body::bf16*)Kp, (const attn_body::bf16*)Vp, (attn_body::bf16*)Op, 132, shm);
                else att::unit(Qp, Kp, Vp, KP, Op, kr0, nwin, nt, na, qgr0, rpbh, shm);
            }
        }
        grid.sync();
        for (int pass = 0; pass < 2; ++pass) {
            pg8::Gemm g{pass ? YB : YA, (const bf16*)(ws + (pass ? WS_WPB : WS_WPA)), MG, DM, 512}; pg8::StaticOrder S; S.init(MG, DM, G, bx);
            EpiMerge E{pass ? SB : SA, H, pass};
            pg8::gemm_phase<EpiMerge, pg8::StaticOrder, true, true>(ldsl, g, S, E);
        }
        grid.sync();
        {
            pg8::Gemm g{H, (const bf16*)(ws + WS_WO), MG, DM, DM}; pg8::StaticOrder S; S.init(MG, DM, G, bx);
            EpiRes E{X, mods + 2048};
            pg8::gemm_phase<EpiRes, pg8::StaticOrder, true, true>(ldsl, g, S, E);
        }
        grid.sync();
        { const int ln = launder(lane);
        for (int row = gw; row < MG; row += NGW) {
            const int v = row < NL ? (row >> 13) : 2;
            norm_row(X + (size_t)row * DM, nullptr, P.norm2 + l * DM, mods + v * 6144 + 3072, mods + v * 6144 + 4096, H + (size_t)row * DM, ln);
        } }
        grid.sync();
        {
            pg8::Gemm g{H, (const bf16*)(ws + WS_WFI), MG, FF2, DM}; pg8::StaticOrder S; S.init(MG, FF2, G, bx);
            EpiSwiglu E{ACT};
            pg8::gemm_phase<EpiSwiglu, pg8::StaticOrder, true, true>(ldsl, g, S, E);
        }
        grid.sync();
        {
            pg8::Gemm g{ACT, (const bf16*)(ws + WS_WFO), MG, DM, FF}; pg8::StaticOrder S; S.init(MG, DM, G, bx);
            EpiRes E{X, mods + 5120};
            pg8::gemm_phase<EpiRes, pg8::StaticOrder, true, true>(ldsl, g, S, E);
        }
        grid.sync();
    }
    for (int row = gw; row < NL; row += NGW) {
        const f32x4* xr = (const f32x4*)(X + (size_t)row * DM) + lane;
        f32x4 v[4]; float s = 0.f;
#pragma unroll
        for (int j = 0; j < 4; ++j) { v[j] = xr[64 * j]; s += (v[j].x * v[j].x + v[j].y * v[j].y) + (v[j].z * v[j].z + v[j].w * v[j].w); }
        const float r = rsqrtf(wave_sum(s) * (1.0f / DM) + EPS);
        f32x4* o = (f32x4*)(P.out + (size_t)row * DM) + lane;
#pragma unroll
        for (int j = 0; j < 4; ++j) o[64 * j] = (v[j] * r) * ((const f32x4*)P.final_norm + lane)[64 * j];
    }
}

extern "C" void kernel_launch(void* const* d_in, const int* in_sizes, int n_in, void* d_out, int out_size, void* d_ws, size_t ws_size, hipStream_t stream) {
    static int grid = 0;
    if (grid == 0) {
        if (n_in != 18 || ws_size < WS_END) { fprintf(stderr, "kernel_launch: need 18 inputs and >= %zu bytes of workspace; got n_in %d ws %zu\n", (size_t)WS_END, n_in, ws_size); grid = -1; return; }
        int dev = 0, cus = 0, per_cu = 0;
        hipGetDevice(&dev);
        hipDeviceGetAttribute(&cus, hipDeviceAttributeMultiprocessorCount, dev);
        if (hipFuncSetAttribute((const void*)mega_fwd, hipFuncAttributeMaxDynamicSharedMemorySize, LDS_BYTES) != hipSuccess) { fprintf(stderr, "kernel_launch: hipFuncSetAttribute failed\n"); grid = -1; return; }
        if (hipOccupancyMaxActiveBlocksPerMultiprocessor(&per_cu, (const void*)mega_fwd, NTHREADS, LDS_BYTES) != hipSuccess || per_cu < 1) { fprintf(stderr, "kernel_launch: occupancy query says %d\n", per_cu); per_cu = 1; }
        (void)hipGetLastError();
        grid = cus * (per_cu > 1 ? 1 : per_cu);
    }
    if (grid < 0) return;
    Params p{};
    const float** pp = (const float**)&p;
    for (int i = 0; i < 18; ++i) pp[i] = (const float*)d_in[i];
    p.out = (float*)d_out; p.ws = (unsigned char*)d_ws;
    void* args[] = {&p};
    hipError_t e = hipLaunchCooperativeKernel((const void*)mega_fwd, dim3(grid), dim3(NTHREADS), args, LDS_BYTES, stream);
    if (e != hipSuccess) fprintf(stderr, "cooperative launch failed: %s (grid %d)\n", hipGetErrorString(e), grid);
}
```

```cpp
#include <hip/hip_runtime.h>
#include <hip/hip_cooperative_groups.h>
#include <cstdio>
#include <cstdint>
#include <hip/hip_bf16.h>
#include <cmath>
namespace cg = cooperative_groups;
__device__ const float ROPE_TAB[128*16*2] = {
1.000000000e+00f, 0.000000000e+00f, 1.000000000e+00f, 0.000000000e+00f, 1.000000000e+00f, 0.000000000e+00f, 1.000000000e+00f, 0.000000000e+00f, 1.000000000e+00f, 0.000000000e+00f, 1.000000000e+00f, 0.000000000e+00f, 1.000000000e+00f, 0.000000000e+00f, 1.000000000e+00f, 0.000000000e+00f, 1.000000000e+00f, 0.000000000e+00f, 1.000000000e+00f, 0.000000000e+00f, 1.000000000e+00f, 0.000000000e+00f, 1.000000000e+00f, 0.000000000e+00f, 1.000000000e+00f, 0.000000000e+00f, 1.000000000e+00f, 0.000000000e+00f, 1.000000000e+00f, 0.000000000e+00f, 1.000000000e+00f, 0.000000000e+00f,
5.403022766e-01f, 8.414710164e-01f, 8.460091352e-01f, 5.331684351e-01f, 9.504152536e-01f, 3.109835982e-01f, 9.842302203e-01f, 1.768921912e-01f, 9.950041771e-01f, 9.983342141e-02f, 9.984192848e-01f, 5.620449781e-02f, 9.995000362e-01f, 3.161750361e-02f, 9.998418689e-01f, 1.778185740e-02f, 9.999499917e-01f, 9.999833070e-03f, 9.999842048e-01f, 5.623383448e-03f, 9.999949932e-01f, 3.162272274e-03f, 9.999983907e-01f, 1.778278500e-03f, 9.999995232e-01f, 9.999999311e-04f, 9.999998212e-01f, 5.623412435e-04f, 9.999999404e-01f, 3.162277571e-04f, 1.000000000e+00f, 1.778279402e-04f,
-4.161468148e-01f, 9.092974067e-01f, 4.314628243e-01f, 9.021307230e-01f, 8.065783978e-01f, 5.911270976e-01f, 9.374182820e-01f, 3.482052684e-01f, 9.800665975e-01f, 1.986693293e-01f, 9.936820865e-01f, 1.122313142e-01f, 9.980006814e-01f, 6.320339441e-02f, 9.993675947e-01f, 3.555808961e-02f, 9.998000264e-01f, 1.999866590e-02f, 9.999367595e-01f, 1.124658901e-02f, 9.999799728e-01f, 6.324512884e-03f, 9.999936819e-01f, 3.556551412e-03f, 9.999979734e-01f, 1.999998698e-03f, 9.999993443e-01f, 1.124682371e-03f, 9.999998212e-01f, 6.324554561e-04f, 9.999999404e-01f, 3.556558804e-04f,
-9.899924994e-01f, 1.411200017e-01f, -1.159661636e-01f, 9.932531714e-01f, 5.827535987e-01f, 8.126488924e-01f, 8.610406518e-01f, 5.085361004e-01f, 9.553365111e-01f, 2.955202162e-01f, 9.858034849e-01f, 1.679033041e-01f, 9.955033660e-01f, 9.472608566e-02f, 9.985772967e-01f, 5.332308263e-02f, 9.995500445e-01f, 2.999549918e-02f, 9.998577237e-01f, 1.686943881e-02f, 9.999549985e-01f, 9.486690164e-03f, 9.999857545e-01f, 5.334813148e-03f, 9.999955297e-01f, 2.999995602e-03f, 9.999985695e-01f, 1.687023090e-03f, 9.999995232e-01f, 9.486831259e-04f, 9.999998808e-01f, 5.334838061e-04f,
-6.536436081e-01f, -7.568024993e-01f, -6.276797056e-01f, 7.784717083e-01f, 3.011374772e-01f, 9.535807371e-01f, 7.575061917e-01f, 6.528279781e-01f, 9.210609794e-01f, 3.894183338e-01f, 9.748082757e-01f, 2.230444849e-01f, 9.920106530e-01f, 1.261540651e-01f, 9.974712729e-01f, 7.107120752e-02f, 9.992001057e-01f, 3.998933360e-02f, 9.997470379e-01f, 2.249175683e-02f, 9.999200106e-01f, 1.264877338e-02f, 9.999747276e-01f, 7.113057654e-03f, 9.999920130e-01f, 3.999989480e-03f, 9.999974966e-01f, 2.249363344e-03f, 9.999992251e-01f, 1.264910679e-03f, 9.999997616e-01f, 7.113117026e-04f,
2.836621702e-01f, -9.589242935e-01f, -9.460792542e-01f, 3.239352703e-01f, -1.034233812e-02f, 9.999465346e-01f, 6.300802827e-01f, 7.765299678e-01f, 8.775825500e-01f, 4.794255495e-01f, 9.607312679e-01f, 2.774805427e-01f, 9.875259995e-01f, 1.574558765e-01f, 9.960497618e-01f, 8.879686147e-02f, 9.987502694e-01f, 4.997916520e-02f, 9.996047616e-01f, 2.811336145e-02f, 9.998750091e-01f, 1.581072807e-02f, 9.999604821e-01f, 8.891279809e-03f, 9.999874830e-01f, 4.999979399e-03f, 9.999960661e-01f, 2.811702900e-03f, 9.999987483e-01f, 1.581138116e-03f, 9.999995828e-01f, 8.891395992e-04f,
9.601702690e-01f, -2.794154882e-01f, -9.731037021e-01f, -2.303675264e-01f, -3.207963705e-01f, 9.471482038e-01f, 4.827820063e-01f, 8.757405281e-01f, 8.253356218e-01f, 5.646424890e-01f, 9.436169863e-01f, 3.310393095e-01f, 9.820539355e-01f, 1.886002719e-01f, 9.943132997e-01f, 1.064944416e-01f, 9.982005358e-01f, 5.996400490e-02f, 9.994308352e-01f, 3.373407945e-02f, 9.998199940e-01f, 1.897252724e-02f, 9.999430776e-01f, 1.066947449e-02f, 9.999819994e-01f, 5.999964196e-03f, 9.999943376e-01f, 3.374041524e-03f, 9.999982119e-01f, 1.897365320e-03f, 9.999994040e-01f, 1.066967379e-03f,
7.539022565e-01f, 6.569865942e-01f, -7.004297972e-01f, -7.137212753e-01f, -5.994374752e-01f, 8.004215956e-01f, 3.202570081e-01f, 9.473307133e-01f, 7.648422122e-01f, 6.442176700e-01f, 9.235194325e-01f, 3.835515678e-01f, 9.755998850e-01f, 2.195560932e-01f, 9.922624230e-01f, 1.241583377e-01f, 9.975510240e-01f, 6.994284689e-02f, 9.992253184e-01f, 3.935372457e-02f, 9.997550249e-01f, 2.213413455e-02f, 9.999225140e-01f, 1.244763471e-02f, 9.999755025e-01f, 6.999942940e-03f, 9.999922514e-01f, 3.936378751e-03f, 9.999975562e-01f, 2.213592408e-03f, 9.999992251e-01f, 1.244795276e-03f,
-1.455000341e-01f, 9.893582463e-01f, -2.120364457e-01f, -9.772617817e-01f, -8.186324239e-01f, 5.743178129e-01f, 1.476312131e-01f, 9.890424609e-01f, 6.967067122e-01f, 7.173560858e-01f, 9.005023241e-01f, 4.348512292e-01f, 9.681702852e-01f, 2.502923310e-01f, 9.898977876e-01f, 1.417829692e-01f, 9.968017340e-01f, 7.991468906e-02f, 9.989882708e-01f, 4.497213289e-02f, 9.996800423e-01f, 2.529552206e-02f, 9.998987913e-01f, 1.422575582e-02f, 9.999679923e-01f, 7.999914698e-03f, 9.999898672e-01f, 4.498715047e-03f, 9.999967813e-01f, 2.529819263e-03f, 9.999989867e-01f, 1.422623056e-03f,
-9.111302495e-01f, 4.121184647e-01f, 3.416602314e-01f, -9.398235083e-01f, -9.566441774e-01f, 2.912592292e-01f, -2.965079620e-02f, 9.995602965e-01f, 6.216099262e-01f, 7.833269238e-01f, 8.746382594e-01f, 4.847761393e-01f, 9.597726464e-01f, 2.807783186e-01f, 9.872201085e-01f, 1.593627781e-01f, 9.959527254e-01f, 8.987854421e-02f, 9.987195730e-01f, 5.058911815e-02f, 9.995950460e-01f, 2.845665626e-02f, 9.998719096e-01f, 1.600383036e-02f, 9.999595284e-01f, 8.999879472e-03f, 9.999871850e-01f, 5.061050411e-03f, 9.999959469e-01f, 2.846045885e-03f, 9.999987483e-01f, 1.600450720e-03f,
-8.390715122e-01f, -5.440210700e-01f, 7.901318669e-01f, -6.129369140e-01f, -9.997860789e-01f, -2.068356983e-02f, -2.059976310e-01f, 9.785524607e-01f, 5.403022766e-01f, 8.414710164e-01f, 8.460091352e-01f, 5.331684351e-01f, 9.504153132e-01f, 3.109835684e-01f, 9.842302203e-01f, 1.768921912e-01f, 9.950041771e-01f, 9.983341396e-02f, 9.984192848e-01f, 5.620449781e-02f, 9.995000362e-01f, 3.161750361e-02f, 9.998418689e-01f, 1.778185740e-02f, 9.999499917e-01f, 9.999834001e-03f, 9.999842048e-01f, 5.623383448e-03f, 9.999949932e-01f, 3.162272274e-03f, 9.999983907e-01f, 1.778278500e-03f,
4.425697960e-03f, -9.999902248e-01f, 9.952573776e-01f, -9.727646410e-02f, -9.437797070e-01f, -3.305749595e-01f, -3.758473992e-01f, 9.266815782e-01f, 4.535961151e-01f, 8.912073374e-01f, 8.147053123e-01f, 5.798751712e-01f, 9.401075840e-01f, 3.408778608e-01f, 9.809291363e-01f, 1.943656504e-01f, 9.939560890e-01f, 1.097782999e-01f, 9.980874062e-01f, 6.181810424e-02f, 9.993950725e-01f, 3.477803990e-02f, 9.998086691e-01f, 1.955982670e-02f, 9.999395013e-01f, 1.099977922e-02f, 9.999808669e-01f, 6.185714621e-03f, 9.999939203e-01f, 3.478498431e-03f, 9.999980927e-01f, 1.956106164e-03f,
8.438539505e-01f, -5.365729332e-01f, 8.938615918e-01f, 4.483429790e-01f, -7.941793799e-01f, -6.076834202e-01f, -5.338430405e-01f, 8.455836177e-01f, 3.623577356e-01f, 9.320390821e-01f, 7.808259130e-01f, 6.247486472e-01f, 9.288598895e-01f, 3.704312742e-01f, 9.773178697e-01f, 2.117776722e-01f, 9.928086400e-01f, 1.197122037e-01f, 9.977239966e-01f, 6.742975861e-02f, 9.992800951e-01f, 3.793822229e-02f, 9.997723103e-01f, 2.133773454e-02f, 9.999279976e-01f, 1.199971233e-02f, 9.999772310e-01f, 6.748044398e-03f, 9.999927878e-01f, 3.794723889e-03f, 9.999977350e-01f, 2.133933594e-03f,
9.074468017e-01f, 4.201670587e-01f, 5.171728134e-01f, 8.558809757e-01f, -5.658205152e-01f, -8.245284557e-01f, -6.750016809e-01f, 7.378162146e-01f, 2.674987614e-01f, 9.635581970e-01f, 7.444779873e-01f, 6.676470041e-01f, 9.166833758e-01f, 3.996143043e-01f, 9.733975530e-01f, 2.291227132e-01f, 9.915618896e-01f, 1.296341419e-01f, 9.973290563e-01f, 7.303927839e-02f, 9.991551042e-01f, 4.109803215e-02f, 9.997327924e-01f, 2.311557345e-02f, 9.999154806e-01f, 1.299963426e-02f, 9.999732971e-01f, 7.310371846e-03f, 9.999915361e-01f, 4.110949114e-03f, 9.999973178e-01f, 2.311761025e-03f,
1.367372274e-01f, 9.906073809e-01f, -1.879615150e-02f, 9.998233318e-01f, -2.813494802e-01f, -9.596053958e-01f, -7.948708534e-01f, 6.067786217e-01f, 1.699671596e-01f, 9.854497313e-01f, 7.057763338e-01f, 7.084347010e-01f, 9.035902619e-01f, 4.283977747e-01f, 9.691694379e-01f, 2.463953048e-01f, 9.902160168e-01f, 1.395431161e-01f, 9.969025850e-01f, 7.864648104e-02f, 9.990201592e-01f, 4.425742477e-02f, 9.996901155e-01f, 2.489333972e-02f, 9.999020100e-01f, 1.399954315e-02f, 9.999690056e-01f, 7.872696966e-03f, 9.999902248e-01f, 4.427174106e-03f, 9.999969006e-01f, 2.489588689e-03f,
-7.596879005e-01f, 6.502878666e-01f, -5.489754677e-01f, 8.358384371e-01f, 3.102234937e-02f, -9.995186925e-01f, -8.896704316e-01f, 4.566032588e-01f, 7.073719800e-02f, 9.974949956e-01f, 6.648434997e-01f, 7.469826937e-01f, 8.895936012e-01f, 4.567528665e-01f, 9.646348357e-01f, 2.635899782e-01f, 9.887710810e-01f, 1.494381279e-01f, 9.964445233e-01f, 8.425120264e-02f, 9.988752007e-01f, 4.741638154e-02f, 9.996442795e-01f, 2.667102963e-02f, 9.998875260e-01f, 1.499943808e-02f, 9.999644160e-01f, 8.435020223e-03f, 9.999887347e-01f, 4.743398633e-03f, 9.999964237e-01f, 2.667415887e-03f,
-9.576594830e-01f, -2.879033387e-01f, -9.100810885e-01f, 4.144302309e-01f, 3.403181434e-01f, -9.403103590e-01f, -9.564100504e-01f, 2.920270860e-01f, -2.919954434e-02f, 9.995735884e-01f, 6.218088269e-01f, 7.831690907e-01f, 8.747074604e-01f, 4.846512377e-01f, 9.597951770e-01f, 2.807013094e-01f, 9.872272611e-01f, 1.593182087e-01f, 9.959549904e-01f, 8.985326439e-02f, 9.987202883e-01f, 5.057485774e-02f, 9.995952845e-01f, 2.844863199e-02f, 9.998720288e-01f, 1.599931903e-02f, 9.999595284e-01f, 8.997339755e-03f, 9.999871850e-01f, 5.059622694e-03f, 9.999959469e-01f, 2.845243318e-03f,
-2.751633525e-01f, -9.613974690e-01f, -9.908979535e-01f, -1.346151382e-01f, 6.158647537e-01f, -7.878518701e-01f, -9.929850101e-01f, 1.182405204e-01f, -1.288445443e-01f, 9.916648269e-01f, 5.768082738e-01f, 8.168795705e-01f, 8.589466810e-01f, 5.120649934e-01f, 9.546520114e-01f, 2.977238595e-01f, 9.855847955e-01f, 1.691823453e-01f, 9.954339862e-01f, 9.545248002e-02f, 9.985553622e-01f, 5.373282731e-02f, 9.995430708e-01f, 3.022614494e-02f, 9.998555183e-01f, 1.699918136e-02f, 9.999542832e-01f, 9.559656493e-03f, 9.999855757e-01f, 5.375845823e-03f, 9.999954104e-01f, 3.023070283e-03f,
6.603167057e-01f, -7.509872317e-01f, -7.665365338e-01f, -6.422007084e-01f, 8.303361535e-01f, -5.572628975e-01f, -9.982416630e-01f, -5.927551538e-02f, -2.272021621e-01f, 9.738476276e-01f, 5.299841762e-01f, 8.480075598e-01f, 8.423270583e-01f, 5.389667153e-01f, 9.492070079e-01f, 3.146522641e-01f, 9.838436842e-01f, 1.790295690e-01f, 9.948815107e-01f, 1.010486856e-01f, 9.983804226e-01f, 5.689026415e-02f, 9.994877577e-01f, 3.200356290e-02f, 9.998379946e-01f, 1.799902879e-02f, 9.999487996e-01f, 1.012197044e-02f, 9.999837875e-01f, 5.692068953e-03f, 9.999948740e-01f, 3.200897481e-03f,
9.887046218e-01f, 1.498772055e-01f, -3.060954213e-01f, -9.520008564e-01f, 9.624637961e-01f, -2.714101076e-01f, -9.720142484e-01f, -2.349218130e-01f, -3.232895434e-01f, 9.463000894e-01f, 4.814845622e-01f, 8.764545918e-01f, 8.248651624e-01f, 5.653295517e-01f, 9.434618354e-01f, 3.314811885e-01f, 9.820042253e-01f, 1.888588965e-01f, 9.942975044e-01f, 1.066416800e-01f, 9.981955290e-01f, 6.004713103e-02f, 9.994292855e-01f, 3.378088027e-02f, 9.998195171e-01f, 1.899885759e-02f, 9.999428988e-01f, 1.068428159e-02f, 9.999819398e-01f, 6.008291151e-03f, 9.999942780e-01f, 3.378724447e-03f,
4.080820680e-01f, 9.129452705e-01f, 2.486167252e-01f, -9.686019421e-01f, 9.991443753e-01f, 4.135829210e-02f, -9.151299596e-01f, -4.031589925e-01f, -4.161468148e-01f, 9.092974067e-01f, 4.314628243e-01f, 9.021307230e-01f, 8.065784574e-01f, 5.911270380e-01f, 9.374182820e-01f, 3.482052684e-01f, 9.800665975e-01f, 1.986693144e-01f, 9.936820865e-01f, 1.122313142e-01f, 9.980006814e-01f, 6.320339441e-02f, 9.993675947e-01f, 3.555808961e-02f, 9.998000264e-01f, 1.999866776e-02f, 9.999367595e-01f, 1.124658901e-02f, 9.999799728e-01f, 6.324512884e-03f, 9.999936819e-01f, 3.556551412e-03f,
-5.477292538e-01f, 8.366556168e-01f, 7.267602682e-01f, -6.868911982e-01f, 9.367404580e-01f, 3.500247598e-01f, -8.293829560e-01f, -5.586804748e-01f, -5.048462152e-01f, 8.632093072e-01f, 3.800770044e-01f, 9.249548316e-01f, 7.874851823e-01f, 6.163335443e-01f, 9.310783744e-01f, 3.648192585e-01f, 9.780309200e-01f, 2.084598988e-01f, 9.930352569e-01f, 1.178173944e-01f, 9.977958202e-01f, 6.635902822e-02f, 9.993028045e-01f, 3.733518720e-02f, 9.997795224e-01f, 2.099845745e-02f, 9.999302626e-01f, 1.180889271e-02f, 9.999779463e-01f, 6.640734151e-03f, 9.999930263e-01f, 3.734378144e-03f,
-9.999608397e-01f, -8.851309307e-03f, 9.810745716e-01f, -1.936302334e-01f, 7.814403772e-01f, 6.239799261e-01f, -7.174775004e-01f, -6.965817213e-01f, -5.885011554e-01f, 8.084963560e-01f, 3.274896145e-01f, 9.448547959e-01f, 7.676045895e-01f, 6.409237385e-01f, 9.244439602e-01f, 3.813178837e-01f, 9.758974314e-01f, 2.182296216e-01f, 9.923570156e-01f, 1.233997419e-01f, 9.975810051e-01f, 6.951400638e-02f, 9.992348552e-01f, 3.911216930e-02f, 9.997580051e-01f, 2.199822664e-02f, 9.999234676e-01f, 1.237119269e-02f, 9.999758005e-01f, 6.956954487e-03f, 9.999923706e-01f, 3.912204877e-03f,
-5.328330398e-01f, -8.462203741e-01f, 9.332357645e-01f, 3.592645228e-01f, 5.486452579e-01f, 8.360552788e-01f, -5.829432607e-01f, -8.125128746e-01f, -6.662759781e-01f, 7.457052469e-01f, 2.738668621e-01f, 9.617676139e-01f, 7.469564080e-01f, 6.648730636e-01f, 9.175173044e-01f, 3.976959288e-01f, 9.736663699e-01f, 2.279775143e-01f, 9.916474223e-01f, 1.289781928e-01f, 9.973561764e-01f, 7.266827673e-02f, 9.991636872e-01f, 4.088902473e-02f, 9.997355342e-01f, 2.299797349e-02f, 9.999163747e-01f, 1.293348987e-02f, 9.999735355e-01f, 7.273174357e-03f, 9.999916553e-01f, 4.090031609e-03f,
4.241790175e-01f, -9.055783749e-01f, 5.979771614e-01f, 8.015131354e-01f, 2.614417076e-01f, 9.652192593e-01f, -4.300232828e-01f, -9.028177857e-01f, -7.373937964e-01f, 6.754631400e-01f, 2.193782777e-01f, 9.756398797e-01f, 7.255613208e-01f, 6.881574988e-01f, 9.103004336e-01f, 4.139482081e-01f, 9.713379741e-01f, 2.377026230e-01f, 9.909064770e-01f, 1.345525682e-01f, 9.971213937e-01f, 7.582182437e-02f, 9.990894198e-01f, 4.266574979e-02f, 9.997119904e-01f, 2.399769612e-02f, 9.999089241e-01f, 1.349578146e-02f, 9.999712110e-01f, 7.589393295e-03f, 9.999908805e-01f, 4.267857410e-03f,
9.912028313e-01f, -1.323517561e-01f, 7.855226099e-02f, 9.969099760e-01f, -5.168933049e-02f, 9.986631870e-01f, -2.635405958e-01f, -9.646483064e-01f, -8.011435866e-01f, 5.984721780e-01f, 1.641961634e-01f, 9.864277244e-01f, 7.034407258e-01f, 7.107539177e-01f, 9.027957320e-01f, 4.300695956e-01f, 9.689124227e-01f, 2.474039644e-01f, 9.901341200e-01f, 1.401226968e-01f, 9.968765974e-01f, 7.897461206e-02f, 9.990119338e-01f, 4.444234073e-02f, 9.996874928e-01f, 2.499739639e-02f, 9.999011755e-01f, 1.405806933e-02f, 9.999687672e-01f, 7.905611768e-03f, 9.999901056e-01f, 4.445684142e-03f,
6.469193697e-01f, 7.625584006e-01f, -4.650644958e-01f, 8.852767944e-01f, -3.596943319e-01f, 9.330701828e-01f, -8.874549717e-02f, -9.960543513e-01f, -8.568888307e-01f, 5.155012608e-01f, 1.084949449e-01f, 9.940969944e-01f, 6.806167960e-01f, 7.326396108e-01f, 8.950055242e-01f, 4.460549951e-01f, 9.663899541e-01f, 2.570805550e-01f, 9.893305302e-01f, 1.456883848e-01f, 9.966219068e-01f, 8.212661743e-02f, 9.989313483e-01f, 4.621879384e-02f, 9.996620417e-01f, 2.599707060e-02f, 9.998931289e-01f, 1.462035347e-02f, 9.999662042e-01f, 8.221829310e-03f, 9.999893308e-01f, 4.623509943e-03f,
-2.921388149e-01f, 9.563759565e-01f, -8.654506207e-01f, 5.009942055e-01f, -6.320286393e-01f, 7.749450207e-01f, 8.884812146e-02f, -9.960451722e-01f, -9.040721655e-01f, 4.273798466e-01f, 5.245061219e-02f, 9.986234903e-01f, 6.571123004e-01f, 7.537927032e-01f, 8.869323730e-01f, 4.618993104e-01f, 9.637709260e-01f, 2.667314112e-01f, 9.884956479e-01f, 1.512494683e-01f, 9.963572025e-01f, 8.527779579e-02f, 9.988475442e-01f, 4.799510166e-02f, 9.996355176e-01f, 2.699672058e-02f, 9.998847246e-01f, 1.518263202e-02f, 9.999635220e-01f, 8.538045920e-03f, 9.999884963e-01f, 4.801335745e-03f,
-9.626058936e-01f, 2.709057927e-01f, -9.992933869e-01f, -3.758566082e-02f, -8.416849375e-01f, 5.399689674e-01f, 2.636395097e-01f, -9.646213055e-01f, -9.422222972e-01f, 3.349882066e-01f, -3.759419080e-03f, 9.999929070e-01f, 6.329506636e-01f, 7.741921544e-01f, 8.785787225e-01f, 4.775975943e-01f, 9.610554576e-01f, 2.763556540e-01f, 9.876294732e-01f, 1.568057537e-01f, 9.960825443e-01f, 8.842811733e-02f, 9.987606406e-01f, 4.977125302e-02f, 9.996080399e-01f, 2.799634263e-02f, 9.998760223e-01f, 1.574490592e-02f, 9.999607801e-01f, 8.854261599e-03f, 9.999876022e-01f, 4.979162011e-03f,
-7.480575442e-01f, -6.636338830e-01f, -8.253716230e-01f, -5.645897985e-01f, -9.678714871e-01f, 2.514452934e-01f, 4.301158488e-01f, -9.027737379e-01f, -9.709581733e-01f, 2.392492294e-01f, -5.995756760e-02f, 9.982009530e-01f, 6.081562042e-01f, 7.938174009e-01f, 8.699471951e-01f, 4.931448400e-01f, 9.582439065e-01f, 2.859522104e-01f, 9.867320657e-01f, 1.623570919e-01f, 9.957979321e-01f, 9.157756716e-02f, 9.986705780e-01f, 5.154724792e-02f, 9.995795488e-01f, 2.899593674e-02f, 9.998670220e-01f, 1.630717516e-02f, 9.999579787e-01f, 9.170476347e-03f, 9.999867082e-01f, 5.156987347e-03f,
1.542514563e-01f, -9.880316257e-01f, -3.972518742e-01f, -9.177096486e-01f, -9.980752468e-01f, -6.201483682e-02f, 5.830269456e-01f, -8.124528527e-01f, -9.899924994e-01f, 1.411200017e-01f, -1.159661636e-01f, 9.932531714e-01f, 5.827535987e-01f, 8.126488924e-01f, 8.610406518e-01f, 5.085361004e-01f, 9.553365111e-01f, 2.955201864e-01f, 9.858034849e-01f, 1.679033041e-01f, 9.955033660e-01f, 9.472609311e-02f, 9.985772967e-01f, 5.332308263e-02f, 9.995500445e-01f, 2.999550104e-02f, 9.998577237e-01f, 1.686943881e-02f, 9.999549985e-01f, 9.486690164e-03f, 9.999857545e-01f, 5.334813148e-03f,
9.147423506e-01f, -4.040376544e-01f, 1.532154679e-01f, -9.881927967e-01f, -9.293003082e-01f, -3.693250120e-01f, 7.175492644e-01f, -6.965078115e-01f, -9.991351366e-01f, 4.158052057e-02f, -1.716081351e-01f, 9.851652980e-01f, 5.567683578e-01f, 8.306677938e-01f, 8.518617749e-01f, 5.237666368e-01f, 9.523335695e-01f, 3.050586283e-01f, 9.848436713e-01f, 1.734442115e-01f, 9.951988459e-01f, 9.787366539e-02f, 9.984809160e-01f, 5.509874597e-02f, 9.995195270e-01f, 3.099503554e-02f, 9.998480678e-01f, 1.743169688e-02f, 9.999519587e-01f, 9.802903049e-03f, 9.999848008e-01f, 5.512638018e-03f,
8.342233300e-01f, 5.514267087e-01f, 6.564951539e-01f, -7.543302178e-01f, -7.683671117e-01f, -6.400093436e-01f, 8.294403553e-01f, -5.585952401e-01f, -9.982947707e-01f, -5.837418884e-02f, -2.267075926e-01f, 9.739628434e-01f, 5.302263498e-01f, 8.478561044e-01f, 8.424135447e-01f, 5.388315320e-01f, 9.492354393e-01f, 3.145665526e-01f, 9.838528037e-01f, 1.789796203e-01f, 9.948843718e-01f, 1.010202691e-01f, 9.983813763e-01f, 5.687423423e-02f, 9.994880557e-01f, 3.199454024e-02f, 9.998381138e-01f, 1.799395122e-02f, 9.999487996e-01f, 1.011911593e-02f, 9.999837875e-01f, 5.690463353e-03f,
-1.327674743e-02f, 9.999118447e-01f, 9.575860500e-01f, -2.881473601e-01f, -5.312352777e-01f, -8.472243547e-01f, 9.151713848e-01f, -4.030649364e-01f, -9.874798059e-01f, -1.577456445e-01f, -2.810902894e-01f, 9.596813321e-01f, 5.031541586e-01f, 8.641966581e-01f, 8.326989412e-01f, 5.537260175e-01f, 9.460423589e-01f, 3.240430057e-01f, 9.828307629e-01f, 1.845093668e-01f, 9.945599437e-01f, 1.041658595e-01f, 9.982786179e-01f, 5.864954367e-02f, 9.994555712e-01f, 3.299400955e-02f, 9.998278022e-01f, 1.855619811e-02f, 9.999455214e-01f, 1.043532696e-02f, 9.999827743e-01f, 5.868288688e-03f,
-8.485702872e-01f, 5.290827155e-01f, 9.637575150e-01f, 2.667797208e-01f, -2.414211035e-01f, -9.704204202e-01f, 9.720383286e-01f, -2.348221242e-01f, -9.667981863e-01f, -2.555412054e-01f, -3.345843554e-01f, 9.423658252e-01f, 4.755789042e-01f, 8.796730638e-01f, 8.227210045e-01f, 5.684453845e-01f, 9.427546859e-01f, 3.334870934e-01f, 9.817776680e-01f, 1.900332868e-01f, 9.942255616e-01f, 1.073104069e-01f, 9.981727600e-01f, 6.042466685e-02f, 9.994220734e-01f, 3.399345279e-02f, 9.998172522e-01f, 1.911843941e-02f, 9.999421835e-01f, 1.075153705e-02f, 9.999817014e-01f, 6.046113092e-03f,
-9.036921859e-01f, -4.281826615e-01f, 6.731102467e-01f, 7.395421863e-01f, 7.233466953e-02f, -9.973804355e-01f, 9.982477427e-01f, -5.917267874e-02f, -9.364566803e-01f, -3.507832289e-01f, -3.870206773e-01f, 9.220710397e-01f, 4.475280643e-01f, 8.942698836e-01f, 8.124829531e-01f, 5.829849839e-01f, 9.393727183e-01f, 3.428978026e-01f, 9.806935191e-01f, 1.955512017e-01f, 9.938812256e-01f, 1.104538813e-01f, 9.980637431e-01f, 6.219960377e-02f, 9.993875623e-01f, 3.499285504e-02f, 9.998063445e-01f, 1.968067512e-02f, 9.999387264e-01f, 1.106774528e-02f, 9.999806285e-01f, 6.223937962e-03f,
-1.279636919e-01f, -9.917788506e-01f, 1.751565337e-01f, 9.845405817e-01f, 3.789161742e-01f, -9.254310131e-01f, 9.929728508e-01f, 1.183425784e-01f, -8.967583776e-01f, -4.425205886e-01f, -4.382335246e-01f, 8.988611698e-01f, 4.190297425e-01f, 9.079725146e-01f, 8.019878864e-01f, 5.973402858e-01f, 9.358968139e-01f, 3.522742093e-01f, 9.795783162e-01f, 2.010629177e-01f, 9.935269952e-01f, 1.135962531e-01f, 9.979515672e-01f, 6.397433579e-02f, 9.993520975e-01f, 3.599222749e-02f, 9.997950792e-01f, 2.024290524e-02f, 9.999352098e-01f, 1.138395350e-02f, 9.999794960e-01f, 6.401761901e-03f,
7.654140592e-01f, -6.435381174e-01f, -3.767422736e-01f, 9.263181090e-01f, 6.479216814e-01f, -7.617069483e-01f, 9.563800097e-01f, 2.921253741e-01f, -8.481000066e-01f, -5.298361778e-01f, -4.880608618e-01f, 8.728095889e-01f, 3.901124299e-01f, 9.207672477e-01f, 7.912392616e-01f, 6.115067005e-01f, 9.323273301e-01f, 3.616154492e-01f, 9.784321785e-01f, 2.065682709e-01f, 9.931628108e-01f, 1.167374924e-01f, 9.978361726e-01f, 6.574887782e-02f, 9.993155599e-01f, 3.699155897e-02f, 9.997835755e-01f, 2.080512606e-02f, 9.999315739e-01f, 1.170015987e-02f, 9.999783635e-01f, 6.579586305e-03f,
9.550736547e-01f, 2.963685691e-01f, -8.126112223e-01f, 5.828061700e-01f, 8.526731133e-01f, -5.224447846e-01f, 8.896234632e-01f, 4.566946924e-01f, -7.909677625e-01f, -6.118578315e-01f, -5.363451838e-01f, 8.439987302e-01f, 3.608050346e-01f, 9.326412678e-01f, 7.802404165e-01f, 6.254796982e-01f, 9.286646247e-01f, 3.709204793e-01f, 9.772551060e-01f, 2.120671123e-01f, 9.927886724e-01f, 1.198775545e-01f, 9.977176785e-01f, 6.752320379e-02f, 9.992780685e-01f, 3.799085692e-02f, 9.997717142e-01f, 2.136734314e-02f, 9.999278188e-01f, 1.201636530e-02f, 9.999771714e-01f, 6.757410709e-03f,
2.666429281e-01f, 9.637953639e-01f, -9.982103705e-01f, 5.980031565e-02f, 9.728653431e-01f, -2.313720286e-01f, 7.948083878e-01f, 6.068604589e-01f, -7.259323001e-01f, -6.877661943e-01f, -5.829339027e-01f, 8.125195503e-01f, 3.311368823e-01f, 9.435827136e-01f, 7.689949274e-01f, 6.392549276e-01f, 9.249090552e-01f, 3.801884055e-01f, 9.760470986e-01f, 2.175592482e-01f, 9.924046397e-01f, 1.230164245e-01f, 9.975960255e-01f, 6.929731369e-02f, 9.992396235e-01f, 3.899011388e-02f, 9.997594953e-01f, 2.192955278e-02f, 9.999239445e-01f, 1.233256981e-02f, 9.999759793e-01f, 6.935234182e-03f,
-6.669380665e-01f, 7.451131940e-01f, -8.763794303e-01f, -4.816212952e-01f, 9.965789914e-01f, 8.264580369e-02f, 6.749256253e-01f, 7.378857732e-01f, -6.536436081e-01f, -7.568024993e-01f, -6.276797056e-01f, 7.784717083e-01f, 3.011375964e-01f, 9.535806775e-01f, 7.575061917e-01f, 6.528279781e-01f, 9.210609794e-01f, 3.894183338e-01f, 9.748082757e-01f, 2.230444849e-01f, 9.920106530e-01f, 1.261540651e-01f, 9.974712729e-01f, 7.107120752e-02f, 9.992001057e-01f, 3.998933733e-02f, 9.997470379e-01f, 2.249175683e-02f, 9.999200106e-01f, 1.264877338e-02f, 9.999747276e-01f, 7.113057654e-03f,
-9.873392582e-01f, -1.586226672e-01f, -4.846394062e-01f, -8.747140765e-01f, 9.214623570e-01f, 3.884676993e-01f, 5.337560773e-01f, 8.456385136e-01f, -5.748240352e-01f, -8.182770610e-01f, -6.704410911e-01f, 7.419627309e-01f, 2.708370984e-01f, 9.626252055e-01f, 7.457779050e-01f, 6.661946774e-01f, 9.171208143e-01f, 3.986093104e-01f, 9.735385776e-01f, 2.285226882e-01f, 9.916067719e-01f, 1.292904317e-01f, 9.973433018e-01f, 7.284487784e-02f, 9.991596341e-01f, 4.098851606e-02f, 9.997342229e-01f, 2.305394970e-02f, 9.999159575e-01f, 1.296497509e-02f, 9.999734163e-01f, 7.290880661e-03f,
-3.999853134e-01f, -9.165215492e-01f, 5.636094138e-02f, -9.984104633e-01f, 7.549653053e-01f, 6.557646990e-01f, 3.757521510e-01f, 9.267202020e-01f, -4.902605712e-01f, -8.715758920e-01f, -7.110829353e-01f, 7.031081319e-01f, 2.402658761e-01f, 9.707071185e-01f, 7.338138223e-01f, 6.793506742e-01f, 9.130889177e-01f, 4.077604413e-01f, 9.722381234e-01f, 2.339936644e-01f, 9.911929369e-01f, 1.324255317e-01f, 9.972121716e-01f, 7.461831719e-02f, 9.991181493e-01f, 4.198765755e-02f, 9.997211099e-01f, 2.361613885e-02f, 9.999117851e-01f, 1.328117587e-02f, 9.999721050e-01f, 7.468704134e-03f,
5.551133156e-01f, -8.317747116e-01f, 5.800030828e-01f, -8.146142364e-01f, 5.135983825e-01f, 8.580306768e-01f, 2.058971673e-01f, 9.785736203e-01f, -4.007990062e-01f, -9.161660075e-01f, -7.494767308e-01f, 6.620306969e-01f, 2.094544172e-01f, 9.778184295e-01f, 7.216176391e-01f, 6.922917962e-01f, 9.089657664e-01f, 4.168707728e-01f, 9.709069133e-01f, 2.394572198e-01f, 9.907692075e-01f, 1.355592906e-01f, 9.970778823e-01f, 7.639151812e-02f, 9.990756512e-01f, 4.298675060e-02f, 9.997076392e-01f, 2.417832054e-02f, 9.999075532e-01f, 1.359737478e-02f, 9.999707937e-01f, 7.646527141e-03f,
9.998432994e-01f, 1.770192571e-02f, 9.250146747e-01f, -3.799313903e-01f, 2.212981731e-01f, 9.752061963e-01f, 2.954782173e-02f, 9.995633960e-01f, -3.073327839e-01f, -9.516021013e-01f, -7.855011225e-01f, 6.188602448e-01f, 1.784335226e-01f, 9.839519858e-01f, 7.091933489e-01f, 7.050140500e-01f, 9.047516584e-01f, 4.259394705e-01f, 9.695450068e-01f, 2.449132055e-01f, 9.903355837e-01f, 1.386916935e-01f, 9.969404936e-01f, 7.816448808e-02f, 9.990321398e-01f, 4.398580641e-02f, 9.996939301e-01f, 2.474049293e-02f, 9.999032021e-01f, 1.391357277e-02f, 9.999693632e-01f, 7.824349217e-03f,
5.253220201e-01f, 8.509035110e-01f, 9.851381779e-01f, 1.717635691e-01f, -9.294810891e-02f, 9.956709743e-01f, -1.477329880e-01f, 9.890272617e-01f, -2.107957900e-01f, -9.775301218e-01f, -8.190422058e-01f, 5.737333298e-01f, 1.472342163e-01f, 9.891016483e-01f, 6.965447664e-01f, 7.175133228e-01f, 9.004471302e-01f, 4.349655211e-01f, 9.681524038e-01f, 2.503614724e-01f, 9.898920655e-01f, 1.418227106e-01f, 9.967998862e-01f, 7.993719727e-02f, 9.989876747e-01f, 4.498481750e-02f, 9.996798635e-01f, 2.530265786e-02f, 9.998987317e-01f, 1.422976889e-02f, 9.999679923e-01f, 8.002171293e-03f,
-4.321779609e-01f, 9.017883539e-01f, 7.418580055e-01f, 6.705570221e-01f, -3.979767561e-01f, 9.173954725e-01f, -3.203543723e-01f, 9.472977519e-01f, -1.121526212e-01f, -9.936909676e-01f, -8.499938846e-01f, 5.267925262e-01f, 1.158876941e-01f, 9.932623506e-01f, 6.836758852e-01f, 7.297858000e-01f, 8.960524797e-01f, 4.439480901e-01f, 9.667292237e-01f, 2.558017969e-01f, 9.894386530e-01f, 1.449523121e-01f, 9.966561794e-01f, 8.170966059e-02f, 9.989421964e-01f, 4.598378390e-02f, 9.996654391e-01f, 2.586481534e-02f, 9.998942018e-01f, 1.454596408e-02f, 9.999665618e-01f, 8.179994300e-03f,
-9.923354983e-01f, 1.235731244e-01f, 2.700984478e-01f, 9.628326893e-01f, -6.635382771e-01f, 7.481423020e-01f, -4.828719497e-01f, 8.756909966e-01f, -1.238837745e-02f, -9.999232888e-01f, -8.782584071e-01f, 4.781863391e-01f, 8.442528546e-02f, 9.964298010e-01f, 6.705908179e-01f, 7.418274283e-01f, 8.915683031e-01f, 4.528862834e-01f, 9.652754664e-01f, 2.612340748e-01f, 9.889753461e-01f, 1.480804533e-01f, 9.965093136e-01f, 8.348185569e-02f, 9.988957047e-01f, 4.698270187e-02f, 9.996507764e-01f, 2.642696351e-02f, 9.998895526e-01f, 1.486215740e-02f, 9.999650717e-01f, 8.357816376e-03f,
-6.401443481e-01f, -7.682546377e-01f, -2.848466039e-01f, 9.585731030e-01f, -8.632964492e-01f, 5.046971440e-01f, -6.301599741e-01f, 7.764653563e-01f, 8.749917895e-02f, -9.961646199e-01f, -9.037463665e-01f, 4.280683994e-01f, 5.287845805e-02f, 9.986009598e-01f, 6.572937369e-01f, 7.536345124e-01f, 8.869948983e-01f, 4.617791772e-01f, 9.637911916e-01f, 2.666580379e-01f, 9.885020852e-01f, 1.512071192e-01f, 9.963592887e-01f, 8.525379747e-02f, 9.988481998e-01f, 4.798157141e-02f, 9.996357560e-01f, 2.698910423e-02f, 9.998847842e-01f, 1.517834887e-02f, 9.999635816e-01f, 8.535637520e-03f,
3.005925417e-01f, -9.537526369e-01f, -7.520639896e-01f, 6.590901017e-01f, -9.774427414e-01f, 2.112006694e-01f, -7.575730681e-01f, 6.527503729e-01f, 1.865124702e-01f, -9.824525714e-01f, -9.263771176e-01f, 3.765971363e-01f, 2.127875946e-02f, 9.997735620e-01f, 6.437888145e-01f, 7.652031779e-01f, 8.823328614e-01f, 4.706258774e-01f, 9.622764587e-01f, 2.720735669e-01f, 9.880189896e-01f, 1.543322802e-01f, 9.962061048e-01f, 8.702547103e-02f, 9.987997413e-01f, 4.898039624e-02f, 9.996203780e-01f, 2.755123749e-02f, 9.998799562e-01f, 1.549453940e-02f, 9.999620318e-01f, 8.713459596e-03f,
9.649659991e-01f, -2.623748481e-01f, -9.876590967e-01f, 1.566190720e-01f, -9.946564436e-01f, -1.032404676e-01f, -8.610926867e-01f, 5.084480047e-01f, 2.836621702e-01f, -9.589242935e-01f, -9.460792542e-01f, 3.239352703e-01f, -1.034221891e-02f, 9.999465346e-01f, 6.300802827e-01f, 7.765299678e-01f, 8.775825500e-01f, 4.794255495e-01f, 9.607312679e-01f, 2.774805427e-01f, 9.875259995e-01f, 1.574558914e-01f, 9.960497618e-01f, 8.879686147e-02f, 9.987502694e-01f, 4.997916892e-02f, 9.996047616e-01f, 2.811335959e-02f, 9.998750091e-01f, 1.581072807e-02f, 9.999604821e-01f, 8.891279809e-03f,
7.421542406e-01f, 6.702291369e-01f, -9.190735221e-01f, -3.940860629e-01f, -9.132301211e-01f, -4.074441493e-01f, -9.374542832e-01f, 3.481085002e-01f, 3.779776394e-01f, -9.258147478e-01f, -9.627903700e-01f, 2.702493370e-01f, -4.195285589e-02f, 9.991195798e-01f, 6.161724925e-01f, 7.876112461e-01f, 8.727445006e-01f, 4.881772399e-01f, 9.591556787e-01f, 2.828786969e-01f, 9.870231748e-01f, 1.605779380e-01f, 9.958902597e-01f, 9.056797624e-02f, 9.986997843e-01f, 5.097789690e-02f, 9.995887876e-01f, 2.867547423e-02f, 9.998699427e-01f, 1.612691768e-02f, 9.999588728e-01f, 9.069100954e-03f,
-1.629907787e-01f, 9.866275787e-01f, -5.674300194e-01f, -8.234215975e-01f, -7.412399650e-01f, -6.712400913e-01f, -9.842484593e-01f, 1.767906845e-01f, 4.685169160e-01f, -8.834545016e-01f, -9.764577150e-01f, 2.157090008e-01f, -7.352153957e-02f, 9.972936511e-01f, 6.020698547e-01f, 7.984433770e-01f, 8.678191900e-01f, 4.968801141e-01f, 9.575498104e-01f, 2.882679403e-01f, 9.865104556e-01f, 1.636983752e-01f, 9.957276583e-01f, 9.233880043e-02f, 9.986482859e-01f, 5.197656900e-02f, 9.995725155e-01f, 2.923758142e-02f, 9.998648167e-01f, 1.644310169e-02f, 9.999572635e-01f, 9.246920235e-03f,
-9.182828069e-01f, 3.959251344e-01f, -4.102819040e-02f, -9.991579652e-01f, -4.957418144e-01f, -8.684699535e-01f, -1.000000000e+00f, -1.030206768e-04f, 5.543745160e-01f, -8.322673440e-01f, -9.870380163e-01f, 1.604867131e-01f, -1.050167158e-01f, 9.944704771e-01f, 5.877768993e-01f, 8.090230227e-01f, 8.628070951e-01f, 5.055333376e-01f, 9.559136033e-01f, 2.936480343e-01f, 9.859878421e-01f, 1.668171734e-01f, 9.955618382e-01f, 9.410934150e-02f, 9.985958338e-01f, 5.297519267e-02f, 9.995558858e-01f, 2.979967557e-02f, 9.998595715e-01f, 1.675928757e-02f, 9.999555945e-01f, 9.424741380e-03f,
-8.293098211e-01f, -5.587890744e-01f, 4.980095923e-01f, -8.671715260e-01f, -2.010796219e-01f, -9.795749187e-01f, -9.842120409e-01f, -1.769934893e-01f, 6.346929669e-01f, -7.727644444e-01f, -9.944978952e-01f, 1.047568321e-01f, -1.364068687e-01f, 9.906529188e-01f, 5.732980371e-01f, 8.193469048e-01f, 8.577086926e-01f, 5.141359568e-01f, 9.542471766e-01f, 2.990188897e-01f, 9.854553938e-01f, 1.699342877e-01f, 9.953929186e-01f, 9.587957710e-02f, 9.985423684e-01f, 5.397376046e-02f, 9.995389581e-01f, 3.036176413e-02f, 9.998542070e-01f, 1.707546785e-02f, 9.999538660e-01f, 9.602561593e-03f,
2.212675475e-02f, -9.997551441e-01f, 8.836693168e-01f, -4.681116939e-01f, 1.135217771e-01f, -9.935355186e-01f, -9.373825192e-01f, -3.483016491e-01f, 7.086697817e-01f, -7.055402994e-01f, -9.988136292e-01f, 4.869600013e-02f, -1.676606387e-01f, 9.858447909e-01f, 5.586378574e-01f, 8.294116855e-01f, 8.525245190e-01f, 5.226872563e-01f, 9.525505900e-01f, 3.043802381e-01f, 9.849131107e-01f, 1.730497181e-01f, 9.952208400e-01f, 9.764950722e-02f, 9.984878898e-01f, 5.497227982e-02f, 9.995217323e-01f, 3.092384152e-02f, 9.998487830e-01f, 1.739165001e-02f, 9.999521971e-01f, 9.780380875e-03f,
8.532201052e-01f, -5.215510130e-01f, 9.971746206e-01f, 7.511820644e-02f, 4.168670774e-01f, -9.089674354e-01f, -8.609884381e-01f, -5.086245537e-01f, 7.755658031e-01f, -6.312667131e-01f, -9.999717474e-01f, -7.518785074e-03f, -1.987468749e-01f, 9.800508618e-01f, 5.438010693e-01f, 8.392141461e-01f, 8.472551107e-01f, 5.311862230e-01f, 9.508239031e-01f, 3.097319603e-01f, 9.843609333e-01f, 1.761634201e-01f, 9.950456619e-01f, 9.941913933e-02f, 9.984323978e-01f, 5.597073585e-02f, 9.995042086e-01f, 3.148590773e-02f, 9.998431802e-01f, 1.770782843e-02f, 9.999504089e-01f, 9.958200157e-03f,
8.998668194e-01f, 4.361647666e-01f, 8.035690784e-01f, 5.952115059e-01f, 6.788702011e-01f, -7.342582941e-01f, -7.574391961e-01f, -6.529057026e-01f, 8.347129226e-01f, -5.506852865e-01f, -9.979684949e-01f, -6.370980293e-02f, -2.296342701e-01f, 9.732769728e-01f, 5.287922621e-01f, 8.487513065e-01f, 8.419009447e-01f, 5.396320224e-01f, 9.490671158e-01f, 3.150739372e-01f, 9.837989211e-01f, 1.792753637e-01f, 9.948672652e-01f, 1.011884511e-01f, 9.983759522e-01f, 5.696914345e-02f, 9.994863272e-01f, 3.204796836e-02f, 9.998375773e-01f, 1.802400686e-02f, 9.999486208e-01f, 1.013601944e-02f,
1.191801354e-01f, 9.928726554e-01f, 3.624766469e-01f, 9.319928288e-01f, 8.735505342e-01f, -4.867334962e-01f, -6.300007105e-01f, -7.765945792e-01f, 8.855196238e-01f, -4.646020234e-01f, -9.928101897e-01f, -1.196994036e-01f, -2.602920234e-01f, 9.655299187e-01f, 5.136163235e-01f, 8.580200076e-01f, 8.364626765e-01f, 5.480239391e-01f, 9.472803473e-01f, 3.204059005e-01f, 9.832270741e-01f, 1.823855042e-01f, 9.946857691e-01f, 1.029574350e-01f, 9.983184934e-01f, 5.796748772e-02f, 9.994681478e-01f, 3.261001408e-02f, 9.998317957e-01f, 1.834018156e-02f, 9.999468327e-01f, 1.031383779e-02f,
-7.710802555e-01f, 6.367380023e-01f, -1.902491003e-01f, 9.817358255e-01f, 9.816020727e-01f, -1.909380108e-01f, -4.826923311e-01f, -8.757900000e-01f, 9.274784923e-01f, -3.738765717e-01f, -9.845131636e-01f, -1.753105819e-01f, -2.906895280e-01f, 9.568174481e-01f, 4.982779026e-01f, 8.670173883e-01f, 8.309406638e-01f, 5.563610196e-01f, 9.454635978e-01f, 3.257277906e-01f, 9.826454520e-01f, 1.854938269e-01f, 9.945011139e-01f, 1.047261059e-01f, 9.982600212e-01f, 5.896577984e-02f, 9.994496703e-01f, 3.317204863e-02f, 9.998259544e-01f, 1.865635626e-02f, 9.999449849e-01f, 1.049165614e-02f,
-9.524129629e-01f, -3.048106432e-01f, -6.843819022e-01f, 7.291237116e-01f, 9.923083186e-01f, 1.237909496e-01f, -3.201591969e-01f, -9.473637342e-01f, 9.601702690e-01f, -2.794154882e-01f, -9.731037021e-01f, -2.303675264e-01f, -3.207963705e-01f, 9.471482038e-01f, 4.827820063e-01f, 8.757405281e-01f, 8.253356218e-01f, 5.646424294e-01f, 9.436169863e-01f, 3.310393095e-01f, 9.820539355e-01f, 1.886002868e-01f, 9.943132997e-01f, 1.064944416e-01f, 9.982005358e-01f, 5.996400863e-02f, 9.994308352e-01f, 3.373407945e-02f, 9.998199940e-01f, 1.897252724e-02f, 9.999430776e-01f, 1.066947449e-02f,
-2.581016421e-01f, -9.661177397e-01f, -9.677396417e-01f, 2.519522905e-01f, 9.046075344e-01f, 4.262454212e-01f, -1.475291997e-01f, -9.890577197e-01f, 9.832684398e-01f, -1.821625978e-01f, -9.586178064e-01f, -2.846961617e-01f, -3.505824506e-01f, 9.365319014e-01f, 4.671334028e-01f, 8.841868639e-01f, 8.196480274e-01f, 5.728674531e-01f, 9.417404532e-01f, 3.363404274e-01f, 9.814526439e-01f, 1.917048544e-01f, 9.941223264e-01f, 1.082624346e-01f, 9.981400967e-01f, 6.096218154e-02f, 9.994117022e-01f, 3.429609165e-02f, 9.998139739e-01f, 1.928869821e-02f, 9.999411702e-01f, 1.084729191e-02f,
6.735071540e-01f, -7.391806841e-01f, -9.530500174e-01f, -3.028128445e-01f, 7.271980643e-01f, 6.864277124e-01f, 2.975377068e-02f, -9.995572567e-01f, 9.965420961e-01f, -8.308912069e-02f, -9.411013126e-01f, -3.381247520e-01f, -3.800179660e-01f, 9.249790907e-01f, 4.513370693e-01f, 8.923535347e-01f, 8.138784766e-01f, 5.810351968e-01f, 9.398342371e-01f, 3.416308761e-01f, 9.808415174e-01f, 1.948075294e-01f, 9.939282537e-01f, 1.100300923e-01f, 9.980786443e-01f, 6.196028739e-02f, 9.993922710e-01f, 3.485809639e-02f, 9.998078346e-01f, 1.960486546e-02f, 9.999392033e-01f, 1.102510840e-02f,
9.858965874e-01f, 1.673557013e-01f, -6.448370218e-01f, -7.643201351e-01f, 4.776714444e-01f, 8.785385489e-01f, 2.060983330e-01f, -9.785313010e-01f, 9.998586178e-01f, 1.681409217e-02f, -9.206095338e-01f, -3.904843926e-01f, -4.090735018e-01f, 9.125014544e-01f, 4.353979826e-01f, 9.002380967e-01f, 8.080275059e-01f, 5.891447663e-01f, 9.378982186e-01f, 3.469105363e-01f, 9.802205563e-01f, 1.979082376e-01f, 9.937310219e-01f, 1.117973924e-01f, 9.980161786e-01f, 6.295833737e-02f, 9.993724823e-01f, 3.542009369e-02f, 9.998015761e-01f, 1.992103085e-02f, 9.999372363e-01f, 1.120292582e-02f,
3.918572366e-01f, 9.200260639e-01f, -1.380281597e-01f, -9.904283285e-01f, 1.807759702e-01f, 9.835243225e-01f, 3.759426475e-01f, -9.266429543e-01f, 9.931849241e-01f, 1.165492982e-01f, -8.972073197e-01f, -4.416095316e-01f, -4.377200007e-01f, 8.991113305e-01f, 4.193212092e-01f, 9.078379273e-01f, 8.020957708e-01f, 5.971954465e-01f, 9.359325767e-01f, 3.521791995e-01f, 9.795898199e-01f, 2.010069788e-01f, 9.935306311e-01f, 1.135643497e-01f, 9.979526997e-01f, 6.395632029e-02f, 9.993524551e-01f, 3.598207608e-02f, 9.997951984e-01f, 2.023719437e-02f, 9.999352098e-01f, 1.138074230e-02f,
-5.624538660e-01f, 8.268286586e-01f, 4.112906456e-01f, -9.115042686e-01f, -1.340468824e-01f, 9.909749627e-01f, 5.339299440e-01f, -8.455287218e-01f, 9.765876532e-01f, 2.151199877e-01f, -8.709686995e-01f, -4.913385212e-01f, -4.659289122e-01f, 8.848221898e-01f, 4.031118751e-01f, 9.151507020e-01f, 7.960838079e-01f, 6.051864028e-01f, 9.339373708e-01f, 3.574367166e-01f, 9.789492488e-01f, 2.041037083e-01f, 9.933271408e-01f, 1.153309494e-01f, 9.978882670e-01f, 6.495424360e-02f, 9.993320704e-01f, 3.654404357e-02f, 9.997887611e-01f, 2.055335604e-02f, 9.999331832e-01f, 1.155855879e-02f,
-9.996474385e-01f, -2.655115537e-02f, 8.339421749e-01f, -5.518518090e-01f, -4.355781674e-01f, 9.001508951e-01f, 6.750773191e-01f, -7.377469540e-01f, 9.502326250e-01f, 3.115412891e-01f, -8.419764638e-01f, -5.395141840e-01f, -4.936717451e-01f, 8.696483374e-01f, 3.867750466e-01f, 9.221740961e-01f, 7.899922729e-01f, 6.131168008e-01f, 9.319126010e-01f, 3.626829684e-01f, 9.782989621e-01f, 2.071983814e-01f, 9.931204915e-01f, 1.170971766e-01f, 9.978227615e-01f, 6.595209241e-02f, 9.993113279e-01f, 3.710600734e-02f, 9.997822046e-01f, 2.086951770e-02f, 9.999310970e-01f, 1.173637528e-02f,
-5.177697539e-01f, -8.555200100e-01f, 9.997526407e-01f, -2.224157006e-02f, -6.939117312e-01f, 7.200600505e-01f, 7.949331403e-01f, -6.066970825e-01f, 9.143830538e-01f, 4.048501849e-01f, -8.103224635e-01f, -5.859842300e-01f, -5.209211111e-01f, 8.536047935e-01f, 3.703159094e-01f, 9.289059043e-01f, 7.838217020e-01f, 6.209859252e-01f, 9.298583269e-01f, 3.679177165e-01f, 9.776388407e-01f, 2.102909982e-01f, 9.929106832e-01f, 1.188630387e-01f, 9.977563620e-01f, 6.694988906e-02f, 9.992902875e-01f, 3.766795248e-02f, 9.997755289e-01f, 2.118567377e-02f, 9.999290109e-01f, 1.191418990e-02f,
4.401430190e-01f, -8.979277015e-01f, 8.576571345e-01f, 5.142219663e-01f, -8.834316730e-01f, 4.685599506e-01f, 8.897171617e-01f, -4.565122128e-01f, 8.693974018e-01f, 4.941135347e-01f, -7.761065960e-01f, -6.306017041e-01f, -5.476494431e-01f, 8.367078900e-01f, 3.537396789e-01f, 9.353439212e-01f, 7.775726914e-01f, 6.287930012e-01f, 9.277747273e-01f, 3.731408715e-01f, 9.769689441e-01f, 2.133814991e-01f, 9.926977158e-01f, 1.206285134e-01f, 9.976888895e-01f, 6.794761121e-02f, 9.992689490e-01f, 3.822989017e-02f, 9.997687936e-01f, 2.150182985e-02f, 9.999268651e-01f, 1.209200546e-02f,
9.933903813e-01f, -1.147848144e-01f, 4.514202476e-01f, 8.923114538e-01f, -9.853413105e-01f, 1.705945879e-01f, 9.564402103e-01f, -2.919283211e-01f, 8.157250285e-01f, 5.784398317e-01f, -7.394371629e-01f, -6.732255816e-01f, -5.738303661e-01f, 8.189741969e-01f, 3.370516896e-01f, 9.414861202e-01f, 7.712460160e-01f, 6.365371943e-01f, 9.256617427e-01f, 3.783521950e-01f, 9.762892723e-01f, 2.164698690e-01f, 9.924816489e-01f, 1.223936230e-01f, 9.976204634e-01f, 6.894526631e-02f, 9.992473125e-01f, 3.879181668e-02f, 9.997619390e-01f, 2.181798220e-02f, 9.999247193e-01f, 1.226981916e-02f,
6.333191991e-01f, 7.738906741e-01f, -9.384513646e-02f, 9.955868125e-01f, -9.895353913e-01f, -1.442903578e-01f, 9.929971695e-01f, -1.181379855e-01f, 7.539022565e-01f, 6.569865942e-01f, -7.004299760e-01f, -7.137210965e-01f, -5.994372964e-01f, 8.004217148e-01f, 3.202570081e-01f, 9.473307133e-01f, 7.648422122e-01f, 6.442176700e-01f, 9.235194325e-01f, 3.835515678e-01f, 9.755998850e-01f, 2.195560932e-01f, 9.922624230e-01f, 1.241583377e-01f, 9.975510240e-01f, 6.994284689e-02f, 9.992253184e-01f, 3.935372457e-02f, 9.997550249e-01f, 2.213413455e-02f, 9.999225140e-01f, 1.244763471e-02f,
-3.090227246e-01f, 9.510546327e-01f, -6.102110744e-01f, 7.922388911e-01f, -8.955979943e-01f, -4.448643327e-01f, 9.982355237e-01f, 5.937835947e-02f, 6.845467091e-01f, 7.289689779e-01f, -6.592084765e-01f, -7.519602180e-01f, -6.244450212e-01f, 7.810688019e-01f, 3.033610582e-01f, 9.528756738e-01f, 7.583618760e-01f, 6.518337727e-01f, 9.213479757e-01f, 3.887388110e-01f, 9.749007225e-01f, 2.226400971e-01f, 9.920400381e-01f, 1.259226501e-01f, 9.974805713e-01f, 7.094036788e-02f, 9.992030263e-01f, 3.991562501e-02f, 9.997479320e-01f, 2.245028317e-02f, 9.999203086e-01f, 1.262544841e-02f,
-9.672505856e-01f, 2.538233697e-01f, -9.386403561e-01f, 3.448974490e-01f, -7.128450871e-01f, -7.013215423e-01f, 9.719900489e-01f, 2.350219339e-01f, 6.083510518e-01f, 7.936680317e-01f, -6.159027219e-01f, -7.878221869e-01f, -6.488281488e-01f, 7.609349489e-01f, 2.863692045e-01f, 9.581193328e-01f, 7.518057823e-01f, 6.593846679e-01f, 9.191473722e-01f, 3.939137757e-01f, 9.741917849e-01f, 2.257218957e-01f, 9.918145537e-01f, 1.276865751e-01f, 9.974091053e-01f, 7.193781435e-02f, 9.991804361e-01f, 4.047751427e-02f, 9.997408390e-01f, 2.276643179e-02f, 9.999180436e-01f, 1.280326117e-02f,
-7.361927032e-01f, -6.767719388e-01f, -9.779862761e-01f, -2.086692750e-01f, -4.593983889e-01f, -8.882303238e-01f, 9.150884748e-01f, 4.032530487e-01f, 5.260773301e-01f, 8.504367471e-01f, -5.706502199e-01f, -8.211932182e-01f, -6.725627184e-01f, 7.400401235e-01f, 2.692867517e-01f, 9.630600214e-01f, 7.451744676e-01f, 6.668695807e-01f, 9.169177413e-01f, 3.990762532e-01f, 9.734731317e-01f, 2.288014293e-01f, 9.915859103e-01f, 1.294501126e-01f, 9.973366857e-01f, 7.293518633e-02f, 9.991575480e-01f, 4.103938490e-02f, 9.997335672e-01f, 2.308257483e-02f, 9.999157190e-01f, 1.298107579e-02f,
1.717173457e-01f, -9.851462841e-01f, -7.161304951e-01f, -6.979663968e-01f, -1.603949666e-01f, -9.870529175e-01f, 8.293254972e-01f, 5.587657690e-01f, 4.385472536e-01f, 8.987081051e-01f, -5.235932469e-01f, -8.519684076e-01f, -6.956245899e-01f, 7.184054852e-01f, 2.521191835e-01f, 9.676961899e-01f, 7.384685278e-01f, 6.742879152e-01f, 9.146590829e-01f, 4.042260945e-01f, 9.727447033e-01f, 2.318786681e-01f, 9.913541675e-01f, 1.312132180e-01f, 9.972632527e-01f, 7.393248379e-02f, 9.991343021e-01f, 4.160124436e-02f, 9.997262359e-01f, 2.339871787e-02f, 9.999133945e-01f, 1.315888762e-02f,
9.217512608e-01f, -3.877816498e-01f, -2.337207645e-01f, -9.723037481e-01f, 1.545165181e-01f, -9.879902005e-01f, 7.174060345e-01f, 6.966552734e-01f, 3.466353416e-01f, 9.379999638e-01f, -4.748813212e-01f, -8.800498247e-01f, -7.179910541e-01f, 6.960523129e-01f, 2.348718494e-01f, 9.720263481e-01f, 7.316888571e-01f, 6.816387773e-01f, 9.123715162e-01f, 4.093632102e-01f, 9.720066190e-01f, 2.349535823e-01f, 9.911192656e-01f, 1.329759061e-01f, 9.971888065e-01f, 7.492970675e-02f, 9.991107583e-01f, 4.216309637e-02f, 9.997187853e-01f, 2.371485718e-02f, 9.999110699e-01f, 1.333669946e-02f,
8.243313432e-01f, 5.661076307e-01f, 3.206739426e-01f, -9.471896291e-01f, 4.541028738e-01f, -8.909492493e-01f, 5.828598738e-01f, 8.125726581e-01f, 2.512599528e-01f, 9.679196477e-01f, -4.246677160e-01f, -9.053493142e-01f, -7.396394610e-01f, 6.730033755e-01f, 2.175502628e-01f, 9.760491252e-01f, 7.248359919e-01f, 6.889214516e-01f, 9.100551009e-01f, 4.144873321e-01f, 9.712587595e-01f, 2.380261570e-01f, 9.908812046e-01f, 1.347381920e-01f, 9.971134067e-01f, 7.592686266e-02f, 9.990868568e-01f, 4.272492975e-02f, 9.997112155e-01f, 2.403099649e-02f, 9.999086857e-01f, 1.351451222e-02f,
-3.097503260e-02f, 9.995201826e-01f, 7.763037086e-01f, -6.303589940e-01f, 7.086563706e-01f, -7.055538297e-01f, 4.299306870e-01f, 9.028618932e-01f, 1.533735693e-01f, 9.881682992e-01f, -3.731119633e-01f, -9.277863503e-01f, -7.605484128e-01f, 6.492812634e-01f, 2.001598924e-01f, 9.797632694e-01f, 7.179107070e-01f, 6.961352229e-01f, 9.077098370e-01f, 4.195984006e-01f, 9.705011845e-01f, 2.410963625e-01f, 9.906400442e-01f, 1.365000308e-01f, 9.970369935e-01f, 7.692394406e-02f, 9.990627170e-01f, 4.328674823e-02f, 9.997035861e-01f, 2.434713021e-02f, 9.999062419e-01f, 1.369232405e-02f,
-8.578031063e-01f, 5.139784217e-01f, 9.928478599e-01f, -1.193865910e-01f, 8.929339647e-01f, -4.501876533e-01f, 2.634407580e-01f, 9.646756053e-01f, 5.395522714e-02f, 9.985433817e-01f, -3.203761876e-01f, -9.472904205e-01f, -7.806967497e-01f, 6.249100566e-01f, 1.827063411e-01f, 9.831675291e-01f, 7.109135985e-01f, 7.032793760e-01f, 9.053359628e-01f, 4.246961474e-01f, 9.697338939e-01f, 2.441641390e-01f, 9.903957844e-01f, 1.382614523e-01f, 9.969595671e-01f, 7.792093605e-02f, 9.990381598e-01f, 4.384855926e-02f, 9.996958375e-01f, 2.466326393e-02f, 9.999037981e-01f, 1.387013402e-02f,
-8.959709406e-01f, -4.441126585e-01f, 9.036121368e-01f, 4.283516109e-01f, 9.886589646e-01f, -1.501781940e-01f, 8.864288777e-02f, 9.960634708e-01f, -4.600222036e-02f, 9.989413619e-01f, -2.666280270e-01f, -9.637995362e-01f, -8.000645638e-01f, 5.999138951e-01f, 1.651948988e-01f, 9.862609506e-01f, 7.038453221e-01f, 7.103532553e-01f, 9.029334188e-01f, 4.297804832e-01f, 9.689569473e-01f, 2.472294867e-01f, 9.901483059e-01f, 1.400224417e-01f, 9.968811274e-01f, 7.891785353e-02f, 9.990133643e-01f, 4.441035166e-02f, 9.996879697e-01f, 2.497939393e-02f, 9.999012947e-01f, 1.404794492e-02f,
-1.103872433e-01f, -9.938886762e-01f, 5.360818505e-01f, 8.441659808e-01f, 9.863393307e-01f, 1.647261530e-01f, -8.895073086e-02f, 9.960360527e-01f, -1.455000341e-01f, 9.893582463e-01f, -2.120364457e-01f, -9.772617817e-01f, -8.186323047e-01f, 5.743179917e-01f, 1.476312131e-01f, 9.890424609e-01f, 6.967067122e-01f, 7.173560858e-01f, 9.005023241e-01f, 4.348512292e-01f, 9.681702852e-01f, 2.502923310e-01f, 9.898977876e-01f, 1.417829692e-01f, 9.968017340e-01f, 7.991469651e-02f, 9.989882708e-01f, 4.497213289e-02f, 9.996800423e-01f, 2.529552206e-02f, 9.998987913e-01f, 1.422575582e-02f,
7.766859531e-01f, -6.298879981e-01f, 3.445185488e-03f, 9.999940395e-01f, 8.862052560e-01f, 4.632928669e-01f, -2.637388706e-01f, 9.645941257e-01f, -2.435445338e-01f, 9.698897004e-01f, -1.567750126e-01f, -9.876343608e-01f, -8.363815546e-01f, 5.481476784e-01f, 1.300208420e-01f, 9.915112853e-01f, 6.894984245e-01f, 7.242871523e-01f, 8.980427384e-01f, 4.399082065e-01f, 9.673739672e-01f, 2.533527315e-01f, 9.896440506e-01f, 1.435430646e-01f, 9.967212677e-01f, 8.091145754e-02f, 9.989628196e-01f, 4.553389549e-02f, 9.996719956e-01f, 2.561164647e-02f, 9.998962879e-01f, 1.440356486e-02f,
9.496777058e-01f, 3.132287860e-01f, -5.302492976e-01f, 8.478417993e-01f, 6.981857419e-01f, 7.159166336e-01f, -4.302088320e-01f, 9.027293921e-01f, -3.391546607e-01f, 9.407306314e-01f, -1.010174751e-01f, -9.948846698e-01f, -8.532945514e-01f, 5.214292407e-01f, 1.123693660e-01f, 9.936665297e-01f, 6.822211742e-01f, 7.311458588e-01f, 8.955547810e-01f, 4.449512959e-01f, 9.665679932e-01f, 2.564105392e-01f, 9.893872738e-01f, 1.453027129e-01f, 9.966399074e-01f, 8.190813661e-02f, 9.989370108e-01f, 4.609564692e-02f, 9.996638298e-01f, 2.592777088e-02f, 9.998936653e-01f, 1.458137389e-02f,
2.495401055e-01f, 9.683644772e-01f, -9.006391764e-01f, 4.345676303e-01f, 4.409287572e-01f, 8.975421190e-01f, -5.831102729e-01f, 8.123930097e-01f, -4.313769937e-01f, 9.021717310e-01f, -4.494105279e-02f, -9.989896417e-01f, -8.693541884e-01f, 4.941895902e-01f, 9.468235075e-02f, 9.955075383e-01f, 6.748757362e-01f, 7.379313707e-01f, 8.930384517e-01f, 4.499803185e-01f, 9.657523036e-01f, 2.594658434e-01f, 9.891272783e-01f, 1.470618844e-01f, 9.965574741e-01f, 8.290474117e-02f, 9.989109635e-01f, 4.665738344e-02f, 9.996555448e-01f, 2.624388970e-02f, 9.998911023e-01f, 1.475918386e-02f,
-6.800234914e-01f, 7.331902981e-01f, -9.936468601e-01f, -1.125427037e-01f, 1.399453431e-01f, 9.901592135e-01f, -7.176206112e-01f, 6.964342594e-01f, -5.192891359e-01f, 8.545985818e-01f, 1.127792522e-02f, -9.999364018e-01f, -8.845446110e-01f, 4.664555788e-01f, 7.696539164e-02f, 9.970337749e-01f, 6.674628258e-01f, 7.446430922e-01f, 8.904939294e-01f, 4.549950957e-01f, 9.649269581e-01f, 2.625184953e-01f, 9.888642430e-01f, 1.488205791e-01f, 9.964740872e-01f, 8.390125632e-02f, 9.988845587e-01f, 4.721910506e-02f, 9.996472001e-01f, 2.656000853e-02f, 9.998884201e-01f, 1.493699197e-02f,
-9.843766689e-01f, -1.760756075e-01f, -7.806286812e-01f, -6.249951124e-01f, -1.749181598e-01f, 9.845829606e-01f, -8.294976354e-01f, 5.585102439e-01f, -6.020119190e-01f, 7.984871268e-01f, 6.746077538e-02f, -9.977219105e-01f, -8.988505006e-01f, 4.382553995e-01f, 5.922409892e-02f, 9.982447028e-01f, 6.599831581e-01f, 7.512803674e-01f, 8.879212737e-01f, 4.599954784e-01f, 9.640919566e-01f, 2.655685544e-01f, 9.885979891e-01f, 1.505788416e-01f, 9.963896871e-01f, 8.489768207e-02f, 9.988578558e-01f, 4.778081179e-02f, 9.996387959e-01f, 2.687612176e-02f, 9.998857379e-01f, 1.511479914e-02f,
-3.836984336e-01f, -9.234584570e-01f, -3.271927834e-01f, -9.449576139e-01f, -4.724333286e-01f, 8.813664317e-01f, -9.152126908e-01f, 4.029710889e-01f, -6.787203550e-01f, 7.343968153e-01f, 1.234308258e-01f, -9.923532009e-01f, -9.122576714e-01f, 4.096167684e-01f, 4.146407545e-02f, 9.991400242e-01f, 6.524375081e-01f, 7.578425407e-01f, 8.853204846e-01f, 4.649813473e-01f, 9.632473588e-01f, 2.686159313e-01f, 9.883286953e-01f, 1.523365974e-01f, 9.963042736e-01f, 8.589403331e-02f, 9.988307953e-01f, 4.834250361e-02f, 9.996302128e-01f, 2.719223499e-02f, 9.998830557e-01f, 1.529260725e-02f,
5.697503090e-01f, -8.218178153e-01f, 2.270120084e-01f, -9.738919735e-01f, -7.230991125e-01f, 6.907442808e-01f, -9.720626473e-01f, 2.347215265e-01f, -7.486464977e-01f, 6.629694104e-01f, 1.790106595e-01f, -9.838471413e-01f, -9.247525930e-01f, 3.805688024e-01f, 2.369106375e-02f, 9.997193217e-01f, 6.448265314e-01f, 7.643289566e-01f, 8.826917410e-01f, 4.699524939e-01f, 9.623931050e-01f, 2.716606259e-01f, 9.880561829e-01f, 1.540938765e-01f, 9.962179065e-01f, 8.689029515e-02f, 9.988034964e-01f, 4.890418053e-02f, 9.996215701e-01f, 2.750834450e-02f, 9.998803139e-01f, 1.547041349e-02f,
9.993732572e-01f, 3.539830074e-02f, 7.113042474e-01f, -7.028842568e-01f, -9.020542502e-01f, 4.316227138e-01f, -9.982538819e-01f, 5.906983837e-02f, -8.110930920e-01f, 5.849170685e-01f, 2.340240777e-01f, -9.722307920e-01f, -9.363229275e-01f, 3.511400521e-01f, 5.910437554e-03f, 9.999825358e-01f, 6.371511221e-01f, 7.707388997e-01f, 8.800350428e-01f, 4.749087691e-01f, 9.615292549e-01f, 2.747026384e-01f, 9.877806306e-01f, 1.558506787e-01f, 9.961305261e-01f, 8.788647503e-02f, 9.987758398e-01f, 4.946583882e-02f, 9.996128082e-01f, 2.782445215e-02f, 9.998775721e-01f, 1.564821973e-02f,
5.101770163e-01f, 8.600693941e-01f, 9.765252471e-01f, -2.154029608e-01f, -9.915538430e-01f, 1.296956539e-01f, -9.929606318e-01f, -1.184448823e-01f, -8.654354811e-01f, 5.010203719e-01f, 2.882981002e-01f, -9.575406909e-01f, -9.469569325e-01f, 3.213604093e-01f, -1.187205687e-02f, 9.999295473e-01f, 6.294120550e-01f, 7.770717740e-01f, 8.773505092e-01f, 4.798500240e-01f, 9.606557488e-01f, 2.777418792e-01f, 9.875019193e-01f, 1.576069742e-01f, 9.960421324e-01f, 8.888255060e-02f, 9.987478256e-01f, 5.002748594e-02f, 9.996039867e-01f, 2.814055420e-02f, 9.998747706e-01f, 1.582602598e-02f,
-4.480736256e-01f, 8.939966559e-01f, 9.409945607e-01f, 3.384217024e-01f, -9.827213287e-01f, -1.850914657e-01f, -9.563499093e-01f, -2.922239304e-01f, -9.111302495e-01f, 4.121184647e-01f, 3.416602314e-01f, -9.398235083e-01f, -9.566441774e-01f, 2.912592292e-01f, -2.965079620e-02f, 9.995602965e-01f, 6.216099858e-01f, 7.833269238e-01f, 8.746382594e-01f, 4.847761393e-01f, 9.597726464e-01f, 2.807783484e-01f, 9.872201085e-01f, 1.593627781e-01f, 9.959527254e-01f, 8.987855166e-02f, 9.987195730e-01f, 5.058911443e-02f, 9.995950460e-01f, 2.845665626e-02f, 9.998719096e-01f, 1.600383036e-02f,
-9.943674803e-01f, 1.059875116e-01f, 6.156554222e-01f, 7.880154848e-01f, -8.764333129e-01f, -4.815232456e-01f, -8.895764351e-01f, -4.567863345e-01f, -9.477217197e-01f, 3.190979958e-01f, 3.939426839e-01f, -9.191350341e-01f, -9.653747678e-01f, 2.608670294e-01f, -4.742016271e-02f, 9.988750219e-01f, 6.137457490e-01f, 7.895037532e-01f, 8.718983531e-01f, 4.896869063e-01f, 9.588799477e-01f, 2.838120162e-01f, 9.869351387e-01f, 1.611180753e-01f, 9.958623648e-01f, 9.087446332e-02f, 9.986909628e-01f, 5.115072429e-02f, 9.995859861e-01f, 2.877275459e-02f, 9.998690486e-01f, 1.618163660e-02f,
-6.264444590e-01f, -7.794660926e-01f, 1.007066220e-01f, 9.949161410e-01f, -6.832289696e-01f, -7.302041650e-01f, -7.947461605e-01f, -6.069419384e-01f, -9.748435616e-01f, 2.228900939e-01f, 4.449792802e-01f, -8.955408931e-01f, -9.731400609e-01f, 2.302137464e-01f, -6.517452747e-02f, 9.978739023e-01f, 6.058201790e-01f, 7.956016064e-01f, 8.691309094e-01f, 4.945821762e-01f, 9.579776525e-01f, 2.868428528e-01f, 9.866470695e-01f, 1.628728807e-01f, 9.957709908e-01f, 9.187027812e-02f, 9.986619949e-01f, 5.171232671e-02f, 9.995768070e-01f, 2.908885106e-02f, 9.998661876e-01f, 1.635944098e-02f,
3.174287081e-01f, -9.482821226e-01f, -4.452612102e-01f, 8.954007030e-01f, -4.222704768e-01f, -9.064698815e-01f, -6.748499870e-01f, -7.379549146e-01f, -9.922253489e-01f, 1.244542375e-01f, 4.946095049e-01f, -8.691152930e-01f, -9.799323082e-01f, 1.993305236e-01f, -8.290828764e-02f, 9.965571761e-01f, 5.978339314e-01f, 8.016199470e-01f, 8.663359284e-01f, 4.994617999e-01f, 9.570658207e-01f, 2.898707688e-01f, 9.863558412e-01f, 1.646271497e-01f, 9.956786036e-01f, 9.286600351e-02f, 9.986327887e-01f, 5.227390677e-02f, 9.995675683e-01f, 2.940494195e-02f, 9.998632669e-01f, 1.653724350e-02f,
9.694593549e-01f, -2.452519834e-01f, -8.540936708e-01f, 5.201192498e-01f, -1.194339693e-01f, -9.928421378e-01f, -5.336694121e-01f, -8.456931710e-01f, -9.996930361e-01f, 2.477485314e-02f, 5.426756740e-01f, -8.399423361e-01f, -9.857447147e-01f, 1.682477444e-01f, -1.006158292e-01f, 9.949253798e-01f, 5.897880197e-01f, 8.075581193e-01f, 8.635135293e-01f, 5.043256879e-01f, 9.561443329e-01f, 2.928958237e-01f, 9.860615730e-01f, 1.663808972e-01f, 9.955852628e-01f, 9.386163205e-02f, 9.986032248e-01f, 5.283546820e-02f, 9.995582104e-01f, 2.972103283e-02f, 9.998602867e-01f, 1.671504788e-02f,
7.301735282e-01f, 6.832616925e-01f, -9.998821616e-01f, -1.535241678e-02f, 1.952449679e-01f, -9.807544947e-01f, -3.756571114e-01f, -9.267587066e-01f, -9.971721768e-01f, -7.515111566e-02f, 5.890265703e-01f, -8.081136942e-01f, -9.905714393e-01f, 1.369969547e-01f, -1.182915568e-01f, 9.929789305e-01f, 5.816830993e-01f, 8.134155273e-01f, 8.606638908e-01f, 5.091735721e-01f, 9.552133679e-01f, 2.959179580e-01f, 9.857641459e-01f, 1.681341380e-01f, 9.954909086e-01f, 9.485717118e-02f, 9.985733628e-01f, 5.339701846e-02f, 9.995487928e-01f, 3.003711812e-02f, 9.998573065e-01f, 1.689285226e-02f,
-1.804304570e-01f, 9.835877419e-01f, -8.377248049e-01f, -5.460926294e-01f, 4.905616641e-01f, -8.714064956e-01f, -2.057968229e-01f, -9.785947204e-01f, -9.846878052e-01f, -1.743271649e-01f, 6.335148811e-01f, -7.737304568e-01f, -9.944077134e-01f, 1.056089550e-01f, -1.359298676e-01f, 9.907184839e-01f, 5.735200047e-01f, 8.191915751e-01f, 8.577870131e-01f, 5.140053630e-01f, 9.542728066e-01f, 2.989371121e-01f, 9.854635596e-01f, 1.698868275e-01f, 9.953955412e-01f, 9.585261345e-02f, 9.985432029e-01f, 5.395854637e-02f, 9.995392561e-01f, 3.035320155e-02f, 9.998542666e-01f, 1.707065292e-02f,
-9.251475334e-01f, 3.796077371e-01f, -4.175648987e-01f, -9.086471200e-01f, 7.372311950e-01f, -6.756405830e-01f, -2.944579907e-02f, -9.995663762e-01f, -9.623649120e-01f, -2.717604339e-01f, 6.760007739e-01f, -7.369009256e-01f, -9.972496629e-01f, 7.411535084e-02f, -1.535250843e-01f, 9.881447554e-01f, 5.652995706e-01f, 8.248857260e-01f, 8.548829556e-01f, 5.188208818e-01f, 9.533227086e-01f, 3.019533157e-01f, 9.851599336e-01f, 1.716389805e-01f, 9.952991605e-01f, 9.684795886e-02f, 9.985126853e-01f, 5.452005938e-02f, 9.995296001e-01f, 3.066928312e-02f, 9.998512268e-01f, 1.724845544e-02f,
-8.192882538e-01f, -5.733818412e-01f, 1.312005073e-01f, -9.913558364e-01f, 9.107885361e-01f, -4.128731191e-01f, 1.478339285e-01f, -9.890121818e-01f, -9.304261804e-01f, -3.664793074e-01f, 7.163491845e-01f, -6.977419257e-01f, -9.990944266e-01f, 4.254788160e-02f, -1.710718721e-01f, 9.852585793e-01f, 5.570225716e-01f, 8.304973245e-01f, 8.519519567e-01f, 5.236200094e-01f, 9.523630738e-01f, 3.049664497e-01f, 9.848531485e-01f, 1.733906120e-01f, 9.952018261e-01f, 9.784321487e-02f, 9.984818697e-01f, 5.508155748e-02f, 9.995198250e-01f, 3.098535910e-02f, 9.998481274e-01f, 1.742625609e-02f,
3.982087970e-02f, -9.992068410e-01f, 6.395553350e-01f, -7.687450647e-01f, 9.940242171e-01f, -1.091595069e-01f, 3.204510510e-01f, -9.472650886e-01f, -8.891909122e-01f, -4.575363994e-01f, 7.544332147e-01f, -6.563767791e-01f, -9.999401569e-01f, 1.093762368e-02f, -1.885645688e-01f, 9.820607901e-01f, 5.486899018e-01f, 8.360259533e-01f, 8.489939570e-01f, 5.284025669e-01f, 9.513939619e-01f, 3.079765737e-01f, 9.845432639e-01f, 1.751416773e-01f, 9.951034784e-01f, 9.883836657e-02f, 9.984506965e-01f, 5.564303696e-02f, 9.995099902e-01f, 3.130143136e-02f, 9.998450279e-01f, 1.760405675e-02f,
8.623188734e-01f, -5.063656569e-01f, 9.509409070e-01f, -3.093724847e-01f, 9.786828160e-01f, 2.053775787e-01f, 4.829612970e-01f, -8.756417036e-01f, -8.390715122e-01f, -5.440210700e-01f, 7.901318669e-01f, -6.129369140e-01f, -9.997860789e-01f, -2.068333142e-02f, -2.059976310e-01f, 9.785524607e-01f, 5.403022766e-01f, 8.414710164e-01f, 8.460091352e-01f, 5.331684351e-01f, 9.504152536e-01f, 3.109835982e-01f, 9.842302203e-01f, 1.768921912e-01f, 9.950041771e-01f, 9.983342141e-02f, 9.984192848e-01f, 5.620449409e-02f, 9.995000362e-01f, 3.161750361e-02f, 9.998418689e-01f, 1.778185740e-02f,
8.920048475e-01f, 4.520258009e-01f, 9.694527388e-01f, 2.452782542e-01f, 8.662855029e-01f, 4.995492697e-01f, 6.302406788e-01f, -7.763997912e-01f, -7.805679440e-01f, -6.250709295e-01f, 8.233328462e-01f, -5.675588250e-01f, -9.986322522e-01f, -5.228384212e-02f, -2.233655602e-01f, 9.747347236e-01f, 5.318607092e-01f, 8.468318582e-01f, 8.429974914e-01f, 5.379174352e-01f, 9.494271278e-01f, 3.139874935e-01f, 9.839141369e-01f, 1.786421537e-01f, 9.949038625e-01f, 1.008283719e-01f, 9.983875155e-01f, 5.676594004e-02f, 9.994900227e-01f, 3.193357214e-02f, 9.998387098e-01f, 1.795965619e-02f,
1.015857086e-01f, 9.948267937e-01f, 6.893923283e-01f, 7.243881822e-01f, 6.679785848e-01f, 7.441805601e-01f, 7.576409578e-01f, -6.526715755e-01f, -7.142657638e-01f, -6.998745203e-01f, 8.539305925e-01f, -5.203868747e-01f, -9.964799285e-01f, -8.383183926e-02f, -2.406628430e-01f, 9.706087708e-01f, 5.233659744e-01f, 8.521080017e-01f, 8.399593234e-01f, 5.426494479e-01f, 9.484294653e-01f, 3.169882894e-01f, 9.835948944e-01f, 1.803915352e-01f, 9.948025346e-01f, 1.018232331e-01f, 9.983554482e-01f, 5.732736737e-02f, 9.994798303e-01f, 3.224964067e-02f, 9.998354912e-01f, 1.813745499e-02f,
-7.822308540e-01f, 6.229886413e-01f, 1.970090568e-01f, 9.804016948e-01f, 4.034298062e-01f, 9.150105715e-01f, 8.611455560e-01f, -5.083584189e-01f, -6.408262849e-01f, -7.676859498e-01f, 8.818289638e-01f, -4.715693891e-01f, -9.933311343e-01f, -1.152962446e-01f, -2.578840256e-01f, 9.661758542e-01f, 5.148188472e-01f, 8.572989702e-01f, 8.368944526e-01f, 5.473642945e-01f, 9.474223256e-01f, 3.199858963e-01f, 9.832725525e-01f, 1.821403503e-01f, 9.947001934e-01f, 1.028179824e-01f, 9.983230233e-01f, 5.788877234e-02f, 9.994695783e-01f, 3.256569803e-02f, 9.998322725e-01f, 1.831525378e-02f,
-9.468680024e-01f, -3.216224015e-01f, -3.560463190e-01f, 9.344683290e-01f, 9.887336940e-02f, 9.951000214e-01f, 9.374901056e-01f, -3.480119109e-01f, -5.609837770e-01f, -8.278267980e-01f, 9.069392681e-01f, -4.212614298e-01f, -9.891891479e-01f, -1.466451287e-01f, -2.750236690e-01f, 9.614374638e-01f, 5.062202811e-01f, 8.624042273e-01f, 8.338031769e-01f, 5.520617962e-01f, 9.464057088e-01f, 3.229803145e-01f, 9.829471111e-01f, 1.838885993e-01f, 9.945968986e-01f, 1.038126275e-01f, 9.982903004e-01f, 5.845016241e-02f, 9.994592667e-01f, 3.288175911e-02f, 9.998289943e-01f, 1.849305071e-02f,
-2.409590483e-01f, -9.705352783e-01f, -7.994487882e-01f, 6.007342339e-01f, -2.154882401e-01f, 9.765064120e-01f, 9.842666984e-01f, -1.766892821e-01f, -4.755369425e-01f, -8.796957731e-01f, 9.291825294e-01f, -3.696212471e-01f, -9.840580225e-01f, -1.778476238e-01f, -2.920763195e-01f, 9.563950300e-01f, 4.975710809e-01f, 8.674232364e-01f, 8.306855559e-01f, 5.567418337e-01f, 9.453796148e-01f, 3.259714842e-01f, 9.826185107e-01f, 1.856362671e-01f, 9.944925904e-01f, 1.048071757e-01f, 9.982572794e-01f, 5.901153386e-02f, 9.994487762e-01f, 3.319781274e-02f, 9.998256564e-01f, 1.867084950e-02f,
6.864865422e-01f, -7.271425128e-01f, -9.966333508e-01f, 8.198728412e-02f, -5.084800720e-01f, 8.610737324e-01f, 1.000000000e+00f, 2.060413535e-04f, -3.853378594e-01f, -9.227755666e-01f, 9.484879971e-01f, -3.168129921e-01f, -9.779430032e-01f, -2.088720351e-01f, -3.090365231e-01f, 9.510501623e-01f, 4.888721108e-01f, 8.723554611e-01f, 8.275416493e-01f, 5.614042878e-01f, 9.443440437e-01f, 3.289594054e-01f, 9.822868705e-01f, 1.873833388e-01f, 9.943872690e-01f, 1.058016121e-01f, 9.982239604e-01f, 5.957288295e-02f, 9.994382262e-01f, 3.351386636e-02f, 9.998223782e-01f, 1.884864643e-02f,
9.827795625e-01f, 1.847817302e-01f, -8.868746758e-01f, -4.620101154e-01f, -7.510490417e-01f, 6.602464318e-01f, 9.841938019e-01f, 1.770948619e-01f, -2.912894785e-01f, -9.566349387e-01f, 9.647951126e-01f, -2.630026639e-01f, -9.708499908e-01f, -2.396878302e-01f, -3.258991241e-01f, 9.454045296e-01f, 4.801242650e-01f, 8.772004843e-01f, 8.243715763e-01f, 5.660489798e-01f, 9.432991147e-01f, 3.319440186e-01f, 9.819520712e-01f, 1.891298145e-01f, 9.942809343e-01f, 1.067959517e-01f, 9.981902838e-01f, 6.013421714e-02f, 9.994276166e-01f, 3.382991254e-02f, 9.998189807e-01f, 1.902644150e-02f,
3.755095899e-01f, 9.268184900e-01f, -5.039728284e-01f, -8.637195230e-01f, -9.191339612e-01f, 3.939450979e-01f, 9.373466372e-01f, 3.483982384e-01f, -1.943297088e-01f, -9.809362888e-01f, 9.780520201e-01f, -2.083608955e-01f, -9.627863169e-01f, -2.702637315e-01f, -3.426586390e-01f, 9.394599795e-01f, 4.713284373e-01f, 8.819577694e-01f, 8.211753964e-01f, 5.706758499e-01f, 9.422446489e-01f, 3.349253237e-01f, 9.816142321e-01f, 1.908757091e-01f, 9.941736460e-01f, 1.077901721e-01f, 9.981563091e-01f, 6.069553271e-02f, 9.994168282e-01f, 3.414595872e-02f, 9.998155832e-01f, 1.920423657e-02f,
-5.770022273e-01f, 8.167425990e-01f, 3.414078429e-02f, -9.994170070e-01f, -9.960693717e-01f, 8.857665956e-02f, 8.609359860e-01f, 5.087132454e-01f, -9.542828053e-02f, -9.954363108e-01f, 9.882167578e-01f, -1.530608535e-01f, -9.537598491e-01f, -3.005696237e-01f, -3.593098223e-01f, 9.332183003e-01f, 4.624853432e-01f, 8.866268992e-01f, 8.179532886e-01f, 5.752846003e-01f, 9.411808252e-01f, 3.379032910e-01f, 9.812732339e-01f, 1.926209927e-01f, 9.940654039e-01f, 1.087842956e-01f, 9.981220365e-01f, 6.125682592e-02f, 9.994059801e-01f, 3.446200117e-02f, 9.998121262e-01f, 1.938203163e-02f,
-9.990208149e-01f, -4.424267635e-02f, 5.617429614e-01f, -8.273118138e-01f, -9.742255807e-01f, -2.255758345e-01f, 7.573719025e-01f, 6.529837251e-01f, 4.425697960e-03f, -9.999902248e-01f, 9.952573776e-01f, -9.727646410e-02f, -9.437798262e-01f, -3.305747509e-01f, -3.758473992e-01f, 9.266815782e-01f, 4.535961151e-01f, 8.912073374e-01f, 8.147053123e-01f, 5.798751712e-01f, 9.401075840e-01f, 3.408778608e-01f, 9.809291363e-01f, 1.943656504e-01f, 9.939560890e-01f, 1.097783074e-01f, 9.980874062e-01f, 6.181810424e-02f, 9.993950725e-01f, 3.477803990e-02f, 9.998086691e-01f, 1.955982484e-02f,
-5.025443435e-01f, -8.645514250e-01f, 9.163355827e-01f, -4.004111886e-01f, -8.557689190e-01f, -5.173581839e-01f, 6.299206614e-01f, 7.766594887e-01f, 1.042364091e-01f, -9.945525527e-01f, 9.991515279e-01f, -4.118499532e-02f, -9.328559637e-01f, -3.602495193e-01f, -3.922660947e-01f, 9.198517799e-01f, 4.446615279e-01f, 8.956986666e-01f, 8.114315867e-01f, 5.844473839e-01f, 9.390249252e-01f, 3.438490629e-01f, 9.805819392e-01f, 1.961097270e-01f, 9.938458204e-01f, 1.107722074e-01f, 9.980525374e-01f, 6.237935647e-02f, 9.993839860e-01f, 3.509407118e-02f, 9.998052120e-01f, 1.973761991e-02f,
4.559690952e-01f, -8.899955750e-01f, 9.887145162e-01f, 1.498119384e-01f, -6.524437070e-01f, -7.578372359e-01f, 4.826020896e-01f, 8.758397102e-01f, 2.030046880e-01f, -9.791777730e-01f, 9.998869300e-01f, 1.503714453e-02f, -9.209993482e-01f, -3.895640969e-01f, -4.085607529e-01f, 9.127311110e-01f, 4.356824458e-01f, 9.001004100e-01f, 8.081322312e-01f, 5.890011191e-01f, 9.379329085e-01f, 3.468167782e-01f, 9.802316427e-01f, 1.978531629e-01f, 9.937345386e-01f, 1.117659956e-01f, 9.980172515e-01f, 6.294059008e-02f, 9.993728399e-01f, 3.541010246e-02f, 9.998016953e-01f, 1.991541311e-02f,
9.952666163e-01f, -9.718190879e-02f, 7.565875053e-01f, 6.538924575e-01f, -3.844182491e-01f, -9.231590629e-01f, 3.200624883e-01f, 9.473964572e-01f, 2.997455299e-01f, -9.540191889e-01f, 9.974612594e-01f, 7.121126354e-02f, -9.082219005e-01f, -4.184889197e-01f, -4.247261286e-01f, 9.053218961e-01f, 4.266598225e-01f, 9.044122100e-01f, 8.048072457e-01f, 5.935363173e-01f, 9.368314743e-01f, 3.497810662e-01f, 9.798783064e-01f, 1.995959580e-01f, 9.936223030e-01f, 1.127596796e-01f, 9.979817271e-01f, 6.350180507e-02f, 9.993616343e-01f, 3.572613373e-02f, 9.997981191e-01f, 2.009320445e-02f,
6.195206046e-01f, 7.849804163e-01f, 2.914465666e-01f, 9.565871358e-01f, -7.827047259e-02f, -9.969321489e-01f, 1.474282593e-01f, 9.890727401e-01f, 3.934913874e-01f, -9.193283319e-01f, 9.918821454e-01f, 1.271607429e-01f, -8.945361972e-01f, -4.469954967e-01f, -4.407573938e-01f, 8.976262808e-01f, 4.175945222e-01f, 9.086334705e-01f, 8.014568090e-01f, 5.980526209e-01f, 9.357206821e-01f, 3.527418077e-01f, 9.795218110e-01f, 2.013381571e-01f, 9.935090542e-01f, 1.137532443e-01f, 9.979458451e-01f, 6.406301260e-02f, 9.993502498e-01f, 3.604215756e-02f, 9.997945428e-01f, 2.027099766e-02f,
-3.258098066e-01f, 9.454353452e-01f, -2.634541392e-01f, 9.646719098e-01f, 2.356393039e-01f, -9.718405604e-01f, -2.985579334e-02f, 9.995542169e-01f, 4.833047390e-01f, -8.754521608e-01f, 9.831672907e-01f, 1.827077270e-01f, -8.799561262e-01f, -4.750549197e-01f, -4.566490650e-01f, 8.896468878e-01f, 4.084874690e-01f, 9.127639532e-01f, 7.980811000e-01f, 6.025500894e-01f, 9.346005321e-01f, 3.556990325e-01f, 9.791622162e-01f, 2.030797005e-01f, 9.933947921e-01f, 1.147466898e-01f, 9.979096651e-01f, 6.462418288e-02f, 9.993388057e-01f, 3.635817394e-02f, 9.997909069e-01f, 2.044878900e-02f,
-9.715921879e-01f, 2.366613895e-01f, -7.372213602e-01f, 6.756513119e-01f, 5.261809826e-01f, -8.503726125e-01f, -2.061982006e-01f, 9.785102606e-01f, 5.682899356e-01f, -8.228283525e-01f, 9.713441133e-01f, 2.376775593e-01f, -8.644961119e-01f, -5.026394725e-01f, -4.723965526e-01f, 8.813861012e-01f, 3.993395865e-01f, 9.168030620e-01f, 7.946801186e-01f, 6.070284247e-01f, 9.334710836e-01f, 3.586527407e-01f, 9.787995219e-01f, 2.048205882e-01f, 9.932795167e-01f, 1.157400310e-01f, 9.978731871e-01f, 6.518533826e-02f, 9.993273020e-01f, 3.667419404e-02f, 9.997872710e-01f, 2.062657848e-02f,
-7.240971923e-01f, -6.896979213e-01f, -9.839316607e-01f, 1.785455495e-01f, 7.645443082e-01f, -6.445711255e-01f, -3.760372102e-01f, 9.266045690e-01f, 6.475961804e-01f, -7.619836926e-01f, 9.564502239e-01f, 2.918955386e-01f, -8.481717706e-01f, -5.297213197e-01f, -4.879944921e-01f, 8.728467226e-01f, 3.901517391e-01f, 9.207505584e-01f, 7.912539840e-01f, 6.114876866e-01f, 9.323322177e-01f, 3.616028130e-01f, 9.784337282e-01f, 2.065608501e-01f, 9.931632876e-01f, 1.167332530e-01f, 9.978363514e-01f, 6.574647129e-02f, 9.993156195e-01f, 3.699020669e-02f, 9.997835755e-01f, 2.080436796e-02f,
1.891294271e-01f, -9.819521904e-01f, -9.276105762e-01f, -3.735487163e-01f, 9.270853400e-01f, -3.748503029e-01f, -5.340162516e-01f, 8.454742432e-01f, 7.204326391e-01f, -6.935249567e-01f, 9.385324121e-01f, 3.451911509e-01f, -8.309991956e-01f, -5.562736392e-01f, -5.034382939e-01f, 8.640311956e-01f, 3.809248805e-01f, 9.246059656e-01f, 7.878028154e-01f, 6.159275174e-01f, 9.311841130e-01f, 3.645493090e-01f, 9.780648947e-01f, 2.083004564e-01f, 9.930460453e-01f, 1.177263632e-01f, 9.977992177e-01f, 6.630758941e-02f, 9.993038774e-01f, 3.730621934e-02f, 9.997798800e-01f, 2.098215744e-02f,
9.284713268e-01f, -3.714041114e-01f, -5.856038332e-01f, -8.105974197e-01f, 9.976883531e-01f, -6.795591116e-02f, -6.751540303e-01f, 7.376767993e-01f, 7.860706449e-01f, -6.181366444e-01f, 9.176476598e-01f, 3.973950148e-01f, -8.129957914e-01f, -5.822695494e-01f, -5.187226534e-01f, 8.549425602e-01f, 3.716599345e-01f, 9.283689260e-01f, 7.843267918e-01f, 6.203478575e-01f, 9.300266504e-01f, 3.674921393e-01f, 9.776929021e-01f, 2.100393921e-01f, 9.929278493e-01f, 1.187193394e-01f, 9.977617860e-01f, 6.686867774e-02f, 9.992920160e-01f, 3.762222081e-02f, 9.997761250e-01f, 2.115994506e-02f,
8.141809702e-01f, 5.806111693e-01f, -6.324278563e-02f, -9.979981780e-01f, 9.693515897e-01f, 2.456775755e-01f, -7.949962020e-01f, 6.066144109e-01f, 8.438539505e-01f, -5.365729332e-01f, 8.938615918e-01f, 4.483429790e-01f, -7.941793799e-01f, -6.076834202e-01f, -5.338430405e-01f, 8.455836177e-01f, 3.623578250e-01f, 9.320390821e-01f, 7.808259130e-01f, 6.247486472e-01f, 9.288598895e-01f, 3.704313040e-01f, 9.773178697e-01f, 2.117776722e-01f, 9.928086400e-01f, 1.197122112e-01f, 9.977239966e-01f, 6.742975861e-02f, 9.992800951e-01f, 3.793822229e-02f, 9.997723103e-01f, 2.133773454e-02f,
-4.866360873e-02f, 9.988152385e-01f, 4.786024988e-01f, -8.780316710e-01f, 8.448832631e-01f, 5.349507332e-01f, -8.897646070e-01f, 4.564197063e-01f, 8.932062984e-01f, -4.496471286e-01f, 8.672499061e-01f, 4.978730977e-01f, -7.745689750e-01f, -6.324894428e-01f, -5.487948060e-01f, 8.359571099e-01f, 3.530194759e-01f, 9.356159568e-01f, 7.773004174e-01f, 6.291296482e-01f, 9.276838303e-01f, 3.733667731e-01f, 9.769397378e-01f, 2.135152817e-01f, 9.926884174e-01f, 1.207049638e-01f, 9.976859689e-01f, 6.799080223e-02f, 9.992680550e-01f, 3.825422376e-02f, 9.997684956e-01f, 2.151552029e-02f,
-8.667671084e-01f, 4.987131655e-01f, 8.730400801e-01f, -4.876484275e-01f, 6.366297007e-01f, 7.711696625e-01f, -9.564702511e-01f, 2.918297648e-01f, 9.336335659e-01f, -3.582294583e-01f, 8.378961682e-01f, 5.458296537e-01f, -7.541838884e-01f, -6.566632986e-01f, -5.635727644e-01f, 8.260664344e-01f, 3.436457217e-01f, 9.390993714e-01f, 7.737502456e-01f, 6.334908009e-01f, 9.264984727e-01f, 3.762984574e-01f, 9.765585065e-01f, 2.152522057e-01f, 9.925672412e-01f, 1.216975898e-01f, 9.976475835e-01f, 6.855183095e-02f, 9.992558956e-01f, 3.857021779e-02f, 9.997646809e-01f, 2.169330604e-02f,
-8.879688978e-01f, -4.599034786e-01f, 9.985986948e-01f, 5.292089656e-02f, 3.652422130e-01f, 9.309124947e-01f, -9.930093288e-01f, 1.180356890e-01f, 9.647326469e-01f, -2.632316053e-01f, 8.058937788e-01f, 5.920601487e-01f, -7.330448627e-01f, -6.801803112e-01f, -5.781728029e-01f, 8.159143329e-01f, 3.342377245e-01f, 9.424887896e-01f, 7.701756358e-01f, 6.378318667e-01f, 9.253038764e-01f, 3.792264462e-01f, 9.761741757e-01f, 2.169884592e-01f, 9.924450517e-01f, 1.226900965e-01f, 9.976088405e-01f, 6.911283731e-02f, 9.992436171e-01f, 3.888620436e-02f, 9.997608066e-01f, 2.187109366e-02f,
-9.277620912e-02f, -9.956870079e-01f, 8.166087270e-01f, 5.771915913e-01f, 5.763408914e-02f, 9.983377457e-01f, -9.982294440e-01f, -5.948119611e-02f, 9.861924052e-01f, -1.656036228e-01f, 7.713432908e-01f, 6.364192963e-01f, -7.111726999e-01f, -7.030173540e-01f, -5.925897360e-01f, 8.055044413e-01f, 3.247962892e-01f, 9.457839727e-01f, 7.665767074e-01f, 6.421527267e-01f, 9.241000414e-01f, 3.821505904e-01f, 9.757867455e-01f, 2.187240422e-01f, 9.923218489e-01f, 1.236824766e-01f, 9.975697994e-01f, 6.967382133e-02f, 9.992312789e-01f, 3.920219466e-02f, 9.997568727e-01f, 2.204887755e-02f,
7.877145410e-01f, -6.160404682e-01f, 3.831194937e-01f, 9.236987829e-01f, -2.556895912e-01f, 9.667589068e-01f, -9.719658494e-01f, -2.351220697e-01f, 9.977982640e-01f, -6.632189453e-02f, 7.343545556e-01f, 6.787660718e-01f, -6.885895729e-01f, -7.251513004e-01f, -6.068195105e-01f, 7.948396206e-01f, 3.153223693e-01f, 9.489846230e-01f, 7.629535198e-01f, 6.464533210e-01f, 9.228869677e-01f, 3.850709498e-01f, 9.753962755e-01f, 2.204589099e-01f, 9.921976924e-01f, 1.246747300e-01f, 9.975304604e-01f, 7.023479044e-02f, 9.992188811e-01f, 3.951817751e-02f, 9.997529387e-01f, 2.222666144e-02f,
9.439841509e-01f, 3.299908042e-01f, -1.683704406e-01f, 9.857237935e-01f, -5.436599255e-01f, 8.393055797e-01f, -9.150469303e-01f, -4.033473432e-01f, 9.994345903e-01f, 3.362342715e-02f, 6.950438619e-01f, 7.189673185e-01f, -6.653177142e-01f, -7.465603352e-01f, -6.208572388e-01f, 7.839236856e-01f, 3.058169186e-01f, 9.520903230e-01f, 7.593061924e-01f, 6.507335305e-01f, 9.216646552e-01f, 3.879874349e-01f, 9.750027061e-01f, 2.221930772e-01f, 9.920725226e-01f, 1.256668717e-01f, 9.974908233e-01f, 7.079573721e-02f, 9.992063046e-01f, 3.983415663e-02f, 9.997490048e-01f, 2.240444534e-02f,
2.323590964e-01f, 9.726300836e-01f, -6.679986119e-01f, 7.441624999e-01f, -7.777124643e-01f, 6.286201477e-01f, -8.292679787e-01f, -5.588511825e-01f, 9.910848737e-01f, 1.332318485e-01f, 6.535362005e-01f, 7.568953037e-01f, -6.413808465e-01f, -7.672226429e-01f, -6.346988082e-01f, 7.727596164e-01f, 2.962808907e-01f, 9.551008344e-01f, 7.556348443e-01f, 6.549931169e-01f, 9.204331040e-01f, 3.909000754e-01f, 9.746060371e-01f, 2.239265591e-01f, 9.919463396e-01f, 1.266588867e-01f, 9.974508882e-01f, 7.135665417e-02f, 9.991936684e-01f, 4.015012830e-02f, 9.997450113e-01f, 2.258222736e-02f
};
namespace pg8 {
#define PG8_LAS __attribute__((address_space(3)))
typedef unsigned short bf16_t;
typedef short bf16x8 __attribute__((ext_vector_type(8)));
typedef float f32x4 __attribute__((ext_vector_type(4)));
typedef unsigned u32x4 __attribute__((ext_vector_type(4)));
constexpr int BM = 256, BK = 64, HALF = 128, HTB = HALF * BK * 2  , STAGE_BYTES = 8 * HTB, NXCD = 8, WGM = 8;

__host__ __device__ __forceinline__ int lds_byte(int r, int c) { const int st = (r >> 4) * 2 + (c >> 5), rr = r & 15, cc = c & 31, ob = rr * 64 + cc * 2; return st * 1024 + (ob ^ (((ob >> 9) & 1) << 5)); }
__host__ __device__ __forceinline__ void stage_rc(int b, int& R, int& C) { const int st = b / 1024, sb = b % 1024, swz = sb ^ (((sb >> 9) & 1) << 5); R = (st >> 1) * 16 + swz / 64; C = (st & 1) * 32 + (swz % 64) / 2; }
__host__ __device__ __forceinline__ int perm32(int rho) { const int n = rho >> 4, i = rho & 15; return 8 * (i >> 2) + 4 * n + (i & 3); }

struct Unit { int pm, pn; };
struct Gemm { const bf16_t* A; const bf16_t* Bt; int M, N, K; };

struct StaticOrder {
    int nM, nN, nwg, G, c;
    __host__ __device__ void init(int M, int N, int G_, int c_) { nM = M / BM; nN = N / BM; nwg = nM * nN; G = G_; c = c_; }
    __host__ __device__ bool next(int i, Unit& u) const {
        const long L = (long)i * G + c; if (L >= nwg) return false;
        int wgid = (int)L; { const int q = nwg / NXCD, r = nwg % NXCD, xcd = wgid % NXCD, off = wgid / NXCD; wgid = (xcd < r ? xcd * (q + 1) : r * (q + 1) + (xcd - r) * q) + off; }
        const int nig = WGM * nN, gid = wgid / nig, fm = gid * WGM, gsz = (nM - fm) < WGM ? (nM - fm) : WGM;
        u.pm = fm + ((wgid % nig) % gsz); u.pn = (wgid % nig) / gsz; return true;
    }
    __device__ __forceinline__ void a_ready(const Unit&) const {}
    __device__ __forceinline__ void done(const Unit&) const {}
};

__device__ __forceinline__ unsigned cvt_pk_bf16(float lo, float hi) { unsigned r; asm volatile("v_cvt_pk_bf16_f32 %0, %1, %2" : "=v"(r) : "v"(lo), "v"(hi)); return r; }
template <class Epi, class Sched, bool ALIGN_EPI = false, bool SP2 = false>
__device__ __forceinline__ void gemm_phase(PG8_LAS unsigned char* lds, const Gemm g, const Sched& S, const Epi& E) {
    int tid_ = threadIdx.x; asm volatile("" : "+v"(tid_));
    const int tid = tid_, wid = __builtin_amdgcn_readfirstlane(tid >> 6), lane = tid & 63, wr = wid >> 2, wc = wid & 3, fr = lane & 15, fq = lane >> 4;
    const int K = g.K, nt = K / BK;
    unsigned voffA[2], voffB[2];
#pragma unroll
    for (int i = 0; i < 2; ++i) { int R, C; stage_rc(tid * 16 + i * 8192, R, C); const int Rb = Epi::PERM ? ((R & ~31) + perm32(R & 31)) : R;
        voffA[i] = (unsigned)(R * K + C) * 2u; voffB[i] = (unsigned)(Rb * K + C) * 2u; }
    const size_t kstep = (size_t)(BK * 2);
    const size_t hstep = (size_t)HALF * K * 2;
    const size_t tstep = 2 * hstep;
    const unsigned ldsw = (unsigned)wid * 1024u;
    const int aoff = lds_byte(wr * 64 + fr, fq * 8), boff = lds_byte(wc * 32 + fr, fq * 8);
#define PG8_SA(b, h) (((b) * 2 + (h)) * HTB)
#define PG8_SB(b, h) ((4 + (b) * 2 + (h)) * HTB)
#define PG8_STAGE(bufoff, gbase, voff) do { _Pragma("unroll") for (int _i = 0; _i < 2; ++_i) \
        __builtin_amdgcn_global_load_lds((const unsigned*)((const char*)(gbase) + (voff)[_i]), (PG8_LAS unsigned*)(lds + (bufoff) + ldsw + _i * 8192), 16, 0, 0); } while (0)
#define PG8_LDA(dst, b, h) do { _Pragma("unroll") for (int m = 0; m < 4; ++m) _Pragma("unroll") for (int k = 0; k < 2; ++k) dst[m][k] = *(const PG8_LAS bf16x8*)(lds + PG8_SA(b, h) + aoff + m * 2048 + k * 1024); } while (0)
#define PG8_LDB(dst, b, h) do { _Pragma("unroll") for (int n = 0; n < 2; ++n) _Pragma("unroll") for (int k = 0; k < 2; ++k) dst[n][k] = *(const PG8_LAS bf16x8*)(lds + PG8_SB(b, h) + boff + n * 2048 + k * 1024); } while (0)
#define PG8_MMA(ai, bj, At, Bt) do { __builtin_amdgcn_s_setprio(1); _Pragma("unroll") for (int m = 0; m < 4; ++m) _Pragma("unroll") for (int n = 0; n < 2; ++n) _Pragma("unroll") for (int k = 0; k < 2; ++k) \
        acc[ai][bj][m][n] = __builtin_amdgcn_mfma_f32_16x16x32_bf16(Bt[n][k], At[m][k], acc[ai][bj][m][n], 0, 0, 0); __builtin_amdgcn_s_setprio(0); } while (0)
#define PG8_WAIT_V(n) asm volatile("s_waitcnt vmcnt(" #n ")" ::: "memory")
#define PG8_WAIT_L(n) asm volatile("s_waitcnt lgkmcnt(" #n ")" ::: "memory")
#define PG8_BAR __builtin_amdgcn_s_barrier()
#define PG8_SCHED __builtin_amdgcn_sched_barrier(0)
    Unit cur, nxt; int ui = 0;
    if (!S.next(0, cur)) return;
    f32x4 acc[2][2][4][2];
#pragma unroll
    for (int a = 0; a < 2; ++a)
#pragma unroll
        for (int b = 0; b < 2; ++b)
#pragma unroll
            for (int m = 0; m < 4; ++m)
#pragma unroll
                for (int n = 0; n < 2; ++n) acc[a][b][m][n] = (f32x4){0.f, 0.f, 0.f, 0.f};
    bf16x8 At[4][2], B0[2][2], B1[2][2];
    const char* cA = (const char*)g.A + (size_t)cur.pm * tstep; const char* cB = (const char*)g.Bt + (size_t)cur.pn * tstep;
    S.a_ready(cur);
    if constexpr (SP2) {
        PG8_STAGE(PG8_SB(0, 0), cB, voffB); PG8_STAGE(PG8_SB(0, 1), cB + hstep, voffB); PG8_STAGE(PG8_SA(0, 0), cA, voffA); PG8_STAGE(PG8_SA(0, 1), cA + hstep, voffA);
        if (wr == 1) PG8_BAR;
        PG8_WAIT_V(2); PG8_BAR;
        PG8_STAGE(PG8_SB(1, 0), cB + kstep, voffB); PG8_STAGE(PG8_SA(1, 0), cA + kstep, voffA); PG8_STAGE(PG8_SB(1, 1), cB + hstep + kstep, voffB);
        PG8_WAIT_V(6); PG8_BAR;
    } else {
        PG8_STAGE(PG8_SB(0, 0), cB, voffB); PG8_STAGE(PG8_SA(0, 0), cA, voffA); PG8_STAGE(PG8_SB(0, 1), cB + hstep, voffB); PG8_STAGE(PG8_SA(0, 1), cA + hstep, voffA);
        if (wr == 1) PG8_BAR;
        PG8_WAIT_V(4); PG8_BAR;
        PG8_STAGE(PG8_SB(1, 0), cB + kstep, voffB); PG8_STAGE(PG8_SA(1, 0), cA + kstep, voffA); PG8_STAGE(PG8_SB(1, 1), cB + hstep + kstep, voffB);
        PG8_WAIT_V(6); PG8_BAR;
    }
    for (;;) {
        const bool has_next = S.next(ui + 1, nxt);
        const char* nA = has_next ? (const char*)g.A + (size_t)nxt.pm * tstep : cA; const char* nB = has_next ? (const char*)g.Bt + (size_t)nxt.pn * tstep : cB;
        for (int t = 0; t < nt; t += 2) {
            const bool last = (t == nt - 2);
            const char* a1 = cA + (size_t)(t + 1) * kstep;
            const char* a2 = last ? nA : cA + (size_t)(t + 2) * kstep; const char* b2 = last ? nB : cB + (size_t)(t + 2) * kstep;
            const char* a3 = a2 + kstep; const char* b3 = b2 + kstep;
            if (last && has_next) S.a_ready(nxt);
            if constexpr (SP2) {
            PG8_LDB(B0, 0, 0); PG8_LDB(B1, 0, 1); PG8_SCHED; PG8_LDA(At, 0, 0); PG8_STAGE(PG8_SA(1, 1), a1 + hstep, voffA);
            PG8_WAIT_V(8); PG8_WAIT_L(0); PG8_BAR; PG8_MMA(0, 0, At, B0); PG8_MMA(0, 1, At, B1); PG8_BAR; PG8_SCHED;
            PG8_LDA(At, 0, 1); PG8_STAGE(PG8_SB(0, 0), b2, voffB); PG8_STAGE(PG8_SB(0, 1), b2 + hstep, voffB); PG8_STAGE(PG8_SA(0, 0), a2, voffA);
            PG8_WAIT_V(8); PG8_WAIT_L(0); PG8_BAR; PG8_MMA(1, 0, At, B0); PG8_MMA(1, 1, At, B1); PG8_BAR; PG8_SCHED;
            PG8_LDB(B0, 1, 0); PG8_LDB(B1, 1, 1); PG8_SCHED; PG8_LDA(At, 1, 0); PG8_STAGE(PG8_SA(0, 1), a2 + hstep, voffA);
            PG8_WAIT_V(8); PG8_WAIT_L(0); PG8_BAR; PG8_MMA(0, 0, At, B0); PG8_MMA(0, 1, At, B1); PG8_BAR; PG8_SCHED;
            PG8_LDA(At, 1, 1); PG8_STAGE(PG8_SB(1, 0), b3, voffB); PG8_STAGE(PG8_SB(1, 1), b3 + hstep, voffB); PG8_STAGE(PG8_SA(1, 0), a3, voffA);
            PG8_WAIT_V(8); PG8_WAIT_L(0); PG8_BAR; PG8_MMA(1, 0, At, B0); PG8_MMA(1, 1, At, B1); PG8_BAR; PG8_SCHED;
            } else {
            PG8_LDB(B0, 0, 0); PG8_SCHED; PG8_LDA(At, 0, 0); PG8_STAGE(PG8_SA(1, 1), a1 + hstep, voffA);
            PG8_WAIT_L(8); PG8_BAR; PG8_WAIT_L(0); PG8_MMA(0, 0, At, B0); PG8_BAR; PG8_SCHED;
            PG8_LDB(B1, 0, 1); PG8_STAGE(PG8_SB(0, 0), b2, voffB);
            PG8_BAR; PG8_WAIT_L(0); PG8_MMA(0, 1, At, B1); PG8_BAR;
            PG8_LDA(At, 0, 1); PG8_STAGE(PG8_SA(0, 0), a2, voffA);
            PG8_BAR; PG8_WAIT_L(0); PG8_MMA(1, 0, At, B0); PG8_BAR; PG8_SCHED;
            PG8_STAGE(PG8_SB(0, 1), b2 + hstep, voffB);
            PG8_WAIT_V(6); PG8_BAR; PG8_MMA(1, 1, At, B1); PG8_BAR;
            PG8_LDB(B0, 1, 0); PG8_SCHED; PG8_LDA(At, 1, 0); PG8_STAGE(PG8_SA(0, 1), a2 + hstep, voffA);
            PG8_WAIT_L(8); PG8_BAR; PG8_WAIT_L(0); PG8_MMA(0, 0, At, B0); PG8_BAR; PG8_SCHED;
            PG8_LDB(B1, 1, 1); PG8_STAGE(PG8_SB(1, 0), b3, voffB);
            PG8_BAR; PG8_WAIT_L(0); PG8_MMA(0, 1, At, B1); PG8_BAR;
            PG8_LDA(At, 1, 1); PG8_STAGE(PG8_SA(1, 0), a3, voffA);
            PG8_BAR; PG8_WAIT_L(0); PG8_MMA(1, 0, At, B0); PG8_BAR; PG8_SCHED;
            PG8_STAGE(PG8_SB(1, 1), b3 + hstep, voffB);
            PG8_WAIT_V(6); PG8_BAR; PG8_MMA(1, 1, At, B1); PG8_BAR;
            }
        }
        if constexpr (ALIGN_EPI) { if (wr == 0) PG8_BAR; }
        if constexpr (!Epi::AFTER_DRAIN) { E(acc, cur, wr, wc, fr, fq); S.done(cur); }
        if (!has_next) break;
#pragma unroll
        for (int a = 0; a < 2; ++a)
#pragma unroll
            for (int b = 0; b < 2; ++b)
#pragma unroll
                for (int m = 0; m < 4; ++m)
#pragma unroll
                    for (int n = 0; n < 2; ++n) acc[a][b][m][n] = (f32x4){0.f, 0.f, 0.f, 0.f};
        cur = nxt; cA = nA; cB = nB; ++ui;
        if constexpr (ALIGN_EPI) { if (wr == 1) PG8_BAR; }
    }
    PG8_WAIT_V(0);
    if constexpr (!ALIGN_EPI) { if (wr == 0) PG8_BAR; }
    PG8_BAR;
    if constexpr (Epi::AFTER_DRAIN) { E.fused(acc, cur, wr, wc, fr, fq, lds, wid, lane); S.done(cur); }
#undef PG8_SA
#undef PG8_SB
#undef PG8_STAGE
#undef PG8_LDA
#undef PG8_LDB
#undef PG8_MMA
#undef PG8_WAIT_V
#undef PG8_WAIT_L
#undef PG8_BAR
#undef PG8_SCHED
}
}
namespace attn_body {
constexpr int QP=512,KP=128,OP=512;
using bf16=__hip_bfloat16;
using bf16x8=__attribute__((ext_vector_type(8)))short;
using s16x4=__attribute__((ext_vector_type(4)))short;
using f32x16=__attribute__((ext_vector_type(16)))float;
using u32x4=__attribute__((ext_vector_type(4)))unsigned;
constexpr int D=64;
constexpr int NW=8,QBLK=32,QB=QBLK*NW,KVBLK=64;
__device__ __forceinline__ int crow(int r,int hi){return (r&3)+8*(r>>2)+4*hi;}
#define SBAR() __builtin_amdgcn_sched_barrier(0)
__device__ __forceinline__ void cmask(f32x16&p0,f32x16&p1,int jb,int qrel,int hi){
  const float NEG=-INFINITY; int kb=64*jb+4*hi;
  #pragma unroll
  for(int r=0;r<16;++r){int kv=kb+(r&3)+8*(r>>2); if(kv>qrel)p0[r]=NEG; if(kv+32>qrel)p1[r]=NEG;}
}

constexpr int NSLOT=3, SLOTB=8192;
constexpr int LDS_K=0, LDS_V=NSLOT*SLOTB, LDS_WS=2*NSLOT*SLOTB, LDS_OST=LDS_WS+NW*64*4, LDS_BYTES=LDS_OST+NW*4096;
constexpr float C2=0.125f*1.4426950408889634f;
__device__ __forceinline__ void glds16(const void*gsrc,unsigned lds_dst){unsigned keep;
  asm volatile("s_mov_b32 %0, m0\n\ts_mov_b32 m0, %2\n\ts_nop 0\n\tglobal_load_lds_dwordx4 %1, off\n\ts_mov_b32 m0, %0":"=&s"(keep):"v"(gsrc),"s"(lds_dst):"memory");}
__device__ __forceinline__ float max3f(float a,float b,float c){float r;asm("v_max3_f32 %0, %1, %2, %3":"=v"(r):"v"(a),"v"(b),"v"(c));return r;}
__device__ __forceinline__ float max2f(float a,float b){float r;asm("v_max_f32_e32 %0, %1, %2":"=v"(r):"v"(a),"v"(b));return r;}
__device__ __forceinline__ float fadd_s(float a,float b){float r;asm("v_add_f32_e32 %0, %1, %2":"=v"(r):"v"(a),"v"(b));return r;}
__device__ __forceinline__ float fsub_s(float a,float b){float r;asm("v_sub_f32_e32 %0, %1, %2":"=v"(r):"v"(a),"v"(b));return r;}
typedef float f32x2_t __attribute__((ext_vector_type(2))); typedef __bf16 bf16x2_t __attribute__((ext_vector_type(2)));
__device__ __forceinline__ unsigned cvtpk_s(float lo,float hi){f32x2_t v={lo,hi};bf16x2_t b=__builtin_convertvector(v,bf16x2_t);return __builtin_bit_cast(unsigned,b);}
#define WAIT_BAR(N) asm volatile("s_waitcnt vmcnt(" #N ") lgkmcnt(0)\n\ts_barrier":::"memory")

__device__ __forceinline__ void qkt(f32x16&p0,f32x16&p1,const char*Kslot,const bf16x8*qr,const f32x16&negm,int r32,int hi){
  const char*kb=Kslot+hi*1024+r32*16;
  #pragma unroll
  for(int d0=0;d0<4;++d0){
    const bf16x8 b0=*reinterpret_cast<const bf16x8*>(kb+d0*2048);
    const bf16x8 b1=*reinterpret_cast<const bf16x8*>(kb+d0*2048+512);
    if(d0==0){p0=__builtin_amdgcn_mfma_f32_32x32x16_bf16(b0,qr[0],negm,0,0,0);p1=__builtin_amdgcn_mfma_f32_32x32x16_bf16(b1,qr[0],negm,0,0,0);}
    else{p0=__builtin_amdgcn_mfma_f32_32x32x16_bf16(b0,qr[d0],p0,0,0,0);p1=__builtin_amdgcn_mfma_f32_32x32x16_bf16(b1,qr[d0],p1,0,0,0);}}
}
typedef __attribute__((address_space(3))) const char* lds_cptr;
typedef short v4i16_t __attribute__((ext_vector_type(4)));
__device__ __forceinline__ void kload8(bf16x8*kf,lds_cptr kp){
  kf[0]=*(const __attribute__((address_space(3))) bf16x8*)(kp);      kf[1]=*(const __attribute__((address_space(3))) bf16x8*)(kp+512);
  kf[2]=*(const __attribute__((address_space(3))) bf16x8*)(kp+2048); kf[3]=*(const __attribute__((address_space(3))) bf16x8*)(kp+2560);
  kf[4]=*(const __attribute__((address_space(3))) bf16x8*)(kp+4096); kf[5]=*(const __attribute__((address_space(3))) bf16x8*)(kp+4608);
  kf[6]=*(const __attribute__((address_space(3))) bf16x8*)(kp+6144); kf[7]=*(const __attribute__((address_space(3))) bf16x8*)(kp+6656);
}
__device__ __forceinline__ void kload2(bf16x8*kf,lds_cptr kp,int j){ kf[2*j]=*(const __attribute__((address_space(3))) bf16x8*)(kp+j*2048); kf[2*j+1]=*(const __attribute__((address_space(3))) bf16x8*)(kp+j*2048+512); }
__device__ __forceinline__ s16x4 vtr(lds_cptr p){ return __builtin_bit_cast(s16x4,__builtin_amdgcn_ds_read_tr16_b64_v4i16((__attribute__((address_space(3))) v4i16_t*)p)); }
__device__ __forceinline__ float rowmax(const f32x16&p0,const f32x16&p1){
  float a=max3f(p0[0],p0[1],p1[0]),b=max3f(p0[2],p0[3],p1[1]);a=max3f(a,p1[2],p1[3]);
  #pragma unroll
  for(int r=4;r<16;r+=4){a=max3f(a,p0[r],p0[r+1]);b=max3f(b,p0[r+2],p0[r+3]);a=max3f(a,p1[r],p1[r+1]);b=max3f(b,p1[r+2],p1[r+3]);}
  const float m=max2f(a,b);
  auto rr=__builtin_amdgcn_permlane32_swap(__float_as_uint(m),__float_as_uint(m),false,false);
  return max2f(__uint_as_float(rr[0]),__uint_as_float(rr[1]));
}
__device__ __forceinline__ void pv(f32x16*o,int vb,bf16x8 pa0,bf16x8 pa1,bf16x8 pa2,bf16x8 pa3){
  #pragma unroll
  for(int d0=0;d0<2;++d0){s16x4 lo[4],hi[4];
    #pragma unroll
    for(int ks=0;ks<4;++ks){
      asm volatile("ds_read_b64_tr_b16 %0,%1 offset:%c2":"=&v"(lo[ks]):"v"(vb),"i"(d0*4096+ks*1024):"memory");
      asm volatile("ds_read_b64_tr_b16 %0,%1 offset:%c2":"=&v"(hi[ks]):"v"(vb),"i"(d0*4096+ks*1024+512):"memory");}
    asm volatile("s_waitcnt lgkmcnt(0)":::"memory");SBAR();
    #define PK(k) (bf16x8){lo[k][0],lo[k][1],lo[k][2],lo[k][3],hi[k][0],hi[k][1],hi[k][2],hi[k][3]}
    o[d0]=__builtin_amdgcn_mfma_f32_32x32x16_bf16(pa0,PK(0),o[d0],0,0,0);
    o[d0]=__builtin_amdgcn_mfma_f32_32x32x16_bf16(pa1,PK(1),o[d0],0,0,0);
    o[d0]=__builtin_amdgcn_mfma_f32_32x32x16_bf16(pa2,PK(2),o[d0],0,0,0);
    o[d0]=__builtin_amdgcn_mfma_f32_32x32x16_bf16(pa3,PK(3),o[d0],0,0,0);
    #undef PK
  }
}

#ifndef ATTN_STORE16
#define ATTN_STORE16(p,v) (*(u32x4*)(p)=(v))
#endif
template<int THRL> __device__ __forceinline__ void attn_unit(const bf16*Qp,const bf16*__restrict__ Kh,const bf16*__restrict__ Vh,bf16*Op,const int NT,char*shm){
  int tid_=threadIdx.x; asm volatile("":"+v"(tid_)); const int tid=tid_,lane=tid&63,r32=lane&31,hi=lane>>5; const int wid=__builtin_amdgcn_readfirstlane(tid>>6);
  const bf16*Qw=Qp+(long)(wid*QBLK)*QP;
  const unsigned lds0=(unsigned)(uintptr_t)shm;
  float*wsf=(float*)(shm+LDS_WS)+wid*64;
  const bf16*ksrc=Kh+(long)lane*KP+wid*8;
  const bf16*vsrc=Vh+(long)(16*(wid&3)+(lane>>2))*KP+(wid>>2)*32+(lane&3)*8;
  const unsigned kdst=lds0+LDS_K+wid*1024, vdst=lds0+LDS_V+wid*1024;
  #define DMA_K(t,slot) glds16(ksrc+(long)(t)*KVBLK*KP,(unsigned)__builtin_amdgcn_readfirstlane(kdst+(slot)))
  #define DMA_V(t,slot) glds16(vsrc+(long)(t)*KVBLK*KP,(unsigned)__builtin_amdgcn_readfirstlane(vdst+(slot)))
  const int vb0=(int)(lds0+LDS_V)+((lane>>4)&1)*32+(lane&3)*8+(4*hi+((lane&15)>>2))*64;
  const char*Kbase=shm+LDS_K; bf16x8 kf[8];
  const lds_cptr shm3=(lds_cptr)shm; const lds_cptr kp0=shm3+LDS_K+hi*1024+r32*16; const lds_cptr vp0=shm3+LDS_V+((lane>>4)&1)*32+(lane&3)*8+(4*hi+((lane&15)>>2))*64;
  DMA_K(0,0);DMA_V(0,0);DMA_K(1,SLOTB);
  bf16x8 qr[4];
  #pragma unroll
  for(int d0=0;d0<4;++d0)qr[d0]=*reinterpret_cast<const bf16x8*>(&Qw[(long)r32*QP+d0*16+hi*8]);
  float mhat=0.f,l_reg=0.f;f32x16 o[2];o[0]=f32x16{};o[1]=f32x16{};f32x16 negm=f32x16{};asm volatile("":"+v"(negm));
  #define CMASK(P0,P1,t) do{}while(0)
  bool resc=false;
  #define START(P0,P1) do{ const float rm=rowmax(P0,P1); resc=false; \
    { const float dl=rm; mhat=fadd_s(mhat,dl); \
      _Pragma("unroll") for(int r=0;r<16;++r){P0[r]=fsub_s(P0[r],dl);P1[r]=fsub_s(P1[r],dl);} \
      _Pragma("unroll") for(int r=0;r<16;++r)negm[r]=-mhat; asm volatile("":"+v"(negm)); } \
    _Pragma("unroll") for(int r=0;r<16;++r)P0[r]=__builtin_amdgcn_exp2f(P0[r]); }while(0)
  #define RESC() do{ if(resc){ asm volatile("s_waitcnt lgkmcnt(0)":::"memory"); \
      _Pragma("unroll") for(int d_=0;d_<2;++d_) _Pragma("unroll") for(int r=0;r<16;++r)o[d_][r]*=wsf[crow(r,hi)]; } }while(0)
  f32x16 pA0,pA1,pB0,pB1;
  int sl_prev=0,sl_cur=0,sl_next=SLOTB;
  #define ROT() do{sl_prev=sl_cur;sl_cur=sl_next;sl_next=(sl_next==(NSLOT-1)*SLOTB)?0:sl_next+SLOTB;}while(0)
  DMA_K(2,2*SLOTB);
  WAIT_BAR(3);
  qkt(pA0,pA1,Kbase,qr,negm,r32,hi);asm volatile("s_nop 15\n\ts_nop 7":"+v"(pA0),"+v"(pA1));CMASK(pA0,pA1,0);
  START(pA0,pA1);
  _Pragma("unroll") for(int r=0;r<16;++r)pA1[r]=__builtin_amdgcn_exp2f(pA1[r]);
  WAIT_BAR(0);
  DMA_K(3,0);DMA_V(1,SLOTB);
  ROT();
  kload8(kf,kp0+sl_cur);
  WAIT_BAR(2);
  s16x4 vlo[8],vhi[8]; u32x4 pw0,pw1,pw2,pw3;
  #define PKW(P,B) cvtpk_s(P[B],P[B+1])
  #define PAF(k) __builtin_bit_cast(bf16x8,pw##k)
  #define VFR(i) (bf16x8){vlo[i][0],vlo[i][1],vlo[i][2],vlo[i][3],vhi[i][0],vhi[i][1],vhi[i][2],vhi[i][3]}
  #define PIN(x) asm volatile("":"+v"(x))
  #define MX3(a,b,c) __builtin_fmaxf(__builtin_fmaxf((a),(b)),(c))
  #define GAPA(MF,A0,A1,A2,A3,W0,W1,PW) do{ MF; sacc+=A0; sacc+=A1; sacc+=A2; sacc+=A3; PIN(sacc); W0; W1; PIN(PW); SBAR(); }while(0)
  #define EX(v) __builtin_amdgcn_exp2f(v)
  #define GAPB(MF,X,B) do{ MF; X[B]=EX(X[B]); X[B+1]=EX(X[B+1]); X[B+2]=EX(X[B+2]); X[B+3]=EX(X[B+3]); PIN(X); SBAR(); }while(0)
  #define VRD(i) do{ vlo[i]=vtr(vp_+(((i)>>2)*4096+((i)&3)*1024)); vhi[i]=vtr(vp_+(((i)>>2)*4096+((i)&3)*1024+512)); }while(0)
  #define KRD(G,j) do{ if(G){ kload2(kf,kp0+sl_next,j); SBAR(); } }while(0)
  #define STEP(C0,C1,P0,P1,t,GK,GV,GL) do{ SBAR(); \
    const lds_cptr vp_=vp0+sl_prev; \
    VRD(0); SBAR(); float sacc=(P0[0]+P0[1]); \
    GAPA(C0=__builtin_amdgcn_mfma_f32_32x32x16_bf16(kf[0],qr[0],negm,0,0,0), P0[2],P0[3],P0[4],P0[5],     pw0[0]=PKW(P0,0), pw0[1]=PKW(P0,2), pw0); \
    VRD(4); SBAR(); GAPA(C1=__builtin_amdgcn_mfma_f32_32x32x16_bf16(kf[1],qr[0],negm,0,0,0), P0[6],P0[7],P0[8],P0[9],     pw0[2]=PKW(P0,4), pw0[3]=PKW(P0,6), pw0); \
    VRD(1); SBAR(); GAPA(C0=__builtin_amdgcn_mfma_f32_32x32x16_bf16(kf[2],qr[1],C0,0,0,0),   P0[10],P0[11],P0[12],P0[13], pw1[0]=PKW(P0,8), pw1[1]=PKW(P0,10), pw1); \
    VRD(5); SBAR(); GAPA(C1=__builtin_amdgcn_mfma_f32_32x32x16_bf16(kf[3],qr[1],C1,0,0,0),   P0[14],P0[15],P1[0],P1[1],   pw1[2]=PKW(P0,12),pw1[3]=PKW(P0,14), pw1); \
    VRD(2); SBAR(); GAPA(C0=__builtin_amdgcn_mfma_f32_32x32x16_bf16(kf[4],qr[2],C0,0,0,0),   P1[2],P1[3],P1[4],P1[5],     pw2[0]=PKW(P1,0), pw2[1]=PKW(P1,2), pw2); \
    VRD(6); SBAR(); GAPA(C1=__builtin_amdgcn_mfma_f32_32x32x16_bf16(kf[5],qr[2],C1,0,0,0),   P1[6],P1[7],P1[8],P1[9],     pw2[2]=PKW(P1,4), pw2[3]=PKW(P1,6), pw2); \
    VRD(3); SBAR(); GAPA(C0=__builtin_amdgcn_mfma_f32_32x32x16_bf16(kf[6],qr[3],C0,0,0,0),   P1[10],P1[11],P1[12],P1[13], pw3[0]=PKW(P1,8), pw3[1]=PKW(P1,10), pw3); \
    VRD(7); SBAR(); GAPA(C1=__builtin_amdgcn_mfma_f32_32x32x16_bf16(kf[7],qr[3],C1,0,0,0),   P1[14],P1[15],0.f,0.f,       pw3[2]=PKW(P1,12),pw3[3]=PKW(P1,14), pw3); \
    l_reg+=sacc; \
    if(GK){DMA_K((t)+3,sl_cur);} if(GV){DMA_V((t)+1,sl_next);} \
    CMASK(C0,C1,t); \
    { float a=MX3(C0[0],C0[1],C1[0]),b=MX3(C0[2],C0[3],C1[1]); a=MX3(a,C1[2],C1[3]); \
      _Pragma("unroll") for(int r=4;r<16;r+=4){a=MX3(a,C0[r],C0[r+1]);b=MX3(b,C0[r+2],C0[r+3]);a=MX3(a,C1[r],C1[r+1]);b=MX3(b,C1[r+2],C1[r+3]);} \
      float rm=__builtin_fmaxf(a,b); { auto rr=__builtin_amdgcn_permlane32_swap(__float_as_uint(rm),__float_as_uint(rm),false,false); rm=__builtin_fmaxf(__uint_as_float(rr[0]),__uint_as_float(rr[1])); } \
      resc=false; \
      if(__builtin_expect(__any(rm>(float)THRL),0)){ const float dl=__builtin_fmaxf(rm,0.f); mhat+=dl; \
        _Pragma("unroll") for(int r=0;r<16;++r){C0[r]-=dl;C1[r]-=dl;} \
        _Pragma("unroll") for(int r=0;r<16;++r)negm[r]=-mhat; asm volatile("":"+v"(negm)); \
        const float f=__builtin_amdgcn_exp2f(-dl); l_reg*=f; if(hi==0)wsf[r32]=f; resc=true; } } \
    SBAR(); \
    GAPB(o[0]=__builtin_amdgcn_mfma_f32_32x32x16_bf16(PAF(0),VFR(0),o[0],0,0,0), C0,0); \
    GAPB(o[1]=__builtin_amdgcn_mfma_f32_32x32x16_bf16(PAF(0),VFR(4),o[1],0,0,0), C0,4); \
    KRD(GL,0); GAPB(o[0]=__builtin_amdgcn_mfma_f32_32x32x16_bf16(PAF(1),VFR(1),o[0],0,0,0), C0,8); \
    KRD(GL,1); GAPB(o[1]=__builtin_amdgcn_mfma_f32_32x32x16_bf16(PAF(1),VFR(5),o[1],0,0,0), C0,12); \
    KRD(GL,2); GAPB(o[0]=__builtin_amdgcn_mfma_f32_32x32x16_bf16(PAF(2),VFR(2),o[0],0,0,0), C1,0); \
    KRD(GL,3); GAPB(o[1]=__builtin_amdgcn_mfma_f32_32x32x16_bf16(PAF(2),VFR(6),o[1],0,0,0), C1,4); \
    GAPB(o[0]=__builtin_amdgcn_mfma_f32_32x32x16_bf16(PAF(3),VFR(3),o[0],0,0,0), C1,8); \
    GAPB(o[1]=__builtin_amdgcn_mfma_f32_32x32x16_bf16(PAF(3),VFR(7),o[1],0,0,0), C1,12); \
    }while(0)
  int t=1;
  for(;t+5<NT;t+=2){
    STEP(pB0,pB1,pA0,pA1,t,true,true,true);     WAIT_BAR(2); RESC(); ROT();
    STEP(pA0,pA1,pB0,pB1,t+1,true,true,true);   WAIT_BAR(2); RESC(); ROT();
  }
  #define ENDW(tt) do{ if((tt)+3<NT){WAIT_BAR(2);} else if((tt)+2<NT){WAIT_BAR(1);} else {WAIT_BAR(0);} }while(0)
  for(;t+1<NT;t+=2){
    STEP(pB0,pB1,pA0,pA1,t,(t+3<NT),(t+1<NT),(t+1<NT));       ENDW(t);   RESC(); ROT();
    STEP(pA0,pA1,pB0,pB1,t+1,(t+4<NT),(t+2<NT),(t+2<NT));     ENDW(t+1); RESC(); ROT();
  }
  STEP(pB0,pB1,pA0,pA1,NT-1,false,false,false); RESC();
  { float sacc=pB0[0]+pB0[1]; _Pragma("unroll") for(int r=2;r<16;++r)sacc+=pB0[r]; _Pragma("unroll") for(int r=0;r<16;++r)sacc+=pB1[r]; l_reg+=sacc;
    pw0=(u32x4){PKW(pB0,0),PKW(pB0,2),PKW(pB0,4),PKW(pB0,6)};pw1=(u32x4){PKW(pB0,8),PKW(pB0,10),PKW(pB0,12),PKW(pB0,14)};pw2=(u32x4){PKW(pB1,0),PKW(pB1,2),PKW(pB1,4),PKW(pB1,6)};pw3=(u32x4){PKW(pB1,8),PKW(pB1,10),PKW(pB1,12),PKW(pB1,14)};
    SBAR(); pv(o,vb0+sl_cur,PAF(0),PAF(1),PAF(2),PAF(3)); }
  #undef PKW
  #undef PAF
  #undef VFR
  #undef PIN
  #undef MX3
  #undef GAPA
  #undef GAPB
  #undef EX
  #undef VRD
  #undef KRD
  #undef STEP
  #undef ENDW
  {auto rr=__builtin_amdgcn_permlane32_swap(__float_as_uint(l_reg),__float_as_uint(l_reg),false,false);l_reg=__uint_as_float(rr[0])+__uint_as_float(rr[1]);}
  if(hi==0)wsf[32+r32]=l_reg;asm volatile("s_waitcnt lgkmcnt(0)":::"memory");
  float rli[16];
  #pragma unroll
  for(int r=0;r<16;++r)rli[r]=__builtin_amdgcn_rcpf(wsf[32+crow(r,hi)]);
  bf16*Ow=Op+(long)(wid*QBLK)*OP;
  { bf16*stg=(bf16*)(shm+LDS_OST)+wid*2048;
    #pragma unroll
    for(int r=0;r<16;++r){const int orow=crow(r,hi);
      #pragma unroll
      for(int d0=0;d0<2;++d0)stg[orow*64+d0*32+r32]=__float2bfloat16(o[d0][r]*rli[r]);}
    asm volatile("s_waitcnt lgkmcnt(0)":::"memory");
    #pragma unroll
    for(int i=0;i<4;++i){const int row=i*8+(lane>>3),ch=lane&7; const u32x4 v=*(const u32x4*)(stg+row*64+ch*8); ATTN_STORE16(Ow+(long)row*OP+ch*8,v);} }
  asm volatile("s_waitcnt lgkmcnt(0)\n\ts_barrier":::"memory");
  #undef DMA_K
  #undef DMA_V
  #undef CMASK
  #undef START
  #undef RESC
  #undef ROT
}
constexpr int ATTN_LDS_BYTES=LDS_BYTES;
#undef SBAR
#undef WAIT_BAR
}

#define LAS __attribute__((address_space(3)))
typedef unsigned short bf16;
typedef unsigned u32x4 __attribute__((ext_vector_type(4)));
typedef unsigned u32x2 __attribute__((ext_vector_type(2)));
typedef float f32x4 __attribute__((ext_vector_type(4)));
typedef float f32x16 __attribute__((ext_vector_type(16)));
typedef short bf16x8 __attribute__((ext_vector_type(8)));
typedef short s16x4 __attribute__((ext_vector_type(4)));

constexpr int DM = 1024, NL = 16384, MT = 16896, SEQ = 8192;
constexpr int INC = 4352, FF = 2816, FF2 = 5632, DEPTH = 4;
constexpr float EPS = 1e-6f;
constexpr float LOG2E = 1.4426950408889634f;
constexpr float C2 = 0.125f * 1.4426950408889634f;
constexpr int NWAVES = 8, NTHREADS = 512;

constexpr size_t MiB = 1u << 20;
constexpr size_t WS_MODS = 1 * MiB;
constexpr size_t WS_WIN = 2 * MiB;
constexpr size_t WS_WPA = 11 * MiB, WS_WPB = 12 * MiB;
constexpr size_t WS_WO = 13 * MiB;
constexpr size_t WS_WFI = 15 * MiB;
constexpr size_t WS_WFO = 26 * MiB;
constexpr size_t WS_X = 32 * MiB;
constexpr size_t WS_H = 98 * MiB;
constexpr size_t SZ512 = (size_t)MT * 512 * 2, SZ128 = (size_t)MT * 128 * 2, SZ1024 = (size_t)MT * 1024 * 2;
constexpr size_t WS_NAQ = 131 * MiB, WS_NAK = WS_NAQ + SZ512, WS_NAV = WS_NAK + SZ512, WS_GQ = WS_NAV + SZ512, WS_GK = WS_GQ + SZ512, WS_GV = WS_GK + SZ128;
constexpr size_t WS_SA = WS_GV + SZ128, WS_SB = WS_SA + SZ1024, WS_YA = WS_SB + SZ1024, WS_YB = WS_YA + SZ512, WS_END = WS_YB + SZ512;
constexpr size_t WS_ACT = 131 * MiB;
static_assert(WS_ACT + (size_t)MT * FF * 2 <= WS_END, "act overlay");
static_assert(WS_WFO + (size_t)DM * FF * 2 <= WS_X && WS_WFI + (size_t)FF2 * DM * 2 <= WS_WFO && WS_WIN + (size_t)INC * DM * 2 <= WS_WPA, "weights map");

constexpr int RING_BYTES = 131072;
constexpr int LDS_BYTES = 147456;
constexpr int A_K = 0, A_V = 16384, A_WS = 32768, A_OST = 34816, A_RPB = 67584;

__device__ __forceinline__ unsigned f2bf(float f) { unsigned u = __builtin_bit_cast(unsigned, f); return (u + 0x7fffu + ((u >> 16) & 1u)) >> 16; }
__device__ __forceinline__ unsigned pk2(float lo, float hi) { return f2bf(lo) | (f2bf(hi) << 16); }
__device__ __forceinline__ float bflo(unsigned w) { return __builtin_bit_cast(float, w << 16); }
__device__ __forceinline__ float bfhi(unsigned w) { return __builtin_bit_cast(float, w & 0xffff0000u); }
__device__ __forceinline__ float wave_sum(float v) {
#pragma unroll
    for (int o = 1; o < 64; o <<= 1) v += __shfl_xor(v, o);
    return v;
}
__device__ __forceinline__ int launder(int v) { asm volatile("" : "+v"(v)); return v; }
__device__ __forceinline__ float sigmoidf_(float x) { return __builtin_amdgcn_rcpf(1.0f + __expf(-x)); }

using pg8::Unit; using pg8::cvt_pk_bf16;
typedef f32x4 Acc[2][2][4][2];

struct EpiIn {
    static constexpr bool PERM = true, AFTER_DRAIN = false;
    bf16 *NAQ, *NAK, *NAV, *GQ, *GK, *GV, *SA, *SB; const float* qgain; const float* kgain;
    __device__ __forceinline__ void operator()(const Acc& acc, const Unit& u, int wr, int wc, int fr, int fq) const {
        const int pm = u.pm, pn = u.pn;
        const int rbase = pm * 256 + wr * 64 + fr;
        const int kvd = pm < 32 ? 0 : (pm < 64 ? 256 : (pm == 64 ? -8192 : 0));
        if (pn < 6 || pn >= 9) {
            bf16* dst; int ld, colt, rowd = 0; float sc = 1.f; bool sig = false;
            if (pn < 2) { dst = NAQ; ld = 512; colt = pn * 256; sc = C2; }
            else if (pn < 4) { dst = NAK; ld = 512; colt = (pn - 2) * 256; rowd = kvd; }
            else if (pn < 6) { dst = NAV; ld = 512; colt = (pn - 4) * 256; rowd = kvd; }
            else if (pn < 13) { dst = SA; ld = 1024; colt = (pn - 9) * 256; sig = true; }
            else { dst = SB; ld = 1024; colt = (pn - 13) * 256; sig = true; }
            const int col0 = colt + wc * 32 + 8 * fq;
#pragma unroll
            for (int ai = 0; ai < 2; ++ai)
#pragma unroll
                for (int m = 0; m < 4; ++m) {
                    bf16* rowp = dst + (size_t)(rbase + ai * 128 + m * 16 + rowd) * ld + col0;
#pragma unroll
                    for (int bj = 0; bj < 2; ++bj) {
                        f32x4 v0 = acc[ai][bj][m][0], v1 = acc[ai][bj][m][1];
                        if (sig) {
#pragma unroll
                            for (int e = 0; e < 4; ++e) { v0[e] = sigmoidf_(v0[e]); v1[e] = sigmoidf_(v1[e]); }
                        } else { v0 = v0 * sc; v1 = v1 * sc; }
                        u32x4 w; w.x = cvt_pk_bf16(v0[0], v0[1]); w.y = cvt_pk_bf16(v0[2], v0[3]); w.z = cvt_pk_bf16(v1[0], v1[1]); w.w = cvt_pk_bf16(v1[2], v1[3]);
                        *(u32x4*)(rowp + bj * 128) = w;
                    }
                }
        } else {
            const int hidx = 4 * (pn - 6) + wc;
            const bool isv = hidx >= 10, isk = (hidx >= 8) && !isv;
            bf16* dst; int ld, hcol, rowd; float sc = 1.f;
            if (isv) { dst = GV; ld = 128; hcol = (hidx - 10) * 64; rowd = kvd; }
            else if (isk) { dst = GK; ld = 128; hcol = (hidx - 8) * 64; rowd = kvd; }
            else { dst = GQ; ld = 512; hcol = hidx * 64; rowd = 0; sc = C2; }
            const float* gain = isk ? kgain : qgain;
            f32x4 gv[2][2];
#pragma unroll
            for (int bj = 0; bj < 2; ++bj)
#pragma unroll
                for (int n = 0; n < 2; ++n) gv[bj][n] = *(const f32x4*)(gain + 32 * bj + 8 * fq + 4 * n);
            const bool latent = pm < 64;
#pragma unroll
            for (int ai = 0; ai < 2; ++ai)
#pragma unroll
                for (int m = 0; m < 4; ++m) {
                    const int row = rbase + ai * 128 + m * 16;
                    bf16* rowp = dst + (size_t)(row + rowd) * ld + hcol + 8 * fq;
                    if (isv) {
#pragma unroll
                        for (int bj = 0; bj < 2; ++bj) {
                            const f32x4 v0 = acc[ai][bj][m][0], v1 = acc[ai][bj][m][1];
                            u32x4 w; w.x = cvt_pk_bf16(v0[0], v0[1]); w.y = cvt_pk_bf16(v0[2], v0[3]); w.z = cvt_pk_bf16(v1[0], v1[1]); w.w = cvt_pk_bf16(v1[2], v1[3]);
                            *(u32x4*)(rowp + bj * 32) = w;
                        }
                    } else {
                        float ss = 0.f;
#pragma unroll
                        for (int bj = 0; bj < 2; ++bj)
#pragma unroll
                            for (int n = 0; n < 2; ++n) { const f32x4 x = acc[ai][bj][m][n]; ss += (x[0] * x[0] + x[1] * x[1]) + (x[2] * x[2] + x[3] * x[3]); }
                        ss += __shfl_xor(ss, 16); ss += __shfl_xor(ss, 32);
                        const float rinv = rsqrtf(ss * (1.0f / 64.0f) + EPS);
                        const int s = row & (SEQ - 1);
#pragma unroll
                        for (int bj = 0; bj < 2; ++bj) {
                            f32x4 v0 = acc[ai][bj][m][0] * rinv * gv[bj][0], v1 = acc[ai][bj][m][1] * rinv * gv[bj][1];
                            if (latent) {
                                const int pos = bj == 0 ? (s >> 6) : (s & 63);
                                const f32x4 t0 = *(const f32x4*)(ROPE_TAB + (pos * 16 + 4 * fq) * 2);
                                const f32x4 t1 = *(const f32x4*)(ROPE_TAB + (pos * 16 + 4 * fq) * 2 + 4);
                                f32x4 r0, r1;
                                r0[0] = v0[0] * t0[0] - v0[1] * t0[1]; r0[1] = v0[0] * t0[1] + v0[1] * t0[0];
                                r0[2] = v0[2] * t0[2] - v0[3] * t0[3]; r0[3] = v0[2] * t0[3] + v0[3] * t0[2];
                                r1[0] = v1[0] * t1[0] - v1[1] * t1[1]; r1[1] = v1[0] * t1[1] + v1[1] * t1[0];
                                r1[2] = v1[2] * t1[2] - v1[3] * t1[3]; r1[3] = v1[2] * t1[3] + v1[3] * t1[2];
                                v0 = r0; v1 = r1;
                            }
                            v0 = v0 * sc; v1 = v1 * sc;
                            u32x4 w; w.x = cvt_pk_bf16(v0[0], v0[1]); w.y = cvt_pk_bf16(v0[2], v0[3]); w.z = cvt_pk_bf16(v1[0], v1[1]); w.w = cvt_pk_bf16(v1[2], v1[3]);
                            *(u32x4*)(rowp + bj * 32) = w;
                        }
                    }
                }
        }
    }
};

struct EpiMerge {
    static constexpr bool PERM = true, AFTER_DRAIN = false;
    const bf16* S; bf16* O; int second;
    __device__ __forceinline__ void operator()(const Acc& acc, const Unit& u, int wr, int wc, int fr, int fq) const {
        const int rbase = u.pm * 256 + wr * 64 + fr, col0 = u.pn * 256 + wc * 32 + 8 * fq;
#pragma unroll
        for (int ai = 0; ai < 2; ++ai)
#pragma unroll
            for (int m = 0; m < 4; ++m)
#pragma unroll
                for (int bj = 0; bj < 2; ++bj) {
                    const size_t off = (size_t)(rbase + ai * 128 + m * 16) * 1024 + col0 + bj * 128;
                    const u32x4 b = *(const u32x4*)(S + off);
                    u32x4 p = {0u, 0u, 0u, 0u};
                    if (second) p = *(const u32x4*)(O + off);
                    const f32x4 v0 = acc[ai][bj][m][0], v1 = acc[ai][bj][m][1];
                    u32x4 w;
                    w.x = cvt_pk_bf16(bflo(p.x) + v0[0] * bflo(b.x), bfhi(p.x) + v0[1] * bfhi(b.x)); w.y = cvt_pk_bf16(bflo(p.y) + v0[2] * bflo(b.y), bfhi(p.y) + v0[3] * bfhi(b.y));
                    w.z = cvt_pk_bf16(bflo(p.z) + v1[0] * bflo(b.z), bfhi(p.z) + v1[1] * bfhi(b.z)); w.w = cvt_pk_bf16(bflo(p.w) + v1[2] * bflo(b.w), bfhi(p.w) + v1[3] * bfhi(b.w));
                    *(u32x4*)(O + off) = w;
                }
    }
};

struct EpiRes {
    static constexpr bool PERM = false, AFTER_DRAIN = false;
    float* X; const float* gate;
    __device__ __forceinline__ void operator()(const Acc& acc, const Unit& u, int wr, int wc, int fr, int fq) const {
        const int pm = u.pm, v = pm < 32 ? 0 : (pm < 64 ? 1 : 2);
        const int rbase = pm * 256 + wr * 64 + fr, col0 = u.pn * 256 + wc * 32 + 4 * fq;
        const float* g = gate + v * 6144 + col0;
        f32x4 gv[2][2];
#pragma unroll
        for (int bj = 0; bj < 2; ++bj)
#pragma unroll
            for (int n = 0; n < 2; ++n) gv[bj][n] = *(const f32x4*)(g + bj * 128 + 16 * n);
#pragma unroll
        for (int ai = 0; ai < 2; ++ai)
#pragma unroll
            for (int m = 0; m < 4; ++m) {
                float* rowp = X + (size_t)(rbase + ai * 128 + m * 16) * DM + col0;
#pragma unroll
                for (int bj = 0; bj < 2; ++bj)
#pragma unroll
                    for (int n = 0; n < 2; ++n) {
                        f32x4* p = (f32x4*)(rowp + bj * 128 + 16 * n);
                        *p = *p + gv[bj][n] * acc[ai][bj][m][n];
                    }
            }
    }
};

struct EpiSwiglu {
    static constexpr bool PERM = true, AFTER_DRAIN = false;
    bf16* O;
    __device__ __forceinline__ void operator()(const Acc& acc, const Unit& u, int wr, int wc, int fr, int fq) const {
        const int rbase = u.pm * 256 + wr * 64 + fr, col0 = u.pn * 128 + wc * 32 + 8 * fq;
#pragma unroll
        for (int ai = 0; ai < 2; ++ai)
#pragma unroll
            for (int m = 0; m < 4; ++m) {
                f32x4 r[2];
#pragma unroll
                for (int n = 0; n < 2; ++n) {
                    const f32x4 a = acc[ai][0][m][n], uu = acc[ai][1][m][n];
#pragma unroll
                    for (int e = 0; e < 4; ++e) r[n][e] = a[e] * sigmoidf_(a[e]) * uu[e];
                }
                u32x4 w; w.x = cvt_pk_bf16(r[0][0], r[0][1]); w.y = cvt_pk_bf16(r[0][2], r[0][3]); w.z = cvt_pk_bf16(r[1][0], r[1][1]); w.w = cvt_pk_bf16(r[1][2], r[1][3]);
                *(u32x4*)(O + (size_t)(rbase + ai * 128 + m * 16) * FF + col0) = w;
            }
    }
};

namespace att {
__device__ __forceinline__ int crow(int r, int hi) { return (r & 3) + 8 * (r >> 2) + 4 * hi; }
__device__ __forceinline__ void glds16(const void* gsrc, unsigned lds_dst) { unsigned keep;
    asm volatile("s_mov_b32 %0, m0\n\ts_mov_b32 m0, %2\n\ts_nop 0\n\tglobal_load_lds_dwordx4 %1, off\n\ts_mov_b32 m0, %0" : "=&s"(keep) : "v"(gsrc), "s"(lds_dst) : "memory"); }
typedef float f32x2_t __attribute__((ext_vector_type(2))); typedef __bf16 bf16x2_t __attribute__((ext_vector_type(2)));
__device__ __forceinline__ unsigned cvtpk_s(float lo, float hi) { f32x2_t v = {lo, hi}; bf16x2_t b = __builtin_convertvector(v, bf16x2_t); return __builtin_bit_cast(unsigned, b); }
__device__ __forceinline__ void qkt(f32x16& p0, f32x16& p1, const char* Kslot, const bf16x8* qr, int r32, int hi) {
    const char* kb = Kslot + hi * 1024 + r32 * 16; const f32x16 z = f32x16{};
#pragma unroll
    for (int d0 = 0; d0 < 4; ++d0) {
        const bf16x8 b0 = *reinterpret_cast<const bf16x8*>(kb + d0 * 2048);
        const bf16x8 b1 = *reinterpret_cast<const bf16x8*>(kb + d0 * 2048 + 512);
        if (d0 == 0) { p0 = __builtin_amdgcn_mfma_f32_32x32x16_bf16(b0, qr[0], z, 0, 0, 0); p1 = __builtin_amdgcn_mfma_f32_32x32x16_bf16(b1, qr[0], z, 0, 0, 0); }
        else { p0 = __builtin_amdgcn_mfma_f32_32x32x16_bf16(b0, qr[d0], p0, 0, 0, 0); p1 = __builtin_amdgcn_mfma_f32_32x32x16_bf16(b1, qr[d0], p1, 0, 0, 0); } }
}
__device__ __forceinline__ void pv(f32x16* o, int vb, bf16x8 pa0, bf16x8 pa1, bf16x8 pa2, bf16x8 pa3) {
#pragma unroll
    for (int d0 = 0; d0 < 2; ++d0) { s16x4 lo[4], hi[4];
#pragma unroll
        for (int ks = 0; ks < 4; ++ks) {
            asm volatile("ds_read_b64_tr_b16 %0,%1 offset:%c2" : "=&v"(lo[ks]) : "v"(vb), "i"(d0 * 4096 + ks * 1024) : "memory");
            asm volatile("ds_read_b64_tr_b16 %0,%1 offset:%c2" : "=&v"(hi[ks]) : "v"(vb), "i"(d0 * 4096 + ks * 1024 + 512) : "memory"); }
        asm volatile("s_waitcnt lgkmcnt(0)" ::: "memory"); __builtin_amdgcn_sched_barrier(0);
#define PK(k) (bf16x8){lo[k][0], lo[k][1], lo[k][2], lo[k][3], hi[k][0], hi[k][1], hi[k][2], hi[k][3]}
        o[d0] = __builtin_amdgcn_mfma_f32_32x32x16_bf16(pa0, PK(0), o[d0], 0, 0, 0);
        o[d0] = __builtin_amdgcn_mfma_f32_32x32x16_bf16(pa1, PK(1), o[d0], 0, 0, 0);
        o[d0] = __builtin_amdgcn_mfma_f32_32x32x16_bf16(pa2, PK(2), o[d0], 0, 0, 0);
        o[d0] = __builtin_amdgcn_mfma_f32_32x32x16_bf16(pa3, PK(3), o[d0], 0, 0, 0);
#undef PK
    }
}
__device__ __forceinline__ float rowmax(const f32x16& p0, const f32x16& p1) {
    float a = fmaxf(p0[0], p1[0]);
#pragma unroll
    for (int r = 1; r < 16; ++r) a = fmaxf(a, fmaxf(p0[r], p1[r]));
    auto rr = __builtin_amdgcn_permlane32_swap(__float_as_uint(a), __float_as_uint(a), false, false);
    return fmaxf(__uint_as_float(rr[0]), __uint_as_float(rr[1]));
}
#define WAIT_BAR0() asm volatile("s_waitcnt vmcnt(0) lgkmcnt(0)\n\ts_barrier" ::: "memory")

__device__ __forceinline__ void unit(const bf16* Qp, const bf16* Kp, const bf16* Vp, int KP, bf16* Op, int kr0, int nwin, int nt, bool na, int qgr0, const float* rpb_h, char* shm) {
    int tid_ = threadIdx.x; asm volatile("" : "+v"(tid_));
    const int tid = tid_, lane = tid & 63, r32 = lane & 31, hi = lane >> 5; const int wid = __builtin_amdgcn_readfirstlane(tid >> 6);
    const unsigned lds0 = (unsigned)(uintptr_t)shm;
    float* wsf = (float*)(shm + A_WS) + wid * 64;
    float* rpbL = (float*)(shm + A_RPB);
    if (na) { for (int i = tid; i < 465; i += NTHREADS) rpbL[i] = rpb_h[i] * LOG2E; }
    const bf16* Qw = Qp + (size_t)(wid * 32) * 512;
    bf16x8 qr[4];
#pragma unroll
    for (int d0 = 0; d0 < 4; ++d0) qr[d0] = *reinterpret_cast<const bf16x8*>(&Qw[(size_t)r32 * 512 + d0 * 16 + hi * 8]);
    const bf16* ksrc = Kp + (size_t)lane * KP + wid * 8;
    const bf16* vsrc = Vp + (size_t)(16 * (wid & 3) + (lane >> 2)) * KP + (wid >> 2) * 32 + (lane & 3) * 8;
    const unsigned kdst = lds0 + A_K + wid * 1024, vdst = lds0 + A_V + wid * 1024;
    const int vb0 = (int)(lds0 + A_V) + ((lane >> 4) & 1) * 32 + (lane & 3) * 8 + (4 * hi + ((lane & 15) >> 2)) * 64;
#define KROW(t) ((t) < nwin ? (kr0 + (t)) * 64 : 8192 + ((t) - nwin) * 64)
    float mrun = -1e30f, lrun = 0.f; f32x16 o[2]; o[0] = f32x16{}; o[1] = f32x16{};
    const int qgr = qgr0 + (wid >> 1), qc = (wid & 1) * 32 + r32;
    const int rs = min(max(qgr - 4, 0), 120), cs = min(max(qc - 8, 0), 48);
    { const size_t r = (size_t)KROW(0) * KP; glds16(ksrc + r, (unsigned)__builtin_amdgcn_readfirstlane(kdst)); glds16(vsrc + r, (unsigned)__builtin_amdgcn_readfirstlane(vdst)); }
    for (int t = 0; t < nt; ++t) {
        const int slot = (t & 1) * 8192;
        WAIT_BAR0();
        if (t + 1 < nt) { const size_t r = (size_t)KROW(t + 1) * KP; const int ns = ((t + 1) & 1) * 8192;
            glds16(ksrc + r, (unsigned)__builtin_amdgcn_readfirstlane(kdst + ns)); glds16(vsrc + r, (unsigned)__builtin_amdgcn_readfirstlane(vdst + ns)); }
        const bool win = na && (t < nwin);
        const int kr = kr0 + t;
        if (win && (kr < rs || kr >= rs + 8)) continue;
        f32x16 p0, p1;
        qkt(p0, p1, shm + A_K + slot, qr, r32, hi);
        if (win) {
            const int brow = (kr - qgr + 7) * 31 + 15 - qc;
#pragma unroll
            for (int r = 0; r < 16; ++r) {
                const int kc = crow(r, hi);
                { const bool ok = (kc >= cs) && (kc < cs + 16); const int idx = min(max(brow + kc, 0), 464); const float bv = rpbL[idx]; p0[r] = ok ? p0[r] + bv : -INFINITY; }
                { const int kc2 = kc + 32; const bool ok = (kc2 >= cs) && (kc2 < cs + 16); const int idx = min(max(brow + kc2, 0), 464); const float bv = rpbL[idx]; p1[r] = ok ? p1[r] + bv : -INFINITY; }
            }
        }
        const float rm = rowmax(p0, p1);
        const float mnew = fmaxf(mrun, rm);
        const float alpha = __builtin_amdgcn_exp2f(mrun - mnew);
        mrun = mnew;
        float ls = 0.f;
#pragma unroll
        for (int r = 0; r < 16; ++r) { p0[r] = __builtin_amdgcn_exp2f(p0[r] - mnew); p1[r] = __builtin_amdgcn_exp2f(p1[r] - mnew); ls += p0[r] + p1[r]; }
        lrun = lrun * alpha + ls;
        if (__any(alpha < 1.0f)) {
            if (hi == 0) wsf[r32] = alpha;
            asm volatile("s_waitcnt lgkmcnt(0)" ::: "memory");
#pragma unroll
            for (int d = 0; d < 2; ++d)
#pragma unroll
                for (int r = 0; r < 16; ++r) o[d][r] *= wsf[crow(r, hi)];
        }
        u32x4 pw0, pw1, pw2, pw3;
        pw0 = (u32x4){cvtpk_s(p0[0], p0[1]), cvtpk_s(p0[2], p0[3]), cvtpk_s(p0[4], p0[5]), cvtpk_s(p0[6], p0[7])};
        pw1 = (u32x4){cvtpk_s(p0[8], p0[9]), cvtpk_s(p0[10], p0[11]), cvtpk_s(p0[12], p0[13]), cvtpk_s(p0[14], p0[15])};
        pw2 = (u32x4){cvtpk_s(p1[0], p1[1]), cvtpk_s(p1[2], p1[3]), cvtpk_s(p1[4], p1[5]), cvtpk_s(p1[6], p1[7])};
        pw3 = (u32x4){cvtpk_s(p1[8], p1[9]), cvtpk_s(p1[10], p1[11]), cvtpk_s(p1[12], p1[13]), cvtpk_s(p1[14], p1[15])};
        pv(o, vb0 + slot, __builtin_bit_cast(bf16x8, pw0), __builtin_bit_cast(bf16x8, pw1), __builtin_bit_cast(bf16x8, pw2), __builtin_bit_cast(bf16x8, pw3));
    }
#undef KROW
    { auto rr = __builtin_amdgcn_permlane32_swap(__float_as_uint(lrun), __float_as_uint(lrun), false, false); lrun = __uint_as_float(rr[0]) + __uint_as_float(rr[1]); }
    if (hi == 0) wsf[32 + r32] = lrun;
    asm volatile("s_waitcnt lgkmcnt(0)" ::: "memory");
    float rli[16];
#pragma unroll
    for (int r = 0; r < 16; ++r) rli[r] = __builtin_amdgcn_rcpf(wsf[32 + crow(r, hi)]);
    bf16* Ow = Op + (size_t)(wid * 32) * 512;
    { bf16* stg = (bf16*)(shm + A_OST) + wid * 2048;
#pragma unroll
        for (int r = 0; r < 16; ++r) { const int orow = crow(r, hi);
#pragma unroll
            for (int d0 = 0; d0 < 2; ++d0) stg[orow * 64 + d0 * 32 + r32] = (bf16)f2bf(o[d0][r] * rli[r]); }
        asm volatile("s_waitcnt lgkmcnt(0)" ::: "memory");
#pragma unroll
        for (int i = 0; i < 4; ++i) { const int row = i * 8 + (lane >> 3), ch = lane & 7; const u32x4 v = *(const u32x4*)(stg + row * 64 + ch * 8); *(u32x4*)(Ow + (size_t)row * 512 + ch * 8) = v; } }
    asm volatile("s_waitcnt vmcnt(0) lgkmcnt(0)\n\ts_barrier" ::: "memory");
}
}

template <int MAP>
__device__ __forceinline__ void transpose_item(const float* W, int N, bf16* WT, int ldk, int koff, LAS float* scr, int item, int lane) {
    const int nblk = N / 32, kb = item / nblk, nb = item % nblk, k0 = 64 * kb, n0 = 32 * nb;
#pragma unroll 8
    for (int i = 0; i < 32; ++i) { const int kk = 2 * i + (lane >> 5); scr[kk * 33 + (lane & 31)] = W[(size_t)(k0 + kk) * N + n0 + (lane & 31)]; }
    asm volatile("s_waitcnt lgkmcnt(0)" ::: "memory");
    int r0 = n0;
    if (MAP == 1) { if (n0 >= 1536 && n0 < 2304) { const int tile = n0 >> 8, within = n0 & 255, hw = within >> 6, bj = (within & 63) >> 5; r0 = tile * 256 + 128 * bj + 32 * hw; } }
    if (MAP == 2) { if (n0 < FF) { r0 = (n0 >> 7) * 256 + (n0 & 127); } else { const int n1 = n0 - FF; r0 = (n1 >> 7) * 256 + 128 + (n1 & 127); } }
    const int c = lane & 7;
#pragma unroll
    for (int j = 0; j < 4; ++j) { const int n = (lane >> 3) + 8 * j; const LAS float* s = scr + (8 * c) * 33 + n;
        u32x4 o; o.x = pk2(s[0 * 33], s[1 * 33]); o.y = pk2(s[2 * 33], s[3 * 33]); o.z = pk2(s[4 * 33], s[5 * 33]); o.w = pk2(s[6 * 33], s[7 * 33]);
        *(u32x4*)(WT + (size_t)(r0 + n) * ldk + koff + k0 + 8 * c) = o; }
    asm volatile("s_waitcnt lgkmcnt(0)" ::: "memory");
}

struct Params {
    const float *x, *c, *ctx, *c_ctx, *w_mod, *b_mod, *norm1, *w_in, *na_rpb, *q_gain, *k_gain, *w_pa, *w_pb, *w_o, *norm2, *w_ffn_in, *w_ffn_out, *final_norm;
    float* out; unsigned char* ws;
};

__device__ __forceinline__ void phase_wconv(const Params& P, int l, unsigned char* ws, LAS unsigned char* lds, int gw, int NGW, int wave, int lane) {
    LAS float* scr = (LAS float*)(lds + wave * 16384);
    constexpr int I_IN = (DM / 64) * (INC / 32), I_PA = (512 / 64) * (DM / 32), I_O = (DM / 64) * (DM / 32), I_FI = (DM / 64) * (FF2 / 32), I_FO = (FF / 64) * (DM / 32);
    constexpr int NITEMS = I_IN + 2 * I_PA + I_O + I_FI + I_FO;
    for (int it = gw; it < NITEMS; it += NGW) {
        int r = it;
        if (r < I_IN) { transpose_item<1>(P.w_in + (size_t)l * DM * INC, INC, (bf16*)(ws + WS_WIN), DM, 0, scr, r, lane); continue; } r -= I_IN;
        if (r < I_PA) { transpose_item<0>(P.w_pa + (size_t)l * 512 * DM, DM, (bf16*)(ws + WS_WPA), 512, 0, scr, r, lane); continue; } r -= I_PA;
        if (r < I_PA) { transpose_item<0>(P.w_pb + (size_t)l * 512 * DM, DM, (bf16*)(ws + WS_WPB), 512, 0, scr, r, lane); continue; } r -= I_PA;
        if (r < I_O) { transpose_item<0>(P.w_o + (size_t)l * DM * DM, DM, (bf16*)(ws + WS_WO), DM, 0, scr, r, lane); continue; } r -= I_O;
        if (r < I_FI) { transpose_item<2>(P.w_ffn_in + (size_t)l * DM * FF2, FF2, (bf16*)(ws + WS_WFI), DM, 0, scr, r, lane); continue; } r -= I_FI;
        transpose_item<0>(P.w_ffn_out + (size_t)l * FF * DM, DM, (bf16*)(ws + WS_WFO), FF, 0, scr, r, lane);
    }
}

__device__ __forceinline__ void norm_row(const float* xrow, float* xcopy, const float* gamma, const float* sh, const float* sc, bf16* hrow, int lane) {
    const f32x4* xr = (const f32x4*)xrow + lane;
    f32x4 v[4]; float s = 0.f;
#pragma unroll
    for (int j = 0; j < 4; ++j) { v[j] = xr[64 * j]; s += (v[j].x * v[j].x + v[j].y * v[j].y) + (v[j].z * v[j].z + v[j].w * v[j].w); }
    const float r = rsqrtf(wave_sum(s) * (1.0f / DM) + EPS);
    if (xcopy) {
#pragma unroll
        for (int j = 0; j < 4; ++j) ((f32x4*)xcopy + lane)[64 * j] = v[j];
    }
    unsigned long long* o8 = (unsigned long long*)hrow + lane;
#pragma unroll
    for (int j = 0; j < 4; ++j) {
        const f32x4 g = ((const f32x4*)gamma + lane)[64 * j], a = ((const f32x4*)sc + lane)[64 * j], b = ((const f32x4*)sh + lane)[64 * j];
        const f32x4 y = (v[j] * r) * g * (a + 1.0f) + b;
        o8[64 * j] = (unsigned long long)pk2(y.x, y.y) | ((unsigned long long)pk2(y.z, y.w) << 32);
    }
}

#define XB_TMO      128
#define XB_XCNT(j)  (256  + 64 * (j))
#define XB_XSUB(j)  (1280 + 64 * (j))
#define XB_XGEN(j)  (2304 + 64 * (j))
#define XB_TOP      3328
#define XB_TOPGEN   3392
#define XCD_BAR_WORDS 3456
#define XB_SPIN_CAP (1u << 18)

__device__ __forceinline__ unsigned xb_ld(unsigned* p)              { return __hip_atomic_load(p, __ATOMIC_RELAXED, __HIP_MEMORY_SCOPE_AGENT); }
__device__ __forceinline__ unsigned xb_add(unsigned* p, unsigned v) { return __hip_atomic_fetch_add(p, v, __ATOMIC_RELAXED, __HIP_MEMORY_SCOPE_AGENT); }
__device__ __forceinline__ unsigned xb_xcc_id() { return (unsigned)__builtin_amdgcn_s_getreg((3 << 11) | 20) & 0xFu; }
#define XB_SPIN(cond, bar) do { unsigned _sp = 0; while (cond) { __builtin_amdgcn_s_sleep(1); \
    if ((++_sp & 255u) == 0u) { if (xb_ld(&(bar)[XB_TMO])) break; if (_sp > XB_SPIN_CAP) { atomicAdd(&(bar)[XB_TMO], 1u); break; } } } } while (0)

struct XcdBarrier {
    unsigned* bar; unsigned x;
    volatile LAS unsigned* st;
};

__device__ __forceinline__ XcdBarrier xcd_barrier_post(unsigned* bar, volatile LAS unsigned* st) {
    XcdBarrier b; b.bar = bar; b.x = xb_xcc_id(); b.st = st;
    if (threadIdx.x == 0) (void)xb_add(&bar[XB_XCNT(b.x)], 1u);
    return b;
}
__device__ __forceinline__ void xcd_barrier_complete(unsigned* bar, unsigned x, unsigned& nloc, unsigned& nx) {
    const unsigned G = gridDim.x * gridDim.y * gridDim.z;
    unsigned sum, cnt, mine, sp = 0u;
    for (;;) {
        sum = 0u; cnt = 0u; mine = 0u;
#pragma unroll
        for (unsigned j = 0; j < 16; ++j) { const unsigned c = xb_ld(&bar[XB_XCNT(j)]); sum += c; cnt += (c > 0u) ? 1u : 0u; mine = (j == x) ? c : mine; }
        if (sum == G) break;
        __builtin_amdgcn_s_sleep(1);
        if ((++sp & 255u) == 0u) { if (xb_ld(&bar[XB_TMO])) break; if (sp > XB_SPIN_CAP) { atomicAdd(&bar[XB_TMO], 1u); break; } }
    }
    nloc = mine > 0u ? mine : 1u; nx = cnt > 0u ? cnt : 1u;
}

__device__ __forceinline__ void xcd_barrier(const XcdBarrier& b) {
    asm volatile("s_waitcnt vmcnt(0)" ::: "memory");
    __syncthreads();
    if (threadIdx.x == 0) {
        unsigned* bar = b.bar;
        __builtin_amdgcn_s_waitcnt(0);
        unsigned nloc = b.st[0], nx = b.st[1];
        if (nloc == 0u) { xcd_barrier_complete(bar, b.x, nloc, nx); b.st[0] = nloc; b.st[1] = nx; }
        const unsigned old = xb_add(&bar[XB_XSUB(b.x)], 1u);
        const unsigned gen = old / nloc;
        if (old + 1u == (gen + 1u) * nloc) {
            __builtin_amdgcn_fence(__ATOMIC_RELEASE, "agent");
            asm volatile("s_waitcnt vmcnt(0)" ::: "memory");
            const unsigned og = xb_add(&bar[XB_TOP], 1u);
            const unsigned tg = og / nx;
            if (og + 1u == (tg + 1u) * nx) xb_add(&bar[XB_TOPGEN], 1u);
            else XB_SPIN(xb_ld(&bar[XB_TOPGEN]) == tg, bar);
            __builtin_amdgcn_fence(__ATOMIC_ACQUIRE, "agent");
            xb_add(&bar[XB_XGEN(b.x)], 1u);
            asm volatile("s_waitcnt vmcnt(0)" ::: "memory");
        } else {
            XB_SPIN(xb_ld(&bar[XB_XGEN(b.x)]) == gen, bar);
            __builtin_amdgcn_fence(__ATOMIC_ACQUIRE, "agent");
            asm volatile("s_waitcnt vmcnt(0)" ::: "memory");
        }
    }
    __syncthreads();
}

__global__ void __launch_bounds__(NTHREADS, 2) mega_fwd(Params P) {
    extern __shared__ __attribute__((aligned(16))) unsigned char lds[];
    cg::grid_group grid = cg::this_grid();
    LAS unsigned char* ldsl = (LAS unsigned char*)lds;
    const int tid = threadIdx.x, lane = tid & 63, wave = __builtin_amdgcn_readfirstlane(tid >> 6);
    const int G = gridDim.x, bx = blockIdx.x;
    const int vcu = (G % 8 == 0) ? (bx % 8) * (G / 8) + bx / 8 : bx;
    const int gw = vcu * NWAVES + wave, NGW = G * NWAVES;
    unsigned char* ws = P.ws;
    volatile LAS unsigned* MISC = (volatile LAS unsigned*)(ldsl + RING_BYTES);
    if (tid < 64) MISC[tid] = 0u;
    __syncthreads();
    const XcdBarrier xbar = xcd_barrier_post((unsigned*)ws, MISC + 8);
#define GRID_BAR() xcd_barrier(xbar)
    float* MODS = (float*)(ws + WS_MODS);
    float* X = (float*)(ws + WS_X);
    bf16* H = (bf16*)(ws + WS_H);
    bf16 *NAQ = (bf16*)(ws + WS_NAQ), *NAK = (bf16*)(ws + WS_NAK), *NAV = (bf16*)(ws + WS_NAV), *GQ = (bf16*)(ws + WS_GQ), *GK = (bf16*)(ws + WS_GK), *GV = (bf16*)(ws + WS_GV);
    bf16 *SA = (bf16*)(ws + WS_SA), *SB = (bf16*)(ws + WS_SB), *YA = (bf16*)(ws + WS_YA), *YB = (bf16*)(ws + WS_YB), *ACT = (bf16*)(ws + WS_ACT);

    {
        float* sl = (float*)lds;
        f32x4* red = (f32x4*)(lds + 16384);
        for (int i = tid; i < 3072; i += NTHREADS) { const int v = i >> 10, k = i & 1023; const float xv = v < 2 ? P.c[v * 1024 + k] : P.c_ctx[k]; sl[i] = xv * sigmoidf_(xv); }
        __syncthreads();
        const int cgi = tid & 31, kc = tid >> 5;
        for (int item = bx; item < 192; item += G) {
            const int l = item / 48, jb = (item % 48) * 128;
            const float* w = P.w_mod + (size_t)l * DM * 6144 + jb + cgi * 4;
            f32x4 a0 = {0.f, 0.f, 0.f, 0.f}, a1 = a0, a2 = a0;
#pragma unroll 8
            for (int kk = 0; kk < 64; ++kk) { const int k = kc * 64 + kk; const f32x4 wv = *(const f32x4*)(w + (size_t)k * 6144);
                a0 = a0 + wv * sl[k]; a1 = a1 + wv * sl[1024 + k]; a2 = a2 + wv * sl[2048 + k]; }
            red[(kc * 3 + 0) * 32 + cgi] = a0; red[(kc * 3 + 1) * 32 + cgi] = a1; red[(kc * 3 + 2) * 32 + cgi] = a2;
            __syncthreads();
            if (tid < 384) { const int v = tid >> 7, cc = tid & 127; float s = 0.f;
#pragma unroll
                for (int q = 0; q < 16; ++q) s += ((const float*)&red[(q * 3 + v) * 32 + (cc >> 2)])[cc & 3];
                MODS[(size_t)(l * 3 + v) * 6144 + jb + cc] = s + P.b_mod[l * 6144 + jb + cc]; }
            __syncthreads();
        }
        __syncthreads();
        phase_wconv(P, 0, ws, ldsl, gw, NGW, wave, launder(lane));
    }
    grid.sync();

    for (int l = 0; l < DEPTH; ++l) {
        const bool last = (l == DEPTH - 1);
        const float* mods = MODS + (size_t)l * 3 * 6144;
        const int MG = last ? NL : MT;
        if (l > 0) phase_wconv(P, l, ws, ldsl, gw, NGW, wave, launder(lane));
        { const int ln = launder(lane);
        for (int row = gw; row < MT; row += NGW) {
            const int v = row < NL ? (row >> 13) : 2;
            const float* xr = (l == 0) ? (row < NL ? P.x + (size_t)row * DM : P.ctx + (size_t)(row - NL) * DM) : X + (size_t)row * DM;
            norm_row(xr, l == 0 ? X + (size_t)row * DM : nullptr, P.norm1 + l * DM, mods + v * 6144 + 0, mods + v * 6144 + 1024, H + (size_t)row * DM, ln);
        } }
        GRID_BAR();
        {
            pg8::Gemm g{H, (const bf16*)(ws + WS_WIN), MT, INC, DM}; pg8::StaticOrder S; S.init(MT, INC, G, bx);
            EpiIn E{NAQ, NAK, NAV, GQ, GK, GV, SA, SB, P.q_gain + l * 64, P.k_gain + l * 64};
            pg8::gemm_phase<EpiIn, pg8::StaticOrder, true, true>(ldsl, g, S, E);
        }
        GRID_BAR();
        {
            char* shm = (char*)lds;
            const int total = last ? 1024 : 1056;
            for (int idx = vcu; idx < total; idx += G) {
                const bf16 *Qp, *Kp, *Vp; bf16* Op; int KP, kr0 = 0, nwin = 0, nt = 4, qgr0 = 0; bool na = false; const float* rpbh = P.na_rpb;
                if (idx < 512) {
                    const int b = idx >> 8, hq = (idx >> 5) & 7, qb = idx & 31, kvh = hq >> 2;
                    Qp = GQ + (size_t)(b * SEQ + qb * 256) * 512 + hq * 64; Kp = GK + (size_t)(b * 8448) * 128 + kvh * 64; Vp = GV + (size_t)(b * 8448) * 128 + kvh * 64; KP = 128;
                    Op = YB + (size_t)(b * SEQ + qb * 256) * 512 + hq * 64; nwin = 128; nt = 132;
                } else if (idx < 1024) {
                    const int un = idx - 512, b = un >> 8, h = (un >> 5) & 7, R = un & 31;
                    kr0 = min(max(4 * R - 4, 0), 120); const int kr1 = min(max(4 * R - 1, 0), 120) + 7; nwin = kr1 - kr0 + 1; nt = nwin + 4; na = true; qgr0 = 4 * R;
                    Qp = NAQ + (size_t)(b * SEQ + R * 256) * 512 + h * 64; Kp = NAK + (size_t)(b * 8448) * 512 + h * 64; Vp = NAV + (size_t)(b * 8448) * 512 + h * 64; KP = 512;
                    Op = YA + (size_t)(b * SEQ + R * 256) * 512 + h * 64; rpbh = P.na_rpb + (size_t)(l * 8 + h) * 465;
                } else {
                    const int uc = idx - 1024, b = (uc >> 3) & 1, h = uc & 7;
                    if (uc < 16) { Qp = NAQ + (size_t)(NL + b * 256) * 512 + h * 64; Kp = NAK + (size_t)(b * 8448) * 512 + h * 64; Vp = NAV + (size_t)(b * 8448) * 512 + h * 64; KP = 512;
                        Op = YA + (size_t)(NL + b * 256) * 512 + h * 64; }
                    else { Qp = GQ + (size_t)(NL + b * 256) * 512 + h * 64; Kp = GK + (size_t)(b * 8448) * 128 + (h >> 2) * 64; Vp = GV + (size_t)(b * 8448) * 128 + (h >> 2) * 64; KP = 128;
                        Op = YB + (size_t)(NL + b * 256) * 512 + h * 64; }
                }
                if (idx < 512) attn_body::attn_unit<8>((const attn_body::bf16*)Qp, (const attn_body::bf16*)Kp, (const attn_body::bf16*)Vp, (attn_body::bf16*)Op, 132, shm);
                else att::unit(Qp, Kp, Vp, KP, Op, kr0, nwin, nt, na, qgr0, rpbh, shm);
            }
        }
        GRID_BAR();
        for (int pass = 0; pass < 2; ++pass) {
            pg8::Gemm g{pass ? YB : YA, (const bf16*)(ws + (pass ? WS_WPB : WS_WPA)), MG, DM, 512}; pg8::StaticOrder S; S.init(MG, DM, G, bx);
            EpiMerge E{pass ? SB : SA, H, pass};
            pg8::gemm_phase<EpiMerge, pg8::StaticOrder, true, true>(ldsl, g, S, E);
        }
        GRID_BAR();
        {
            pg8::Gemm g{H, (const bf16*)(ws + WS_WO), MG, DM, DM}; pg8::StaticOrder S; S.init(MG, DM, G, bx);
            EpiRes E{X, mods + 2048};
            pg8::gemm_phase<EpiRes, pg8::StaticOrder, true, true>(ldsl, g, S, E);
        }
        GRID_BAR();
        { const int ln = launder(lane);
        for (int row = gw; row < MG; row += NGW) {
            const int v = row < NL ? (row >> 13) : 2;
            norm_row(X + (size_t)row * DM, nullptr, P.norm2 + l * DM, mods + v * 6144 + 3072, mods + v * 6144 + 4096, H + (size_t)row * DM, ln);
        } }
        GRID_BAR();
        {
            pg8::Gemm g{H, (const bf16*)(ws + WS_WFI), MG, FF2, DM}; pg8::StaticOrder S; S.init(MG, FF2, G, bx);
            EpiSwiglu E{ACT};
            pg8::gemm_phase<EpiSwiglu, pg8::StaticOrder, true, true>(ldsl, g, S, E);
        }
        GRID_BAR();
        {
            pg8::Gemm g{ACT, (const bf16*)(ws + WS_WFO), MG, DM, FF}; pg8::StaticOrder S; S.init(MG, DM, G, bx);
            EpiRes E{X, mods + 5120};
            pg8::gemm_phase<EpiRes, pg8::StaticOrder, true, true>(ldsl, g, S, E);
        }
        GRID_BAR();
    }
    for (int row = gw; row < NL; row += NGW) {
        const f32x4* xr = (const f32x4*)(X + (size_t)row * DM) + lane;
        f32x4 v[4]; float s = 0.f;
#pragma unroll
        for (int j = 0; j < 4; ++j) { v[j] = xr[64 * j]; s += (v[j].x * v[j].x + v[j].y * v[j].y) + (v[j].z * v[j].z + v[j].w * v[j].w); }
        const float r = rsqrtf(wave_sum(s) * (1.0f / DM) + EPS);
        f32x4* o = (f32x4*)(P.out + (size_t)row * DM) + lane;
#pragma unroll
        for (int j = 0; j < 4; ++j) o[64 * j] = (v[j] * r) * ((const f32x4*)P.final_norm + lane)[64 * j];
    }
}

extern "C" void kernel_launch(void* const* d_in, const int* in_sizes, int n_in, void* d_out, int out_size, void* d_ws, size_t ws_size, hipStream_t stream) {
    static int grid = 0;
    if (grid == 0) {
        if (n_in != 18 || ws_size < WS_END) { fprintf(stderr, "kernel_launch: need 18 inputs and >= %zu bytes of workspace; got n_in %d ws %zu\n", (size_t)WS_END, n_in, ws_size); grid = -1; return; }
        int dev = 0, cus = 0, per_cu = 0;
        hipGetDevice(&dev);
        hipDeviceGetAttribute(&cus, hipDeviceAttributeMultiprocessorCount, dev);
        if (hipFuncSetAttribute((const void*)mega_fwd, hipFuncAttributeMaxDynamicSharedMemorySize, LDS_BYTES) != hipSuccess) { fprintf(stderr, "kernel_launch: hipFuncSetAttribute failed\n"); grid = -1; return; }
        if (hipOccupancyMaxActiveBlocksPerMultiprocessor(&per_cu, (const void*)mega_fwd, NTHREADS, LDS_BYTES) != hipSuccess || per_cu < 1) { fprintf(stderr, "kernel_launch: occupancy query says %d\n", per_cu); per_cu = 1; }
        (void)hipGetLastError();
        grid = cus * (per_cu > 1 ? 1 : per_cu);
    }
    if (grid < 0) return;
    if (hipMemsetAsync(d_ws, 0, 16384, stream) != hipSuccess) { fprintf(stderr, "kernel_launch: hipMemsetAsync failed\n"); return; }
    Params p{};
    const float** pp = (const float**)&p;
    for (int i = 0; i < 18; ++i) pp[i] = (const float*)d_in[i];
    p.out = (float*)d_out; p.ws = (unsigned char*)d_ws;
    void* args[] = {&p};
    hipError_t e = hipLaunchCooperativeKernel((const void*)mega_fwd, dim3(grid), dim3(NTHREADS), args, LDS_BYTES, stream);
    if (e != hipSuccess) fprintf(stderr, "cooperative launch failed: %s (grid %d)\n", hipGetErrorString(e), grid);
}
```

```cpp
#include <hip/hip_runtime.h>
#include <hip/hip_cooperative_groups.h>
#include <cstdio>
#include <cstdint>
#include <hip/hip_bf16.h>
#include <cmath>
namespace cg = cooperative_groups;
__device__ const float ROPE_TAB[128*16*2] = {
1.000000000e+00f, 0.000000000e+00f, 1.000000000e+00f, 0.000000000e+00f, 1.000000000e+00f, 0.000000000e+00f, 1.000000000e+00f, 0.000000000e+00f, 1.000000000e+00f, 0.000000000e+00f, 1.000000000e+00f, 0.000000000e+00f, 1.000000000e+00f, 0.000000000e+00f, 1.000000000e+00f, 0.000000000e+00f, 1.000000000e+00f, 0.000000000e+00f, 1.000000000e+00f, 0.000000000e+00f, 1.000000000e+00f, 0.000000000e+00f, 1.000000000e+00f, 0.000000000e+00f, 1.000000000e+00f, 0.000000000e+00f, 1.000000000e+00f, 0.000000000e+00f, 1.000000000e+00f, 0.000000000e+00f, 1.000000000e+00f, 0.000000000e+00f,
5.403022766e-01f, 8.414710164e-01f, 8.460091352e-01f, 5.331684351e-01f, 9.504152536e-01f, 3.109835982e-01f, 9.842302203e-01f, 1.768921912e-01f, 9.950041771e-01f, 9.983342141e-02f, 9.984192848e-01f, 5.620449781e-02f, 9.995000362e-01f, 3.161750361e-02f, 9.998418689e-01f, 1.778185740e-02f, 9.999499917e-01f, 9.999833070e-03f, 9.999842048e-01f, 5.623383448e-03f, 9.999949932e-01f, 3.162272274e-03f, 9.999983907e-01f, 1.778278500e-03f, 9.999995232e-01f, 9.999999311e-04f, 9.999998212e-01f, 5.623412435e-04f, 9.999999404e-01f, 3.162277571e-04f, 1.000000000e+00f, 1.778279402e-04f,
-4.161468148e-01f, 9.092974067e-01f, 4.314628243e-01f, 9.021307230e-01f, 8.065783978e-01f, 5.911270976e-01f, 9.374182820e-01f, 3.482052684e-01f, 9.800665975e-01f, 1.986693293e-01f, 9.936820865e-01f, 1.122313142e-01f, 9.980006814e-01f, 6.320339441e-02f, 9.993675947e-01f, 3.555808961e-02f, 9.998000264e-01f, 1.999866590e-02f, 9.999367595e-01f, 1.124658901e-02f, 9.999799728e-01f, 6.324512884e-03f, 9.999936819e-01f, 3.556551412e-03f, 9.999979734e-01f, 1.999998698e-03f, 9.999993443e-01f, 1.124682371e-03f, 9.999998212e-01f, 6.324554561e-04f, 9.999999404e-01f, 3.556558804e-04f,
-9.899924994e-01f, 1.411200017e-01f, -1.159661636e-01f, 9.932531714e-01f, 5.827535987e-01f, 8.126488924e-01f, 8.610406518e-01f, 5.085361004e-01f, 9.553365111e-01f, 2.955202162e-01f, 9.858034849e-01f, 1.679033041e-01f, 9.955033660e-01f, 9.472608566e-02f, 9.985772967e-01f, 5.332308263e-02f, 9.995500445e-01f, 2.999549918e-02f, 9.998577237e-01f, 1.686943881e-02f, 9.999549985e-01f, 9.486690164e-03f, 9.999857545e-01f, 5.334813148e-03f, 9.999955297e-01f, 2.999995602e-03f, 9.999985695e-01f, 1.687023090e-03f, 9.999995232e-01f, 9.486831259e-04f, 9.999998808e-01f, 5.334838061e-04f,
-6.536436081e-01f, -7.568024993e-01f, -6.276797056e-01f, 7.784717083e-01f, 3.011374772e-01f, 9.535807371e-01f, 7.575061917e-01f, 6.528279781e-01f, 9.210609794e-01f, 3.894183338e-01f, 9.748082757e-01f, 2.230444849e-01f, 9.920106530e-01f, 1.261540651e-01f, 9.974712729e-01f, 7.107120752e-02f, 9.992001057e-01f, 3.998933360e-02f, 9.997470379e-01f, 2.249175683e-02f, 9.999200106e-01f, 1.264877338e-02f, 9.999747276e-01f, 7.113057654e-03f, 9.999920130e-01f, 3.999989480e-03f, 9.999974966e-01f, 2.249363344e-03f, 9.999992251e-01f, 1.264910679e-03f, 9.999997616e-01f, 7.113117026e-04f,
2.836621702e-01f, -9.589242935e-01f, -9.460792542e-01f, 3.239352703e-01f, -1.034233812e-02f, 9.999465346e-01f, 6.300802827e-01f, 7.765299678e-01f, 8.775825500e-01f, 4.794255495e-01f, 9.607312679e-01f, 2.774805427e-01f, 9.875259995e-01f, 1.574558765e-01f, 9.960497618e-01f, 8.879686147e-02f, 9.987502694e-01f, 4.997916520e-02f, 9.996047616e-01f, 2.811336145e-02f, 9.998750091e-01f, 1.581072807e-02f, 9.999604821e-01f, 8.891279809e-03f, 9.999874830e-01f, 4.999979399e-03f, 9.999960661e-01f, 2.811702900e-03f, 9.999987483e-01f, 1.581138116e-03f, 9.999995828e-01f, 8.891395992e-04f,
9.601702690e-01f, -2.794154882e-01f, -9.731037021e-01f, -2.303675264e-01f, -3.207963705e-01f, 9.471482038e-01f, 4.827820063e-01f, 8.757405281e-01f, 8.253356218e-01f, 5.646424890e-01f, 9.436169863e-01f, 3.310393095e-01f, 9.820539355e-01f, 1.886002719e-01f, 9.943132997e-01f, 1.064944416e-01f, 9.982005358e-01f, 5.996400490e-02f, 9.994308352e-01f, 3.373407945e-02f, 9.998199940e-01f, 1.897252724e-02f, 9.999430776e-01f, 1.066947449e-02f, 9.999819994e-01f, 5.999964196e-03f, 9.999943376e-01f, 3.374041524e-03f, 9.999982119e-01f, 1.897365320e-03f, 9.999994040e-01f, 1.066967379e-03f,
7.539022565e-01f, 6.569865942e-01f, -7.004297972e-01f, -7.137212753e-01f, -5.994374752e-01f, 8.004215956e-01f, 3.202570081e-01f, 9.473307133e-01f, 7.648422122e-01f, 6.442176700e-01f, 9.235194325e-01f, 3.835515678e-01f, 9.755998850e-01f, 2.195560932e-01f, 9.922624230e-01f, 1.241583377e-01f, 9.975510240e-01f, 6.994284689e-02f, 9.992253184e-01f, 3.935372457e-02f, 9.997550249e-01f, 2.213413455e-02f, 9.999225140e-01f, 1.244763471e-02f, 9.999755025e-01f, 6.999942940e-03f, 9.999922514e-01f, 3.936378751e-03f, 9.999975562e-01f, 2.213592408e-03f, 9.999992251e-01f, 1.244795276e-03f,
-1.455000341e-01f, 9.893582463e-01f, -2.120364457e-01f, -9.772617817e-01f, -8.186324239e-01f, 5.743178129e-01f, 1.476312131e-01f, 9.890424609e-01f, 6.967067122e-01f, 7.173560858e-01f, 9.005023241e-01f, 4.348512292e-01f, 9.681702852e-01f, 2.502923310e-01f, 9.898977876e-01f, 1.417829692e-01f, 9.968017340e-01f, 7.991468906e-02f, 9.989882708e-01f, 4.497213289e-02f, 9.996800423e-01f, 2.529552206e-02f, 9.998987913e-01f, 1.422575582e-02f, 9.999679923e-01f, 7.999914698e-03f, 9.999898672e-01f, 4.498715047e-03f, 9.999967813e-01f, 2.529819263e-03f, 9.999989867e-01f, 1.422623056e-03f,
-9.111302495e-01f, 4.121184647e-01f, 3.416602314e-01f, -9.398235083e-01f, -9.566441774e-01f, 2.912592292e-01f, -2.965079620e-02f, 9.995602965e-01f, 6.216099262e-01f, 7.833269238e-01f, 8.746382594e-01f, 4.847761393e-01f, 9.597726464e-01f, 2.807783186e-01f, 9.872201085e-01f, 1.593627781e-01f, 9.959527254e-01f, 8.987854421e-02f, 9.987195730e-01f, 5.058911815e-02f, 9.995950460e-01f, 2.845665626e-02f, 9.998719096e-01f, 1.600383036e-02f, 9.999595284e-01f, 8.999879472e-03f, 9.999871850e-01f, 5.061050411e-03f, 9.999959469e-01f, 2.846045885e-03f, 9.999987483e-01f, 1.600450720e-03f,
-8.390715122e-01f, -5.440210700e-01f, 7.901318669e-01f, -6.129369140e-01f, -9.997860789e-01f, -2.068356983e-02f, -2.059976310e-01f, 9.785524607e-01f, 5.403022766e-01f, 8.414710164e-01f, 8.460091352e-01f, 5.331684351e-01f, 9.504153132e-01f, 3.109835684e-01f, 9.842302203e-01f, 1.768921912e-01f, 9.950041771e-01f, 9.983341396e-02f, 9.984192848e-01f, 5.620449781e-02f, 9.995000362e-01f, 3.161750361e-02f, 9.998418689e-01f, 1.778185740e-02f, 9.999499917e-01f, 9.999834001e-03f, 9.999842048e-01f, 5.623383448e-03f, 9.999949932e-01f, 3.162272274e-03f, 9.999983907e-01f, 1.778278500e-03f,
4.425697960e-03f, -9.999902248e-01f, 9.952573776e-01f, -9.727646410e-02f, -9.437797070e-01f, -3.305749595e-01f, -3.758473992e-01f, 9.266815782e-01f, 4.535961151e-01f, 8.912073374e-01f, 8.147053123e-01f, 5.798751712e-01f, 9.401075840e-01f, 3.408778608e-01f, 9.809291363e-01f, 1.943656504e-01f, 9.939560890e-01f, 1.097782999e-01f, 9.980874062e-01f, 6.181810424e-02f, 9.993950725e-01f, 3.477803990e-02f, 9.998086691e-01f, 1.955982670e-02f, 9.999395013e-01f, 1.099977922e-02f, 9.999808669e-01f, 6.185714621e-03f, 9.999939203e-01f, 3.478498431e-03f, 9.999980927e-01f, 1.956106164e-03f,
8.438539505e-01f, -5.365729332e-01f, 8.938615918e-01f, 4.483429790e-01f, -7.941793799e-01f, -6.076834202e-01f, -5.338430405e-01f, 8.455836177e-01f, 3.623577356e-01f, 9.320390821e-01f, 7.808259130e-01f, 6.247486472e-01f, 9.288598895e-01f, 3.704312742e-01f, 9.773178697e-01f, 2.117776722e-01f, 9.928086400e-01f, 1.197122037e-01f, 9.977239966e-01f, 6.742975861e-02f, 9.992800951e-01f, 3.793822229e-02f, 9.997723103e-01f, 2.133773454e-02f, 9.999279976e-01f, 1.199971233e-02f, 9.999772310e-01f, 6.748044398e-03f, 9.999927878e-01f, 3.794723889e-03f, 9.999977350e-01f, 2.133933594e-03f,
9.074468017e-01f, 4.201670587e-01f, 5.171728134e-01f, 8.558809757e-01f, -5.658205152e-01f, -8.245284557e-01f, -6.750016809e-01f, 7.378162146e-01f, 2.674987614e-01f, 9.635581970e-01f, 7.444779873e-01f, 6.676470041e-01f, 9.166833758e-01f, 3.996143043e-01f, 9.733975530e-01f, 2.291227132e-01f, 9.915618896e-01f, 1.296341419e-01f, 9.973290563e-01f, 7.303927839e-02f, 9.991551042e-01f, 4.109803215e-02f, 9.997327924e-01f, 2.311557345e-02f, 9.999154806e-01f, 1.299963426e-02f, 9.999732971e-01f, 7.310371846e-03f, 9.999915361e-01f, 4.110949114e-03f, 9.999973178e-01f, 2.311761025e-03f,
1.367372274e-01f, 9.906073809e-01f, -1.879615150e-02f, 9.998233318e-01f, -2.813494802e-01f, -9.596053958e-01f, -7.948708534e-01f, 6.067786217e-01f, 1.699671596e-01f, 9.854497313e-01f, 7.057763338e-01f, 7.084347010e-01f, 9.035902619e-01f, 4.283977747e-01f, 9.691694379e-01f, 2.463953048e-01f, 9.902160168e-01f, 1.395431161e-01f, 9.969025850e-01f, 7.864648104e-02f, 9.990201592e-01f, 4.425742477e-02f, 9.996901155e-01f, 2.489333972e-02f, 9.999020100e-01f, 1.399954315e-02f, 9.999690056e-01f, 7.872696966e-03f, 9.999902248e-01f, 4.427174106e-03f, 9.999969006e-01f, 2.489588689e-03f,
-7.596879005e-01f, 6.502878666e-01f, -5.489754677e-01f, 8.358384371e-01f, 3.102234937e-02f, -9.995186925e-01f, -8.896704316e-01f, 4.566032588e-01f, 7.073719800e-02f, 9.974949956e-01f, 6.648434997e-01f, 7.469826937e-01f, 8.895936012e-01f, 4.567528665e-01f, 9.646348357e-01f, 2.635899782e-01f, 9.887710810e-01f, 1.494381279e-01f, 9.964445233e-01f, 8.425120264e-02f, 9.988752007e-01f, 4.741638154e-02f, 9.996442795e-01f, 2.667102963e-02f, 9.998875260e-01f, 1.499943808e-02f, 9.999644160e-01f, 8.435020223e-03f, 9.999887347e-01f, 4.743398633e-03f, 9.999964237e-01f, 2.667415887e-03f,
-9.576594830e-01f, -2.879033387e-01f, -9.100810885e-01f, 4.144302309e-01f, 3.403181434e-01f, -9.403103590e-01f, -9.564100504e-01f, 2.920270860e-01f, -2.919954434e-02f, 9.995735884e-01f, 6.218088269e-01f, 7.831690907e-01f, 8.747074604e-01f, 4.846512377e-01f, 9.597951770e-01f, 2.807013094e-01f, 9.872272611e-01f, 1.593182087e-01f, 9.959549904e-01f, 8.985326439e-02f, 9.987202883e-01f, 5.057485774e-02f, 9.995952845e-01f, 2.844863199e-02f, 9.998720288e-01f, 1.599931903e-02f, 9.999595284e-01f, 8.997339755e-03f, 9.999871850e-01f, 5.059622694e-03f, 9.999959469e-01f, 2.845243318e-03f,
-2.751633525e-01f, -9.613974690e-01f, -9.908979535e-01f, -1.346151382e-01f, 6.158647537e-01f, -7.878518701e-01f, -9.929850101e-01f, 1.182405204e-01f, -1.288445443e-01f, 9.916648269e-01f, 5.768082738e-01f, 8.168795705e-01f, 8.589466810e-01f, 5.120649934e-01f, 9.546520114e-01f, 2.977238595e-01f, 9.855847955e-01f, 1.691823453e-01f, 9.954339862e-01f, 9.545248002e-02f, 9.985553622e-01f, 5.373282731e-02f, 9.995430708e-01f, 3.022614494e-02f, 9.998555183e-01f, 1.699918136e-02f, 9.999542832e-01f, 9.559656493e-03f, 9.999855757e-01f, 5.375845823e-03f, 9.999954104e-01f, 3.023070283e-03f,
6.603167057e-01f, -7.509872317e-01f, -7.665365338e-01f, -6.422007084e-01f, 8.303361535e-01f, -5.572628975e-01f, -9.982416630e-01f, -5.927551538e-02f, -2.272021621e-01f, 9.738476276e-01f, 5.299841762e-01f, 8.480075598e-01f, 8.423270583e-01f, 5.389667153e-01f, 9.492070079e-01f, 3.146522641e-01f, 9.838436842e-01f, 1.790295690e-01f, 9.948815107e-01f, 1.010486856e-01f, 9.983804226e-01f, 5.689026415e-02f, 9.994877577e-01f, 3.200356290e-02f, 9.998379946e-01f, 1.799902879e-02f, 9.999487996e-01f, 1.012197044e-02f, 9.999837875e-01f, 5.692068953e-03f, 9.999948740e-01f, 3.200897481e-03f,
9.887046218e-01f, 1.498772055e-01f, -3.060954213e-01f, -9.520008564e-01f, 9.624637961e-01f, -2.714101076e-01f, -9.720142484e-01f, -2.349218130e-01f, -3.232895434e-01f, 9.463000894e-01f, 4.814845622e-01f, 8.764545918e-01f, 8.248651624e-01f, 5.653295517e-01f, 9.434618354e-01f, 3.314811885e-01f, 9.820042253e-01f, 1.888588965e-01f, 9.942975044e-01f, 1.066416800e-01f, 9.981955290e-01f, 6.004713103e-02f, 9.994292855e-01f, 3.378088027e-02f, 9.998195171e-01f, 1.899885759e-02f, 9.999428988e-01f, 1.068428159e-02f, 9.999819398e-01f, 6.008291151e-03f, 9.999942780e-01f, 3.378724447e-03f,
4.080820680e-01f, 9.129452705e-01f, 2.486167252e-01f, -9.686019421e-01f, 9.991443753e-01f, 4.135829210e-02f, -9.151299596e-01f, -4.031589925e-01f, -4.161468148e-01f, 9.092974067e-01f, 4.314628243e-01f, 9.021307230e-01f, 8.065784574e-01f, 5.911270380e-01f, 9.374182820e-01f, 3.482052684e-01f, 9.800665975e-01f, 1.986693144e-01f, 9.936820865e-01f, 1.122313142e-01f, 9.980006814e-01f, 6.320339441e-02f, 9.993675947e-01f, 3.555808961e-02f, 9.998000264e-01f, 1.999866776e-02f, 9.999367595e-01f, 1.124658901e-02f, 9.999799728e-01f, 6.324512884e-03f, 9.999936819e-01f, 3.556551412e-03f,
-5.477292538e-01f, 8.366556168e-01f, 7.267602682e-01f, -6.868911982e-01f, 9.367404580e-01f, 3.500247598e-01f, -8.293829560e-01f, -5.586804748e-01f, -5.048462152e-01f, 8.632093072e-01f, 3.800770044e-01f, 9.249548316e-01f, 7.874851823e-01f, 6.163335443e-01f, 9.310783744e-01f, 3.648192585e-01f, 9.780309200e-01f, 2.084598988e-01f, 9.930352569e-01f, 1.178173944e-01f, 9.977958202e-01f, 6.635902822e-02f, 9.993028045e-01f, 3.733518720e-02f, 9.997795224e-01f, 2.099845745e-02f, 9.999302626e-01f, 1.180889271e-02f, 9.999779463e-01f, 6.640734151e-03f, 9.999930263e-01f, 3.734378144e-03f,
-9.999608397e-01f, -8.851309307e-03f, 9.810745716e-01f, -1.936302334e-01f, 7.814403772e-01f, 6.239799261e-01f, -7.174775004e-01f, -6.965817213e-01f, -5.885011554e-01f, 8.084963560e-01f, 3.274896145e-01f, 9.448547959e-01f, 7.676045895e-01f, 6.409237385e-01f, 9.244439602e-01f, 3.813178837e-01f, 9.758974314e-01f, 2.182296216e-01f, 9.923570156e-01f, 1.233997419e-01f, 9.975810051e-01f, 6.951400638e-02f, 9.992348552e-01f, 3.911216930e-02f, 9.997580051e-01f, 2.199822664e-02f, 9.999234676e-01f, 1.237119269e-02f, 9.999758005e-01f, 6.956954487e-03f, 9.999923706e-01f, 3.912204877e-03f,
-5.328330398e-01f, -8.462203741e-01f, 9.332357645e-01f, 3.592645228e-01f, 5.486452579e-01f, 8.360552788e-01f, -5.829432607e-01f, -8.125128746e-01f, -6.662759781e-01f, 7.457052469e-01f, 2.738668621e-01f, 9.617676139e-01f, 7.469564080e-01f, 6.648730636e-01f, 9.175173044e-01f, 3.976959288e-01f, 9.736663699e-01f, 2.279775143e-01f, 9.916474223e-01f, 1.289781928e-01f, 9.973561764e-01f, 7.266827673e-02f, 9.991636872e-01f, 4.088902473e-02f, 9.997355342e-01f, 2.299797349e-02f, 9.999163747e-01f, 1.293348987e-02f, 9.999735355e-01f, 7.273174357e-03f, 9.999916553e-01f, 4.090031609e-03f,
4.241790175e-01f, -9.055783749e-01f, 5.979771614e-01f, 8.015131354e-01f, 2.614417076e-01f, 9.652192593e-01f, -4.300232828e-01f, -9.028177857e-01f, -7.373937964e-01f, 6.754631400e-01f, 2.193782777e-01f, 9.756398797e-01f, 7.255613208e-01f, 6.881574988e-01f, 9.103004336e-01f, 4.139482081e-01f, 9.713379741e-01f, 2.377026230e-01f, 9.909064770e-01f, 1.345525682e-01f, 9.971213937e-01f, 7.582182437e-02f, 9.990894198e-01f, 4.266574979e-02f, 9.997119904e-01f, 2.399769612e-02f, 9.999089241e-01f, 1.349578146e-02f, 9.999712110e-01f, 7.589393295e-03f, 9.999908805e-01f, 4.267857410e-03f,
9.912028313e-01f, -1.323517561e-01f, 7.855226099e-02f, 9.969099760e-01f, -5.168933049e-02f, 9.986631870e-01f, -2.635405958e-01f, -9.646483064e-01f, -8.011435866e-01f, 5.984721780e-01f, 1.641961634e-01f, 9.864277244e-01f, 7.034407258e-01f, 7.107539177e-01f, 9.027957320e-01f, 4.300695956e-01f, 9.689124227e-01f, 2.474039644e-01f, 9.901341200e-01f, 1.401226968e-01f, 9.968765974e-01f, 7.897461206e-02f, 9.990119338e-01f, 4.444234073e-02f, 9.996874928e-01f, 2.499739639e-02f, 9.999011755e-01f, 1.405806933e-02f, 9.999687672e-01f, 7.905611768e-03f, 9.999901056e-01f, 4.445684142e-03f,
6.469193697e-01f, 7.625584006e-01f, -4.650644958e-01f, 8.852767944e-01f, -3.596943319e-01f, 9.330701828e-01f, -8.874549717e-02f, -9.960543513e-01f, -8.568888307e-01f, 5.155012608e-01f, 1.084949449e-01f, 9.940969944e-01f, 6.806167960e-01f, 7.326396108e-01f, 8.950055242e-01f, 4.460549951e-01f, 9.663899541e-01f, 2.570805550e-01f, 9.893305302e-01f, 1.456883848e-01f, 9.966219068e-01f, 8.212661743e-02f, 9.989313483e-01f, 4.621879384e-02f, 9.996620417e-01f, 2.599707060e-02f, 9.998931289e-01f, 1.462035347e-02f, 9.999662042e-01f, 8.221829310e-03f, 9.999893308e-01f, 4.623509943e-03f,
-2.921388149e-01f, 9.563759565e-01f, -8.654506207e-01f, 5.009942055e-01f, -6.320286393e-01f, 7.749450207e-01f, 8.884812146e-02f, -9.960451722e-01f, -9.040721655e-01f, 4.273798466e-01f, 5.245061219e-02f, 9.986234903e-01f, 6.571123004e-01f, 7.537927032e-01f, 8.869323730e-01f, 4.618993104e-01f, 9.637709260e-01f, 2.667314112e-01f, 9.884956479e-01f, 1.512494683e-01f, 9.963572025e-01f, 8.527779579e-02f, 9.988475442e-01f, 4.799510166e-02f, 9.996355176e-01f, 2.699672058e-02f, 9.998847246e-01f, 1.518263202e-02f, 9.999635220e-01f, 8.538045920e-03f, 9.999884963e-01f, 4.801335745e-03f,
-9.626058936e-01f, 2.709057927e-01f, -9.992933869e-01f, -3.758566082e-02f, -8.416849375e-01f, 5.399689674e-01f, 2.636395097e-01f, -9.646213055e-01f, -9.422222972e-01f, 3.349882066e-01f, -3.759419080e-03f, 9.999929070e-01f, 6.329506636e-01f, 7.741921544e-01f, 8.785787225e-01f, 4.775975943e-01f, 9.610554576e-01f, 2.763556540e-01f, 9.876294732e-01f, 1.568057537e-01f, 9.960825443e-01f, 8.842811733e-02f, 9.987606406e-01f, 4.977125302e-02f, 9.996080399e-01f, 2.799634263e-02f, 9.998760223e-01f, 1.574490592e-02f, 9.999607801e-01f, 8.854261599e-03f, 9.999876022e-01f, 4.979162011e-03f,
-7.480575442e-01f, -6.636338830e-01f, -8.253716230e-01f, -5.645897985e-01f, -9.678714871e-01f, 2.514452934e-01f, 4.301158488e-01f, -9.027737379e-01f, -9.709581733e-01f, 2.392492294e-01f, -5.995756760e-02f, 9.982009530e-01f, 6.081562042e-01f, 7.938174009e-01f, 8.699471951e-01f, 4.931448400e-01f, 9.582439065e-01f, 2.859522104e-01f, 9.867320657e-01f, 1.623570919e-01f, 9.957979321e-01f, 9.157756716e-02f, 9.986705780e-01f, 5.154724792e-02f, 9.995795488e-01f, 2.899593674e-02f, 9.998670220e-01f, 1.630717516e-02f, 9.999579787e-01f, 9.170476347e-03f, 9.999867082e-01f, 5.156987347e-03f,
1.542514563e-01f, -9.880316257e-01f, -3.972518742e-01f, -9.177096486e-01f, -9.980752468e-01f, -6.201483682e-02f, 5.830269456e-01f, -8.124528527e-01f, -9.899924994e-01f, 1.411200017e-01f, -1.159661636e-01f, 9.932531714e-01f, 5.827535987e-01f, 8.126488924e-01f, 8.610406518e-01f, 5.085361004e-01f, 9.553365111e-01f, 2.955201864e-01f, 9.858034849e-01f, 1.679033041e-01f, 9.955033660e-01f, 9.472609311e-02f, 9.985772967e-01f, 5.332308263e-02f, 9.995500445e-01f, 2.999550104e-02f, 9.998577237e-01f, 1.686943881e-02f, 9.999549985e-01f, 9.486690164e-03f, 9.999857545e-01f, 5.334813148e-03f,
9.147423506e-01f, -4.040376544e-01f, 1.532154679e-01f, -9.881927967e-01f, -9.293003082e-01f, -3.693250120e-01f, 7.175492644e-01f, -6.965078115e-01f, -9.991351366e-01f, 4.158052057e-02f, -1.716081351e-01f, 9.851652980e-01f, 5.567683578e-01f, 8.306677938e-01f, 8.518617749e-01f, 5.237666368e-01f, 9.523335695e-01f, 3.050586283e-01f, 9.848436713e-01f, 1.734442115e-01f, 9.951988459e-01f, 9.787366539e-02f, 9.984809160e-01f, 5.509874597e-02f, 9.995195270e-01f, 3.099503554e-02f, 9.998480678e-01f, 1.743169688e-02f, 9.999519587e-01f, 9.802903049e-03f, 9.999848008e-01f, 5.512638018e-03f,
8.342233300e-01f, 5.514267087e-01f, 6.564951539e-01f, -7.543302178e-01f, -7.683671117e-01f, -6.400093436e-01f, 8.294403553e-01f, -5.585952401e-01f, -9.982947707e-01f, -5.837418884e-02f, -2.267075926e-01f, 9.739628434e-01f, 5.302263498e-01f, 8.478561044e-01f, 8.424135447e-01f, 5.388315320e-01f, 9.492354393e-01f, 3.145665526e-01f, 9.838528037e-01f, 1.789796203e-01f, 9.948843718e-01f, 1.010202691e-01f, 9.983813763e-01f, 5.687423423e-02f, 9.994880557e-01f, 3.199454024e-02f, 9.998381138e-01f, 1.799395122e-02f, 9.999487996e-01f, 1.011911593e-02f, 9.999837875e-01f, 5.690463353e-03f,
-1.327674743e-02f, 9.999118447e-01f, 9.575860500e-01f, -2.881473601e-01f, -5.312352777e-01f, -8.472243547e-01f, 9.151713848e-01f, -4.030649364e-01f, -9.874798059e-01f, -1.577456445e-01f, -2.810902894e-01f, 9.596813321e-01f, 5.031541586e-01f, 8.641966581e-01f, 8.326989412e-01f, 5.537260175e-01f, 9.460423589e-01f, 3.240430057e-01f, 9.828307629e-01f, 1.845093668e-01f, 9.945599437e-01f, 1.041658595e-01f, 9.982786179e-01f, 5.864954367e-02f, 9.994555712e-01f, 3.299400955e-02f, 9.998278022e-01f, 1.855619811e-02f, 9.999455214e-01f, 1.043532696e-02f, 9.999827743e-01f, 5.868288688e-03f,
-8.485702872e-01f, 5.290827155e-01f, 9.637575150e-01f, 2.667797208e-01f, -2.414211035e-01f, -9.704204202e-01f, 9.720383286e-01f, -2.348221242e-01f, -9.667981863e-01f, -2.555412054e-01f, -3.345843554e-01f, 9.423658252e-01f, 4.755789042e-01f, 8.796730638e-01f, 8.227210045e-01f, 5.684453845e-01f, 9.427546859e-01f, 3.334870934e-01f, 9.817776680e-01f, 1.900332868e-01f, 9.942255616e-01f, 1.073104069e-01f, 9.981727600e-01f, 6.042466685e-02f, 9.994220734e-01f, 3.399345279e-02f, 9.998172522e-01f, 1.911843941e-02f, 9.999421835e-01f, 1.075153705e-02f, 9.999817014e-01f, 6.046113092e-03f,
-9.036921859e-01f, -4.281826615e-01f, 6.731102467e-01f, 7.395421863e-01f, 7.233466953e-02f, -9.973804355e-01f, 9.982477427e-01f, -5.917267874e-02f, -9.364566803e-01f, -3.507832289e-01f, -3.870206773e-01f, 9.220710397e-01f, 4.475280643e-01f, 8.942698836e-01f, 8.124829531e-01f, 5.829849839e-01f, 9.393727183e-01f, 3.428978026e-01f, 9.806935191e-01f, 1.955512017e-01f, 9.938812256e-01f, 1.104538813e-01f, 9.980637431e-01f, 6.219960377e-02f, 9.993875623e-01f, 3.499285504e-02f, 9.998063445e-01f, 1.968067512e-02f, 9.999387264e-01f, 1.106774528e-02f, 9.999806285e-01f, 6.223937962e-03f,
-1.279636919e-01f, -9.917788506e-01f, 1.751565337e-01f, 9.845405817e-01f, 3.789161742e-01f, -9.254310131e-01f, 9.929728508e-01f, 1.183425784e-01f, -8.967583776e-01f, -4.425205886e-01f, -4.382335246e-01f, 8.988611698e-01f, 4.190297425e-01f, 9.079725146e-01f, 8.019878864e-01f, 5.973402858e-01f, 9.358968139e-01f, 3.522742093e-01f, 9.795783162e-01f, 2.010629177e-01f, 9.935269952e-01f, 1.135962531e-01f, 9.979515672e-01f, 6.397433579e-02f, 9.993520975e-01f, 3.599222749e-02f, 9.997950792e-01f, 2.024290524e-02f, 9.999352098e-01f, 1.138395350e-02f, 9.999794960e-01f, 6.401761901e-03f,
7.654140592e-01f, -6.435381174e-01f, -3.767422736e-01f, 9.263181090e-01f, 6.479216814e-01f, -7.617069483e-01f, 9.563800097e-01f, 2.921253741e-01f, -8.481000066e-01f, -5.298361778e-01f, -4.880608618e-01f, 8.728095889e-01f, 3.901124299e-01f, 9.207672477e-01f, 7.912392616e-01f, 6.115067005e-01f, 9.323273301e-01f, 3.616154492e-01f, 9.784321785e-01f, 2.065682709e-01f, 9.931628108e-01f, 1.167374924e-01f, 9.978361726e-01f, 6.574887782e-02f, 9.993155599e-01f, 3.699155897e-02f, 9.997835755e-01f, 2.080512606e-02f, 9.999315739e-01f, 1.170015987e-02f, 9.999783635e-01f, 6.579586305e-03f,
9.550736547e-01f, 2.963685691e-01f, -8.126112223e-01f, 5.828061700e-01f, 8.526731133e-01f, -5.224447846e-01f, 8.896234632e-01f, 4.566946924e-01f, -7.909677625e-01f, -6.118578315e-01f, -5.363451838e-01f, 8.439987302e-01f, 3.608050346e-01f, 9.326412678e-01f, 7.802404165e-01f, 6.254796982e-01f, 9.286646247e-01f, 3.709204793e-01f, 9.772551060e-01f, 2.120671123e-01f, 9.927886724e-01f, 1.198775545e-01f, 9.977176785e-01f, 6.752320379e-02f, 9.992780685e-01f, 3.799085692e-02f, 9.997717142e-01f, 2.136734314e-02f, 9.999278188e-01f, 1.201636530e-02f, 9.999771714e-01f, 6.757410709e-03f,
2.666429281e-01f, 9.637953639e-01f, -9.982103705e-01f, 5.980031565e-02f, 9.728653431e-01f, -2.313720286e-01f, 7.948083878e-01f, 6.068604589e-01f, -7.259323001e-01f, -6.877661943e-01f, -5.829339027e-01f, 8.125195503e-01f, 3.311368823e-01f, 9.435827136e-01f, 7.689949274e-01f, 6.392549276e-01f, 9.249090552e-01f, 3.801884055e-01f, 9.760470986e-01f, 2.175592482e-01f, 9.924046397e-01f, 1.230164245e-01f, 9.975960255e-01f, 6.929731369e-02f, 9.992396235e-01f, 3.899011388e-02f, 9.997594953e-01f, 2.192955278e-02f, 9.999239445e-01f, 1.233256981e-02f, 9.999759793e-01f, 6.935234182e-03f,
-6.669380665e-01f, 7.451131940e-01f, -8.763794303e-01f, -4.816212952e-01f, 9.965789914e-01f, 8.264580369e-02f, 6.749256253e-01f, 7.378857732e-01f, -6.536436081e-01f, -7.568024993e-01f, -6.276797056e-01f, 7.784717083e-01f, 3.011375964e-01f, 9.535806775e-01f, 7.575061917e-01f, 6.528279781e-01f, 9.210609794e-01f, 3.894183338e-01f, 9.748082757e-01f, 2.230444849e-01f, 9.920106530e-01f, 1.261540651e-01f, 9.974712729e-01f, 7.107120752e-02f, 9.992001057e-01f, 3.998933733e-02f, 9.997470379e-01f, 2.249175683e-02f, 9.999200106e-01f, 1.264877338e-02f, 9.999747276e-01f, 7.113057654e-03f,
-9.873392582e-01f, -1.586226672e-01f, -4.846394062e-01f, -8.747140765e-01f, 9.214623570e-01f, 3.884676993e-01f, 5.337560773e-01f, 8.456385136e-01f, -5.748240352e-01f, -8.182770610e-01f, -6.704410911e-01f, 7.419627309e-01f, 2.708370984e-01f, 9.626252055e-01f, 7.457779050e-01f, 6.661946774e-01f, 9.171208143e-01f, 3.986093104e-01f, 9.735385776e-01f, 2.285226882e-01f, 9.916067719e-01f, 1.292904317e-01f, 9.973433018e-01f, 7.284487784e-02f, 9.991596341e-01f, 4.098851606e-02f, 9.997342229e-01f, 2.305394970e-02f, 9.999159575e-01f, 1.296497509e-02f, 9.999734163e-01f, 7.290880661e-03f,
-3.999853134e-01f, -9.165215492e-01f, 5.636094138e-02f, -9.984104633e-01f, 7.549653053e-01f, 6.557646990e-01f, 3.757521510e-01f, 9.267202020e-01f, -4.902605712e-01f, -8.715758920e-01f, -7.110829353e-01f, 7.031081319e-01f, 2.402658761e-01f, 9.707071185e-01f, 7.338138223e-01f, 6.793506742e-01f, 9.130889177e-01f, 4.077604413e-01f, 9.722381234e-01f, 2.339936644e-01f, 9.911929369e-01f, 1.324255317e-01f, 9.972121716e-01f, 7.461831719e-02f, 9.991181493e-01f, 4.198765755e-02f, 9.997211099e-01f, 2.361613885e-02f, 9.999117851e-01f, 1.328117587e-02f, 9.999721050e-01f, 7.468704134e-03f,
5.551133156e-01f, -8.317747116e-01f, 5.800030828e-01f, -8.146142364e-01f, 5.135983825e-01f, 8.580306768e-01f, 2.058971673e-01f, 9.785736203e-01f, -4.007990062e-01f, -9.161660075e-01f, -7.494767308e-01f, 6.620306969e-01f, 2.094544172e-01f, 9.778184295e-01f, 7.216176391e-01f, 6.922917962e-01f, 9.089657664e-01f, 4.168707728e-01f, 9.709069133e-01f, 2.394572198e-01f, 9.907692075e-01f, 1.355592906e-01f, 9.970778823e-01f, 7.639151812e-02f, 9.990756512e-01f, 4.298675060e-02f, 9.997076392e-01f, 2.417832054e-02f, 9.999075532e-01f, 1.359737478e-02f, 9.999707937e-01f, 7.646527141e-03f,
9.998432994e-01f, 1.770192571e-02f, 9.250146747e-01f, -3.799313903e-01f, 2.212981731e-01f, 9.752061963e-01f, 2.954782173e-02f, 9.995633960e-01f, -3.073327839e-01f, -9.516021013e-01f, -7.855011225e-01f, 6.188602448e-01f, 1.784335226e-01f, 9.839519858e-01f, 7.091933489e-01f, 7.050140500e-01f, 9.047516584e-01f, 4.259394705e-01f, 9.695450068e-01f, 2.449132055e-01f, 9.903355837e-01f, 1.386916935e-01f, 9.969404936e-01f, 7.816448808e-02f, 9.990321398e-01f, 4.398580641e-02f, 9.996939301e-01f, 2.474049293e-02f, 9.999032021e-01f, 1.391357277e-02f, 9.999693632e-01f, 7.824349217e-03f,
5.253220201e-01f, 8.509035110e-01f, 9.851381779e-01f, 1.717635691e-01f, -9.294810891e-02f, 9.956709743e-01f, -1.477329880e-01f, 9.890272617e-01f, -2.107957900e-01f, -9.775301218e-01f, -8.190422058e-01f, 5.737333298e-01f, 1.472342163e-01f, 9.891016483e-01f, 6.965447664e-01f, 7.175133228e-01f, 9.004471302e-01f, 4.349655211e-01f, 9.681524038e-01f, 2.503614724e-01f, 9.898920655e-01f, 1.418227106e-01f, 9.967998862e-01f, 7.993719727e-02f, 9.989876747e-01f, 4.498481750e-02f, 9.996798635e-01f, 2.530265786e-02f, 9.998987317e-01f, 1.422976889e-02f, 9.999679923e-01f, 8.002171293e-03f,
-4.321779609e-01f, 9.017883539e-01f, 7.418580055e-01f, 6.705570221e-01f, -3.979767561e-01f, 9.173954725e-01f, -3.203543723e-01f, 9.472977519e-01f, -1.121526212e-01f, -9.936909676e-01f, -8.499938846e-01f, 5.267925262e-01f, 1.158876941e-01f, 9.932623506e-01f, 6.836758852e-01f, 7.297858000e-01f, 8.960524797e-01f, 4.439480901e-01f, 9.667292237e-01f, 2.558017969e-01f, 9.894386530e-01f, 1.449523121e-01f, 9.966561794e-01f, 8.170966059e-02f, 9.989421964e-01f, 4.598378390e-02f, 9.996654391e-01f, 2.586481534e-02f, 9.998942018e-01f, 1.454596408e-02f, 9.999665618e-01f, 8.179994300e-03f,
-9.923354983e-01f, 1.235731244e-01f, 2.700984478e-01f, 9.628326893e-01f, -6.635382771e-01f, 7.481423020e-01f, -4.828719497e-01f, 8.756909966e-01f, -1.238837745e-02f, -9.999232888e-01f, -8.782584071e-01f, 4.781863391e-01f, 8.442528546e-02f, 9.964298010e-01f, 6.705908179e-01f, 7.418274283e-01f, 8.915683031e-01f, 4.528862834e-01f, 9.652754664e-01f, 2.612340748e-01f, 9.889753461e-01f, 1.480804533e-01f, 9.965093136e-01f, 8.348185569e-02f, 9.988957047e-01f, 4.698270187e-02f, 9.996507764e-01f, 2.642696351e-02f, 9.998895526e-01f, 1.486215740e-02f, 9.999650717e-01f, 8.357816376e-03f,
-6.401443481e-01f, -7.682546377e-01f, -2.848466039e-01f, 9.585731030e-01f, -8.632964492e-01f, 5.046971440e-01f, -6.301599741e-01f, 7.764653563e-01f, 8.749917895e-02f, -9.961646199e-01f, -9.037463665e-01f, 4.280683994e-01f, 5.287845805e-02f, 9.986009598e-01f, 6.572937369e-01f, 7.536345124e-01f, 8.869948983e-01f, 4.617791772e-01f, 9.637911916e-01f, 2.666580379e-01f, 9.885020852e-01f, 1.512071192e-01f, 9.963592887e-01f, 8.525379747e-02f, 9.988481998e-01f, 4.798157141e-02f, 9.996357560e-01f, 2.698910423e-02f, 9.998847842e-01f, 1.517834887e-02f, 9.999635816e-01f, 8.535637520e-03f,
3.005925417e-01f, -9.537526369e-01f, -7.520639896e-01f, 6.590901017e-01f, -9.774427414e-01f, 2.112006694e-01f, -7.575730681e-01f, 6.527503729e-01f, 1.865124702e-01f, -9.824525714e-01f, -9.263771176e-01f, 3.765971363e-01f, 2.127875946e-02f, 9.997735620e-01f, 6.437888145e-01f, 7.652031779e-01f, 8.823328614e-01f, 4.706258774e-01f, 9.622764587e-01f, 2.720735669e-01f, 9.880189896e-01f, 1.543322802e-01f, 9.962061048e-01f, 8.702547103e-02f, 9.987997413e-01f, 4.898039624e-02f, 9.996203780e-01f, 2.755123749e-02f, 9.998799562e-01f, 1.549453940e-02f, 9.999620318e-01f, 8.713459596e-03f,
9.649659991e-01f, -2.623748481e-01f, -9.876590967e-01f, 1.566190720e-01f, -9.946564436e-01f, -1.032404676e-01f, -8.610926867e-01f, 5.084480047e-01f, 2.836621702e-01f, -9.589242935e-01f, -9.460792542e-01f, 3.239352703e-01f, -1.034221891e-02f, 9.999465346e-01f, 6.300802827e-01f, 7.765299678e-01f, 8.775825500e-01f, 4.794255495e-01f, 9.607312679e-01f, 2.774805427e-01f, 9.875259995e-01f, 1.574558914e-01f, 9.960497618e-01f, 8.879686147e-02f, 9.987502694e-01f, 4.997916892e-02f, 9.996047616e-01f, 2.811335959e-02f, 9.998750091e-01f, 1.581072807e-02f, 9.999604821e-01f, 8.891279809e-03f,
7.421542406e-01f, 6.702291369e-01f, -9.190735221e-01f, -3.940860629e-01f, -9.132301211e-01f, -4.074441493e-01f, -9.374542832e-01f, 3.481085002e-01f, 3.779776394e-01f, -9.258147478e-01f, -9.627903700e-01f, 2.702493370e-01f, -4.195285589e-02f, 9.991195798e-01f, 6.161724925e-01f, 7.876112461e-01f, 8.727445006e-01f, 4.881772399e-01f, 9.591556787e-01f, 2.828786969e-01f, 9.870231748e-01f, 1.605779380e-01f, 9.958902597e-01f, 9.056797624e-02f, 9.986997843e-01f, 5.097789690e-02f, 9.995887876e-01f, 2.867547423e-02f, 9.998699427e-01f, 1.612691768e-02f, 9.999588728e-01f, 9.069100954e-03f,
-1.629907787e-01f, 9.866275787e-01f, -5.674300194e-01f, -8.234215975e-01f, -7.412399650e-01f, -6.712400913e-01f, -9.842484593e-01f, 1.767906845e-01f, 4.685169160e-01f, -8.834545016e-01f, -9.764577150e-01f, 2.157090008e-01f, -7.352153957e-02f, 9.972936511e-01f, 6.020698547e-01f, 7.984433770e-01f, 8.678191900e-01f, 4.968801141e-01f, 9.575498104e-01f, 2.882679403e-01f, 9.865104556e-01f, 1.636983752e-01f, 9.957276583e-01f, 9.233880043e-02f, 9.986482859e-01f, 5.197656900e-02f, 9.995725155e-01f, 2.923758142e-02f, 9.998648167e-01f, 1.644310169e-02f, 9.999572635e-01f, 9.246920235e-03f,
-9.182828069e-01f, 3.959251344e-01f, -4.102819040e-02f, -9.991579652e-01f, -4.957418144e-01f, -8.684699535e-01f, -1.000000000e+00f, -1.030206768e-04f, 5.543745160e-01f, -8.322673440e-01f, -9.870380163e-01f, 1.604867131e-01f, -1.050167158e-01f, 9.944704771e-01f, 5.877768993e-01f, 8.090230227e-01f, 8.628070951e-01f, 5.055333376e-01f, 9.559136033e-01f, 2.936480343e-01f, 9.859878421e-01f, 1.668171734e-01f, 9.955618382e-01f, 9.410934150e-02f, 9.985958338e-01f, 5.297519267e-02f, 9.995558858e-01f, 2.979967557e-02f, 9.998595715e-01f, 1.675928757e-02f, 9.999555945e-01f, 9.424741380e-03f,
-8.293098211e-01f, -5.587890744e-01f, 4.980095923e-01f, -8.671715260e-01f, -2.010796219e-01f, -9.795749187e-01f, -9.842120409e-01f, -1.769934893e-01f, 6.346929669e-01f, -7.727644444e-01f, -9.944978952e-01f, 1.047568321e-01f, -1.364068687e-01f, 9.906529188e-01f, 5.732980371e-01f, 8.193469048e-01f, 8.577086926e-01f, 5.141359568e-01f, 9.542471766e-01f, 2.990188897e-01f, 9.854553938e-01f, 1.699342877e-01f, 9.953929186e-01f, 9.587957710e-02f, 9.985423684e-01f, 5.397376046e-02f, 9.995389581e-01f, 3.036176413e-02f, 9.998542070e-01f, 1.707546785e-02f, 9.999538660e-01f, 9.602561593e-03f,
2.212675475e-02f, -9.997551441e-01f, 8.836693168e-01f, -4.681116939e-01f, 1.135217771e-01f, -9.935355186e-01f, -9.373825192e-01f, -3.483016491e-01f, 7.086697817e-01f, -7.055402994e-01f, -9.988136292e-01f, 4.869600013e-02f, -1.676606387e-01f, 9.858447909e-01f, 5.586378574e-01f, 8.294116855e-01f, 8.525245190e-01f, 5.226872563e-01f, 9.525505900e-01f, 3.043802381e-01f, 9.849131107e-01f, 1.730497181e-01f, 9.952208400e-01f, 9.764950722e-02f, 9.984878898e-01f, 5.497227982e-02f, 9.995217323e-01f, 3.092384152e-02f, 9.998487830e-01f, 1.739165001e-02f, 9.999521971e-01f, 9.780380875e-03f,
8.532201052e-01f, -5.215510130e-01f, 9.971746206e-01f, 7.511820644e-02f, 4.168670774e-01f, -9.089674354e-01f, -8.609884381e-01f, -5.086245537e-01f, 7.755658031e-01f, -6.312667131e-01f, -9.999717474e-01f, -7.518785074e-03f, -1.987468749e-01f, 9.800508618e-01f, 5.438010693e-01f, 8.392141461e-01f, 8.472551107e-01f, 5.311862230e-01f, 9.508239031e-01f, 3.097319603e-01f, 9.843609333e-01f, 1.761634201e-01f, 9.950456619e-01f, 9.941913933e-02f, 9.984323978e-01f, 5.597073585e-02f, 9.995042086e-01f, 3.148590773e-02f, 9.998431802e-01f, 1.770782843e-02f, 9.999504089e-01f, 9.958200157e-03f,
8.998668194e-01f, 4.361647666e-01f, 8.035690784e-01f, 5.952115059e-01f, 6.788702011e-01f, -7.342582941e-01f, -7.574391961e-01f, -6.529057026e-01f, 8.347129226e-01f, -5.506852865e-01f, -9.979684949e-01f, -6.370980293e-02f, -2.296342701e-01f, 9.732769728e-01f, 5.287922621e-01f, 8.487513065e-01f, 8.419009447e-01f, 5.396320224e-01f, 9.490671158e-01f, 3.150739372e-01f, 9.837989211e-01f, 1.792753637e-01f, 9.948672652e-01f, 1.011884511e-01f, 9.983759522e-01f, 5.696914345e-02f, 9.994863272e-01f, 3.204796836e-02f, 9.998375773e-01f, 1.802400686e-02f, 9.999486208e-01f, 1.013601944e-02f,
1.191801354e-01f, 9.928726554e-01f, 3.624766469e-01f, 9.319928288e-01f, 8.735505342e-01f, -4.867334962e-01f, -6.300007105e-01f, -7.765945792e-01f, 8.855196238e-01f, -4.646020234e-01f, -9.928101897e-01f, -1.196994036e-01f, -2.602920234e-01f, 9.655299187e-01f, 5.136163235e-01f, 8.580200076e-01f, 8.364626765e-01f, 5.480239391e-01f, 9.472803473e-01f, 3.204059005e-01f, 9.832270741e-01f, 1.823855042e-01f, 9.946857691e-01f, 1.029574350e-01f, 9.983184934e-01f, 5.796748772e-02f, 9.994681478e-01f, 3.261001408e-02f, 9.998317957e-01f, 1.834018156e-02f, 9.999468327e-01f, 1.031383779e-02f,
-7.710802555e-01f, 6.367380023e-01f, -1.902491003e-01f, 9.817358255e-01f, 9.816020727e-01f, -1.909380108e-01f, -4.826923311e-01f, -8.757900000e-01f, 9.274784923e-01f, -3.738765717e-01f, -9.845131636e-01f, -1.753105819e-01f, -2.906895280e-01f, 9.568174481e-01f, 4.982779026e-01f, 8.670173883e-01f, 8.309406638e-01f, 5.563610196e-01f, 9.454635978e-01f, 3.257277906e-01f, 9.826454520e-01f, 1.854938269e-01f, 9.945011139e-01f, 1.047261059e-01f, 9.982600212e-01f, 5.896577984e-02f, 9.994496703e-01f, 3.317204863e-02f, 9.998259544e-01f, 1.865635626e-02f, 9.999449849e-01f, 1.049165614e-02f,
-9.524129629e-01f, -3.048106432e-01f, -6.843819022e-01f, 7.291237116e-01f, 9.923083186e-01f, 1.237909496e-01f, -3.201591969e-01f, -9.473637342e-01f, 9.601702690e-01f, -2.794154882e-01f, -9.731037021e-01f, -2.303675264e-01f, -3.207963705e-01f, 9.471482038e-01f, 4.827820063e-01f, 8.757405281e-01f, 8.253356218e-01f, 5.646424294e-01f, 9.436169863e-01f, 3.310393095e-01f, 9.820539355e-01f, 1.886002868e-01f, 9.943132997e-01f, 1.064944416e-01f, 9.982005358e-01f, 5.996400863e-02f, 9.994308352e-01f, 3.373407945e-02f, 9.998199940e-01f, 1.897252724e-02f, 9.999430776e-01f, 1.066947449e-02f,
-2.581016421e-01f, -9.661177397e-01f, -9.677396417e-01f, 2.519522905e-01f, 9.046075344e-01f, 4.262454212e-01f, -1.475291997e-01f, -9.890577197e-01f, 9.832684398e-01f, -1.821625978e-01f, -9.586178064e-01f, -2.846961617e-01f, -3.505824506e-01f, 9.365319014e-01f, 4.671334028e-01f, 8.841868639e-01f, 8.196480274e-01f, 5.728674531e-01f, 9.417404532e-01f, 3.363404274e-01f, 9.814526439e-01f, 1.917048544e-01f, 9.941223264e-01f, 1.082624346e-01f, 9.981400967e-01f, 6.096218154e-02f, 9.994117022e-01f, 3.429609165e-02f, 9.998139739e-01f, 1.928869821e-02f, 9.999411702e-01f, 1.084729191e-02f,
6.735071540e-01f, -7.391806841e-01f, -9.530500174e-01f, -3.028128445e-01f, 7.271980643e-01f, 6.864277124e-01f, 2.975377068e-02f, -9.995572567e-01f, 9.965420961e-01f, -8.308912069e-02f, -9.411013126e-01f, -3.381247520e-01f, -3.800179660e-01f, 9.249790907e-01f, 4.513370693e-01f, 8.923535347e-01f, 8.138784766e-01f, 5.810351968e-01f, 9.398342371e-01f, 3.416308761e-01f, 9.808415174e-01f, 1.948075294e-01f, 9.939282537e-01f, 1.100300923e-01f, 9.980786443e-01f, 6.196028739e-02f, 9.993922710e-01f, 3.485809639e-02f, 9.998078346e-01f, 1.960486546e-02f, 9.999392033e-01f, 1.102510840e-02f,
9.858965874e-01f, 1.673557013e-01f, -6.448370218e-01f, -7.643201351e-01f, 4.776714444e-01f, 8.785385489e-01f, 2.060983330e-01f, -9.785313010e-01f, 9.998586178e-01f, 1.681409217e-02f, -9.206095338e-01f, -3.904843926e-01f, -4.090735018e-01f, 9.125014544e-01f, 4.353979826e-01f, 9.002380967e-01f, 8.080275059e-01f, 5.891447663e-01f, 9.378982186e-01f, 3.469105363e-01f, 9.802205563e-01f, 1.979082376e-01f, 9.937310219e-01f, 1.117973924e-01f, 9.980161786e-01f, 6.295833737e-02f, 9.993724823e-01f, 3.542009369e-02f, 9.998015761e-01f, 1.992103085e-02f, 9.999372363e-01f, 1.120292582e-02f,
3.918572366e-01f, 9.200260639e-01f, -1.380281597e-01f, -9.904283285e-01f, 1.807759702e-01f, 9.835243225e-01f, 3.759426475e-01f, -9.266429543e-01f, 9.931849241e-01f, 1.165492982e-01f, -8.972073197e-01f, -4.416095316e-01f, -4.377200007e-01f, 8.991113305e-01f, 4.193212092e-01f, 9.078379273e-01f, 8.020957708e-01f, 5.971954465e-01f, 9.359325767e-01f, 3.521791995e-01f, 9.795898199e-01f, 2.010069788e-01f, 9.935306311e-01f, 1.135643497e-01f, 9.979526997e-01f, 6.395632029e-02f, 9.993524551e-01f, 3.598207608e-02f, 9.997951984e-01f, 2.023719437e-02f, 9.999352098e-01f, 1.138074230e-02f,
-5.624538660e-01f, 8.268286586e-01f, 4.112906456e-01f, -9.115042686e-01f, -1.340468824e-01f, 9.909749627e-01f, 5.339299440e-01f, -8.455287218e-01f, 9.765876532e-01f, 2.151199877e-01f, -8.709686995e-01f, -4.913385212e-01f, -4.659289122e-01f, 8.848221898e-01f, 4.031118751e-01f, 9.151507020e-01f, 7.960838079e-01f, 6.051864028e-01f, 9.339373708e-01f, 3.574367166e-01f, 9.789492488e-01f, 2.041037083e-01f, 9.933271408e-01f, 1.153309494e-01f, 9.978882670e-01f, 6.495424360e-02f, 9.993320704e-01f, 3.654404357e-02f, 9.997887611e-01f, 2.055335604e-02f, 9.999331832e-01f, 1.155855879e-02f,
-9.996474385e-01f, -2.655115537e-02f, 8.339421749e-01f, -5.518518090e-01f, -4.355781674e-01f, 9.001508951e-01f, 6.750773191e-01f, -7.377469540e-01f, 9.502326250e-01f, 3.115412891e-01f, -8.419764638e-01f, -5.395141840e-01f, -4.936717451e-01f, 8.696483374e-01f, 3.867750466e-01f, 9.221740961e-01f, 7.899922729e-01f, 6.131168008e-01f, 9.319126010e-01f, 3.626829684e-01f, 9.782989621e-01f, 2.071983814e-01f, 9.931204915e-01f, 1.170971766e-01f, 9.978227615e-01f, 6.595209241e-02f, 9.993113279e-01f, 3.710600734e-02f, 9.997822046e-01f, 2.086951770e-02f, 9.999310970e-01f, 1.173637528e-02f,
-5.177697539e-01f, -8.555200100e-01f, 9.997526407e-01f, -2.224157006e-02f, -6.939117312e-01f, 7.200600505e-01f, 7.949331403e-01f, -6.066970825e-01f, 9.143830538e-01f, 4.048501849e-01f, -8.103224635e-01f, -5.859842300e-01f, -5.209211111e-01f, 8.536047935e-01f, 3.703159094e-01f, 9.289059043e-01f, 7.838217020e-01f, 6.209859252e-01f, 9.298583269e-01f, 3.679177165e-01f, 9.776388407e-01f, 2.102909982e-01f, 9.929106832e-01f, 1.188630387e-01f, 9.977563620e-01f, 6.694988906e-02f, 9.992902875e-01f, 3.766795248e-02f, 9.997755289e-01f, 2.118567377e-02f, 9.999290109e-01f, 1.191418990e-02f,
4.401430190e-01f, -8.979277015e-01f, 8.576571345e-01f, 5.142219663e-01f, -8.834316730e-01f, 4.685599506e-01f, 8.897171617e-01f, -4.565122128e-01f, 8.693974018e-01f, 4.941135347e-01f, -7.761065960e-01f, -6.306017041e-01f, -5.476494431e-01f, 8.367078900e-01f, 3.537396789e-01f, 9.353439212e-01f, 7.775726914e-01f, 6.287930012e-01f, 9.277747273e-01f, 3.731408715e-01f, 9.769689441e-01f, 2.133814991e-01f, 9.926977158e-01f, 1.206285134e-01f, 9.976888895e-01f, 6.794761121e-02f, 9.992689490e-01f, 3.822989017e-02f, 9.997687936e-01f, 2.150182985e-02f, 9.999268651e-01f, 1.209200546e-02f,
9.933903813e-01f, -1.147848144e-01f, 4.514202476e-01f, 8.923114538e-01f, -9.853413105e-01f, 1.705945879e-01f, 9.564402103e-01f, -2.919283211e-01f, 8.157250285e-01f, 5.784398317e-01f, -7.394371629e-01f, -6.732255816e-01f, -5.738303661e-01f, 8.189741969e-01f, 3.370516896e-01f, 9.414861202e-01f, 7.712460160e-01f, 6.365371943e-01f, 9.256617427e-01f, 3.783521950e-01f, 9.762892723e-01f, 2.164698690e-01f, 9.924816489e-01f, 1.223936230e-01f, 9.976204634e-01f, 6.894526631e-02f, 9.992473125e-01f, 3.879181668e-02f, 9.997619390e-01f, 2.181798220e-02f, 9.999247193e-01f, 1.226981916e-02f,
6.333191991e-01f, 7.738906741e-01f, -9.384513646e-02f, 9.955868125e-01f, -9.895353913e-01f, -1.442903578e-01f, 9.929971695e-01f, -1.181379855e-01f, 7.539022565e-01f, 6.569865942e-01f, -7.004299760e-01f, -7.137210965e-01f, -5.994372964e-01f, 8.004217148e-01f, 3.202570081e-01f, 9.473307133e-01f, 7.648422122e-01f, 6.442176700e-01f, 9.235194325e-01f, 3.835515678e-01f, 9.755998850e-01f, 2.195560932e-01f, 9.922624230e-01f, 1.241583377e-01f, 9.975510240e-01f, 6.994284689e-02f, 9.992253184e-01f, 3.935372457e-02f, 9.997550249e-01f, 2.213413455e-02f, 9.999225140e-01f, 1.244763471e-02f,
-3.090227246e-01f, 9.510546327e-01f, -6.102110744e-01f, 7.922388911e-01f, -8.955979943e-01f, -4.448643327e-01f, 9.982355237e-01f, 5.937835947e-02f, 6.845467091e-01f, 7.289689779e-01f, -6.592084765e-01f, -7.519602180e-01f, -6.244450212e-01f, 7.810688019e-01f, 3.033610582e-01f, 9.528756738e-01f, 7.583618760e-01f, 6.518337727e-01f, 9.213479757e-01f, 3.887388110e-01f, 9.749007225e-01f, 2.226400971e-01f, 9.920400381e-01f, 1.259226501e-01f, 9.974805713e-01f, 7.094036788e-02f, 9.992030263e-01f, 3.991562501e-02f, 9.997479320e-01f, 2.245028317e-02f, 9.999203086e-01f, 1.262544841e-02f,
-9.672505856e-01f, 2.538233697e-01f, -9.386403561e-01f, 3.448974490e-01f, -7.128450871e-01f, -7.013215423e-01f, 9.719900489e-01f, 2.350219339e-01f, 6.083510518e-01f, 7.936680317e-01f, -6.159027219e-01f, -7.878221869e-01f, -6.488281488e-01f, 7.609349489e-01f, 2.863692045e-01f, 9.581193328e-01f, 7.518057823e-01f, 6.593846679e-01f, 9.191473722e-01f, 3.939137757e-01f, 9.741917849e-01f, 2.257218957e-01f, 9.918145537e-01f, 1.276865751e-01f, 9.974091053e-01f, 7.193781435e-02f, 9.991804361e-01f, 4.047751427e-02f, 9.997408390e-01f, 2.276643179e-02f, 9.999180436e-01f, 1.280326117e-02f,
-7.361927032e-01f, -6.767719388e-01f, -9.779862761e-01f, -2.086692750e-01f, -4.593983889e-01f, -8.882303238e-01f, 9.150884748e-01f, 4.032530487e-01f, 5.260773301e-01f, 8.504367471e-01f, -5.706502199e-01f, -8.211932182e-01f, -6.725627184e-01f, 7.400401235e-01f, 2.692867517e-01f, 9.630600214e-01f, 7.451744676e-01f, 6.668695807e-01f, 9.169177413e-01f, 3.990762532e-01f, 9.734731317e-01f, 2.288014293e-01f, 9.915859103e-01f, 1.294501126e-01f, 9.973366857e-01f, 7.293518633e-02f, 9.991575480e-01f, 4.103938490e-02f, 9.997335672e-01f, 2.308257483e-02f, 9.999157190e-01f, 1.298107579e-02f,
1.717173457e-01f, -9.851462841e-01f, -7.161304951e-01f, -6.979663968e-01f, -1.603949666e-01f, -9.870529175e-01f, 8.293254972e-01f, 5.587657690e-01f, 4.385472536e-01f, 8.987081051e-01f, -5.235932469e-01f, -8.519684076e-01f, -6.956245899e-01f, 7.184054852e-01f, 2.521191835e-01f, 9.676961899e-01f, 7.384685278e-01f, 6.742879152e-01f, 9.146590829e-01f, 4.042260945e-01f, 9.727447033e-01f, 2.318786681e-01f, 9.913541675e-01f, 1.312132180e-01f, 9.972632527e-01f, 7.393248379e-02f, 9.991343021e-01f, 4.160124436e-02f, 9.997262359e-01f, 2.339871787e-02f, 9.999133945e-01f, 1.315888762e-02f,
9.217512608e-01f, -3.877816498e-01f, -2.337207645e-01f, -9.723037481e-01f, 1.545165181e-01f, -9.879902005e-01f, 7.174060345e-01f, 6.966552734e-01f, 3.466353416e-01f, 9.379999638e-01f, -4.748813212e-01f, -8.800498247e-01f, -7.179910541e-01f, 6.960523129e-01f, 2.348718494e-01f, 9.720263481e-01f, 7.316888571e-01f, 6.816387773e-01f, 9.123715162e-01f, 4.093632102e-01f, 9.720066190e-01f, 2.349535823e-01f, 9.911192656e-01f, 1.329759061e-01f, 9.971888065e-01f, 7.492970675e-02f, 9.991107583e-01f, 4.216309637e-02f, 9.997187853e-01f, 2.371485718e-02f, 9.999110699e-01f, 1.333669946e-02f,
8.243313432e-01f, 5.661076307e-01f, 3.206739426e-01f, -9.471896291e-01f, 4.541028738e-01f, -8.909492493e-01f, 5.828598738e-01f, 8.125726581e-01f, 2.512599528e-01f, 9.679196477e-01f, -4.246677160e-01f, -9.053493142e-01f, -7.396394610e-01f, 6.730033755e-01f, 2.175502628e-01f, 9.760491252e-01f, 7.248359919e-01f, 6.889214516e-01f, 9.100551009e-01f, 4.144873321e-01f, 9.712587595e-01f, 2.380261570e-01f, 9.908812046e-01f, 1.347381920e-01f, 9.971134067e-01f, 7.592686266e-02f, 9.990868568e-01f, 4.272492975e-02f, 9.997112155e-01f, 2.403099649e-02f, 9.999086857e-01f, 1.351451222e-02f,
-3.097503260e-02f, 9.995201826e-01f, 7.763037086e-01f, -6.303589940e-01f, 7.086563706e-01f, -7.055538297e-01f, 4.299306870e-01f, 9.028618932e-01f, 1.533735693e-01f, 9.881682992e-01f, -3.731119633e-01f, -9.277863503e-01f, -7.605484128e-01f, 6.492812634e-01f, 2.001598924e-01f, 9.797632694e-01f, 7.179107070e-01f, 6.961352229e-01f, 9.077098370e-01f, 4.195984006e-01f, 9.705011845e-01f, 2.410963625e-01f, 9.906400442e-01f, 1.365000308e-01f, 9.970369935e-01f, 7.692394406e-02f, 9.990627170e-01f, 4.328674823e-02f, 9.997035861e-01f, 2.434713021e-02f, 9.999062419e-01f, 1.369232405e-02f,
-8.578031063e-01f, 5.139784217e-01f, 9.928478599e-01f, -1.193865910e-01f, 8.929339647e-01f, -4.501876533e-01f, 2.634407580e-01f, 9.646756053e-01f, 5.395522714e-02f, 9.985433817e-01f, -3.203761876e-01f, -9.472904205e-01f, -7.806967497e-01f, 6.249100566e-01f, 1.827063411e-01f, 9.831675291e-01f, 7.109135985e-01f, 7.032793760e-01f, 9.053359628e-01f, 4.246961474e-01f, 9.697338939e-01f, 2.441641390e-01f, 9.903957844e-01f, 1.382614523e-01f, 9.969595671e-01f, 7.792093605e-02f, 9.990381598e-01f, 4.384855926e-02f, 9.996958375e-01f, 2.466326393e-02f, 9.999037981e-01f, 1.387013402e-02f,
-8.959709406e-01f, -4.441126585e-01f, 9.036121368e-01f, 4.283516109e-01f, 9.886589646e-01f, -1.501781940e-01f, 8.864288777e-02f, 9.960634708e-01f, -4.600222036e-02f, 9.989413619e-01f, -2.666280270e-01f, -9.637995362e-01f, -8.000645638e-01f, 5.999138951e-01f, 1.651948988e-01f, 9.862609506e-01f, 7.038453221e-01f, 7.103532553e-01f, 9.029334188e-01f, 4.297804832e-01f, 9.689569473e-01f, 2.472294867e-01f, 9.901483059e-01f, 1.400224417e-01f, 9.968811274e-01f, 7.891785353e-02f, 9.990133643e-01f, 4.441035166e-02f, 9.996879697e-01f, 2.497939393e-02f, 9.999012947e-01f, 1.404794492e-02f,
-1.103872433e-01f, -9.938886762e-01f, 5.360818505e-01f, 8.441659808e-01f, 9.863393307e-01f, 1.647261530e-01f, -8.895073086e-02f, 9.960360527e-01f, -1.455000341e-01f, 9.893582463e-01f, -2.120364457e-01f, -9.772617817e-01f, -8.186323047e-01f, 5.743179917e-01f, 1.476312131e-01f, 9.890424609e-01f, 6.967067122e-01f, 7.173560858e-01f, 9.005023241e-01f, 4.348512292e-01f, 9.681702852e-01f, 2.502923310e-01f, 9.898977876e-01f, 1.417829692e-01f, 9.968017340e-01f, 7.991469651e-02f, 9.989882708e-01f, 4.497213289e-02f, 9.996800423e-01f, 2.529552206e-02f, 9.998987913e-01f, 1.422575582e-02f,
7.766859531e-01f, -6.298879981e-01f, 3.445185488e-03f, 9.999940395e-01f, 8.862052560e-01f, 4.632928669e-01f, -2.637388706e-01f, 9.645941257e-01f, -2.435445338e-01f, 9.698897004e-01f, -1.567750126e-01f, -9.876343608e-01f, -8.363815546e-01f, 5.481476784e-01f, 1.300208420e-01f, 9.915112853e-01f, 6.894984245e-01f, 7.242871523e-01f, 8.980427384e-01f, 4.399082065e-01f, 9.673739672e-01f, 2.533527315e-01f, 9.896440506e-01f, 1.435430646e-01f, 9.967212677e-01f, 8.091145754e-02f, 9.989628196e-01f, 4.553389549e-02f, 9.996719956e-01f, 2.561164647e-02f, 9.998962879e-01f, 1.440356486e-02f,
9.496777058e-01f, 3.132287860e-01f, -5.302492976e-01f, 8.478417993e-01f, 6.981857419e-01f, 7.159166336e-01f, -4.302088320e-01f, 9.027293921e-01f, -3.391546607e-01f, 9.407306314e-01f, -1.010174751e-01f, -9.948846698e-01f, -8.532945514e-01f, 5.214292407e-01f, 1.123693660e-01f, 9.936665297e-01f, 6.822211742e-01f, 7.311458588e-01f, 8.955547810e-01f, 4.449512959e-01f, 9.665679932e-01f, 2.564105392e-01f, 9.893872738e-01f, 1.453027129e-01f, 9.966399074e-01f, 8.190813661e-02f, 9.989370108e-01f, 4.609564692e-02f, 9.996638298e-01f, 2.592777088e-02f, 9.998936653e-01f, 1.458137389e-02f,
2.495401055e-01f, 9.683644772e-01f, -9.006391764e-01f, 4.345676303e-01f, 4.409287572e-01f, 8.975421190e-01f, -5.831102729e-01f, 8.123930097e-01f, -4.313769937e-01f, 9.021717310e-01f, -4.494105279e-02f, -9.989896417e-01f, -8.693541884e-01f, 4.941895902e-01f, 9.468235075e-02f, 9.955075383e-01f, 6.748757362e-01f, 7.379313707e-01f, 8.930384517e-01f, 4.499803185e-01f, 9.657523036e-01f, 2.594658434e-01f, 9.891272783e-01f, 1.470618844e-01f, 9.965574741e-01f, 8.290474117e-02f, 9.989109635e-01f, 4.665738344e-02f, 9.996555448e-01f, 2.624388970e-02f, 9.998911023e-01f, 1.475918386e-02f,
-6.800234914e-01f, 7.331902981e-01f, -9.936468601e-01f, -1.125427037e-01f, 1.399453431e-01f, 9.901592135e-01f, -7.176206112e-01f, 6.964342594e-01f, -5.192891359e-01f, 8.545985818e-01f, 1.127792522e-02f, -9.999364018e-01f, -8.845446110e-01f, 4.664555788e-01f, 7.696539164e-02f, 9.970337749e-01f, 6.674628258e-01f, 7.446430922e-01f, 8.904939294e-01f, 4.549950957e-01f, 9.649269581e-01f, 2.625184953e-01f, 9.888642430e-01f, 1.488205791e-01f, 9.964740872e-01f, 8.390125632e-02f, 9.988845587e-01f, 4.721910506e-02f, 9.996472001e-01f, 2.656000853e-02f, 9.998884201e-01f, 1.493699197e-02f,
-9.843766689e-01f, -1.760756075e-01f, -7.806286812e-01f, -6.249951124e-01f, -1.749181598e-01f, 9.845829606e-01f, -8.294976354e-01f, 5.585102439e-01f, -6.020119190e-01f, 7.984871268e-01f, 6.746077538e-02f, -9.977219105e-01f, -8.988505006e-01f, 4.382553995e-01f, 5.922409892e-02f, 9.982447028e-01f, 6.599831581e-01f, 7.512803674e-01f, 8.879212737e-01f, 4.599954784e-01f, 9.640919566e-01f, 2.655685544e-01f, 9.885979891e-01f, 1.505788416e-01f, 9.963896871e-01f, 8.489768207e-02f, 9.988578558e-01f, 4.778081179e-02f, 9.996387959e-01f, 2.687612176e-02f, 9.998857379e-01f, 1.511479914e-02f,
-3.836984336e-01f, -9.234584570e-01f, -3.271927834e-01f, -9.449576139e-01f, -4.724333286e-01f, 8.813664317e-01f, -9.152126908e-01f, 4.029710889e-01f, -6.787203550e-01f, 7.343968153e-01f, 1.234308258e-01f, -9.923532009e-01f, -9.122576714e-01f, 4.096167684e-01f, 4.146407545e-02f, 9.991400242e-01f, 6.524375081e-01f, 7.578425407e-01f, 8.853204846e-01f, 4.649813473e-01f, 9.632473588e-01f, 2.686159313e-01f, 9.883286953e-01f, 1.523365974e-01f, 9.963042736e-01f, 8.589403331e-02f, 9.988307953e-01f, 4.834250361e-02f, 9.996302128e-01f, 2.719223499e-02f, 9.998830557e-01f, 1.529260725e-02f,
5.697503090e-01f, -8.218178153e-01f, 2.270120084e-01f, -9.738919735e-01f, -7.230991125e-01f, 6.907442808e-01f, -9.720626473e-01f, 2.347215265e-01f, -7.486464977e-01f, 6.629694104e-01f, 1.790106595e-01f, -9.838471413e-01f, -9.247525930e-01f, 3.805688024e-01f, 2.369106375e-02f, 9.997193217e-01f, 6.448265314e-01f, 7.643289566e-01f, 8.826917410e-01f, 4.699524939e-01f, 9.623931050e-01f, 2.716606259e-01f, 9.880561829e-01f, 1.540938765e-01f, 9.962179065e-01f, 8.689029515e-02f, 9.988034964e-01f, 4.890418053e-02f, 9.996215701e-01f, 2.750834450e-02f, 9.998803139e-01f, 1.547041349e-02f,
9.993732572e-01f, 3.539830074e-02f, 7.113042474e-01f, -7.028842568e-01f, -9.020542502e-01f, 4.316227138e-01f, -9.982538819e-01f, 5.906983837e-02f, -8.110930920e-01f, 5.849170685e-01f, 2.340240777e-01f, -9.722307920e-01f, -9.363229275e-01f, 3.511400521e-01f, 5.910437554e-03f, 9.999825358e-01f, 6.371511221e-01f, 7.707388997e-01f, 8.800350428e-01f, 4.749087691e-01f, 9.615292549e-01f, 2.747026384e-01f, 9.877806306e-01f, 1.558506787e-01f, 9.961305261e-01f, 8.788647503e-02f, 9.987758398e-01f, 4.946583882e-02f, 9.996128082e-01f, 2.782445215e-02f, 9.998775721e-01f, 1.564821973e-02f,
5.101770163e-01f, 8.600693941e-01f, 9.765252471e-01f, -2.154029608e-01f, -9.915538430e-01f, 1.296956539e-01f, -9.929606318e-01f, -1.184448823e-01f, -8.654354811e-01f, 5.010203719e-01f, 2.882981002e-01f, -9.575406909e-01f, -9.469569325e-01f, 3.213604093e-01f, -1.187205687e-02f, 9.999295473e-01f, 6.294120550e-01f, 7.770717740e-01f, 8.773505092e-01f, 4.798500240e-01f, 9.606557488e-01f, 2.777418792e-01f, 9.875019193e-01f, 1.576069742e-01f, 9.960421324e-01f, 8.888255060e-02f, 9.987478256e-01f, 5.002748594e-02f, 9.996039867e-01f, 2.814055420e-02f, 9.998747706e-01f, 1.582602598e-02f,
-4.480736256e-01f, 8.939966559e-01f, 9.409945607e-01f, 3.384217024e-01f, -9.827213287e-01f, -1.850914657e-01f, -9.563499093e-01f, -2.922239304e-01f, -9.111302495e-01f, 4.121184647e-01f, 3.416602314e-01f, -9.398235083e-01f, -9.566441774e-01f, 2.912592292e-01f, -2.965079620e-02f, 9.995602965e-01f, 6.216099858e-01f, 7.833269238e-01f, 8.746382594e-01f, 4.847761393e-01f, 9.597726464e-01f, 2.807783484e-01f, 9.872201085e-01f, 1.593627781e-01f, 9.959527254e-01f, 8.987855166e-02f, 9.987195730e-01f, 5.058911443e-02f, 9.995950460e-01f, 2.845665626e-02f, 9.998719096e-01f, 1.600383036e-02f,
-9.943674803e-01f, 1.059875116e-01f, 6.156554222e-01f, 7.880154848e-01f, -8.764333129e-01f, -4.815232456e-01f, -8.895764351e-01f, -4.567863345e-01f, -9.477217197e-01f, 3.190979958e-01f, 3.939426839e-01f, -9.191350341e-01f, -9.653747678e-01f, 2.608670294e-01f, -4.742016271e-02f, 9.988750219e-01f, 6.137457490e-01f, 7.895037532e-01f, 8.718983531e-01f, 4.896869063e-01f, 9.588799477e-01f, 2.838120162e-01f, 9.869351387e-01f, 1.611180753e-01f, 9.958623648e-01f, 9.087446332e-02f, 9.986909628e-01f, 5.115072429e-02f, 9.995859861e-01f, 2.877275459e-02f, 9.998690486e-01f, 1.618163660e-02f,
-6.264444590e-01f, -7.794660926e-01f, 1.007066220e-01f, 9.949161410e-01f, -6.832289696e-01f, -7.302041650e-01f, -7.947461605e-01f, -6.069419384e-01f, -9.748435616e-01f, 2.228900939e-01f, 4.449792802e-01f, -8.955408931e-01f, -9.731400609e-01f, 2.302137464e-01f, -6.517452747e-02f, 9.978739023e-01f, 6.058201790e-01f, 7.956016064e-01f, 8.691309094e-01f, 4.945821762e-01f, 9.579776525e-01f, 2.868428528e-01f, 9.866470695e-01f, 1.628728807e-01f, 9.957709908e-01f, 9.187027812e-02f, 9.986619949e-01f, 5.171232671e-02f, 9.995768070e-01f, 2.908885106e-02f, 9.998661876e-01f, 1.635944098e-02f,
3.174287081e-01f, -9.482821226e-01f, -4.452612102e-01f, 8.954007030e-01f, -4.222704768e-01f, -9.064698815e-01f, -6.748499870e-01f, -7.379549146e-01f, -9.922253489e-01f, 1.244542375e-01f, 4.946095049e-01f, -8.691152930e-01f, -9.799323082e-01f, 1.993305236e-01f, -8.290828764e-02f, 9.965571761e-01f, 5.978339314e-01f, 8.016199470e-01f, 8.663359284e-01f, 4.994617999e-01f, 9.570658207e-01f, 2.898707688e-01f, 9.863558412e-01f, 1.646271497e-01f, 9.956786036e-01f, 9.286600351e-02f, 9.986327887e-01f, 5.227390677e-02f, 9.995675683e-01f, 2.940494195e-02f, 9.998632669e-01f, 1.653724350e-02f,
9.694593549e-01f, -2.452519834e-01f, -8.540936708e-01f, 5.201192498e-01f, -1.194339693e-01f, -9.928421378e-01f, -5.336694121e-01f, -8.456931710e-01f, -9.996930361e-01f, 2.477485314e-02f, 5.426756740e-01f, -8.399423361e-01f, -9.857447147e-01f, 1.682477444e-01f, -1.006158292e-01f, 9.949253798e-01f, 5.897880197e-01f, 8.075581193e-01f, 8.635135293e-01f, 5.043256879e-01f, 9.561443329e-01f, 2.928958237e-01f, 9.860615730e-01f, 1.663808972e-01f, 9.955852628e-01f, 9.386163205e-02f, 9.986032248e-01f, 5.283546820e-02f, 9.995582104e-01f, 2.972103283e-02f, 9.998602867e-01f, 1.671504788e-02f,
7.301735282e-01f, 6.832616925e-01f, -9.998821616e-01f, -1.535241678e-02f, 1.952449679e-01f, -9.807544947e-01f, -3.756571114e-01f, -9.267587066e-01f, -9.971721768e-01f, -7.515111566e-02f, 5.890265703e-01f, -8.081136942e-01f, -9.905714393e-01f, 1.369969547e-01f, -1.182915568e-01f, 9.929789305e-01f, 5.816830993e-01f, 8.134155273e-01f, 8.606638908e-01f, 5.091735721e-01f, 9.552133679e-01f, 2.959179580e-01f, 9.857641459e-01f, 1.681341380e-01f, 9.954909086e-01f, 9.485717118e-02f, 9.985733628e-01f, 5.339701846e-02f, 9.995487928e-01f, 3.003711812e-02f, 9.998573065e-01f, 1.689285226e-02f,
-1.804304570e-01f, 9.835877419e-01f, -8.377248049e-01f, -5.460926294e-01f, 4.905616641e-01f, -8.714064956e-01f, -2.057968229e-01f, -9.785947204e-01f, -9.846878052e-01f, -1.743271649e-01f, 6.335148811e-01f, -7.737304568e-01f, -9.944077134e-01f, 1.056089550e-01f, -1.359298676e-01f, 9.907184839e-01f, 5.735200047e-01f, 8.191915751e-01f, 8.577870131e-01f, 5.140053630e-01f, 9.542728066e-01f, 2.989371121e-01f, 9.854635596e-01f, 1.698868275e-01f, 9.953955412e-01f, 9.585261345e-02f, 9.985432029e-01f, 5.395854637e-02f, 9.995392561e-01f, 3.035320155e-02f, 9.998542666e-01f, 1.707065292e-02f,
-9.251475334e-01f, 3.796077371e-01f, -4.175648987e-01f, -9.086471200e-01f, 7.372311950e-01f, -6.756405830e-01f, -2.944579907e-02f, -9.995663762e-01f, -9.623649120e-01f, -2.717604339e-01f, 6.760007739e-01f, -7.369009256e-01f, -9.972496629e-01f, 7.411535084e-02f, -1.535250843e-01f, 9.881447554e-01f, 5.652995706e-01f, 8.248857260e-01f, 8.548829556e-01f, 5.188208818e-01f, 9.533227086e-01f, 3.019533157e-01f, 9.851599336e-01f, 1.716389805e-01f, 9.952991605e-01f, 9.684795886e-02f, 9.985126853e-01f, 5.452005938e-02f, 9.995296001e-01f, 3.066928312e-02f, 9.998512268e-01f, 1.724845544e-02f,
-8.192882538e-01f, -5.733818412e-01f, 1.312005073e-01f, -9.913558364e-01f, 9.107885361e-01f, -4.128731191e-01f, 1.478339285e-01f, -9.890121818e-01f, -9.304261804e-01f, -3.664793074e-01f, 7.163491845e-01f, -6.977419257e-01f, -9.990944266e-01f, 4.254788160e-02f, -1.710718721e-01f, 9.852585793e-01f, 5.570225716e-01f, 8.304973245e-01f, 8.519519567e-01f, 5.236200094e-01f, 9.523630738e-01f, 3.049664497e-01f, 9.848531485e-01f, 1.733906120e-01f, 9.952018261e-01f, 9.784321487e-02f, 9.984818697e-01f, 5.508155748e-02f, 9.995198250e-01f, 3.098535910e-02f, 9.998481274e-01f, 1.742625609e-02f,
3.982087970e-02f, -9.992068410e-01f, 6.395553350e-01f, -7.687450647e-01f, 9.940242171e-01f, -1.091595069e-01f, 3.204510510e-01f, -9.472650886e-01f, -8.891909122e-01f, -4.575363994e-01f, 7.544332147e-01f, -6.563767791e-01f, -9.999401569e-01f, 1.093762368e-02f, -1.885645688e-01f, 9.820607901e-01f, 5.486899018e-01f, 8.360259533e-01f, 8.489939570e-01f, 5.284025669e-01f, 9.513939619e-01f, 3.079765737e-01f, 9.845432639e-01f, 1.751416773e-01f, 9.951034784e-01f, 9.883836657e-02f, 9.984506965e-01f, 5.564303696e-02f, 9.995099902e-01f, 3.130143136e-02f, 9.998450279e-01f, 1.760405675e-02f,
8.623188734e-01f, -5.063656569e-01f, 9.509409070e-01f, -3.093724847e-01f, 9.786828160e-01f, 2.053775787e-01f, 4.829612970e-01f, -8.756417036e-01f, -8.390715122e-01f, -5.440210700e-01f, 7.901318669e-01f, -6.129369140e-01f, -9.997860789e-01f, -2.068333142e-02f, -2.059976310e-01f, 9.785524607e-01f, 5.403022766e-01f, 8.414710164e-01f, 8.460091352e-01f, 5.331684351e-01f, 9.504152536e-01f, 3.109835982e-01f, 9.842302203e-01f, 1.768921912e-01f, 9.950041771e-01f, 9.983342141e-02f, 9.984192848e-01f, 5.620449409e-02f, 9.995000362e-01f, 3.161750361e-02f, 9.998418689e-01f, 1.778185740e-02f,
8.920048475e-01f, 4.520258009e-01f, 9.694527388e-01f, 2.452782542e-01f, 8.662855029e-01f, 4.995492697e-01f, 6.302406788e-01f, -7.763997912e-01f, -7.805679440e-01f, -6.250709295e-01f, 8.233328462e-01f, -5.675588250e-01f, -9.986322522e-01f, -5.228384212e-02f, -2.233655602e-01f, 9.747347236e-01f, 5.318607092e-01f, 8.468318582e-01f, 8.429974914e-01f, 5.379174352e-01f, 9.494271278e-01f, 3.139874935e-01f, 9.839141369e-01f, 1.786421537e-01f, 9.949038625e-01f, 1.008283719e-01f, 9.983875155e-01f, 5.676594004e-02f, 9.994900227e-01f, 3.193357214e-02f, 9.998387098e-01f, 1.795965619e-02f,
1.015857086e-01f, 9.948267937e-01f, 6.893923283e-01f, 7.243881822e-01f, 6.679785848e-01f, 7.441805601e-01f, 7.576409578e-01f, -6.526715755e-01f, -7.142657638e-01f, -6.998745203e-01f, 8.539305925e-01f, -5.203868747e-01f, -9.964799285e-01f, -8.383183926e-02f, -2.406628430e-01f, 9.706087708e-01f, 5.233659744e-01f, 8.521080017e-01f, 8.399593234e-01f, 5.426494479e-01f, 9.484294653e-01f, 3.169882894e-01f, 9.835948944e-01f, 1.803915352e-01f, 9.948025346e-01f, 1.018232331e-01f, 9.983554482e-01f, 5.732736737e-02f, 9.994798303e-01f, 3.224964067e-02f, 9.998354912e-01f, 1.813745499e-02f,
-7.822308540e-01f, 6.229886413e-01f, 1.970090568e-01f, 9.804016948e-01f, 4.034298062e-01f, 9.150105715e-01f, 8.611455560e-01f, -5.083584189e-01f, -6.408262849e-01f, -7.676859498e-01f, 8.818289638e-01f, -4.715693891e-01f, -9.933311343e-01f, -1.152962446e-01f, -2.578840256e-01f, 9.661758542e-01f, 5.148188472e-01f, 8.572989702e-01f, 8.368944526e-01f, 5.473642945e-01f, 9.474223256e-01f, 3.199858963e-01f, 9.832725525e-01f, 1.821403503e-01f, 9.947001934e-01f, 1.028179824e-01f, 9.983230233e-01f, 5.788877234e-02f, 9.994695783e-01f, 3.256569803e-02f, 9.998322725e-01f, 1.831525378e-02f,
-9.468680024e-01f, -3.216224015e-01f, -3.560463190e-01f, 9.344683290e-01f, 9.887336940e-02f, 9.951000214e-01f, 9.374901056e-01f, -3.480119109e-01f, -5.609837770e-01f, -8.278267980e-01f, 9.069392681e-01f, -4.212614298e-01f, -9.891891479e-01f, -1.466451287e-01f, -2.750236690e-01f, 9.614374638e-01f, 5.062202811e-01f, 8.624042273e-01f, 8.338031769e-01f, 5.520617962e-01f, 9.464057088e-01f, 3.229803145e-01f, 9.829471111e-01f, 1.838885993e-01f, 9.945968986e-01f, 1.038126275e-01f, 9.982903004e-01f, 5.845016241e-02f, 9.994592667e-01f, 3.288175911e-02f, 9.998289943e-01f, 1.849305071e-02f,
-2.409590483e-01f, -9.705352783e-01f, -7.994487882e-01f, 6.007342339e-01f, -2.154882401e-01f, 9.765064120e-01f, 9.842666984e-01f, -1.766892821e-01f, -4.755369425e-01f, -8.796957731e-01f, 9.291825294e-01f, -3.696212471e-01f, -9.840580225e-01f, -1.778476238e-01f, -2.920763195e-01f, 9.563950300e-01f, 4.975710809e-01f, 8.674232364e-01f, 8.306855559e-01f, 5.567418337e-01f, 9.453796148e-01f, 3.259714842e-01f, 9.826185107e-01f, 1.856362671e-01f, 9.944925904e-01f, 1.048071757e-01f, 9.982572794e-01f, 5.901153386e-02f, 9.994487762e-01f, 3.319781274e-02f, 9.998256564e-01f, 1.867084950e-02f,
6.864865422e-01f, -7.271425128e-01f, -9.966333508e-01f, 8.198728412e-02f, -5.084800720e-01f, 8.610737324e-01f, 1.000000000e+00f, 2.060413535e-04f, -3.853378594e-01f, -9.227755666e-01f, 9.484879971e-01f, -3.168129921e-01f, -9.779430032e-01f, -2.088720351e-01f, -3.090365231e-01f, 9.510501623e-01f, 4.888721108e-01f, 8.723554611e-01f, 8.275416493e-01f, 5.614042878e-01f, 9.443440437e-01f, 3.289594054e-01f, 9.822868705e-01f, 1.873833388e-01f, 9.943872690e-01f, 1.058016121e-01f, 9.982239604e-01f, 5.957288295e-02f, 9.994382262e-01f, 3.351386636e-02f, 9.998223782e-01f, 1.884864643e-02f,
9.827795625e-01f, 1.847817302e-01f, -8.868746758e-01f, -4.620101154e-01f, -7.510490417e-01f, 6.602464318e-01f, 9.841938019e-01f, 1.770948619e-01f, -2.912894785e-01f, -9.566349387e-01f, 9.647951126e-01f, -2.630026639e-01f, -9.708499908e-01f, -2.396878302e-01f, -3.258991241e-01f, 9.454045296e-01f, 4.801242650e-01f, 8.772004843e-01f, 8.243715763e-01f, 5.660489798e-01f, 9.432991147e-01f, 3.319440186e-01f, 9.819520712e-01f, 1.891298145e-01f, 9.942809343e-01f, 1.067959517e-01f, 9.981902838e-01f, 6.013421714e-02f, 9.994276166e-01f, 3.382991254e-02f, 9.998189807e-01f, 1.902644150e-02f,
3.755095899e-01f, 9.268184900e-01f, -5.039728284e-01f, -8.637195230e-01f, -9.191339612e-01f, 3.939450979e-01f, 9.373466372e-01f, 3.483982384e-01f, -1.943297088e-01f, -9.809362888e-01f, 9.780520201e-01f, -2.083608955e-01f, -9.627863169e-01f, -2.702637315e-01f, -3.426586390e-01f, 9.394599795e-01f, 4.713284373e-01f, 8.819577694e-01f, 8.211753964e-01f, 5.706758499e-01f, 9.422446489e-01f, 3.349253237e-01f, 9.816142321e-01f, 1.908757091e-01f, 9.941736460e-01f, 1.077901721e-01f, 9.981563091e-01f, 6.069553271e-02f, 9.994168282e-01f, 3.414595872e-02f, 9.998155832e-01f, 1.920423657e-02f,
-5.770022273e-01f, 8.167425990e-01f, 3.414078429e-02f, -9.994170070e-01f, -9.960693717e-01f, 8.857665956e-02f, 8.609359860e-01f, 5.087132454e-01f, -9.542828053e-02f, -9.954363108e-01f, 9.882167578e-01f, -1.530608535e-01f, -9.537598491e-01f, -3.005696237e-01f, -3.593098223e-01f, 9.332183003e-01f, 4.624853432e-01f, 8.866268992e-01f, 8.179532886e-01f, 5.752846003e-01f, 9.411808252e-01f, 3.379032910e-01f, 9.812732339e-01f, 1.926209927e-01f, 9.940654039e-01f, 1.087842956e-01f, 9.981220365e-01f, 6.125682592e-02f, 9.994059801e-01f, 3.446200117e-02f, 9.998121262e-01f, 1.938203163e-02f,
-9.990208149e-01f, -4.424267635e-02f, 5.617429614e-01f, -8.273118138e-01f, -9.742255807e-01f, -2.255758345e-01f, 7.573719025e-01f, 6.529837251e-01f, 4.425697960e-03f, -9.999902248e-01f, 9.952573776e-01f, -9.727646410e-02f, -9.437798262e-01f, -3.305747509e-01f, -3.758473992e-01f, 9.266815782e-01f, 4.535961151e-01f, 8.912073374e-01f, 8.147053123e-01f, 5.798751712e-01f, 9.401075840e-01f, 3.408778608e-01f, 9.809291363e-01f, 1.943656504e-01f, 9.939560890e-01f, 1.097783074e-01f, 9.980874062e-01f, 6.181810424e-02f, 9.993950725e-01f, 3.477803990e-02f, 9.998086691e-01f, 1.955982484e-02f,
-5.025443435e-01f, -8.645514250e-01f, 9.163355827e-01f, -4.004111886e-01f, -8.557689190e-01f, -5.173581839e-01f, 6.299206614e-01f, 7.766594887e-01f, 1.042364091e-01f, -9.945525527e-01f, 9.991515279e-01f, -4.118499532e-02f, -9.328559637e-01f, -3.602495193e-01f, -3.922660947e-01f, 9.198517799e-01f, 4.446615279e-01f, 8.956986666e-01f, 8.114315867e-01f, 5.844473839e-01f, 9.390249252e-01f, 3.438490629e-01f, 9.805819392e-01f, 1.961097270e-01f, 9.938458204e-01f, 1.107722074e-01f, 9.980525374e-01f, 6.237935647e-02f, 9.993839860e-01f, 3.509407118e-02f, 9.998052120e-01f, 1.973761991e-02f,
4.559690952e-01f, -8.899955750e-01f, 9.887145162e-01f, 1.498119384e-01f, -6.524437070e-01f, -7.578372359e-01f, 4.826020896e-01f, 8.758397102e-01f, 2.030046880e-01f, -9.791777730e-01f, 9.998869300e-01f, 1.503714453e-02f, -9.209993482e-01f, -3.895640969e-01f, -4.085607529e-01f, 9.127311110e-01f, 4.356824458e-01f, 9.001004100e-01f, 8.081322312e-01f, 5.890011191e-01f, 9.379329085e-01f, 3.468167782e-01f, 9.802316427e-01f, 1.978531629e-01f, 9.937345386e-01f, 1.117659956e-01f, 9.980172515e-01f, 6.294059008e-02f, 9.993728399e-01f, 3.541010246e-02f, 9.998016953e-01f, 1.991541311e-02f,
9.952666163e-01f, -9.718190879e-02f, 7.565875053e-01f, 6.538924575e-01f, -3.844182491e-01f, -9.231590629e-01f, 3.200624883e-01f, 9.473964572e-01f, 2.997455299e-01f, -9.540191889e-01f, 9.974612594e-01f, 7.121126354e-02f, -9.082219005e-01f, -4.184889197e-01f, -4.247261286e-01f, 9.053218961e-01f, 4.266598225e-01f, 9.044122100e-01f, 8.048072457e-01f, 5.935363173e-01f, 9.368314743e-01f, 3.497810662e-01f, 9.798783064e-01f, 1.995959580e-01f, 9.936223030e-01f, 1.127596796e-01f, 9.979817271e-01f, 6.350180507e-02f, 9.993616343e-01f, 3.572613373e-02f, 9.997981191e-01f, 2.009320445e-02f,
6.195206046e-01f, 7.849804163e-01f, 2.914465666e-01f, 9.565871358e-01f, -7.827047259e-02f, -9.969321489e-01f, 1.474282593e-01f, 9.890727401e-01f, 3.934913874e-01f, -9.193283319e-01f, 9.918821454e-01f, 1.271607429e-01f, -8.945361972e-01f, -4.469954967e-01f, -4.407573938e-01f, 8.976262808e-01f, 4.175945222e-01f, 9.086334705e-01f, 8.014568090e-01f, 5.980526209e-01f, 9.357206821e-01f, 3.527418077e-01f, 9.795218110e-01f, 2.013381571e-01f, 9.935090542e-01f, 1.137532443e-01f, 9.979458451e-01f, 6.406301260e-02f, 9.993502498e-01f, 3.604215756e-02f, 9.997945428e-01f, 2.027099766e-02f,
-3.258098066e-01f, 9.454353452e-01f, -2.634541392e-01f, 9.646719098e-01f, 2.356393039e-01f, -9.718405604e-01f, -2.985579334e-02f, 9.995542169e-01f, 4.833047390e-01f, -8.754521608e-01f, 9.831672907e-01f, 1.827077270e-01f, -8.799561262e-01f, -4.750549197e-01f, -4.566490650e-01f, 8.896468878e-01f, 4.084874690e-01f, 9.127639532e-01f, 7.980811000e-01f, 6.025500894e-01f, 9.346005321e-01f, 3.556990325e-01f, 9.791622162e-01f, 2.030797005e-01f, 9.933947921e-01f, 1.147466898e-01f, 9.979096651e-01f, 6.462418288e-02f, 9.993388057e-01f, 3.635817394e-02f, 9.997909069e-01f, 2.044878900e-02f,
-9.715921879e-01f, 2.366613895e-01f, -7.372213602e-01f, 6.756513119e-01f, 5.261809826e-01f, -8.503726125e-01f, -2.061982006e-01f, 9.785102606e-01f, 5.682899356e-01f, -8.228283525e-01f, 9.713441133e-01f, 2.376775593e-01f, -8.644961119e-01f, -5.026394725e-01f, -4.723965526e-01f, 8.813861012e-01f, 3.993395865e-01f, 9.168030620e-01f, 7.946801186e-01f, 6.070284247e-01f, 9.334710836e-01f, 3.586527407e-01f, 9.787995219e-01f, 2.048205882e-01f, 9.932795167e-01f, 1.157400310e-01f, 9.978731871e-01f, 6.518533826e-02f, 9.993273020e-01f, 3.667419404e-02f, 9.997872710e-01f, 2.062657848e-02f,
-7.240971923e-01f, -6.896979213e-01f, -9.839316607e-01f, 1.785455495e-01f, 7.645443082e-01f, -6.445711255e-01f, -3.760372102e-01f, 9.266045690e-01f, 6.475961804e-01f, -7.619836926e-01f, 9.564502239e-01f, 2.918955386e-01f, -8.481717706e-01f, -5.297213197e-01f, -4.879944921e-01f, 8.728467226e-01f, 3.901517391e-01f, 9.207505584e-01f, 7.912539840e-01f, 6.114876866e-01f, 9.323322177e-01f, 3.616028130e-01f, 9.784337282e-01f, 2.065608501e-01f, 9.931632876e-01f, 1.167332530e-01f, 9.978363514e-01f, 6.574647129e-02f, 9.993156195e-01f, 3.699020669e-02f, 9.997835755e-01f, 2.080436796e-02f,
1.891294271e-01f, -9.819521904e-01f, -9.276105762e-01f, -3.735487163e-01f, 9.270853400e-01f, -3.748503029e-01f, -5.340162516e-01f, 8.454742432e-01f, 7.204326391e-01f, -6.935249567e-01f, 9.385324121e-01f, 3.451911509e-01f, -8.309991956e-01f, -5.562736392e-01f, -5.034382939e-01f, 8.640311956e-01f, 3.809248805e-01f, 9.246059656e-01f, 7.878028154e-01f, 6.159275174e-01f, 9.311841130e-01f, 3.645493090e-01f, 9.780648947e-01f, 2.083004564e-01f, 9.930460453e-01f, 1.177263632e-01f, 9.977992177e-01f, 6.630758941e-02f, 9.993038774e-01f, 3.730621934e-02f, 9.997798800e-01f, 2.098215744e-02f,
9.284713268e-01f, -3.714041114e-01f, -5.856038332e-01f, -8.105974197e-01f, 9.976883531e-01f, -6.795591116e-02f, -6.751540303e-01f, 7.376767993e-01f, 7.860706449e-01f, -6.181366444e-01f, 9.176476598e-01f, 3.973950148e-01f, -8.129957914e-01f, -5.822695494e-01f, -5.187226534e-01f, 8.549425602e-01f, 3.716599345e-01f, 9.283689260e-01f, 7.843267918e-01f, 6.203478575e-01f, 9.300266504e-01f, 3.674921393e-01f, 9.776929021e-01f, 2.100393921e-01f, 9.929278493e-01f, 1.187193394e-01f, 9.977617860e-01f, 6.686867774e-02f, 9.992920160e-01f, 3.762222081e-02f, 9.997761250e-01f, 2.115994506e-02f,
8.141809702e-01f, 5.806111693e-01f, -6.324278563e-02f, -9.979981780e-01f, 9.693515897e-01f, 2.456775755e-01f, -7.949962020e-01f, 6.066144109e-01f, 8.438539505e-01f, -5.365729332e-01f, 8.938615918e-01f, 4.483429790e-01f, -7.941793799e-01f, -6.076834202e-01f, -5.338430405e-01f, 8.455836177e-01f, 3.623578250e-01f, 9.320390821e-01f, 7.808259130e-01f, 6.247486472e-01f, 9.288598895e-01f, 3.704313040e-01f, 9.773178697e-01f, 2.117776722e-01f, 9.928086400e-01f, 1.197122112e-01f, 9.977239966e-01f, 6.742975861e-02f, 9.992800951e-01f, 3.793822229e-02f, 9.997723103e-01f, 2.133773454e-02f,
-4.866360873e-02f, 9.988152385e-01f, 4.786024988e-01f, -8.780316710e-01f, 8.448832631e-01f, 5.349507332e-01f, -8.897646070e-01f, 4.564197063e-01f, 8.932062984e-01f, -4.496471286e-01f, 8.672499061e-01f, 4.978730977e-01f, -7.745689750e-01f, -6.324894428e-01f, -5.487948060e-01f, 8.359571099e-01f, 3.530194759e-01f, 9.356159568e-01f, 7.773004174e-01f, 6.291296482e-01f, 9.276838303e-01f, 3.733667731e-01f, 9.769397378e-01f, 2.135152817e-01f, 9.926884174e-01f, 1.207049638e-01f, 9.976859689e-01f, 6.799080223e-02f, 9.992680550e-01f, 3.825422376e-02f, 9.997684956e-01f, 2.151552029e-02f,
-8.667671084e-01f, 4.987131655e-01f, 8.730400801e-01f, -4.876484275e-01f, 6.366297007e-01f, 7.711696625e-01f, -9.564702511e-01f, 2.918297648e-01f, 9.336335659e-01f, -3.582294583e-01f, 8.378961682e-01f, 5.458296537e-01f, -7.541838884e-01f, -6.566632986e-01f, -5.635727644e-01f, 8.260664344e-01f, 3.436457217e-01f, 9.390993714e-01f, 7.737502456e-01f, 6.334908009e-01f, 9.264984727e-01f, 3.762984574e-01f, 9.765585065e-01f, 2.152522057e-01f, 9.925672412e-01f, 1.216975898e-01f, 9.976475835e-01f, 6.855183095e-02f, 9.992558956e-01f, 3.857021779e-02f, 9.997646809e-01f, 2.169330604e-02f,
-8.879688978e-01f, -4.599034786e-01f, 9.985986948e-01f, 5.292089656e-02f, 3.652422130e-01f, 9.309124947e-01f, -9.930093288e-01f, 1.180356890e-01f, 9.647326469e-01f, -2.632316053e-01f, 8.058937788e-01f, 5.920601487e-01f, -7.330448627e-01f, -6.801803112e-01f, -5.781728029e-01f, 8.159143329e-01f, 3.342377245e-01f, 9.424887896e-01f, 7.701756358e-01f, 6.378318667e-01f, 9.253038764e-01f, 3.792264462e-01f, 9.761741757e-01f, 2.169884592e-01f, 9.924450517e-01f, 1.226900965e-01f, 9.976088405e-01f, 6.911283731e-02f, 9.992436171e-01f, 3.888620436e-02f, 9.997608066e-01f, 2.187109366e-02f,
-9.277620912e-02f, -9.956870079e-01f, 8.166087270e-01f, 5.771915913e-01f, 5.763408914e-02f, 9.983377457e-01f, -9.982294440e-01f, -5.948119611e-02f, 9.861924052e-01f, -1.656036228e-01f, 7.713432908e-01f, 6.364192963e-01f, -7.111726999e-01f, -7.030173540e-01f, -5.925897360e-01f, 8.055044413e-01f, 3.247962892e-01f, 9.457839727e-01f, 7.665767074e-01f, 6.421527267e-01f, 9.241000414e-01f, 3.821505904e-01f, 9.757867455e-01f, 2.187240422e-01f, 9.923218489e-01f, 1.236824766e-01f, 9.975697994e-01f, 6.967382133e-02f, 9.992312789e-01f, 3.920219466e-02f, 9.997568727e-01f, 2.204887755e-02f,
7.877145410e-01f, -6.160404682e-01f, 3.831194937e-01f, 9.236987829e-01f, -2.556895912e-01f, 9.667589068e-01f, -9.719658494e-01f, -2.351220697e-01f, 9.977982640e-01f, -6.632189453e-02f, 7.343545556e-01f, 6.787660718e-01f, -6.885895729e-01f, -7.251513004e-01f, -6.068195105e-01f, 7.948396206e-01f, 3.153223693e-01f, 9.489846230e-01f, 7.629535198e-01f, 6.464533210e-01f, 9.228869677e-01f, 3.850709498e-01f, 9.753962755e-01f, 2.204589099e-01f, 9.921976924e-01f, 1.246747300e-01f, 9.975304604e-01f, 7.023479044e-02f, 9.992188811e-01f, 3.951817751e-02f, 9.997529387e-01f, 2.222666144e-02f,
9.439841509e-01f, 3.299908042e-01f, -1.683704406e-01f, 9.857237935e-01f, -5.436599255e-01f, 8.393055797e-01f, -9.150469303e-01f, -4.033473432e-01f, 9.994345903e-01f, 3.362342715e-02f, 6.950438619e-01f, 7.189673185e-01f, -6.653177142e-01f, -7.465603352e-01f, -6.208572388e-01f, 7.839236856e-01f, 3.058169186e-01f, 9.520903230e-01f, 7.593061924e-01f, 6.507335305e-01f, 9.216646552e-01f, 3.879874349e-01f, 9.750027061e-01f, 2.221930772e-01f, 9.920725226e-01f, 1.256668717e-01f, 9.974908233e-01f, 7.079573721e-02f, 9.992063046e-01f, 3.983415663e-02f, 9.997490048e-01f, 2.240444534e-02f,
2.323590964e-01f, 9.726300836e-01f, -6.679986119e-01f, 7.441624999e-01f, -7.777124643e-01f, 6.286201477e-01f, -8.292679787e-01f, -5.588511825e-01f, 9.910848737e-01f, 1.332318485e-01f, 6.535362005e-01f, 7.568953037e-01f, -6.413808465e-01f, -7.672226429e-01f, -6.346988082e-01f, 7.727596164e-01f, 2.962808907e-01f, 9.551008344e-01f, 7.556348443e-01f, 6.549931169e-01f, 9.204331040e-01f, 3.909000754e-01f, 9.746060371e-01f, 2.239265591e-01f, 9.919463396e-01f, 1.266588867e-01f, 9.974508882e-01f, 7.135665417e-02f, 9.991936684e-01f, 4.015012830e-02f, 9.997450113e-01f, 2.258222736e-02f
};
namespace pg8 {
#define PG8_LAS __attribute__((address_space(3)))
typedef unsigned short bf16_t;
typedef short bf16x8 __attribute__((ext_vector_type(8)));
typedef float f32x4 __attribute__((ext_vector_type(4)));
typedef unsigned u32x4 __attribute__((ext_vector_type(4)));
constexpr int BM = 256, BK = 64, HALF = 128, HTB = HALF * BK * 2  , STAGE_BYTES = 8 * HTB, NXCD = 8, WGM = 8;

__host__ __device__ __forceinline__ int lds_byte(int r, int c) { const int st = (r >> 4) * 2 + (c >> 5), rr = r & 15, cc = c & 31, ob = rr * 64 + cc * 2; return st * 1024 + (ob ^ (((ob >> 9) & 1) << 5)); }
__host__ __device__ __forceinline__ void stage_rc(int b, int& R, int& C) { const int st = b / 1024, sb = b % 1024, swz = sb ^ (((sb >> 9) & 1) << 5); R = (st >> 1) * 16 + swz / 64; C = (st & 1) * 32 + (swz % 64) / 2; }
__host__ __device__ __forceinline__ int perm32(int rho) { const int n = rho >> 4, i = rho & 15; return 8 * (i >> 2) + 4 * n + (i & 3); }

__device__ __forceinline__ int pg8_lane_id() { int r_; asm volatile("v_mbcnt_lo_u32_b32 %0, -1, 0\n\tv_mbcnt_hi_u32_b32 %0, -1, %0" : "=v"(r_)); return r_; }
struct Unit { int pm, pn, kc; };
struct Gemm { const bf16_t* A; const bf16_t* Bt; int M, N, K, ld; };

struct StaticOrder {
    int nM, nN, nwg, G, c;
    __host__ __device__ void init(int M, int N, int G_, int c_) { nM = M / BM; nN = N / BM; nwg = nM * nN; G = G_; c = c_; }
    __host__ __device__ bool next(int i, Unit& u) const {
        const long L = (long)i * G + c; if (L >= nwg) return false;
        int wgid = (int)L; { const int q = nwg / NXCD, r = nwg % NXCD, xcd = wgid % NXCD, off = wgid / NXCD; wgid = (xcd < r ? xcd * (q + 1) : r * (q + 1) + (xcd - r) * q) + off; }
        const int nig = WGM * nN, gid = wgid / nig, fm = gid * WGM, gsz = (nM - fm) < WGM ? (nM - fm) : WGM;
        u.pm = fm + ((wgid % nig) % gsz); u.pn = (wgid % nig) / gsz; u.kc = 0; return true;
    }
    __device__ __forceinline__ void a_ready(const Unit&) const {}
    __device__ __forceinline__ void done(const Unit&) const {}
};
struct CtxSplitOrder {
    int n, G, c, nN;
    __host__ __device__ void init(int nN_, int nch, int G_, int c_) { nN = nN_; n = 2 * nN_ * nch; G = G_; c = c_; }
    __host__ __device__ bool next(int i, Unit& u) const { const int L = i * G + c; if (L >= n) return false; const int tile = L % (2 * nN); u.kc = L / (2 * nN); u.pm = tile / nN; u.pn = tile % nN; return true; }
    __device__ __forceinline__ void a_ready(const Unit&) const {}
    __device__ __forceinline__ void done(const Unit&) const {}
};

__device__ __forceinline__ unsigned cvt_pk_bf16(float lo, float hi) { unsigned r; asm volatile("v_cvt_pk_bf16_f32 %0, %1, %2" : "=v"(r) : "v"(lo), "v"(hi)); return r; }
template <class Epi, class Sched, bool ALIGN_EPI = false, bool SP2 = false>
__device__ __forceinline__ void gemm_phase(PG8_LAS unsigned char* lds, const Gemm g, const Sched& S, const Epi& E, const int wave_in) {
    int tid_ = wave_in * 64 + pg8_lane_id(); asm volatile("" : "+v"(tid_));
    const int tid = tid_, wid = __builtin_amdgcn_readfirstlane(tid >> 6), lane = tid & 63, wr = wid >> 2, wc = wid & 3, fr = lane & 15, fq = lane >> 4;
    const int K = g.K, nt = K / BK, ld = g.ld;
    unsigned voffA[2], voffB[2];
#pragma unroll
    for (int i = 0; i < 2; ++i) { int R, C; stage_rc(tid * 16 + i * 8192, R, C); const int Rb = Epi::PERM ? ((R & ~31) + perm32(R & 31)) : R;
        voffA[i] = (unsigned)(R * ld + C) * 2u; voffB[i] = (unsigned)(Rb * ld + C) * 2u; }
    const size_t kstep = (size_t)(BK * 2);
    const size_t hstep = (size_t)HALF * ld * 2;
    const size_t tstep = 2 * hstep;
    const unsigned ldsw = (unsigned)wid * 1024u;
    const int aoff = lds_byte(wr * 64 + fr, fq * 8), boff = lds_byte(wc * 32 + fr, fq * 8);
#define PG8_SA(b, h) (((b) * 2 + (h)) * HTB)
#define PG8_SB(b, h) ((4 + (b) * 2 + (h)) * HTB)
#define PG8_STAGE(bufoff, gbase, voff) do { _Pragma("unroll") for (int _i = 0; _i < 2; ++_i) \
        __builtin_amdgcn_global_load_lds((const unsigned*)((const char*)(gbase) + (voff)[_i]), (PG8_LAS unsigned*)(lds + (bufoff) + ldsw + _i * 8192), 16, 0, 0); } while (0)
#define PG8_LDA(dst, b, h) do { _Pragma("unroll") for (int m = 0; m < 4; ++m) _Pragma("unroll") for (int k = 0; k < 2; ++k) dst[m][k] = *(const PG8_LAS bf16x8*)(lds + PG8_SA(b, h) + aoff + m * 2048 + k * 1024); } while (0)
#define PG8_LDB(dst, b, h) do { _Pragma("unroll") for (int n = 0; n < 2; ++n) _Pragma("unroll") for (int k = 0; k < 2; ++k) dst[n][k] = *(const PG8_LAS bf16x8*)(lds + PG8_SB(b, h) + boff + n * 2048 + k * 1024); } while (0)
#define PG8_MMA(ai, bj, At, Bt) do { __builtin_amdgcn_s_setprio(1); _Pragma("unroll") for (int m = 0; m < 4; ++m) _Pragma("unroll") for (int n = 0; n < 2; ++n) _Pragma("unroll") for (int k = 0; k < 2; ++k) \
        acc[ai][bj][m][n] = __builtin_amdgcn_mfma_f32_16x16x32_bf16(Bt[n][k], At[m][k], acc[ai][bj][m][n], 0, 0, 0); __builtin_amdgcn_s_setprio(0); } while (0)
#define PG8_WAIT_V(n) asm volatile("s_waitcnt vmcnt(" #n ")" ::: "memory")
#define PG8_WAIT_L(n) asm volatile("s_waitcnt lgkmcnt(" #n ")" ::: "memory")
#define PG8_BAR __builtin_amdgcn_s_barrier()
#define PG8_SCHED __builtin_amdgcn_sched_barrier(0)
    Unit cur, nxt; int ui = 0;
    if (!S.next(0, cur)) return;
    f32x4 acc[2][2][4][2];
#pragma unroll
    for (int a = 0; a < 2; ++a)
#pragma unroll
        for (int b = 0; b < 2; ++b)
#pragma unroll
            for (int m = 0; m < 4; ++m)
#pragma unroll
                for (int n = 0; n < 2; ++n) acc[a][b][m][n] = (f32x4){0.f, 0.f, 0.f, 0.f};
    bf16x8 At[4][2], B0[2][2], B1[2][2];
    const char* cA = (const char*)g.A + (size_t)cur.pm * tstep + (size_t)cur.kc * K * 2; const char* cB = (const char*)g.Bt + (size_t)cur.pn * tstep + (size_t)cur.kc * K * 2;
    S.a_ready(cur);
    if constexpr (SP2) {
        PG8_STAGE(PG8_SB(0, 0), cB, voffB); PG8_STAGE(PG8_SB(0, 1), cB + hstep, voffB); PG8_STAGE(PG8_SA(0, 0), cA, voffA); PG8_STAGE(PG8_SA(0, 1), cA + hstep, voffA);
        if (wr == 1) PG8_BAR;
        PG8_WAIT_V(2); PG8_BAR;
        PG8_STAGE(PG8_SB(1, 0), cB + kstep, voffB); PG8_STAGE(PG8_SA(1, 0), cA + kstep, voffA); PG8_STAGE(PG8_SB(1, 1), cB + hstep + kstep, voffB);
        PG8_WAIT_V(6); PG8_BAR;
    } else {
        PG8_STAGE(PG8_SB(0, 0), cB, voffB); PG8_STAGE(PG8_SA(0, 0), cA, voffA); PG8_STAGE(PG8_SB(0, 1), cB + hstep, voffB); PG8_STAGE(PG8_SA(0, 1), cA + hstep, voffA);
        if (wr == 1) PG8_BAR;
        PG8_WAIT_V(4); PG8_BAR;
        PG8_STAGE(PG8_SB(1, 0), cB + kstep, voffB); PG8_STAGE(PG8_SA(1, 0), cA + kstep, voffA); PG8_STAGE(PG8_SB(1, 1), cB + hstep + kstep, voffB);
        PG8_WAIT_V(6); PG8_BAR;
    }
    for (;;) {
        const bool has_next = S.next(ui + 1, nxt);
        const char* nA = has_next ? (const char*)g.A + (size_t)nxt.pm * tstep + (size_t)nxt.kc * K * 2 : cA; const char* nB = has_next ? (const char*)g.Bt + (size_t)nxt.pn * tstep + (size_t)nxt.kc * K * 2 : cB;
        for (int t = 0; t < nt; t += 2) {
            const bool last = (t == nt - 2);
            const char* a1 = cA + (size_t)(t + 1) * kstep;
            const char* a2 = last ? nA : cA + (size_t)(t + 2) * kstep; const char* b2 = last ? nB : cB + (size_t)(t + 2) * kstep;
            const char* a3 = a2 + kstep; const char* b3 = b2 + kstep;
            if (last && has_next) S.a_ready(nxt);
            if constexpr (SP2) {
            PG8_LDB(B0, 0, 0); PG8_LDB(B1, 0, 1); PG8_SCHED; PG8_LDA(At, 0, 0); PG8_STAGE(PG8_SA(1, 1), a1 + hstep, voffA);
            PG8_WAIT_V(8); PG8_WAIT_L(0); PG8_BAR; PG8_MMA(0, 0, At, B0); PG8_MMA(0, 1, At, B1); PG8_BAR; PG8_SCHED;
            PG8_LDA(At, 0, 1); PG8_STAGE(PG8_SB(0, 0), b2, voffB); PG8_STAGE(PG8_SB(0, 1), b2 + hstep, voffB); PG8_STAGE(PG8_SA(0, 0), a2, voffA);
            PG8_WAIT_V(8); PG8_WAIT_L(0); PG8_BAR; PG8_MMA(1, 0, At, B0); PG8_MMA(1, 1, At, B1); PG8_BAR; PG8_SCHED;
            PG8_LDB(B0, 1, 0); PG8_LDB(B1, 1, 1); PG8_SCHED; PG8_LDA(At, 1, 0); PG8_STAGE(PG8_SA(0, 1), a2 + hstep, voffA);
            PG8_WAIT_V(8); PG8_WAIT_L(0); PG8_BAR; PG8_MMA(0, 0, At, B0); PG8_MMA(0, 1, At, B1); PG8_BAR; PG8_SCHED;
            PG8_LDA(At, 1, 1); PG8_STAGE(PG8_SB(1, 0), b3, voffB); PG8_STAGE(PG8_SB(1, 1), b3 + hstep, voffB); PG8_STAGE(PG8_SA(1, 0), a3, voffA);
            PG8_WAIT_V(8); PG8_WAIT_L(0); PG8_BAR; PG8_MMA(1, 0, At, B0); PG8_MMA(1, 1, At, B1); PG8_BAR; PG8_SCHED;
            } else {
            PG8_LDB(B0, 0, 0); PG8_SCHED; PG8_LDA(At, 0, 0); PG8_STAGE(PG8_SA(1, 1), a1 + hstep, voffA);
            PG8_WAIT_L(8); PG8_BAR; PG8_WAIT_L(0); PG8_MMA(0, 0, At, B0); PG8_BAR; PG8_SCHED;
            PG8_LDB(B1, 0, 1); PG8_STAGE(PG8_SB(0, 0), b2, voffB);
            PG8_BAR; PG8_WAIT_L(0); PG8_MMA(0, 1, At, B1); PG8_BAR;
            PG8_LDA(At, 0, 1); PG8_STAGE(PG8_SA(0, 0), a2, voffA);
            PG8_BAR; PG8_WAIT_L(0); PG8_MMA(1, 0, At, B0); PG8_BAR; PG8_SCHED;
            PG8_STAGE(PG8_SB(0, 1), b2 + hstep, voffB);
            PG8_WAIT_V(6); PG8_BAR; PG8_MMA(1, 1, At, B1); PG8_BAR;
            PG8_LDB(B0, 1, 0); PG8_SCHED; PG8_LDA(At, 1, 0); PG8_STAGE(PG8_SA(0, 1), a2 + hstep, voffA);
            PG8_WAIT_L(8); PG8_BAR; PG8_WAIT_L(0); PG8_MMA(0, 0, At, B0); PG8_BAR; PG8_SCHED;
            PG8_LDB(B1, 1, 1); PG8_STAGE(PG8_SB(1, 0), b3, voffB);
            PG8_BAR; PG8_WAIT_L(0); PG8_MMA(0, 1, At, B1); PG8_BAR;
            PG8_LDA(At, 1, 1); PG8_STAGE(PG8_SA(1, 0), a3, voffA);
            PG8_BAR; PG8_WAIT_L(0); PG8_MMA(1, 0, At, B0); PG8_BAR; PG8_SCHED;
            PG8_STAGE(PG8_SB(1, 1), b3 + hstep, voffB);
            PG8_WAIT_V(6); PG8_BAR; PG8_MMA(1, 1, At, B1); PG8_BAR;
            }
        }
        if constexpr (ALIGN_EPI) { if (wr == 0) PG8_BAR; }
        if constexpr (!Epi::AFTER_DRAIN) { E(acc, cur, wr, wc, fr, fq); S.done(cur); }
        if (!has_next) break;
#pragma unroll
        for (int a = 0; a < 2; ++a)
#pragma unroll
            for (int b = 0; b < 2; ++b)
#pragma unroll
                for (int m = 0; m < 4; ++m)
#pragma unroll
                    for (int n = 0; n < 2; ++n) acc[a][b][m][n] = (f32x4){0.f, 0.f, 0.f, 0.f};
        cur = nxt; cA = nA; cB = nB; ++ui;
        if constexpr (ALIGN_EPI) { if (wr == 1) PG8_BAR; }
    }
    PG8_WAIT_V(0);
    if constexpr (!ALIGN_EPI) { if (wr == 0) PG8_BAR; }
    PG8_BAR;
    if constexpr (Epi::AFTER_DRAIN) { E.fused(acc, cur, wr, wc, fr, fq, lds, wid, lane); S.done(cur); }
#undef PG8_SA
#undef PG8_SB
#undef PG8_STAGE
#undef PG8_LDA
#undef PG8_LDB
#undef PG8_MMA
#undef PG8_WAIT_V
#undef PG8_WAIT_L
#undef PG8_BAR
#undef PG8_SCHED
}
}
namespace attn_body {
constexpr int QP=512,OP=512;
constexpr int NA_RPB_OFF=90112;
using bf16=__hip_bfloat16;
using bf16x8=__attribute__((ext_vector_type(8)))short;
using s16x4=__attribute__((ext_vector_type(4)))short;
using f32x16=__attribute__((ext_vector_type(16)))float;
using u32x4=__attribute__((ext_vector_type(4)))unsigned;
constexpr int D=64;
constexpr int NW=8,QBLK=32,QB=QBLK*NW,KVBLK=64;
__device__ __forceinline__ int crow(int r,int hi){return (r&3)+8*(r>>2)+4*hi;}
#define SBAR() __builtin_amdgcn_sched_barrier(0)
__device__ __forceinline__ void cmask(f32x16&p0,f32x16&p1,int jb,int qrel,int hi){
  const float NEG=-INFINITY; int kb=64*jb+4*hi;
  #pragma unroll
  for(int r=0;r<16;++r){int kv=kb+(r&3)+8*(r>>2); if(kv>qrel)p0[r]=NEG; if(kv+32>qrel)p1[r]=NEG;}
}

constexpr int NSLOT=3, SLOTB=8192;
constexpr int LDS_K=0, LDS_V=NSLOT*SLOTB, LDS_WS=2*NSLOT*SLOTB, LDS_OST=LDS_WS+NW*64*4, LDS_BYTES=LDS_OST+NW*4096;
constexpr float C2=0.125f*1.4426950408889634f;
__device__ __forceinline__ void glds16(const void*gsrc,unsigned lds_dst){unsigned keep;
  asm volatile("s_mov_b32 %0, m0\n\ts_mov_b32 m0, %2\n\ts_nop 0\n\tglobal_load_lds_dwordx4 %1, off\n\ts_mov_b32 m0, %0":"=&s"(keep):"v"(gsrc),"s"(lds_dst):"memory");}
__device__ __forceinline__ float max3f(float a,float b,float c){float r;asm("v_max3_f32 %0, %1, %2, %3":"=v"(r):"v"(a),"v"(b),"v"(c));return r;}
__device__ __forceinline__ float max2f(float a,float b){float r;asm("v_max_f32_e32 %0, %1, %2":"=v"(r):"v"(a),"v"(b));return r;}
__device__ __forceinline__ float fadd_s(float a,float b){float r;asm("v_add_f32_e32 %0, %1, %2":"=v"(r):"v"(a),"v"(b));return r;}
__device__ __forceinline__ float fsub_s(float a,float b){float r;asm("v_sub_f32_e32 %0, %1, %2":"=v"(r):"v"(a),"v"(b));return r;}
typedef float f32x2_t __attribute__((ext_vector_type(2))); typedef __bf16 bf16x2_t __attribute__((ext_vector_type(2)));
__device__ __forceinline__ unsigned cvtpk_s(float lo,float hi){f32x2_t v={lo,hi};bf16x2_t b=__builtin_convertvector(v,bf16x2_t);return __builtin_bit_cast(unsigned,b);}
#define WAIT_BAR(N) asm volatile("s_waitcnt vmcnt(" #N ") lgkmcnt(0)\n\ts_barrier":::"memory")

__device__ __forceinline__ void qkt(f32x16&p0,f32x16&p1,const char*Kslot,const bf16x8*qr,const f32x16&negm,int r32,int hi){
  const char*kb=Kslot+hi*1024+r32*16;
  #pragma unroll
  for(int d0=0;d0<4;++d0){
    const bf16x8 b0=*reinterpret_cast<const bf16x8*>(kb+d0*2048);
    const bf16x8 b1=*reinterpret_cast<const bf16x8*>(kb+d0*2048+512);
    if(d0==0){p0=__builtin_amdgcn_mfma_f32_32x32x16_bf16(b0,qr[0],negm,0,0,0);p1=__builtin_amdgcn_mfma_f32_32x32x16_bf16(b1,qr[0],negm,0,0,0);}
    else{p0=__builtin_amdgcn_mfma_f32_32x32x16_bf16(b0,qr[d0],p0,0,0,0);p1=__builtin_amdgcn_mfma_f32_32x32x16_bf16(b1,qr[d0],p1,0,0,0);}}
}
typedef __attribute__((address_space(3))) const char* lds_cptr;
typedef short v4i16_t __attribute__((ext_vector_type(4)));
__device__ __forceinline__ void kload8(bf16x8*kf,lds_cptr kp){
  kf[0]=*(const __attribute__((address_space(3))) bf16x8*)(kp);      kf[1]=*(const __attribute__((address_space(3))) bf16x8*)(kp+512);
  kf[2]=*(const __attribute__((address_space(3))) bf16x8*)(kp+2048); kf[3]=*(const __attribute__((address_space(3))) bf16x8*)(kp+2560);
  kf[4]=*(const __attribute__((address_space(3))) bf16x8*)(kp+4096); kf[5]=*(const __attribute__((address_space(3))) bf16x8*)(kp+4608);
  kf[6]=*(const __attribute__((address_space(3))) bf16x8*)(kp+6144); kf[7]=*(const __attribute__((address_space(3))) bf16x8*)(kp+6656);
}
__device__ __forceinline__ void kload2(bf16x8*kf,lds_cptr kp,int j){ kf[2*j]=*(const __attribute__((address_space(3))) bf16x8*)(kp+j*2048); kf[2*j+1]=*(const __attribute__((address_space(3))) bf16x8*)(kp+j*2048+512); }
__device__ __forceinline__ s16x4 vtr(lds_cptr p){ return __builtin_bit_cast(s16x4,__builtin_amdgcn_ds_read_tr16_b64_v4i16((__attribute__((address_space(3))) v4i16_t*)p)); }
__device__ __forceinline__ float rowmax(const f32x16&p0,const f32x16&p1){
  float a=max3f(p0[0],p0[1],p1[0]),b=max3f(p0[2],p0[3],p1[1]);a=max3f(a,p1[2],p1[3]);
  #pragma unroll
  for(int r=4;r<16;r+=4){a=max3f(a,p0[r],p0[r+1]);b=max3f(b,p0[r+2],p0[r+3]);a=max3f(a,p1[r],p1[r+1]);b=max3f(b,p1[r+2],p1[r+3]);}
  const float m=max2f(a,b);
  auto rr=__builtin_amdgcn_permlane32_swap(__float_as_uint(m),__float_as_uint(m),false,false);
  return max2f(__uint_as_float(rr[0]),__uint_as_float(rr[1]));
}
__device__ __forceinline__ void pv(f32x16*o,int vb,bf16x8 pa0,bf16x8 pa1,bf16x8 pa2,bf16x8 pa3){
  #pragma unroll
  for(int d0=0;d0<2;++d0){s16x4 lo[4],hi[4];
    #pragma unroll
    for(int ks=0;ks<4;++ks){
      asm volatile("ds_read_b64_tr_b16 %0,%1 offset:%c2":"=&v"(lo[ks]):"v"(vb),"i"(d0*4096+ks*1024):"memory");
      asm volatile("ds_read_b64_tr_b16 %0,%1 offset:%c2":"=&v"(hi[ks]):"v"(vb),"i"(d0*4096+ks*1024+512):"memory");}
    asm volatile("s_waitcnt lgkmcnt(0)":::"memory");SBAR();
    #define PK(k) (bf16x8){lo[k][0],lo[k][1],lo[k][2],lo[k][3],hi[k][0],hi[k][1],hi[k][2],hi[k][3]}
    o[d0]=__builtin_amdgcn_mfma_f32_32x32x16_bf16(pa0,PK(0),o[d0],0,0,0);
    o[d0]=__builtin_amdgcn_mfma_f32_32x32x16_bf16(pa1,PK(1),o[d0],0,0,0);
    o[d0]=__builtin_amdgcn_mfma_f32_32x32x16_bf16(pa2,PK(2),o[d0],0,0,0);
    o[d0]=__builtin_amdgcn_mfma_f32_32x32x16_bf16(pa3,PK(3),o[d0],0,0,0);
    #undef PK
  }
}

#ifndef ATTN_STORE16
#define ATTN_STORE16(p,v) (*(u32x4*)(p)=(v))
#endif
template<int THRL,bool NA> __device__ __forceinline__ void attn_unit(const bf16*Qp,const bf16*__restrict__ Kh,const bf16*__restrict__ Vh,bf16*Op,const int NT,char*shm,const int wave_in,const int kr0=0,const int nwin=0,const int qgr0=0,const float*rpb_h=nullptr){
  constexpr int KP=NA?512:128;
  int tid_=wave_in*64+pg8::pg8_lane_id(); asm volatile("":"+v"(tid_)); const int tid=tid_,lane=tid&63,r32=lane&31,hi=lane>>5; const int wid=__builtin_amdgcn_readfirstlane(tid>>6);
  const bf16*Qw=Qp+(long)(wid*QBLK)*QP;
  const unsigned lds0=(unsigned)(uintptr_t)shm;
  float*wsf=(float*)(shm+LDS_WS)+wid*64;
  float*rpbL=(float*)(shm+NA_RPB_OFF);
  if(NA){ for(int i=tid;i<465;i+=512)rpbL[i]=rpb_h[i]*1.4426950408889634f; }
  const int qgr=qgr0+(wid>>1),qc=(wid&1)*32+r32;
  const int rs=min(max(qgr-4,0),120),cs=min(max(qc-8,0),48);
  #define TROW(t) (NA?(((t)<4)?(8192+64*(t)):(min(kr0+(t)-4,127)*64)):(64*(t)))
  const bf16*ksrc=Kh+(long)lane*KP+wid*8;
  const bf16*vsrc=Vh+(long)(16*(wid&3)+(lane>>2))*KP+(wid>>2)*32+(lane&3)*8;
  const unsigned kdst=lds0+LDS_K+wid*1024, vdst=lds0+LDS_V+wid*1024;
  #define DMA_K(t,slot) glds16(ksrc+(long)TROW(t)*KP,(unsigned)__builtin_amdgcn_readfirstlane(kdst+(slot)))
  #define DMA_V(t,slot) glds16(vsrc+(long)TROW(t)*KP,(unsigned)__builtin_amdgcn_readfirstlane(vdst+(slot)))
  const int vb0=(int)(lds0+LDS_V)+((lane>>4)&1)*32+(lane&3)*8+(4*hi+((lane&15)>>2))*64;
  const char*Kbase=shm+LDS_K; bf16x8 kf[8];
  const lds_cptr shm3=(lds_cptr)shm; const lds_cptr kp0=shm3+LDS_K+hi*1024+r32*16; const lds_cptr vp0=shm3+LDS_V+((lane>>4)&1)*32+(lane&3)*8+(4*hi+((lane&15)>>2))*64;
  DMA_K(0,0);DMA_V(0,0);DMA_K(1,SLOTB);
  bf16x8 qr[4];
  #pragma unroll
  for(int d0=0;d0<4;++d0)qr[d0]=*reinterpret_cast<const bf16x8*>(&Qw[(long)r32*QP+d0*16+hi*8]);
  float mhat=0.f,l_reg=0.f;f32x16 o[2];o[0]=f32x16{};o[1]=f32x16{};f32x16 negm=f32x16{};asm volatile("":"+v"(negm));
  #define CMASK(P0,P1,t) do{ if(NA&&(t)>=4){ const int kr_=kr0+(t)-4; const bool rowok_=((t)-4<nwin)&&(kr_>=rs)&&(kr_<rs+8); const int brow_=(kr_-qgr+7)*31+15-qc; \
      _Pragma("unroll") for(int r=0;r<16;++r){ const int kc_=crow(r,hi); \
        { const bool ok_=rowok_&&(kc_>=cs)&&(kc_<cs+16); const float bv_=rpbL[min(max(brow_+kc_,0),464)]; P0[r]=ok_?P0[r]+bv_:-INFINITY; } \
        { const bool ok_=rowok_&&(kc_+32>=cs)&&(kc_+32<cs+16); const float bv_=rpbL[min(max(brow_+kc_+32,0),464)]; P1[r]=ok_?P1[r]+bv_:-INFINITY; } } } }while(0)
  bool resc=false;
  #define START(P0,P1) do{ const float rm=rowmax(P0,P1); resc=false; \
    { const float dl=rm; mhat=fadd_s(mhat,dl); \
      _Pragma("unroll") for(int r=0;r<16;++r){P0[r]=fsub_s(P0[r],dl);P1[r]=fsub_s(P1[r],dl);} \
      _Pragma("unroll") for(int r=0;r<16;++r)negm[r]=-mhat; asm volatile("":"+v"(negm)); } \
    _Pragma("unroll") for(int r=0;r<16;++r)P0[r]=__builtin_amdgcn_exp2f(P0[r]); }while(0)
  #define RESC() do{ if(resc){ asm volatile("s_waitcnt lgkmcnt(0)":::"memory"); \
      _Pragma("unroll") for(int d_=0;d_<2;++d_) _Pragma("unroll") for(int r=0;r<16;++r)o[d_][r]*=wsf[crow(r,hi)]; } }while(0)
  f32x16 pA0,pA1,pB0,pB1;
  int sl_prev=0,sl_cur=0,sl_next=SLOTB;
  #define ROT() do{sl_prev=sl_cur;sl_cur=sl_next;sl_next=(sl_next==(NSLOT-1)*SLOTB)?0:sl_next+SLOTB;}while(0)
  DMA_K(2,2*SLOTB);
  WAIT_BAR(3);
  qkt(pA0,pA1,Kbase,qr,negm,r32,hi);asm volatile("s_nop 15\n\ts_nop 7":"+v"(pA0),"+v"(pA1));CMASK(pA0,pA1,0);
  START(pA0,pA1);
  _Pragma("unroll") for(int r=0;r<16;++r)pA1[r]=__builtin_amdgcn_exp2f(pA1[r]);
  WAIT_BAR(0);
  DMA_K(3,0);DMA_V(1,SLOTB);
  ROT();
  kload8(kf,kp0+sl_cur);
  WAIT_BAR(2);
  s16x4 vlo[8],vhi[8]; u32x4 pw0,pw1,pw2,pw3;
  #define PKW(P,B) cvtpk_s(P[B],P[B+1])
  #define PAF(k) __builtin_bit_cast(bf16x8,pw##k)
  #define VFR(i) (bf16x8){vlo[i][0],vlo[i][1],vlo[i][2],vlo[i][3],vhi[i][0],vhi[i][1],vhi[i][2],vhi[i][3]}
  #define PIN(x) asm volatile("":"+v"(x))
  #define MX3(a,b,c) __builtin_fmaxf(__builtin_fmaxf((a),(b)),(c))
  #define GAPA(MF,A0,A1,A2,A3,W0,W1,PW) do{ MF; sacc+=A0; sacc+=A1; sacc+=A2; sacc+=A3; PIN(sacc); W0; W1; PIN(PW); SBAR(); }while(0)
  #define EX(v) __builtin_amdgcn_exp2f(v)
  #define GAPB(MF,X,B) do{ MF; X[B]=EX(X[B]); X[B+1]=EX(X[B+1]); X[B+2]=EX(X[B+2]); X[B+3]=EX(X[B+3]); PIN(X); SBAR(); }while(0)
  #define VRD(i) do{ vlo[i]=vtr(vp_+(((i)>>2)*4096+((i)&3)*1024)); vhi[i]=vtr(vp_+(((i)>>2)*4096+((i)&3)*1024+512)); }while(0)
  #define KRD(G,j) do{ if(G){ kload2(kf,kp0+sl_next,j); SBAR(); } }while(0)
  #define STEP(C0,C1,P0,P1,t,GK,GV,GL) do{ SBAR(); \
    const lds_cptr vp_=vp0+sl_prev; \
    VRD(0); SBAR(); float sacc=(P0[0]+P0[1]); \
    GAPA(C0=__builtin_amdgcn_mfma_f32_32x32x16_bf16(kf[0],qr[0],negm,0,0,0), P0[2],P0[3],P0[4],P0[5],     pw0[0]=PKW(P0,0), pw0[1]=PKW(P0,2), pw0); \
    VRD(4); SBAR(); GAPA(C1=__builtin_amdgcn_mfma_f32_32x32x16_bf16(kf[1],qr[0],negm,0,0,0), P0[6],P0[7],P0[8],P0[9],     pw0[2]=PKW(P0,4), pw0[3]=PKW(P0,6), pw0); \
    VRD(1); SBAR(); GAPA(C0=__builtin_amdgcn_mfma_f32_32x32x16_bf16(kf[2],qr[1],C0,0,0,0),   P0[10],P0[11],P0[12],P0[13], pw1[0]=PKW(P0,8), pw1[1]=PKW(P0,10), pw1); \
    VRD(5); SBAR(); GAPA(C1=__builtin_amdgcn_mfma_f32_32x32x16_bf16(kf[3],qr[1],C1,0,0,0),   P0[14],P0[15],P1[0],P1[1],   pw1[2]=PKW(P0,12),pw1[3]=PKW(P0,14), pw1); \
    VRD(2); SBAR(); GAPA(C0=__builtin_amdgcn_mfma_f32_32x32x16_bf16(kf[4],qr[2],C0,0,0,0),   P1[2],P1[3],P1[4],P1[5],     pw2[0]=PKW(P1,0), pw2[1]=PKW(P1,2), pw2); \
    VRD(6); SBAR(); GAPA(C1=__builtin_amdgcn_mfma_f32_32x32x16_bf16(kf[5],qr[2],C1,0,0,0),   P1[6],P1[7],P1[8],P1[9],     pw2[2]=PKW(P1,4), pw2[3]=PKW(P1,6), pw2); \
    VRD(3); SBAR(); GAPA(C0=__builtin_amdgcn_mfma_f32_32x32x16_bf16(kf[6],qr[3],C0,0,0,0),   P1[10],P1[11],P1[12],P1[13], pw3[0]=PKW(P1,8), pw3[1]=PKW(P1,10), pw3); \
    VRD(7); SBAR(); GAPA(C1=__builtin_amdgcn_mfma_f32_32x32x16_bf16(kf[7],qr[3],C1,0,0,0),   P1[14],P1[15],0.f,0.f,       pw3[2]=PKW(P1,12),pw3[3]=PKW(P1,14), pw3); \
    l_reg+=sacc; \
    if(GK){DMA_K((t)+3,sl_cur);} if(GV){DMA_V((t)+1,sl_next);} \
    CMASK(C0,C1,t); \
    { float a=MX3(C0[0],C0[1],C1[0]),b=MX3(C0[2],C0[3],C1[1]); a=MX3(a,C1[2],C1[3]); \
      _Pragma("unroll") for(int r=4;r<16;r+=4){a=MX3(a,C0[r],C0[r+1]);b=MX3(b,C0[r+2],C0[r+3]);a=MX3(a,C1[r],C1[r+1]);b=MX3(b,C1[r+2],C1[r+3]);} \
      float rm=__builtin_fmaxf(a,b); { auto rr=__builtin_amdgcn_permlane32_swap(__float_as_uint(rm),__float_as_uint(rm),false,false); rm=__builtin_fmaxf(__uint_as_float(rr[0]),__uint_as_float(rr[1])); } \
      resc=false; \
      if(__builtin_expect(__any(rm>(float)THRL),0)){ const float dl=__builtin_fmaxf(rm,0.f); mhat+=dl; \
        _Pragma("unroll") for(int r=0;r<16;++r){C0[r]-=dl;C1[r]-=dl;} \
        _Pragma("unroll") for(int r=0;r<16;++r)negm[r]=-mhat; asm volatile("":"+v"(negm)); \
        const float f=__builtin_amdgcn_exp2f(-dl); l_reg*=f; if(hi==0)wsf[r32]=f; resc=true; } } \
    SBAR(); \
    GAPB(o[0]=__builtin_amdgcn_mfma_f32_32x32x16_bf16(PAF(0),VFR(0),o[0],0,0,0), C0,0); \
    GAPB(o[1]=__builtin_amdgcn_mfma_f32_32x32x16_bf16(PAF(0),VFR(4),o[1],0,0,0), C0,4); \
    KRD(GL,0); GAPB(o[0]=__builtin_amdgcn_mfma_f32_32x32x16_bf16(PAF(1),VFR(1),o[0],0,0,0), C0,8); \
    KRD(GL,1); GAPB(o[1]=__builtin_amdgcn_mfma_f32_32x32x16_bf16(PAF(1),VFR(5),o[1],0,0,0), C0,12); \
    KRD(GL,2); GAPB(o[0]=__builtin_amdgcn_mfma_f32_32x32x16_bf16(PAF(2),VFR(2),o[0],0,0,0), C1,0); \
    KRD(GL,3); GAPB(o[1]=__builtin_amdgcn_mfma_f32_32x32x16_bf16(PAF(2),VFR(6),o[1],0,0,0), C1,4); \
    GAPB(o[0]=__builtin_amdgcn_mfma_f32_32x32x16_bf16(PAF(3),VFR(3),o[0],0,0,0), C1,8); \
    GAPB(o[1]=__builtin_amdgcn_mfma_f32_32x32x16_bf16(PAF(3),VFR(7),o[1],0,0,0), C1,12); \
    }while(0)
  int t=1;
  for(;t+5<NT;t+=2){
    STEP(pB0,pB1,pA0,pA1,t,true,true,true);     WAIT_BAR(2); RESC(); ROT();
    STEP(pA0,pA1,pB0,pB1,t+1,true,true,true);   WAIT_BAR(2); RESC(); ROT();
  }
  #define ENDW(tt) do{ if((tt)+3<NT){WAIT_BAR(2);} else if((tt)+2<NT){WAIT_BAR(1);} else {WAIT_BAR(0);} }while(0)
  for(;t+1<NT;t+=2){
    STEP(pB0,pB1,pA0,pA1,t,(t+3<NT),(t+1<NT),(t+1<NT));       ENDW(t);   RESC(); ROT();
    STEP(pA0,pA1,pB0,pB1,t+1,(t+4<NT),(t+2<NT),(t+2<NT));     ENDW(t+1); RESC(); ROT();
  }
  STEP(pB0,pB1,pA0,pA1,NT-1,false,false,false); RESC();
  { float sacc=pB0[0]+pB0[1]; _Pragma("unroll") for(int r=2;r<16;++r)sacc+=pB0[r]; _Pragma("unroll") for(int r=0;r<16;++r)sacc+=pB1[r]; l_reg+=sacc;
    pw0=(u32x4){PKW(pB0,0),PKW(pB0,2),PKW(pB0,4),PKW(pB0,6)};pw1=(u32x4){PKW(pB0,8),PKW(pB0,10),PKW(pB0,12),PKW(pB0,14)};pw2=(u32x4){PKW(pB1,0),PKW(pB1,2),PKW(pB1,4),PKW(pB1,6)};pw3=(u32x4){PKW(pB1,8),PKW(pB1,10),PKW(pB1,12),PKW(pB1,14)};
    SBAR(); pv(o,vb0+sl_cur,PAF(0),PAF(1),PAF(2),PAF(3)); }
  #undef PKW
  #undef PAF
  #undef VFR
  #undef PIN
  #undef MX3
  #undef GAPA
  #undef GAPB
  #undef EX
  #undef VRD
  #undef KRD
  #undef STEP
  #undef ENDW
  {auto rr=__builtin_amdgcn_permlane32_swap(__float_as_uint(l_reg),__float_as_uint(l_reg),false,false);l_reg=__uint_as_float(rr[0])+__uint_as_float(rr[1]);}
  if(hi==0)wsf[32+r32]=l_reg;asm volatile("s_waitcnt lgkmcnt(0)":::"memory");
  float rli[16];
  #pragma unroll
  for(int r=0;r<16;++r)rli[r]=__builtin_amdgcn_rcpf(wsf[32+crow(r,hi)]);
  bf16*Ow=Op+(long)(wid*QBLK)*OP;
  { bf16*stg=(bf16*)(shm+LDS_OST)+wid*2048;
    #pragma unroll
    for(int r=0;r<16;++r){const int orow=crow(r,hi);
      #pragma unroll
      for(int d0=0;d0<2;++d0)stg[orow*64+d0*32+r32]=__float2bfloat16(o[d0][r]*rli[r]);}
    asm volatile("s_waitcnt lgkmcnt(0)":::"memory");
    #pragma unroll
    for(int i=0;i<4;++i){const int row=i*8+(lane>>3),ch=lane&7; const u32x4 v=*(const u32x4*)(stg+row*64+ch*8); ATTN_STORE16(Ow+(long)row*OP+ch*8,v);} }
  asm volatile("s_waitcnt lgkmcnt(0)\n\ts_barrier":::"memory");
  #undef DMA_K
  #undef DMA_V
  #undef CMASK
  #undef TROW
  #undef START
  #undef RESC
  #undef ROT
}
constexpr int ATTN_LDS_BYTES=LDS_BYTES;
#undef SBAR
#undef WAIT_BAR
}

#define LAS __attribute__((address_space(3)))
typedef unsigned short bf16;
typedef unsigned u32x4 __attribute__((ext_vector_type(4)));
typedef unsigned u32x2 __attribute__((ext_vector_type(2)));
typedef float f32x4 __attribute__((ext_vector_type(4)));
typedef float f32x16 __attribute__((ext_vector_type(16)));
typedef short bf16x8 __attribute__((ext_vector_type(8)));
typedef short s16x4 __attribute__((ext_vector_type(4)));

constexpr int DM = 1024, NL = 16384, MT = 16896, SEQ = 8192;
constexpr int INC = 4352, FF = 2816, FF2 = 5632, DEPTH = 4;
constexpr float EPS = 1e-6f;
constexpr float LOG2E = 1.4426950408889634f;
constexpr float C2 = 0.125f * 1.4426950408889634f;
constexpr int NWAVES = 8, NTHREADS = 512;

constexpr size_t MiB = 1u << 20;
constexpr size_t WS_MODS = 1 * MiB;
constexpr size_t WS_WIN = 2 * MiB;
constexpr size_t WS_WPA = 11 * MiB, WS_WPB = 12 * MiB;
constexpr size_t WS_WO = 13 * MiB;
constexpr size_t WS_WFI = 15 * MiB;
constexpr size_t WS_WFO = 26 * MiB;
constexpr size_t WS_X = 32 * MiB;
constexpr size_t WS_H = 98 * MiB;
constexpr size_t SZ512 = (size_t)MT * 512 * 2, SZ128 = (size_t)MT * 128 * 2, SZ1024 = (size_t)MT * 1024 * 2;
constexpr size_t WS_NAQ = 131 * MiB, WS_NAK = WS_NAQ + SZ512, WS_NAV = WS_NAK + SZ512, WS_GQ = WS_NAV + SZ512, WS_GK = WS_GQ + SZ512, WS_GV = WS_GK + SZ128;
constexpr size_t WS_SA = WS_GV + SZ128, WS_SB = WS_SA + SZ1024, WS_YA = WS_SB + SZ1024, WS_YB = WS_YA + SZ512, WS_END = WS_YB + SZ512;
constexpr size_t WS_SLAB = 240 * MiB;
static_assert(WS_SLAB >= WS_SB && WS_SLAB + (size_t)11 * 512 * DM * 4 <= WS_YA, "slab inside SB");
constexpr size_t WS_ACT = 131 * MiB;
static_assert(WS_ACT + (size_t)MT * FF * 2 <= WS_END, "act overlay");
static_assert(WS_WFO + (size_t)DM * FF * 2 <= WS_X && WS_WFI + (size_t)FF2 * DM * 2 <= WS_WFO && WS_WIN + (size_t)INC * DM * 2 <= WS_WPA, "weights map");

constexpr int RING_BYTES = 131072;
constexpr int LDS_BYTES = 147456;
constexpr int A_K = 0, A_V = 16384, A_WS = 32768, A_OST = 34816, A_RPB = 67584;

__device__ __forceinline__ unsigned f2bf(float f) { unsigned u = __builtin_bit_cast(unsigned, f); return (u + 0x7fffu + ((u >> 16) & 1u)) >> 16; }
__device__ __forceinline__ unsigned pk2(float lo, float hi) { return f2bf(lo) | (f2bf(hi) << 16); }
__device__ __forceinline__ float bflo(unsigned w) { return __builtin_bit_cast(float, w << 16); }
__device__ __forceinline__ float bfhi(unsigned w) { return __builtin_bit_cast(float, w & 0xffff0000u); }
__device__ __forceinline__ float shx(float v, int o, int ln) { return __builtin_bit_cast(float, __builtin_amdgcn_ds_bpermute((ln ^ o) << 2, __builtin_bit_cast(int, v))); }
__device__ __forceinline__ float wave_sum(float v, int ln) {
#pragma unroll
    for (int o = 1; o < 64; o <<= 1) v += shx(v, o, ln);
    return v;
}
__device__ __forceinline__ unsigned char* lws(unsigned char* p) { asm volatile("" : "+s"(p)); return p; }
__device__ __forceinline__ int launder(int v) { asm volatile("" : "+v"(v)); return v; }
__device__ __forceinline__ float sigmoidf_(float x) { return __builtin_amdgcn_rcpf(1.0f + __expf(-x)); }

using pg8::Unit; using pg8::cvt_pk_bf16;
typedef f32x4 Acc[2][2][4][2];

struct EpiIn {
    static constexpr bool PERM = true, AFTER_DRAIN = false;
    bf16 *NAQ, *NAK, *NAV, *GQ, *GK, *GV, *SA, *SB; const float* qgain; const float* kgain;
    __device__ __forceinline__ void operator()(const Acc& acc, const Unit& u, int wr, int wc, int fr, int fq) const {
        const int pm = u.pm, pn = u.pn;
        const int rbase = pm * 256 + wr * 64 + fr;
        const int kvd = pm < 32 ? 0 : (pm < 64 ? 256 : (pm == 64 ? -8192 : 0));
        if (pn < 6 || pn >= 9) {
            bf16* dst; int ld, colt, rowd = 0; float sc = 1.f; bool sig = false;
            if (pn < 2) { dst = NAQ; ld = 512; colt = pn * 256; sc = C2; }
            else if (pn < 4) { dst = NAK; ld = 512; colt = (pn - 2) * 256; rowd = kvd; }
            else if (pn < 6) { dst = NAV; ld = 512; colt = (pn - 4) * 256; rowd = kvd; }
            else if (pn < 13) { dst = SA; ld = 1024; colt = (pn - 9) * 256; sig = true; }
            else { dst = SB; ld = 1024; colt = (pn - 13) * 256; sig = true; }
            const int col0 = colt + wc * 32 + 8 * fq;
#pragma unroll
            for (int ai = 0; ai < 2; ++ai)
#pragma unroll
                for (int m = 0; m < 4; ++m) {
                    bf16* rowp = dst + (size_t)(rbase + ai * 128 + m * 16 + rowd) * ld + col0;
#pragma unroll
                    for (int bj = 0; bj < 2; ++bj) {
                        f32x4 v0 = acc[ai][bj][m][0], v1 = acc[ai][bj][m][1];
                        if (sig) {
#pragma unroll
                            for (int e = 0; e < 4; ++e) { v0[e] = sigmoidf_(v0[e]); v1[e] = sigmoidf_(v1[e]); }
                        } else { v0 = v0 * sc; v1 = v1 * sc; }
                        u32x4 w; w.x = cvt_pk_bf16(v0[0], v0[1]); w.y = cvt_pk_bf16(v0[2], v0[3]); w.z = cvt_pk_bf16(v1[0], v1[1]); w.w = cvt_pk_bf16(v1[2], v1[3]);
                        *(u32x4*)(rowp + bj * 128) = w;
                    }
                    __builtin_amdgcn_sched_barrier(0);
                }
        } else {
            const int hidx = 4 * (pn - 6) + wc;
            const bool isv = hidx >= 10, isk = (hidx >= 8) && !isv;
            bf16* dst; int ld, hcol, rowd; float sc = 1.f;
            if (isv) { dst = GV; ld = 128; hcol = (hidx - 10) * 64; rowd = kvd; }
            else if (isk) { dst = GK; ld = 128; hcol = (hidx - 8) * 64; rowd = kvd; }
            else { dst = GQ; ld = 512; hcol = hidx * 64; rowd = 0; sc = C2; }
            const float* gain = isk ? kgain : qgain;
            f32x4 gv[2][2];
#pragma unroll
            for (int bj = 0; bj < 2; ++bj)
#pragma unroll
                for (int n = 0; n < 2; ++n) gv[bj][n] = *(const f32x4*)(gain + 32 * bj + 8 * fq + 4 * n);
            const bool latent = pm < 64;
#pragma unroll
            for (int ai = 0; ai < 2; ++ai)
#pragma unroll
                for (int m = 0; m < 4; ++m) {
                    const int row = rbase + ai * 128 + m * 16;
                    bf16* rowp = dst + (size_t)(row + rowd) * ld + hcol + 8 * fq;
                    if (isv) {
#pragma unroll
                        for (int bj = 0; bj < 2; ++bj) {
                            const f32x4 v0 = acc[ai][bj][m][0], v1 = acc[ai][bj][m][1];
                            u32x4 w; w.x = cvt_pk_bf16(v0[0], v0[1]); w.y = cvt_pk_bf16(v0[2], v0[3]); w.z = cvt_pk_bf16(v1[0], v1[1]); w.w = cvt_pk_bf16(v1[2], v1[3]);
                            *(u32x4*)(rowp + bj * 32) = w;
                        }
                    } else {
                        float ss = 0.f;
#pragma unroll
                        for (int bj = 0; bj < 2; ++bj)
#pragma unroll
                            for (int n = 0; n < 2; ++n) { const f32x4 x = acc[ai][bj][m][n]; ss += (x[0] * x[0] + x[1] * x[1]) + (x[2] * x[2] + x[3] * x[3]); }
                        { const int ln_ = fq * 16 + fr; ss += shx(ss, 16, ln_); ss += shx(ss, 32, ln_); }
                        const float rinv = rsqrtf(ss * (1.0f / 64.0f) + EPS);
                        const int s = row & (SEQ - 1);
#pragma unroll
                        for (int bj = 0; bj < 2; ++bj) {
                            f32x4 v0 = acc[ai][bj][m][0] * rinv * gv[bj][0], v1 = acc[ai][bj][m][1] * rinv * gv[bj][1];
                            if (latent) {
                                const int pos = bj == 0 ? (s >> 6) : (s & 63);
                                const f32x4 t0 = *(const f32x4*)(ROPE_TAB + (pos * 16 + 4 * fq) * 2);
                                const f32x4 t1 = *(const f32x4*)(ROPE_TAB + (pos * 16 + 4 * fq) * 2 + 4);
                                f32x4 r0, r1;
                                r0[0] = v0[0] * t0[0] - v0[1] * t0[1]; r0[1] = v0[0] * t0[1] + v0[1] * t0[0];
                                r0[2] = v0[2] * t0[2] - v0[3] * t0[3]; r0[3] = v0[2] * t0[3] + v0[3] * t0[2];
                                r1[0] = v1[0] * t1[0] - v1[1] * t1[1]; r1[1] = v1[0] * t1[1] + v1[1] * t1[0];
                                r1[2] = v1[2] * t1[2] - v1[3] * t1[3]; r1[3] = v1[2] * t1[3] + v1[3] * t1[2];
                                v0 = r0; v1 = r1;
                            }
                            v0 = v0 * sc; v1 = v1 * sc;
                            u32x4 w; w.x = cvt_pk_bf16(v0[0], v0[1]); w.y = cvt_pk_bf16(v0[2], v0[3]); w.z = cvt_pk_bf16(v1[0], v1[1]); w.w = cvt_pk_bf16(v1[2], v1[3]);
                            *(u32x4*)(rowp + bj * 32) = w;
                        }
                    }
                    __builtin_amdgcn_sched_barrier(0);
                }
        }
    }
};

struct EpiMerge {
    static constexpr bool PERM = true, AFTER_DRAIN = false;
    const bf16* S; bf16* O; int second;
    __device__ __forceinline__ void operator()(const Acc& acc, const Unit& u, int wr, int wc, int fr, int fq) const {
        const int rbase = u.pm * 256 + wr * 64 + fr, col0 = u.pn * 256 + wc * 32 + 8 * fq;
#pragma unroll
        for (int ai = 0; ai < 2; ++ai)
#pragma unroll
            for (int m = 0; m < 4; ++m)
#pragma unroll
                for (int bj = 0; bj < 2; ++bj) {
                    const size_t off = (size_t)(rbase + ai * 128 + m * 16) * 1024 + col0 + bj * 128;
                    const u32x4 b = *(const u32x4*)(S + off);
                    u32x4 p = {0u, 0u, 0u, 0u};
                    if (second) p = *(const u32x4*)(O + off);
                    const f32x4 v0 = acc[ai][bj][m][0], v1 = acc[ai][bj][m][1];
                    u32x4 w;
                    w.x = cvt_pk_bf16(bflo(p.x) + v0[0] * bflo(b.x), bfhi(p.x) + v0[1] * bfhi(b.x)); w.y = cvt_pk_bf16(bflo(p.y) + v0[2] * bflo(b.y), bfhi(p.y) + v0[3] * bfhi(b.y));
                    w.z = cvt_pk_bf16(bflo(p.z) + v1[0] * bflo(b.z), bfhi(p.z) + v1[1] * bfhi(b.z)); w.w = cvt_pk_bf16(bflo(p.w) + v1[2] * bflo(b.w), bfhi(p.w) + v1[3] * bfhi(b.w));
                    *(u32x4*)(O + off) = w;
                }
    }
};

template <bool PARTIAL> struct EpiRes {
    static constexpr bool PERM = false, AFTER_DRAIN = false;
    float* X; const float* gate; float* slab;
    __device__ __forceinline__ void operator()(const Acc& acc, const Unit& u, int wr, int wc, int fr, int fq) const {
        const int pm = u.pm, v = PARTIAL ? 2 : (pm < 32 ? 0 : (pm < 64 ? 1 : 2));
        const int rbase = pm * 256 + wr * 64 + fr, col0 = u.pn * 256 + wc * 32 + 4 * fq;
        const float* g = gate + v * 6144 + col0;
        float* base = PARTIAL ? slab + (size_t)u.kc * 512 * DM : X;
        f32x4 gv[2][2];
#pragma unroll
        for (int bj = 0; bj < 2; ++bj)
#pragma unroll
            for (int n = 0; n < 2; ++n) gv[bj][n] = *(const f32x4*)(g + bj * 128 + 16 * n);
#pragma unroll
        for (int ai = 0; ai < 2; ++ai)
#pragma unroll
            for (int m = 0; m < 4; ++m) {
                float* rowp = base + (size_t)(rbase + ai * 128 + m * 16) * DM + col0;
#pragma unroll
                for (int bj = 0; bj < 2; ++bj)
#pragma unroll
                    for (int n = 0; n < 2; ++n) {
                        const f32x4 d = gv[bj][n] * acc[ai][bj][m][n];
                        f32x4* p = (f32x4*)(rowp + bj * 128 + 16 * n);
                        if constexpr (PARTIAL) *p = d; else *p = *p + d;
                    }
            }
    }
};

struct EpiSwiglu {
    static constexpr bool PERM = true, AFTER_DRAIN = false;
    bf16* O;
    __device__ __forceinline__ void operator()(const Acc& acc, const Unit& u, int wr, int wc, int fr, int fq) const {
        const int rbase = u.pm * 256 + wr * 64 + fr, col0 = u.pn * 128 + wc * 32 + 8 * fq;
#pragma unroll
        for (int ai = 0; ai < 2; ++ai)
#pragma unroll
            for (int m = 0; m < 4; ++m) {
                f32x4 r[2];
#pragma unroll
                for (int n = 0; n < 2; ++n) {
                    const f32x4 a = acc[ai][0][m][n], uu = acc[ai][1][m][n];
#pragma unroll
                    for (int e = 0; e < 4; ++e) r[n][e] = a[e] * sigmoidf_(a[e]) * uu[e];
                }
                u32x4 w; w.x = cvt_pk_bf16(r[0][0], r[0][1]); w.y = cvt_pk_bf16(r[0][2], r[0][3]); w.z = cvt_pk_bf16(r[1][0], r[1][1]); w.w = cvt_pk_bf16(r[1][2], r[1][3]);
                *(u32x4*)(O + (size_t)(rbase + ai * 128 + m * 16) * FF + col0) = w;
            }
    }
};

template <int MAP>
__device__ __forceinline__ void transpose_item(const float* W, int N, bf16* WT, int ldk, int koff, LAS float* scr, int item, int lane) {
    const int nblk = N / 32, kb = item / nblk, nb = item % nblk, k0 = 64 * kb, n0 = 32 * nb;
#pragma unroll 8
    for (int i = 0; i < 32; ++i) { const int kk = 2 * i + (lane >> 5); scr[kk * 33 + (lane & 31)] = W[(size_t)(k0 + kk) * N + n0 + (lane & 31)]; }
    asm volatile("s_waitcnt lgkmcnt(0)" ::: "memory");
    int r0 = n0;
    if (MAP == 1) { if (n0 >= 1536 && n0 < 2304) { const int tile = n0 >> 8, within = n0 & 255, hw = within >> 6, bj = (within & 63) >> 5; r0 = tile * 256 + 128 * bj + 32 * hw; } }
    if (MAP == 2) { if (n0 < FF) { r0 = (n0 >> 7) * 256 + (n0 & 127); } else { const int n1 = n0 - FF; r0 = (n1 >> 7) * 256 + 128 + (n1 & 127); } }
    const int c = lane & 7;
#pragma unroll
    for (int j = 0; j < 4; ++j) { const int n = (lane >> 3) + 8 * j; const LAS float* s = scr + (8 * c) * 33 + n;
        u32x4 o; o.x = pk2(s[0 * 33], s[1 * 33]); o.y = pk2(s[2 * 33], s[3 * 33]); o.z = pk2(s[4 * 33], s[5 * 33]); o.w = pk2(s[6 * 33], s[7 * 33]);
        *(u32x4*)(WT + (size_t)(r0 + n) * ldk + koff + k0 + 8 * c) = o; }
    asm volatile("s_waitcnt lgkmcnt(0)" ::: "memory");
}

struct Params {
    const float *x, *c, *ctx, *c_ctx, *w_mod, *b_mod, *norm1, *w_in, *na_rpb, *q_gain, *k_gain, *w_pa, *w_pb, *w_o, *norm2, *w_ffn_in, *w_ffn_out, *final_norm;
    float* out; unsigned char* ws;
};

__device__ __forceinline__ void phase_wconv(const Params& P, int l, unsigned char* ws, LAS unsigned char* lds, int gw, int NGW, int wave, int lane) {
    LAS float* scr = (LAS float*)(lds + wave * 16384);
    constexpr int I_IN = (DM / 64) * (INC / 32), I_PA = (512 / 64) * (DM / 32), I_O = (DM / 64) * (DM / 32), I_FI = (DM / 64) * (FF2 / 32), I_FO = (FF / 64) * (DM / 32);
    constexpr int NITEMS = I_IN + 2 * I_PA + I_O + I_FI + I_FO;
    for (int it = gw; it < NITEMS; it += NGW) {
        int r = it;
        if (r < I_IN) { transpose_item<1>(P.w_in + (size_t)l * DM * INC, INC, (bf16*)(ws + WS_WIN), DM, 0, scr, r, lane); continue; } r -= I_IN;
        if (r < I_PA) { transpose_item<0>(P.w_pa + (size_t)l * 512 * DM, DM, (bf16*)(ws + WS_WPA), 512, 0, scr, r, lane); continue; } r -= I_PA;
        if (r < I_PA) { transpose_item<0>(P.w_pb + (size_t)l * 512 * DM, DM, (bf16*)(ws + WS_WPB), 512, 0, scr, r, lane); continue; } r -= I_PA;
        if (r < I_O) { transpose_item<0>(P.w_o + (size_t)l * DM * DM, DM, (bf16*)(ws + WS_WO), DM, 0, scr, r, lane); continue; } r -= I_O;
        if (r < I_FI) { transpose_item<2>(P.w_ffn_in + (size_t)l * DM * FF2, FF2, (bf16*)(ws + WS_WFI), DM, 0, scr, r, lane); continue; } r -= I_FI;
        transpose_item<0>(P.w_ffn_out + (size_t)l * FF * DM, DM, (bf16*)(ws + WS_WFO), FF, 0, scr, r, lane);
    }
}

__device__ __forceinline__ void norm_row(const float* xrow, float* xcopy, const float* gamma, const float* sh, const float* sc, bf16* hrow, int lane, const float* part = nullptr, int npart = 0) {
    const f32x4* xr = (const f32x4*)xrow + lane;
    f32x4 v[4]; float s = 0.f;
#pragma unroll
    for (int j = 0; j < 4; ++j) v[j] = xr[64 * j];
    for (int c = 0; c < npart; ++c) { const f32x4* pr = (const f32x4*)(part + (size_t)c * 512 * DM) + lane;
#pragma unroll
        for (int j = 0; j < 4; ++j) v[j] = v[j] + pr[64 * j]; }
#pragma unroll
    for (int j = 0; j < 4; ++j) { s += (v[j].x * v[j].x + v[j].y * v[j].y) + (v[j].z * v[j].z + v[j].w * v[j].w); }
    const float r = rsqrtf(wave_sum(s, lane) * (1.0f / DM) + EPS);
    if (xcopy) {
#pragma unroll
        for (int j = 0; j < 4; ++j) ((f32x4*)xcopy + lane)[64 * j] = v[j];
    }
    unsigned long long* o8 = (unsigned long long*)hrow + lane;
#pragma unroll
    for (int j = 0; j < 4; ++j) {
        const f32x4 g = ((const f32x4*)gamma + lane)[64 * j], a = ((const f32x4*)sc + lane)[64 * j], b = ((const f32x4*)sh + lane)[64 * j];
        const f32x4 y = (v[j] * r) * g * (a + 1.0f) + b;
        o8[64 * j] = (unsigned long long)pk2(y.x, y.y) | ((unsigned long long)pk2(y.z, y.w) << 32);
    }
}

#define XB_TMO      128
#define XB_XCNT(j)  (256  + 64 * (j))
#define XB_XSUB(j)  (1280 + 64 * (j))
#define XB_XGEN(j)  (2304 + 64 * (j))
#define XB_TOP      3328
#define XB_TOPGEN   3392
#define XCD_BAR_WORDS 3456
#define XB_SPIN_CAP (1u << 18)

__device__ __forceinline__ unsigned xb_ld(unsigned* p)              { return __hip_atomic_load(p, __ATOMIC_RELAXED, __HIP_MEMORY_SCOPE_AGENT); }
__device__ __forceinline__ unsigned xb_add(unsigned* p, unsigned v) { return __hip_atomic_fetch_add(p, v, __ATOMIC_RELAXED, __HIP_MEMORY_SCOPE_AGENT); }
__device__ __forceinline__ unsigned xb_xcc_id() { return (unsigned)__builtin_amdgcn_s_getreg((3 << 11) | 20) & 0xFu; }
#define XB_SPIN(cond, bar) do { unsigned _sp = 0; while (cond) { __builtin_amdgcn_s_sleep(1); \
    if ((++_sp & 255u) == 0u) { if (xb_ld(&(bar)[XB_TMO])) break; if (_sp > XB_SPIN_CAP) { atomicAdd(&(bar)[XB_TMO], 1u); break; } } } } while (0)

struct XcdBarrier {
    unsigned* bar; unsigned x;
    volatile LAS unsigned* st;
};

__device__ __forceinline__ XcdBarrier xcd_barrier_post(unsigned* bar, volatile LAS unsigned* st) {
    XcdBarrier b; b.bar = bar; b.x = xb_xcc_id(); b.st = st;
    if (threadIdx.x == 0) (void)xb_add(&bar[XB_XCNT(b.x)], 1u);
    return b;
}
__device__ __forceinline__ void xcd_barrier_complete(unsigned* bar, unsigned x, unsigned& nloc, unsigned& nx) {
    const unsigned G = gridDim.x * gridDim.y * gridDim.z;
    unsigned sum, cnt, mine, sp = 0u;
    for (;;) {
        sum = 0u; cnt = 0u; mine = 0u;
#pragma unroll
        for (unsigned j = 0; j < 16; ++j) { const unsigned c = xb_ld(&bar[XB_XCNT(j)]); sum += c; cnt += (c > 0u) ? 1u : 0u; mine = (j == x) ? c : mine; }
        if (sum == G) break;
        __builtin_amdgcn_s_sleep(1);
        if ((++sp & 255u) == 0u) { if (xb_ld(&bar[XB_TMO])) break; if (sp > XB_SPIN_CAP) { atomicAdd(&bar[XB_TMO], 1u); break; } }
    }
    nloc = mine > 0u ? mine : 1u; nx = cnt > 0u ? cnt : 1u;
}

__device__ __forceinline__ void xcd_barrier(const XcdBarrier& b) {
    asm volatile("s_waitcnt vmcnt(0)" ::: "memory");
    __syncthreads();
    if (threadIdx.x == 0) {
        unsigned* bar = b.bar;
        __builtin_amdgcn_s_waitcnt(0);
        unsigned nloc = b.st[0], nx = b.st[1];
        if (nloc == 0u) { xcd_barrier_complete(bar, b.x, nloc, nx); b.st[0] = nloc; b.st[1] = nx; }
        const unsigned old = xb_add(&bar[XB_XSUB(b.x)], 1u);
        const unsigned gen = old / nloc;
        if (old + 1u == (gen + 1u) * nloc) {
            __builtin_amdgcn_fence(__ATOMIC_RELEASE, "agent");
            asm volatile("s_waitcnt vmcnt(0)" ::: "memory");
            const unsigned og = xb_add(&bar[XB_TOP], 1u);
            const unsigned tg = og / nx;
            if (og + 1u == (tg + 1u) * nx) xb_add(&bar[XB_TOPGEN], 1u);
            else XB_SPIN(xb_ld(&bar[XB_TOPGEN]) == tg, bar);
            __builtin_amdgcn_fence(__ATOMIC_ACQUIRE, "agent");
            xb_add(&bar[XB_XGEN(b.x)], 1u);
            asm volatile("s_waitcnt vmcnt(0)" ::: "memory");
        } else {
            XB_SPIN(xb_ld(&bar[XB_XGEN(b.x)]) == gen, bar);
            __builtin_amdgcn_fence(__ATOMIC_ACQUIRE, "agent");
            asm volatile("s_waitcnt vmcnt(0)" ::: "memory");
        }
    }
    __syncthreads();
}

#define MODS ((float*)(ws + WS_MODS))
#define mods (MODS + (size_t)l * 3 * 6144)
#define X ((float*)(ws + WS_X))
#define H ((bf16*)(ws + WS_H))
#define NAQ ((bf16*)(ws + WS_NAQ))
#define NAK ((bf16*)(ws + WS_NAK))
#define NAV ((bf16*)(ws + WS_NAV))
#define GQ ((bf16*)(ws + WS_GQ))
#define GK ((bf16*)(ws + WS_GK))
#define GV ((bf16*)(ws + WS_GV))
#define SA ((bf16*)(ws + WS_SA))
#define SB ((bf16*)(ws + WS_SB))
#define YA ((bf16*)(ws + WS_YA))
#define YB ((bf16*)(ws + WS_YB))
#define ACT ((bf16*)(ws + WS_ACT))
__global__ void __launch_bounds__(NTHREADS, 2) mega_fwd(Params P) {
    extern __shared__ __attribute__((aligned(16))) unsigned char lds[];
    cg::grid_group grid = cg::this_grid();
    LAS unsigned char* ldsl = (LAS unsigned char*)lds;
    const int wave = __builtin_amdgcn_readfirstlane((int)threadIdx.x >> 6);
#define FRESH_LANE() pg8::pg8_lane_id()
#define FRESH_TID() (wave * 64 + FRESH_LANE())
    const int G = gridDim.x, bx = blockIdx.x;
    const int vcu = (G % 8 == 0) ? (bx % 8) * (G / 8) + bx / 8 : bx;
    const int gw = vcu * NWAVES + wave, NGW = G * NWAVES;
    volatile LAS unsigned* MISC = (volatile LAS unsigned*)(ldsl + RING_BYTES);
    { const int t0 = FRESH_TID(); if (t0 < 64) MISC[t0] = 0u; }
    __syncthreads();
    const XcdBarrier xbar = xcd_barrier_post((unsigned*)P.ws, MISC + 8);
#define GRID_BAR() do { XcdBarrier b_ = xbar; b_.bar = (unsigned*)lws(P.ws); xcd_barrier(b_); } while (0)

    {
        unsigned char* ws = lws(P.ws); const int tid = FRESH_TID();
        float* sl = (float*)lds;
        f32x4* red = (f32x4*)(lds + 16384);
        for (int i = tid; i < 3072; i += NTHREADS) { const int v = i >> 10, k = i & 1023; const float xv = v < 2 ? P.c[v * 1024 + k] : P.c_ctx[k]; sl[i] = xv * sigmoidf_(xv); }
        __syncthreads();
        const int cgi = tid & 31, kc = tid >> 5;
        for (int item = bx; item < 192; item += G) {
            const int l = item / 48, jb = (item % 48) * 128;
            const float* w = P.w_mod + (size_t)l * DM * 6144 + jb + cgi * 4;
            f32x4 a0 = {0.f, 0.f, 0.f, 0.f}, a1 = a0, a2 = a0;
#pragma unroll 8
            for (int kk = 0; kk < 64; ++kk) { const int k = kc * 64 + kk; const f32x4 wv = *(const f32x4*)(w + (size_t)k * 6144);
                a0 = a0 + wv * sl[k]; a1 = a1 + wv * sl[1024 + k]; a2 = a2 + wv * sl[2048 + k]; }
            red[(kc * 3 + 0) * 32 + cgi] = a0; red[(kc * 3 + 1) * 32 + cgi] = a1; red[(kc * 3 + 2) * 32 + cgi] = a2;
            __syncthreads();
            if (tid < 384) { const int v = tid >> 7, cc = tid & 127; float s = 0.f;
#pragma unroll
                for (int q = 0; q < 16; ++q) s += ((const float*)&red[(q * 3 + v) * 32 + (cc >> 2)])[cc & 3];
                MODS[(size_t)(l * 3 + v) * 6144 + jb + cc] = s + P.b_mod[l * 6144 + jb + cc]; }
            __syncthreads();
        }
        __syncthreads();
        phase_wconv(P, 0, ws, ldsl, gw, NGW, wave, FRESH_LANE());
    }
    grid.sync();

    for (int l = 0; l < DEPTH; ++l) {
        const bool last = (l == DEPTH - 1);
        const int MG = last ? NL : MT;
        { unsigned char* ws = lws(P.ws);
        if (l > 0) phase_wconv(P, l, ws, ldsl, gw, NGW, wave, FRESH_LANE());
        const int ln = FRESH_LANE();
        for (int row = gw; row < MT; row += NGW) {
            const int v = row < NL ? (row >> 13) : 2;
            const float* xr = (l == 0) ? (row < NL ? P.x + (size_t)row * DM : P.ctx + (size_t)(row - NL) * DM) : X + (size_t)row * DM;
            const bool addp = (l > 0) && (row >= NL);
            norm_row(xr, (l == 0 || addp) ? X + (size_t)row * DM : nullptr, P.norm1 + l * DM, mods + v * 6144 + 0, mods + v * 6144 + 1024, H + (size_t)row * DM, ln,
                     (const float*)(ws + WS_SLAB) + (size_t)(row - NL) * DM, addp ? FF / 256 : 0);
        } }
        GRID_BAR();
        {
            unsigned char* ws = lws(P.ws);
            pg8::Gemm g{H, (const bf16*)(ws + WS_WIN), MT, INC, DM, DM}; pg8::StaticOrder S; S.init(MT, INC, G, bx);
            EpiIn E{NAQ, NAK, NAV, GQ, GK, GV, SA, SB, P.q_gain + l * 64, P.k_gain + l * 64};
            pg8::gemm_phase<EpiIn, pg8::StaticOrder, true, true>(ldsl, g, S, E, wave);
        }
        GRID_BAR();
        {
            unsigned char* ws = lws(P.ws);
            char* shm = (char*)lds;
            const int total = last ? 1024 : 1056;
            typedef attn_body::bf16 abf;
            for (int idx = vcu; idx < total; idx += G) {
                const bool isna = (idx >= 512) && (idx < 1040);
                if (!isna) {
                    const bool isc = idx >= 1040; const int un = isc ? idx - 1040 : idx;
                    const int b = isc ? (un >> 3) : (un >> 8), hq = isc ? (un & 7) : ((un >> 5) & 7), qb = un & 31, kvh = hq >> 2;
                    const size_t qrow = isc ? (size_t)(NL + b * 256) : (size_t)(b * SEQ + qb * 256), krow = (size_t)(b * 8448 + (isc ? 8192 : 0));
                    attn_body::attn_unit<8, false>((const abf*)(GQ + qrow * 512 + hq * 64), (const abf*)(GK + krow * 128 + kvh * 64), (const abf*)(GV + krow * 128 + kvh * 64),
                                                   (abf*)(YB + qrow * 512 + hq * 64), isc ? 4 : 132, shm, wave);
                } else {
                    const bool isc = idx >= 1024; const int un = isc ? idx - 1024 : idx - 512;
                    const int b = isc ? (un >> 3) : (un >> 8), h = isc ? (un & 7) : ((un >> 5) & 7), R = un & 31;
                    const int kr0 = min(max(4 * R - 4, 0), 120), kr1 = min(max(4 * R - 1, 0), 120) + 7, nwin = isc ? 0 : kr1 - kr0 + 1, NT = (4 + nwin + 1) & ~1;
                    const size_t qrow = isc ? (size_t)(NL + b * 256) : (size_t)(b * SEQ + R * 256);
                    attn_body::attn_unit<8, true>((const abf*)(NAQ + qrow * 512 + h * 64), (const abf*)(NAK + (size_t)(b * 8448) * 512 + h * 64), (const abf*)(NAV + (size_t)(b * 8448) * 512 + h * 64),
                                                  (abf*)(YA + qrow * 512 + h * 64), NT, shm, wave, kr0, nwin, 4 * R, P.na_rpb + (size_t)(l * 8 + h) * 465);
                }
            }
        }
        GRID_BAR();
        for (int pass = 0; pass < 2; ++pass) {
            unsigned char* ws = lws(P.ws);
            pg8::Gemm g{pass ? YB : YA, (const bf16*)(ws + (pass ? WS_WPB : WS_WPA)), MG, DM, 512, 512}; pg8::StaticOrder S; S.init(MG, DM, G, bx);
            EpiMerge E{pass ? SB : SA, H, pass};
            pg8::gemm_phase<EpiMerge, pg8::StaticOrder, true, true>(ldsl, g, S, E, wave);
        }
        GRID_BAR();
        {
            unsigned char* ws = lws(P.ws);
            pg8::Gemm g{H, (const bf16*)(ws + WS_WO), NL, DM, DM, DM}; pg8::StaticOrder S; S.init(NL, DM, G, bx);
            EpiRes<false> E{X, mods + 2048, nullptr};
            pg8::gemm_phase<EpiRes<false>, pg8::StaticOrder, true, true>(ldsl, g, S, E, wave);
        }
        if (!last) {
            unsigned char* ws = lws(P.ws);
            pg8::Gemm g{H + (size_t)NL * DM, (const bf16*)(ws + WS_WO), 512, DM, 256, DM}; pg8::CtxSplitOrder S; S.init(DM / 256, DM / 256, G, bx);
            EpiRes<true> E{X, mods + 2048, (float*)(ws + WS_SLAB)};
            pg8::gemm_phase<EpiRes<true>, pg8::CtxSplitOrder, false, true>(ldsl, g, S, E, wave);
        }
        GRID_BAR();
        { unsigned char* ws = lws(P.ws); const int ln = FRESH_LANE();
        for (int row = gw; row < MG; row += NGW) {
            const int v = row < NL ? (row >> 13) : 2;
            const bool addp = row >= NL;
            norm_row(X + (size_t)row * DM, addp ? X + (size_t)row * DM : nullptr, P.norm2 + l * DM, mods + v * 6144 + 3072, mods + v * 6144 + 4096, H + (size_t)row * DM, ln,
                     (const float*)(ws + WS_SLAB) + (size_t)(row - NL) * DM, addp ? DM / 256 : 0);
        } }
        GRID_BAR();
        {
            unsigned char* ws = lws(P.ws);
            pg8::Gemm g{H, (const bf16*)(ws + WS_WFI), MG, FF2, DM, DM}; pg8::StaticOrder S; S.init(MG, FF2, G, bx);
            EpiSwiglu E{ACT};
            pg8::gemm_phase<EpiSwiglu, pg8::StaticOrder, true, true>(ldsl, g, S, E, wave);
        }
        GRID_BAR();
        {
            unsigned char* ws = lws(P.ws);
            pg8::Gemm g{ACT, (const bf16*)(ws + WS_WFO), NL, DM, FF, FF}; pg8::StaticOrder S; S.init(NL, DM, G, bx);
            EpiRes<false> E{X, mods + 5120, nullptr};
            pg8::gemm_phase<EpiRes<false>, pg8::StaticOrder, true, true>(ldsl, g, S, E, wave);
        }
        if (!last) {
            unsigned char* ws = lws(P.ws);
            pg8::Gemm g{ACT + (size_t)NL * FF, (const bf16*)(ws + WS_WFO), 512, DM, 256, FF}; pg8::CtxSplitOrder S; S.init(DM / 256, FF / 256, G, bx);
            EpiRes<true> E{X, mods + 5120, (float*)(ws + WS_SLAB)};
            pg8::gemm_phase<EpiRes<true>, pg8::CtxSplitOrder, false, true>(ldsl, g, S, E, wave);
        }
        GRID_BAR();
    }
    unsigned char* ws = lws(P.ws); const int lane = FRESH_LANE();
    for (int row = gw; row < NL; row += NGW) {
        const f32x4* xr = (const f32x4*)(X + (size_t)row * DM) + lane;
        f32x4 v[4]; float s = 0.f;
#pragma unroll
        for (int j = 0; j < 4; ++j) { v[j] = xr[64 * j]; s += (v[j].x * v[j].x + v[j].y * v[j].y) + (v[j].z * v[j].z + v[j].w * v[j].w); }
        const float r = rsqrtf(wave_sum(s, lane) * (1.0f / DM) + EPS);
        f32x4* o = (f32x4*)(P.out + (size_t)row * DM) + lane;
#pragma unroll
        for (int j = 0; j < 4; ++j) o[64 * j] = (v[j] * r) * ((const f32x4*)P.final_norm + lane)[64 * j];
    }
}

#undef MODS
#undef mods
#undef X
#undef H
#undef NAQ
#undef NAK
#undef NAV
#undef GQ
#undef GK
#undef GV
#undef SA
#undef SB
#undef YA
#undef YB
#undef ACT
extern "C" void kernel_launch(void* const* d_in, const int* in_sizes, int n_in, void* d_out, int out_size, void* d_ws, size_t ws_size, hipStream_t stream) {
    static int grid = 0;
    if (grid == 0) {
        if (n_in != 18 || ws_size < WS_END) { fprintf(stderr, "kernel_launch: need 18 inputs and >= %zu bytes of workspace; got n_in %d ws %zu\n", (size_t)WS_END, n_in, ws_size); grid = -1; return; }
        int dev = 0, cus = 0, per_cu = 0;
        hipGetDevice(&dev);
        hipDeviceGetAttribute(&cus, hipDeviceAttributeMultiprocessorCount, dev);
        if (hipFuncSetAttribute((const void*)mega_fwd, hipFuncAttributeMaxDynamicSharedMemorySize, LDS_BYTES) != hipSuccess) { fprintf(stderr, "kernel_launch: hipFuncSetAttribute failed\n"); grid = -1; return; }
        if (hipOccupancyMaxActiveBlocksPerMultiprocessor(&per_cu, (const void*)mega_fwd, NTHREADS, LDS_BYTES) != hipSuccess || per_cu < 1) { fprintf(stderr, "kernel_launch: occupancy query says %d\n", per_cu); per_cu = 1; }
        (void)hipGetLastError();
        grid = cus * (per_cu > 1 ? 1 : per_cu);
    }
    if (grid < 0) return;
    if (hipMemsetAsync(d_ws, 0, 16384, stream) != hipSuccess) { fprintf(stderr, "kernel_launch: hipMemsetAsync failed\n"); return; }
    Params p{};
    const float** pp = (const float**)&p;
    for (int i = 0; i < 18; ++i) pp[i] = (const float*)d_in[i];
    p.out = (float*)d_out; p.ws = (unsigned char*)d_ws;
    void* args[] = {&p};
    hipError_t e = hipLaunchCooperativeKernel((const void*)mega_fwd, dim3(grid), dim3(NTHREADS), args, LDS_BYTES, stream);
    if (e != hipSuccess) fprintf(stderr, "cooperative launch failed: %s (grid %d)\n", hipGetErrorString(e), grid);
}
```

```cpp
#include <hip/hip_runtime.h>
#include <hip/hip_cooperative_groups.h>
#include <cstdio>
#include <cstdint>
#include <hip/hip_bf16.h>
#include <cmath>
namespace cg = cooperative_groups;
__device__ const float ROPE_TAB[128*16*2] = {
1.000000000e+00f, 0.000000000e+00f, 1.000000000e+00f, 0.000000000e+00f, 1.000000000e+00f, 0.000000000e+00f, 1.000000000e+00f, 0.000000000e+00f, 1.000000000e+00f, 0.000000000e+00f, 1.000000000e+00f, 0.000000000e+00f, 1.000000000e+00f, 0.000000000e+00f, 1.000000000e+00f, 0.000000000e+00f, 1.000000000e+00f, 0.000000000e+00f, 1.000000000e+00f, 0.000000000e+00f, 1.000000000e+00f, 0.000000000e+00f, 1.000000000e+00f, 0.000000000e+00f, 1.000000000e+00f, 0.000000000e+00f, 1.000000000e+00f, 0.000000000e+00f, 1.000000000e+00f, 0.000000000e+00f, 1.000000000e+00f, 0.000000000e+00f,
5.403022766e-01f, 8.414710164e-01f, 8.460091352e-01f, 5.331684351e-01f, 9.504152536e-01f, 3.109835982e-01f, 9.842302203e-01f, 1.768921912e-01f, 9.950041771e-01f, 9.983342141e-02f, 9.984192848e-01f, 5.620449781e-02f, 9.995000362e-01f, 3.161750361e-02f, 9.998418689e-01f, 1.778185740e-02f, 9.999499917e-01f, 9.999833070e-03f, 9.999842048e-01f, 5.623383448e-03f, 9.999949932e-01f, 3.162272274e-03f, 9.999983907e-01f, 1.778278500e-03f, 9.999995232e-01f, 9.999999311e-04f, 9.999998212e-01f, 5.623412435e-04f, 9.999999404e-01f, 3.162277571e-04f, 1.000000000e+00f, 1.778279402e-04f,
-4.161468148e-01f, 9.092974067e-01f, 4.314628243e-01f, 9.021307230e-01f, 8.065783978e-01f, 5.911270976e-01f, 9.374182820e-01f, 3.482052684e-01f, 9.800665975e-01f, 1.986693293e-01f, 9.936820865e-01f, 1.122313142e-01f, 9.980006814e-01f, 6.320339441e-02f, 9.993675947e-01f, 3.555808961e-02f, 9.998000264e-01f, 1.999866590e-02f, 9.999367595e-01f, 1.124658901e-02f, 9.999799728e-01f, 6.324512884e-03f, 9.999936819e-01f, 3.556551412e-03f, 9.999979734e-01f, 1.999998698e-03f, 9.999993443e-01f, 1.124682371e-03f, 9.999998212e-01f, 6.324554561e-04f, 9.999999404e-01f, 3.556558804e-04f,
-9.899924994e-01f, 1.411200017e-01f, -1.159661636e-01f, 9.932531714e-01f, 5.827535987e-01f, 8.126488924e-01f, 8.610406518e-01f, 5.085361004e-01f, 9.553365111e-01f, 2.955202162e-01f, 9.858034849e-01f, 1.679033041e-01f, 9.955033660e-01f, 9.472608566e-02f, 9.985772967e-01f, 5.332308263e-02f, 9.995500445e-01f, 2.999549918e-02f, 9.998577237e-01f, 1.686943881e-02f, 9.999549985e-01f, 9.486690164e-03f, 9.999857545e-01f, 5.334813148e-03f, 9.999955297e-01f, 2.999995602e-03f, 9.999985695e-01f, 1.687023090e-03f, 9.999995232e-01f, 9.486831259e-04f, 9.999998808e-01f, 5.334838061e-04f,
-6.536436081e-01f, -7.568024993e-01f, -6.276797056e-01f, 7.784717083e-01f, 3.011374772e-01f, 9.535807371e-01f, 7.575061917e-01f, 6.528279781e-01f, 9.210609794e-01f, 3.894183338e-01f, 9.748082757e-01f, 2.230444849e-01f, 9.920106530e-01f, 1.261540651e-01f, 9.974712729e-01f, 7.107120752e-02f, 9.992001057e-01f, 3.998933360e-02f, 9.997470379e-01f, 2.249175683e-02f, 9.999200106e-01f, 1.264877338e-02f, 9.999747276e-01f, 7.113057654e-03f, 9.999920130e-01f, 3.999989480e-03f, 9.999974966e-01f, 2.249363344e-03f, 9.999992251e-01f, 1.264910679e-03f, 9.999997616e-01f, 7.113117026e-04f,
2.836621702e-01f, -9.589242935e-01f, -9.460792542e-01f, 3.239352703e-01f, -1.034233812e-02f, 9.999465346e-01f, 6.300802827e-01f, 7.765299678e-01f, 8.775825500e-01f, 4.794255495e-01f, 9.607312679e-01f, 2.774805427e-01f, 9.875259995e-01f, 1.574558765e-01f, 9.960497618e-01f, 8.879686147e-02f, 9.987502694e-01f, 4.997916520e-02f, 9.996047616e-01f, 2.811336145e-02f, 9.998750091e-01f, 1.581072807e-02f, 9.999604821e-01f, 8.891279809e-03f, 9.999874830e-01f, 4.999979399e-03f, 9.999960661e-01f, 2.811702900e-03f, 9.999987483e-01f, 1.581138116e-03f, 9.999995828e-01f, 8.891395992e-04f,
9.601702690e-01f, -2.794154882e-01f, -9.731037021e-01f, -2.303675264e-01f, -3.207963705e-01f, 9.471482038e-01f, 4.827820063e-01f, 8.757405281e-01f, 8.253356218e-01f, 5.646424890e-01f, 9.436169863e-01f, 3.310393095e-01f, 9.820539355e-01f, 1.886002719e-01f, 9.943132997e-01f, 1.064944416e-01f, 9.982005358e-01f, 5.996400490e-02f, 9.994308352e-01f, 3.373407945e-02f, 9.998199940e-01f, 1.897252724e-02f, 9.999430776e-01f, 1.066947449e-02f, 9.999819994e-01f, 5.999964196e-03f, 9.999943376e-01f, 3.374041524e-03f, 9.999982119e-01f, 1.897365320e-03f, 9.999994040e-01f, 1.066967379e-03f,
7.539022565e-01f, 6.569865942e-01f, -7.004297972e-01f, -7.137212753e-01f, -5.994374752e-01f, 8.004215956e-01f, 3.202570081e-01f, 9.473307133e-01f, 7.648422122e-01f, 6.442176700e-01f, 9.235194325e-01f, 3.835515678e-01f, 9.755998850e-01f, 2.195560932e-01f, 9.922624230e-01f, 1.241583377e-01f, 9.975510240e-01f, 6.994284689e-02f, 9.992253184e-01f, 3.935372457e-02f, 9.997550249e-01f, 2.213413455e-02f, 9.999225140e-01f, 1.244763471e-02f, 9.999755025e-01f, 6.999942940e-03f, 9.999922514e-01f, 3.936378751e-03f, 9.999975562e-01f, 2.213592408e-03f, 9.999992251e-01f, 1.244795276e-03f,
-1.455000341e-01f, 9.893582463e-01f, -2.120364457e-01f, -9.772617817e-01f, -8.186324239e-01f, 5.743178129e-01f, 1.476312131e-01f, 9.890424609e-01f, 6.967067122e-01f, 7.173560858e-01f, 9.005023241e-01f, 4.348512292e-01f, 9.681702852e-01f, 2.502923310e-01f, 9.898977876e-01f, 1.417829692e-01f, 9.968017340e-01f, 7.991468906e-02f, 9.989882708e-01f, 4.497213289e-02f, 9.996800423e-01f, 2.529552206e-02f, 9.998987913e-01f, 1.422575582e-02f, 9.999679923e-01f, 7.999914698e-03f, 9.999898672e-01f, 4.498715047e-03f, 9.999967813e-01f, 2.529819263e-03f, 9.999989867e-01f, 1.422623056e-03f,
-9.111302495e-01f, 4.121184647e-01f, 3.416602314e-01f, -9.398235083e-01f, -9.566441774e-01f, 2.912592292e-01f, -2.965079620e-02f, 9.995602965e-01f, 6.216099262e-01f, 7.833269238e-01f, 8.746382594e-01f, 4.847761393e-01f, 9.597726464e-01f, 2.807783186e-01f, 9.872201085e-01f, 1.593627781e-01f, 9.959527254e-01f, 8.987854421e-02f, 9.987195730e-01f, 5.058911815e-02f, 9.995950460e-01f, 2.845665626e-02f, 9.998719096e-01f, 1.600383036e-02f, 9.999595284e-01f, 8.999879472e-03f, 9.999871850e-01f, 5.061050411e-03f, 9.999959469e-01f, 2.846045885e-03f, 9.999987483e-01f, 1.600450720e-03f,
-8.390715122e-01f, -5.440210700e-01f, 7.901318669e-01f, -6.129369140e-01f, -9.997860789e-01f, -2.068356983e-02f, -2.059976310e-01f, 9.785524607e-01f, 5.403022766e-01f, 8.414710164e-01f, 8.460091352e-01f, 5.331684351e-01f, 9.504153132e-01f, 3.109835684e-01f, 9.842302203e-01f, 1.768921912e-01f, 9.950041771e-01f, 9.983341396e-02f, 9.984192848e-01f, 5.620449781e-02f, 9.995000362e-01f, 3.161750361e-02f, 9.998418689e-01f, 1.778185740e-02f, 9.999499917e-01f, 9.999834001e-03f, 9.999842048e-01f, 5.623383448e-03f, 9.999949932e-01f, 3.162272274e-03f, 9.999983907e-01f, 1.778278500e-03f,
4.425697960e-03f, -9.999902248e-01f, 9.952573776e-01f, -9.727646410e-02f, -9.437797070e-01f, -3.305749595e-01f, -3.758473992e-01f, 9.266815782e-01f, 4.535961151e-01f, 8.912073374e-01f, 8.147053123e-01f, 5.798751712e-01f, 9.401075840e-01f, 3.408778608e-01f, 9.809291363e-01f, 1.943656504e-01f, 9.939560890e-01f, 1.097782999e-01f, 9.980874062e-01f, 6.181810424e-02f, 9.993950725e-01f, 3.477803990e-02f, 9.998086691e-01f, 1.955982670e-02f, 9.999395013e-01f, 1.099977922e-02f, 9.999808669e-01f, 6.185714621e-03f, 9.999939203e-01f, 3.478498431e-03f, 9.999980927e-01f, 1.956106164e-03f,
8.438539505e-01f, -5.365729332e-01f, 8.938615918e-01f, 4.483429790e-01f, -7.941793799e-01f, -6.076834202e-01f, -5.338430405e-01f, 8.455836177e-01f, 3.623577356e-01f, 9.320390821e-01f, 7.808259130e-01f, 6.247486472e-01f, 9.288598895e-01f, 3.704312742e-01f, 9.773178697e-01f, 2.117776722e-01f, 9.928086400e-01f, 1.197122037e-01f, 9.977239966e-01f, 6.742975861e-02f, 9.992800951e-01f, 3.793822229e-02f, 9.997723103e-01f, 2.133773454e-02f, 9.999279976e-01f, 1.199971233e-02f, 9.999772310e-01f, 6.748044398e-03f, 9.999927878e-01f, 3.794723889e-03f, 9.999977350e-01f, 2.133933594e-03f,
9.074468017e-01f, 4.201670587e-01f, 5.171728134e-01f, 8.558809757e-01f, -5.658205152e-01f, -8.245284557e-01f, -6.750016809e-01f, 7.378162146e-01f, 2.674987614e-01f, 9.635581970e-01f, 7.444779873e-01f, 6.676470041e-01f, 9.166833758e-01f, 3.996143043e-01f, 9.733975530e-01f, 2.291227132e-01f, 9.915618896e-01f, 1.296341419e-01f, 9.973290563e-01f, 7.303927839e-02f, 9.991551042e-01f, 4.109803215e-02f, 9.997327924e-01f, 2.311557345e-02f, 9.999154806e-01f, 1.299963426e-02f, 9.999732971e-01f, 7.310371846e-03f, 9.999915361e-01f, 4.110949114e-03f, 9.999973178e-01f, 2.311761025e-03f,
1.367372274e-01f, 9.906073809e-01f, -1.879615150e-02f, 9.998233318e-01f, -2.813494802e-01f, -9.596053958e-01f, -7.948708534e-01f, 6.067786217e-01f, 1.699671596e-01f, 9.854497313e-01f, 7.057763338e-01f, 7.084347010e-01f, 9.035902619e-01f, 4.283977747e-01f, 9.691694379e-01f, 2.463953048e-01f, 9.902160168e-01f, 1.395431161e-01f, 9.969025850e-01f, 7.864648104e-02f, 9.990201592e-01f, 4.425742477e-02f, 9.996901155e-01f, 2.489333972e-02f, 9.999020100e-01f, 1.399954315e-02f, 9.999690056e-01f, 7.872696966e-03f, 9.999902248e-01f, 4.427174106e-03f, 9.999969006e-01f, 2.489588689e-03f,
-7.596879005e-01f, 6.502878666e-01f, -5.489754677e-01f, 8.358384371e-01f, 3.102234937e-02f, -9.995186925e-01f, -8.896704316e-01f, 4.566032588e-01f, 7.073719800e-02f, 9.974949956e-01f, 6.648434997e-01f, 7.469826937e-01f, 8.895936012e-01f, 4.567528665e-01f, 9.646348357e-01f, 2.635899782e-01f, 9.887710810e-01f, 1.494381279e-01f, 9.964445233e-01f, 8.425120264e-02f, 9.988752007e-01f, 4.741638154e-02f, 9.996442795e-01f, 2.667102963e-02f, 9.998875260e-01f, 1.499943808e-02f, 9.999644160e-01f, 8.435020223e-03f, 9.999887347e-01f, 4.743398633e-03f, 9.999964237e-01f, 2.667415887e-03f,
-9.576594830e-01f, -2.879033387e-01f, -9.100810885e-01f, 4.144302309e-01f, 3.403181434e-01f, -9.403103590e-01f, -9.564100504e-01f, 2.920270860e-01f, -2.919954434e-02f, 9.995735884e-01f, 6.218088269e-01f, 7.831690907e-01f, 8.747074604e-01f, 4.846512377e-01f, 9.597951770e-01f, 2.807013094e-01f, 9.872272611e-01f, 1.593182087e-01f, 9.959549904e-01f, 8.985326439e-02f, 9.987202883e-01f, 5.057485774e-02f, 9.995952845e-01f, 2.844863199e-02f, 9.998720288e-01f, 1.599931903e-02f, 9.999595284e-01f, 8.997339755e-03f, 9.999871850e-01f, 5.059622694e-03f, 9.999959469e-01f, 2.845243318e-03f,
-2.751633525e-01f, -9.613974690e-01f, -9.908979535e-01f, -1.346151382e-01f, 6.158647537e-01f, -7.878518701e-01f, -9.929850101e-01f, 1.182405204e-01f, -1.288445443e-01f, 9.916648269e-01f, 5.768082738e-01f, 8.168795705e-01f, 8.589466810e-01f, 5.120649934e-01f, 9.546520114e-01f, 2.977238595e-01f, 9.855847955e-01f, 1.691823453e-01f, 9.954339862e-01f, 9.545248002e-02f, 9.985553622e-01f, 5.373282731e-02f, 9.995430708e-01f, 3.022614494e-02f, 9.998555183e-01f, 1.699918136e-02f, 9.999542832e-01f, 9.559656493e-03f, 9.999855757e-01f, 5.375845823e-03f, 9.999954104e-01f, 3.023070283e-03f,
6.603167057e-01f, -7.509872317e-01f, -7.665365338e-01f, -6.422007084e-01f, 8.303361535e-01f, -5.572628975e-01f, -9.982416630e-01f, -5.927551538e-02f, -2.272021621e-01f, 9.738476276e-01f, 5.299841762e-01f, 8.480075598e-01f, 8.423270583e-01f, 5.389667153e-01f, 9.492070079e-01f, 3.146522641e-01f, 9.838436842e-01f, 1.790295690e-01f, 9.948815107e-01f, 1.010486856e-01f, 9.983804226e-01f, 5.689026415e-02f, 9.994877577e-01f, 3.200356290e-02f, 9.998379946e-01f, 1.799902879e-02f, 9.999487996e-01f, 1.012197044e-02f, 9.999837875e-01f, 5.692068953e-03f, 9.999948740e-01f, 3.200897481e-03f,
9.887046218e-01f, 1.498772055e-01f, -3.060954213e-01f, -9.520008564e-01f, 9.624637961e-01f, -2.714101076e-01f, -9.720142484e-01f, -2.349218130e-01f, -3.232895434e-01f, 9.463000894e-01f, 4.814845622e-01f, 8.764545918e-01f, 8.248651624e-01f, 5.653295517e-01f, 9.434618354e-01f, 3.314811885e-01f, 9.820042253e-01f, 1.888588965e-01f, 9.942975044e-01f, 1.066416800e-01f, 9.981955290e-01f, 6.004713103e-02f, 9.994292855e-01f, 3.378088027e-02f, 9.998195171e-01f, 1.899885759e-02f, 9.999428988e-01f, 1.068428159e-02f, 9.999819398e-01f, 6.008291151e-03f, 9.999942780e-01f, 3.378724447e-03f,
4.080820680e-01f, 9.129452705e-01f, 2.486167252e-01f, -9.686019421e-01f, 9.991443753e-01f, 4.135829210e-02f, -9.151299596e-01f, -4.031589925e-01f, -4.161468148e-01f, 9.092974067e-01f, 4.314628243e-01f, 9.021307230e-01f, 8.065784574e-01f, 5.911270380e-01f, 9.374182820e-01f, 3.482052684e-01f, 9.800665975e-01f, 1.986693144e-01f, 9.936820865e-01f, 1.122313142e-01f, 9.980006814e-01f, 6.320339441e-02f, 9.993675947e-01f, 3.555808961e-02f, 9.998000264e-01f, 1.999866776e-02f, 9.999367595e-01f, 1.124658901e-02f, 9.999799728e-01f, 6.324512884e-03f, 9.999936819e-01f, 3.556551412e-03f,
-5.477292538e-01f, 8.366556168e-01f, 7.267602682e-01f, -6.868911982e-01f, 9.367404580e-01f, 3.500247598e-01f, -8.293829560e-01f, -5.586804748e-01f, -5.048462152e-01f, 8.632093072e-01f, 3.800770044e-01f, 9.249548316e-01f, 7.874851823e-01f, 6.163335443e-01f, 9.310783744e-01f, 3.648192585e-01f, 9.780309200e-01f, 2.084598988e-01f, 9.930352569e-01f, 1.178173944e-01f, 9.977958202e-01f, 6.635902822e-02f, 9.993028045e-01f, 3.733518720e-02f, 9.997795224e-01f, 2.099845745e-02f, 9.999302626e-01f, 1.180889271e-02f, 9.999779463e-01f, 6.640734151e-03f, 9.999930263e-01f, 3.734378144e-03f,
-9.999608397e-01f, -8.851309307e-03f, 9.810745716e-01f, -1.936302334e-01f, 7.814403772e-01f, 6.239799261e-01f, -7.174775004e-01f, -6.965817213e-01f, -5.885011554e-01f, 8.084963560e-01f, 3.274896145e-01f, 9.448547959e-01f, 7.676045895e-01f, 6.409237385e-01f, 9.244439602e-01f, 3.813178837e-01f, 9.758974314e-01f, 2.182296216e-01f, 9.923570156e-01f, 1.233997419e-01f, 9.975810051e-01f, 6.951400638e-02f, 9.992348552e-01f, 3.911216930e-02f, 9.997580051e-01f, 2.199822664e-02f, 9.999234676e-01f, 1.237119269e-02f, 9.999758005e-01f, 6.956954487e-03f, 9.999923706e-01f, 3.912204877e-03f,
-5.328330398e-01f, -8.462203741e-01f, 9.332357645e-01f, 3.592645228e-01f, 5.486452579e-01f, 8.360552788e-01f, -5.829432607e-01f, -8.125128746e-01f, -6.662759781e-01f, 7.457052469e-01f, 2.738668621e-01f, 9.617676139e-01f, 7.469564080e-01f, 6.648730636e-01f, 9.175173044e-01f, 3.976959288e-01f, 9.736663699e-01f, 2.279775143e-01f, 9.916474223e-01f, 1.289781928e-01f, 9.973561764e-01f, 7.266827673e-02f, 9.991636872e-01f, 4.088902473e-02f, 9.997355342e-01f, 2.299797349e-02f, 9.999163747e-01f, 1.293348987e-02f, 9.999735355e-01f, 7.273174357e-03f, 9.999916553e-01f, 4.090031609e-03f,
4.241790175e-01f, -9.055783749e-01f, 5.979771614e-01f, 8.015131354e-01f, 2.614417076e-01f, 9.652192593e-01f, -4.300232828e-01f, -9.028177857e-01f, -7.373937964e-01f, 6.754631400e-01f, 2.193782777e-01f, 9.756398797e-01f, 7.255613208e-01f, 6.881574988e-01f, 9.103004336e-01f, 4.139482081e-01f, 9.713379741e-01f, 2.377026230e-01f, 9.909064770e-01f, 1.345525682e-01f, 9.971213937e-01f, 7.582182437e-02f, 9.990894198e-01f, 4.266574979e-02f, 9.997119904e-01f, 2.399769612e-02f, 9.999089241e-01f, 1.349578146e-02f, 9.999712110e-01f, 7.589393295e-03f, 9.999908805e-01f, 4.267857410e-03f,
9.912028313e-01f, -1.323517561e-01f, 7.855226099e-02f, 9.969099760e-01f, -5.168933049e-02f, 9.986631870e-01f, -2.635405958e-01f, -9.646483064e-01f, -8.011435866e-01f, 5.984721780e-01f, 1.641961634e-01f, 9.864277244e-01f, 7.034407258e-01f, 7.107539177e-01f, 9.027957320e-01f, 4.300695956e-01f, 9.689124227e-01f, 2.474039644e-01f, 9.901341200e-01f, 1.401226968e-01f, 9.968765974e-01f, 7.897461206e-02f, 9.990119338e-01f, 4.444234073e-02f, 9.996874928e-01f, 2.499739639e-02f, 9.999011755e-01f, 1.405806933e-02f, 9.999687672e-01f, 7.905611768e-03f, 9.999901056e-01f, 4.445684142e-03f,
6.469193697e-01f, 7.625584006e-01f, -4.650644958e-01f, 8.852767944e-01f, -3.596943319e-01f, 9.330701828e-01f, -8.874549717e-02f, -9.960543513e-01f, -8.568888307e-01f, 5.155012608e-01f, 1.084949449e-01f, 9.940969944e-01f, 6.806167960e-01f, 7.326396108e-01f, 8.950055242e-01f, 4.460549951e-01f, 9.663899541e-01f, 2.570805550e-01f, 9.893305302e-01f, 1.456883848e-01f, 9.966219068e-01f, 8.212661743e-02f, 9.989313483e-01f, 4.621879384e-02f, 9.996620417e-01f, 2.599707060e-02f, 9.998931289e-01f, 1.462035347e-02f, 9.999662042e-01f, 8.221829310e-03f, 9.999893308e-01f, 4.623509943e-03f,
-2.921388149e-01f, 9.563759565e-01f, -8.654506207e-01f, 5.009942055e-01f, -6.320286393e-01f, 7.749450207e-01f, 8.884812146e-02f, -9.960451722e-01f, -9.040721655e-01f, 4.273798466e-01f, 5.245061219e-02f, 9.986234903e-01f, 6.571123004e-01f, 7.537927032e-01f, 8.869323730e-01f, 4.618993104e-01f, 9.637709260e-01f, 2.667314112e-01f, 9.884956479e-01f, 1.512494683e-01f, 9.963572025e-01f, 8.527779579e-02f, 9.988475442e-01f, 4.799510166e-02f, 9.996355176e-01f, 2.699672058e-02f, 9.998847246e-01f, 1.518263202e-02f, 9.999635220e-01f, 8.538045920e-03f, 9.999884963e-01f, 4.801335745e-03f,
-9.626058936e-01f, 2.709057927e-01f, -9.992933869e-01f, -3.758566082e-02f, -8.416849375e-01f, 5.399689674e-01f, 2.636395097e-01f, -9.646213055e-01f, -9.422222972e-01f, 3.349882066e-01f, -3.759419080e-03f, 9.999929070e-01f, 6.329506636e-01f, 7.741921544e-01f, 8.785787225e-01f, 4.775975943e-01f, 9.610554576e-01f, 2.763556540e-01f, 9.876294732e-01f, 1.568057537e-01f, 9.960825443e-01f, 8.842811733e-02f, 9.987606406e-01f, 4.977125302e-02f, 9.996080399e-01f, 2.799634263e-02f, 9.998760223e-01f, 1.574490592e-02f, 9.999607801e-01f, 8.854261599e-03f, 9.999876022e-01f, 4.979162011e-03f,
-7.480575442e-01f, -6.636338830e-01f, -8.253716230e-01f, -5.645897985e-01f, -9.678714871e-01f, 2.514452934e-01f, 4.301158488e-01f, -9.027737379e-01f, -9.709581733e-01f, 2.392492294e-01f, -5.995756760e-02f, 9.982009530e-01f, 6.081562042e-01f, 7.938174009e-01f, 8.699471951e-01f, 4.931448400e-01f, 9.582439065e-01f, 2.859522104e-01f, 9.867320657e-01f, 1.623570919e-01f, 9.957979321e-01f, 9.157756716e-02f, 9.986705780e-01f, 5.154724792e-02f, 9.995795488e-01f, 2.899593674e-02f, 9.998670220e-01f, 1.630717516e-02f, 9.999579787e-01f, 9.170476347e-03f, 9.999867082e-01f, 5.156987347e-03f,
1.542514563e-01f, -9.880316257e-01f, -3.972518742e-01f, -9.177096486e-01f, -9.980752468e-01f, -6.201483682e-02f, 5.830269456e-01f, -8.124528527e-01f, -9.899924994e-01f, 1.411200017e-01f, -1.159661636e-01f, 9.932531714e-01f, 5.827535987e-01f, 8.126488924e-01f, 8.610406518e-01f, 5.085361004e-01f, 9.553365111e-01f, 2.955201864e-01f, 9.858034849e-01f, 1.679033041e-01f, 9.955033660e-01f, 9.472609311e-02f, 9.985772967e-01f, 5.332308263e-02f, 9.995500445e-01f, 2.999550104e-02f, 9.998577237e-01f, 1.686943881e-02f, 9.999549985e-01f, 9.486690164e-03f, 9.999857545e-01f, 5.334813148e-03f,
9.147423506e-01f, -4.040376544e-01f, 1.532154679e-01f, -9.881927967e-01f, -9.293003082e-01f, -3.693250120e-01f, 7.175492644e-01f, -6.965078115e-01f, -9.991351366e-01f, 4.158052057e-02f, -1.716081351e-01f, 9.851652980e-01f, 5.567683578e-01f, 8.306677938e-01f, 8.518617749e-01f, 5.237666368e-01f, 9.523335695e-01f, 3.050586283e-01f, 9.848436713e-01f, 1.734442115e-01f, 9.951988459e-01f, 9.787366539e-02f, 9.984809160e-01f, 5.509874597e-02f, 9.995195270e-01f, 3.099503554e-02f, 9.998480678e-01f, 1.743169688e-02f, 9.999519587e-01f, 9.802903049e-03f, 9.999848008e-01f, 5.512638018e-03f,
8.342233300e-01f, 5.514267087e-01f, 6.564951539e-01f, -7.543302178e-01f, -7.683671117e-01f, -6.400093436e-01f, 8.294403553e-01f, -5.585952401e-01f, -9.982947707e-01f, -5.837418884e-02f, -2.267075926e-01f, 9.739628434e-01f, 5.302263498e-01f, 8.478561044e-01f, 8.424135447e-01f, 5.388315320e-01f, 9.492354393e-01f, 3.145665526e-01f, 9.838528037e-01f, 1.789796203e-01f, 9.948843718e-01f, 1.010202691e-01f, 9.983813763e-01f, 5.687423423e-02f, 9.994880557e-01f, 3.199454024e-02f, 9.998381138e-01f, 1.799395122e-02f, 9.999487996e-01f, 1.011911593e-02f, 9.999837875e-01f, 5.690463353e-03f,
-1.327674743e-02f, 9.999118447e-01f, 9.575860500e-01f, -2.881473601e-01f, -5.312352777e-01f, -8.472243547e-01f, 9.151713848e-01f, -4.030649364e-01f, -9.874798059e-01f, -1.577456445e-01f, -2.810902894e-01f, 9.596813321e-01f, 5.031541586e-01f, 8.641966581e-01f, 8.326989412e-01f, 5.537260175e-01f, 9.460423589e-01f, 3.240430057e-01f, 9.828307629e-01f, 1.845093668e-01f, 9.945599437e-01f, 1.041658595e-01f, 9.982786179e-01f, 5.864954367e-02f, 9.994555712e-01f, 3.299400955e-02f, 9.998278022e-01f, 1.855619811e-02f, 9.999455214e-01f, 1.043532696e-02f, 9.999827743e-01f, 5.868288688e-03f,
-8.485702872e-01f, 5.290827155e-01f, 9.637575150e-01f, 2.667797208e-01f, -2.414211035e-01f, -9.704204202e-01f, 9.720383286e-01f, -2.348221242e-01f, -9.667981863e-01f, -2.555412054e-01f, -3.345843554e-01f, 9.423658252e-01f, 4.755789042e-01f, 8.796730638e-01f, 8.227210045e-01f, 5.684453845e-01f, 9.427546859e-01f, 3.334870934e-01f, 9.817776680e-01f, 1.900332868e-01f, 9.942255616e-01f, 1.073104069e-01f, 9.981727600e-01f, 6.042466685e-02f, 9.994220734e-01f, 3.399345279e-02f, 9.998172522e-01f, 1.911843941e-02f, 9.999421835e-01f, 1.075153705e-02f, 9.999817014e-01f, 6.046113092e-03f,
-9.036921859e-01f, -4.281826615e-01f, 6.731102467e-01f, 7.395421863e-01f, 7.233466953e-02f, -9.973804355e-01f, 9.982477427e-01f, -5.917267874e-02f, -9.364566803e-01f, -3.507832289e-01f, -3.870206773e-01f, 9.220710397e-01f, 4.475280643e-01f, 8.942698836e-01f, 8.124829531e-01f, 5.829849839e-01f, 9.393727183e-01f, 3.428978026e-01f, 9.806935191e-01f, 1.955512017e-01f, 9.938812256e-01f, 1.104538813e-01f, 9.980637431e-01f, 6.219960377e-02f, 9.993875623e-01f, 3.499285504e-02f, 9.998063445e-01f, 1.968067512e-02f, 9.999387264e-01f, 1.106774528e-02f, 9.999806285e-01f, 6.223937962e-03f,
-1.279636919e-01f, -9.917788506e-01f, 1.751565337e-01f, 9.845405817e-01f, 3.789161742e-01f, -9.254310131e-01f, 9.929728508e-01f, 1.183425784e-01f, -8.967583776e-01f, -4.425205886e-01f, -4.382335246e-01f, 8.988611698e-01f, 4.190297425e-01f, 9.079725146e-01f, 8.019878864e-01f, 5.973402858e-01f, 9.358968139e-01f, 3.522742093e-01f, 9.795783162e-01f, 2.010629177e-01f, 9.935269952e-01f, 1.135962531e-01f, 9.979515672e-01f, 6.397433579e-02f, 9.993520975e-01f, 3.599222749e-02f, 9.997950792e-01f, 2.024290524e-02f, 9.999352098e-01f, 1.138395350e-02f, 9.999794960e-01f, 6.401761901e-03f,
7.654140592e-01f, -6.435381174e-01f, -3.767422736e-01f, 9.263181090e-01f, 6.479216814e-01f, -7.617069483e-01f, 9.563800097e-01f, 2.921253741e-01f, -8.481000066e-01f, -5.298361778e-01f, -4.880608618e-01f, 8.728095889e-01f, 3.901124299e-01f, 9.207672477e-01f, 7.912392616e-01f, 6.115067005e-01f, 9.323273301e-01f, 3.616154492e-01f, 9.784321785e-01f, 2.065682709e-01f, 9.931628108e-01f, 1.167374924e-01f, 9.978361726e-01f, 6.574887782e-02f, 9.993155599e-01f, 3.699155897e-02f, 9.997835755e-01f, 2.080512606e-02f, 9.999315739e-01f, 1.170015987e-02f, 9.999783635e-01f, 6.579586305e-03f,
9.550736547e-01f, 2.963685691e-01f, -8.126112223e-01f, 5.828061700e-01f, 8.526731133e-01f, -5.224447846e-01f, 8.896234632e-01f, 4.566946924e-01f, -7.909677625e-01f, -6.118578315e-01f, -5.363451838e-01f, 8.439987302e-01f, 3.608050346e-01f, 9.326412678e-01f, 7.802404165e-01f, 6.254796982e-01f, 9.286646247e-01f, 3.709204793e-01f, 9.772551060e-01f, 2.120671123e-01f, 9.927886724e-01f, 1.198775545e-01f, 9.977176785e-01f, 6.752320379e-02f, 9.992780685e-01f, 3.799085692e-02f, 9.997717142e-01f, 2.136734314e-02f, 9.999278188e-01f, 1.201636530e-02f, 9.999771714e-01f, 6.757410709e-03f,
2.666429281e-01f, 9.637953639e-01f, -9.982103705e-01f, 5.980031565e-02f, 9.728653431e-01f, -2.313720286e-01f, 7.948083878e-01f, 6.068604589e-01f, -7.259323001e-01f, -6.877661943e-01f, -5.829339027e-01f, 8.125195503e-01f, 3.311368823e-01f, 9.435827136e-01f, 7.689949274e-01f, 6.392549276e-01f, 9.249090552e-01f, 3.801884055e-01f, 9.760470986e-01f, 2.175592482e-01f, 9.924046397e-01f, 1.230164245e-01f, 9.975960255e-01f, 6.929731369e-02f, 9.992396235e-01f, 3.899011388e-02f, 9.997594953e-01f, 2.192955278e-02f, 9.999239445e-01f, 1.233256981e-02f, 9.999759793e-01f, 6.935234182e-03f,
-6.669380665e-01f, 7.451131940e-01f, -8.763794303e-01f, -4.816212952e-01f, 9.965789914e-01f, 8.264580369e-02f, 6.749256253e-01f, 7.378857732e-01f, -6.536436081e-01f, -7.568024993e-01f, -6.276797056e-01f, 7.784717083e-01f, 3.011375964e-01f, 9.535806775e-01f, 7.575061917e-01f, 6.528279781e-01f, 9.210609794e-01f, 3.894183338e-01f, 9.748082757e-01f, 2.230444849e-01f, 9.920106530e-01f, 1.261540651e-01f, 9.974712729e-01f, 7.107120752e-02f, 9.992001057e-01f, 3.998933733e-02f, 9.997470379e-01f, 2.249175683e-02f, 9.999200106e-01f, 1.264877338e-02f, 9.999747276e-01f, 7.113057654e-03f,
-9.873392582e-01f, -1.586226672e-01f, -4.846394062e-01f, -8.747140765e-01f, 9.214623570e-01f, 3.884676993e-01f, 5.337560773e-01f, 8.456385136e-01f, -5.748240352e-01f, -8.182770610e-01f, -6.704410911e-01f, 7.419627309e-01f, 2.708370984e-01f, 9.626252055e-01f, 7.457779050e-01f, 6.661946774e-01f, 9.171208143e-01f, 3.986093104e-01f, 9.735385776e-01f, 2.285226882e-01f, 9.916067719e-01f, 1.292904317e-01f, 9.973433018e-01f, 7.284487784e-02f, 9.991596341e-01f, 4.098851606e-02f, 9.997342229e-01f, 2.305394970e-02f, 9.999159575e-01f, 1.296497509e-02f, 9.999734163e-01f, 7.290880661e-03f,
-3.999853134e-01f, -9.165215492e-01f, 5.636094138e-02f, -9.984104633e-01f, 7.549653053e-01f, 6.557646990e-01f, 3.757521510e-01f, 9.267202020e-01f, -4.902605712e-01f, -8.715758920e-01f, -7.110829353e-01f, 7.031081319e-01f, 2.402658761e-01f, 9.707071185e-01f, 7.338138223e-01f, 6.793506742e-01f, 9.130889177e-01f, 4.077604413e-01f, 9.722381234e-01f, 2.339936644e-01f, 9.911929369e-01f, 1.324255317e-01f, 9.972121716e-01f, 7.461831719e-02f, 9.991181493e-01f, 4.198765755e-02f, 9.997211099e-01f, 2.361613885e-02f, 9.999117851e-01f, 1.328117587e-02f, 9.999721050e-01f, 7.468704134e-03f,
5.551133156e-01f, -8.317747116e-01f, 5.800030828e-01f, -8.146142364e-01f, 5.135983825e-01f, 8.580306768e-01f, 2.058971673e-01f, 9.785736203e-01f, -4.007990062e-01f, -9.161660075e-01f, -7.494767308e-01f, 6.620306969e-01f, 2.094544172e-01f, 9.778184295e-01f, 7.216176391e-01f, 6.922917962e-01f, 9.089657664e-01f, 4.168707728e-01f, 9.709069133e-01f, 2.394572198e-01f, 9.907692075e-01f, 1.355592906e-01f, 9.970778823e-01f, 7.639151812e-02f, 9.990756512e-01f, 4.298675060e-02f, 9.997076392e-01f, 2.417832054e-02f, 9.999075532e-01f, 1.359737478e-02f, 9.999707937e-01f, 7.646527141e-03f,
9.998432994e-01f, 1.770192571e-02f, 9.250146747e-01f, -3.799313903e-01f, 2.212981731e-01f, 9.752061963e-01f, 2.954782173e-02f, 9.995633960e-01f, -3.073327839e-01f, -9.516021013e-01f, -7.855011225e-01f, 6.188602448e-01f, 1.784335226e-01f, 9.839519858e-01f, 7.091933489e-01f, 7.050140500e-01f, 9.047516584e-01f, 4.259394705e-01f, 9.695450068e-01f, 2.449132055e-01f, 9.903355837e-01f, 1.386916935e-01f, 9.969404936e-01f, 7.816448808e-02f, 9.990321398e-01f, 4.398580641e-02f, 9.996939301e-01f, 2.474049293e-02f, 9.999032021e-01f, 1.391357277e-02f, 9.999693632e-01f, 7.824349217e-03f,
5.253220201e-01f, 8.509035110e-01f, 9.851381779e-01f, 1.717635691e-01f, -9.294810891e-02f, 9.956709743e-01f, -1.477329880e-01f, 9.890272617e-01f, -2.107957900e-01f, -9.775301218e-01f, -8.190422058e-01f, 5.737333298e-01f, 1.472342163e-01f, 9.891016483e-01f, 6.965447664e-01f, 7.175133228e-01f, 9.004471302e-01f, 4.349655211e-01f, 9.681524038e-01f, 2.503614724e-01f, 9.898920655e-01f, 1.418227106e-01f, 9.967998862e-01f, 7.993719727e-02f, 9.989876747e-01f, 4.498481750e-02f, 9.996798635e-01f, 2.530265786e-02f, 9.998987317e-01f, 1.422976889e-02f, 9.999679923e-01f, 8.002171293e-03f,
-4.321779609e-01f, 9.017883539e-01f, 7.418580055e-01f, 6.705570221e-01f, -3.979767561e-01f, 9.173954725e-01f, -3.203543723e-01f, 9.472977519e-01f, -1.121526212e-01f, -9.936909676e-01f, -8.499938846e-01f, 5.267925262e-01f, 1.158876941e-01f, 9.932623506e-01f, 6.836758852e-01f, 7.297858000e-01f, 8.960524797e-01f, 4.439480901e-01f, 9.667292237e-01f, 2.558017969e-01f, 9.894386530e-01f, 1.449523121e-01f, 9.966561794e-01f, 8.170966059e-02f, 9.989421964e-01f, 4.598378390e-02f, 9.996654391e-01f, 2.586481534e-02f, 9.998942018e-01f, 1.454596408e-02f, 9.999665618e-01f, 8.179994300e-03f,
-9.923354983e-01f, 1.235731244e-01f, 2.700984478e-01f, 9.628326893e-01f, -6.635382771e-01f, 7.481423020e-01f, -4.828719497e-01f, 8.756909966e-01f, -1.238837745e-02f, -9.999232888e-01f, -8.782584071e-01f, 4.781863391e-01f, 8.442528546e-02f, 9.964298010e-01f, 6.705908179e-01f, 7.418274283e-01f, 8.915683031e-01f, 4.528862834e-01f, 9.652754664e-01f, 2.612340748e-01f, 9.889753461e-01f, 1.480804533e-01f, 9.965093136e-01f, 8.348185569e-02f, 9.988957047e-01f, 4.698270187e-02f, 9.996507764e-01f, 2.642696351e-02f, 9.998895526e-01f, 1.486215740e-02f, 9.999650717e-01f, 8.357816376e-03f,
-6.401443481e-01f, -7.682546377e-01f, -2.848466039e-01f, 9.585731030e-01f, -8.632964492e-01f, 5.046971440e-01f, -6.301599741e-01f, 7.764653563e-01f, 8.749917895e-02f, -9.961646199e-01f, -9.037463665e-01f, 4.280683994e-01f, 5.287845805e-02f, 9.986009598e-01f, 6.572937369e-01f, 7.536345124e-01f, 8.869948983e-01f, 4.617791772e-01f, 9.637911916e-01f, 2.666580379e-01f, 9.885020852e-01f, 1.512071192e-01f, 9.963592887e-01f, 8.525379747e-02f, 9.988481998e-01f, 4.798157141e-02f, 9.996357560e-01f, 2.698910423e-02f, 9.998847842e-01f, 1.517834887e-02f, 9.999635816e-01f, 8.535637520e-03f,
3.005925417e-01f, -9.537526369e-01f, -7.520639896e-01f, 6.590901017e-01f, -9.774427414e-01f, 2.112006694e-01f, -7.575730681e-01f, 6.527503729e-01f, 1.865124702e-01f, -9.824525714e-01f, -9.263771176e-01f, 3.765971363e-01f, 2.127875946e-02f, 9.997735620e-01f, 6.437888145e-01f, 7.652031779e-01f, 8.823328614e-01f, 4.706258774e-01f, 9.622764587e-01f, 2.720735669e-01f, 9.880189896e-01f, 1.543322802e-01f, 9.962061048e-01f, 8.702547103e-02f, 9.987997413e-01f, 4.898039624e-02f, 9.996203780e-01f, 2.755123749e-02f, 9.998799562e-01f, 1.549453940e-02f, 9.999620318e-01f, 8.713459596e-03f,
9.649659991e-01f, -2.623748481e-01f, -9.876590967e-01f, 1.566190720e-01f, -9.946564436e-01f, -1.032404676e-01f, -8.610926867e-01f, 5.084480047e-01f, 2.836621702e-01f, -9.589242935e-01f, -9.460792542e-01f, 3.239352703e-01f, -1.034221891e-02f, 9.999465346e-01f, 6.300802827e-01f, 7.765299678e-01f, 8.775825500e-01f, 4.794255495e-01f, 9.607312679e-01f, 2.774805427e-01f, 9.875259995e-01f, 1.574558914e-01f, 9.960497618e-01f, 8.879686147e-02f, 9.987502694e-01f, 4.997916892e-02f, 9.996047616e-01f, 2.811335959e-02f, 9.998750091e-01f, 1.581072807e-02f, 9.999604821e-01f, 8.891279809e-03f,
7.421542406e-01f, 6.702291369e-01f, -9.190735221e-01f, -3.940860629e-01f, -9.132301211e-01f, -4.074441493e-01f, -9.374542832e-01f, 3.481085002e-01f, 3.779776394e-01f, -9.258147478e-01f, -9.627903700e-01f, 2.702493370e-01f, -4.195285589e-02f, 9.991195798e-01f, 6.161724925e-01f, 7.876112461e-01f, 8.727445006e-01f, 4.881772399e-01f, 9.591556787e-01f, 2.828786969e-01f, 9.870231748e-01f, 1.605779380e-01f, 9.958902597e-01f, 9.056797624e-02f, 9.986997843e-01f, 5.097789690e-02f, 9.995887876e-01f, 2.867547423e-02f, 9.998699427e-01f, 1.612691768e-02f, 9.999588728e-01f, 9.069100954e-03f,
-1.629907787e-01f, 9.866275787e-01f, -5.674300194e-01f, -8.234215975e-01f, -7.412399650e-01f, -6.712400913e-01f, -9.842484593e-01f, 1.767906845e-01f, 4.685169160e-01f, -8.834545016e-01f, -9.764577150e-01f, 2.157090008e-01f, -7.352153957e-02f, 9.972936511e-01f, 6.020698547e-01f, 7.984433770e-01f, 8.678191900e-01f, 4.968801141e-01f, 9.575498104e-01f, 2.882679403e-01f, 9.865104556e-01f, 1.636983752e-01f, 9.957276583e-01f, 9.233880043e-02f, 9.986482859e-01f, 5.197656900e-02f, 9.995725155e-01f, 2.923758142e-02f, 9.998648167e-01f, 1.644310169e-02f, 9.999572635e-01f, 9.246920235e-03f,
-9.182828069e-01f, 3.959251344e-01f, -4.102819040e-02f, -9.991579652e-01f, -4.957418144e-01f, -8.684699535e-01f, -1.000000000e+00f, -1.030206768e-04f, 5.543745160e-01f, -8.322673440e-01f, -9.870380163e-01f, 1.604867131e-01f, -1.050167158e-01f, 9.944704771e-01f, 5.877768993e-01f, 8.090230227e-01f, 8.628070951e-01f, 5.055333376e-01f, 9.559136033e-01f, 2.936480343e-01f, 9.859878421e-01f, 1.668171734e-01f, 9.955618382e-01f, 9.410934150e-02f, 9.985958338e-01f, 5.297519267e-02f, 9.995558858e-01f, 2.979967557e-02f, 9.998595715e-01f, 1.675928757e-02f, 9.999555945e-01f, 9.424741380e-03f,
-8.293098211e-01f, -5.587890744e-01f, 4.980095923e-01f, -8.671715260e-01f, -2.010796219e-01f, -9.795749187e-01f, -9.842120409e-01f, -1.769934893e-01f, 6.346929669e-01f, -7.727644444e-01f, -9.944978952e-01f, 1.047568321e-01f, -1.364068687e-01f, 9.906529188e-01f, 5.732980371e-01f, 8.193469048e-01f, 8.577086926e-01f, 5.141359568e-01f, 9.542471766e-01f, 2.990188897e-01f, 9.854553938e-01f, 1.699342877e-01f, 9.953929186e-01f, 9.587957710e-02f, 9.985423684e-01f, 5.397376046e-02f, 9.995389581e-01f, 3.036176413e-02f, 9.998542070e-01f, 1.707546785e-02f, 9.999538660e-01f, 9.602561593e-03f,
2.212675475e-02f, -9.997551441e-01f, 8.836693168e-01f, -4.681116939e-01f, 1.135217771e-01f, -9.935355186e-01f, -9.373825192e-01f, -3.483016491e-01f, 7.086697817e-01f, -7.055402994e-01f, -9.988136292e-01f, 4.869600013e-02f, -1.676606387e-01f, 9.858447909e-01f, 5.586378574e-01f, 8.294116855e-01f, 8.525245190e-01f, 5.226872563e-01f, 9.525505900e-01f, 3.043802381e-01f, 9.849131107e-01f, 1.730497181e-01f, 9.952208400e-01f, 9.764950722e-02f, 9.984878898e-01f, 5.497227982e-02f, 9.995217323e-01f, 3.092384152e-02f, 9.998487830e-01f, 1.739165001e-02f, 9.999521971e-01f, 9.780380875e-03f,
8.532201052e-01f, -5.215510130e-01f, 9.971746206e-01f, 7.511820644e-02f, 4.168670774e-01f, -9.089674354e-01f, -8.609884381e-01f, -5.086245537e-01f, 7.755658031e-01f, -6.312667131e-01f, -9.999717474e-01f, -7.518785074e-03f, -1.987468749e-01f, 9.800508618e-01f, 5.438010693e-01f, 8.392141461e-01f, 8.472551107e-01f, 5.311862230e-01f, 9.508239031e-01f, 3.097319603e-01f, 9.843609333e-01f, 1.761634201e-01f, 9.950456619e-01f, 9.941913933e-02f, 9.984323978e-01f, 5.597073585e-02f, 9.995042086e-01f, 3.148590773e-02f, 9.998431802e-01f, 1.770782843e-02f, 9.999504089e-01f, 9.958200157e-03f,
8.998668194e-01f, 4.361647666e-01f, 8.035690784e-01f, 5.952115059e-01f, 6.788702011e-01f, -7.342582941e-01f, -7.574391961e-01f, -6.529057026e-01f, 8.347129226e-01f, -5.506852865e-01f, -9.979684949e-01f, -6.370980293e-02f, -2.296342701e-01f, 9.732769728e-01f, 5.287922621e-01f, 8.487513065e-01f, 8.419009447e-01f, 5.396320224e-01f, 9.490671158e-01f, 3.150739372e-01f, 9.837989211e-01f, 1.792753637e-01f, 9.948672652e-01f, 1.011884511e-01f, 9.983759522e-01f, 5.696914345e-02f, 9.994863272e-01f, 3.204796836e-02f, 9.998375773e-01f, 1.802400686e-02f, 9.999486208e-01f, 1.013601944e-02f,
1.191801354e-01f, 9.928726554e-01f, 3.624766469e-01f, 9.319928288e-01f, 8.735505342e-01f, -4.867334962e-01f, -6.300007105e-01f, -7.765945792e-01f, 8.855196238e-01f, -4.646020234e-01f, -9.928101897e-01f, -1.196994036e-01f, -2.602920234e-01f, 9.655299187e-01f, 5.136163235e-01f, 8.580200076e-01f, 8.364626765e-01f, 5.480239391e-01f, 9.472803473e-01f, 3.204059005e-01f, 9.832270741e-01f, 1.823855042e-01f, 9.946857691e-01f, 1.029574350e-01f, 9.983184934e-01f, 5.796748772e-02f, 9.994681478e-01f, 3.261001408e-02f, 9.998317957e-01f, 1.834018156e-02f, 9.999468327e-01f, 1.031383779e-02f,
-7.710802555e-01f, 6.367380023e-01f, -1.902491003e-01f, 9.817358255e-01f, 9.816020727e-01f, -1.909380108e-01f, -4.826923311e-01f, -8.757900000e-01f, 9.274784923e-01f, -3.738765717e-01f, -9.845131636e-01f, -1.753105819e-01f, -2.906895280e-01f, 9.568174481e-01f, 4.982779026e-01f, 8.670173883e-01f, 8.309406638e-01f, 5.563610196e-01f, 9.454635978e-01f, 3.257277906e-01f, 9.826454520e-01f, 1.854938269e-01f, 9.945011139e-01f, 1.047261059e-01f, 9.982600212e-01f, 5.896577984e-02f, 9.994496703e-01f, 3.317204863e-02f, 9.998259544e-01f, 1.865635626e-02f, 9.999449849e-01f, 1.049165614e-02f,
-9.524129629e-01f, -3.048106432e-01f, -6.843819022e-01f, 7.291237116e-01f, 9.923083186e-01f, 1.237909496e-01f, -3.201591969e-01f, -9.473637342e-01f, 9.601702690e-01f, -2.794154882e-01f, -9.731037021e-01f, -2.303675264e-01f, -3.207963705e-01f, 9.471482038e-01f, 4.827820063e-01f, 8.757405281e-01f, 8.253356218e-01f, 5.646424294e-01f, 9.436169863e-01f, 3.310393095e-01f, 9.820539355e-01f, 1.886002868e-01f, 9.943132997e-01f, 1.064944416e-01f, 9.982005358e-01f, 5.996400863e-02f, 9.994308352e-01f, 3.373407945e-02f, 9.998199940e-01f, 1.897252724e-02f, 9.999430776e-01f, 1.066947449e-02f,
-2.581016421e-01f, -9.661177397e-01f, -9.677396417e-01f, 2.519522905e-01f, 9.046075344e-01f, 4.262454212e-01f, -1.475291997e-01f, -9.890577197e-01f, 9.832684398e-01f, -1.821625978e-01f, -9.586178064e-01f, -2.846961617e-01f, -3.505824506e-01f, 9.365319014e-01f, 4.671334028e-01f, 8.841868639e-01f, 8.196480274e-01f, 5.728674531e-01f, 9.417404532e-01f, 3.363404274e-01f, 9.814526439e-01f, 1.917048544e-01f, 9.941223264e-01f, 1.082624346e-01f, 9.981400967e-01f, 6.096218154e-02f, 9.994117022e-01f, 3.429609165e-02f, 9.998139739e-01f, 1.928869821e-02f, 9.999411702e-01f, 1.084729191e-02f,
6.735071540e-01f, -7.391806841e-01f, -9.530500174e-01f, -3.028128445e-01f, 7.271980643e-01f, 6.864277124e-01f, 2.975377068e-02f, -9.995572567e-01f, 9.965420961e-01f, -8.308912069e-02f, -9.411013126e-01f, -3.381247520e-01f, -3.800179660e-01f, 9.249790907e-01f, 4.513370693e-01f, 8.923535347e-01f, 8.138784766e-01f, 5.810351968e-01f, 9.398342371e-01f, 3.416308761e-01f, 9.808415174e-01f, 1.948075294e-01f, 9.939282537e-01f, 1.100300923e-01f, 9.980786443e-01f, 6.196028739e-02f, 9.993922710e-01f, 3.485809639e-02f, 9.998078346e-01f, 1.960486546e-02f, 9.999392033e-01f, 1.102510840e-02f,
9.858965874e-01f, 1.673557013e-01f, -6.448370218e-01f, -7.643201351e-01f, 4.776714444e-01f, 8.785385489e-01f, 2.060983330e-01f, -9.785313010e-01f, 9.998586178e-01f, 1.681409217e-02f, -9.206095338e-01f, -3.904843926e-01f, -4.090735018e-01f, 9.125014544e-01f, 4.353979826e-01f, 9.002380967e-01f, 8.080275059e-01f, 5.891447663e-01f, 9.378982186e-01f, 3.469105363e-01f, 9.802205563e-01f, 1.979082376e-01f, 9.937310219e-01f, 1.117973924e-01f, 9.980161786e-01f, 6.295833737e-02f, 9.993724823e-01f, 3.542009369e-02f, 9.998015761e-01f, 1.992103085e-02f, 9.999372363e-01f, 1.120292582e-02f,
3.918572366e-01f, 9.200260639e-01f, -1.380281597e-01f, -9.904283285e-01f, 1.807759702e-01f, 9.835243225e-01f, 3.759426475e-01f, -9.266429543e-01f, 9.931849241e-01f, 1.165492982e-01f, -8.972073197e-01f, -4.416095316e-01f, -4.377200007e-01f, 8.991113305e-01f, 4.193212092e-01f, 9.078379273e-01f, 8.020957708e-01f, 5.971954465e-01f, 9.359325767e-01f, 3.521791995e-01f, 9.795898199e-01f, 2.010069788e-01f, 9.935306311e-01f, 1.135643497e-01f, 9.979526997e-01f, 6.395632029e-02f, 9.993524551e-01f, 3.598207608e-02f, 9.997951984e-01f, 2.023719437e-02f, 9.999352098e-01f, 1.138074230e-02f,
-5.624538660e-01f, 8.268286586e-01f, 4.112906456e-01f, -9.115042686e-01f, -1.340468824e-01f, 9.909749627e-01f, 5.339299440e-01f, -8.455287218e-01f, 9.765876532e-01f, 2.151199877e-01f, -8.709686995e-01f, -4.913385212e-01f, -4.659289122e-01f, 8.848221898e-01f, 4.031118751e-01f, 9.151507020e-01f, 7.960838079e-01f, 6.051864028e-01f, 9.339373708e-01f, 3.574367166e-01f, 9.789492488e-01f, 2.041037083e-01f, 9.933271408e-01f, 1.153309494e-01f, 9.978882670e-01f, 6.495424360e-02f, 9.993320704e-01f, 3.654404357e-02f, 9.997887611e-01f, 2.055335604e-02f, 9.999331832e-01f, 1.155855879e-02f,
-9.996474385e-01f, -2.655115537e-02f, 8.339421749e-01f, -5.518518090e-01f, -4.355781674e-01f, 9.001508951e-01f, 6.750773191e-01f, -7.377469540e-01f, 9.502326250e-01f, 3.115412891e-01f, -8.419764638e-01f, -5.395141840e-01f, -4.936717451e-01f, 8.696483374e-01f, 3.867750466e-01f, 9.221740961e-01f, 7.899922729e-01f, 6.131168008e-01f, 9.319126010e-01f, 3.626829684e-01f, 9.782989621e-01f, 2.071983814e-01f, 9.931204915e-01f, 1.170971766e-01f, 9.978227615e-01f, 6.595209241e-02f, 9.993113279e-01f, 3.710600734e-02f, 9.997822046e-01f, 2.086951770e-02f, 9.999310970e-01f, 1.173637528e-02f,
-5.177697539e-01f, -8.555200100e-01f, 9.997526407e-01f, -2.224157006e-02f, -6.939117312e-01f, 7.200600505e-01f, 7.949331403e-01f, -6.066970825e-01f, 9.143830538e-01f, 4.048501849e-01f, -8.103224635e-01f, -5.859842300e-01f, -5.209211111e-01f, 8.536047935e-01f, 3.703159094e-01f, 9.289059043e-01f, 7.838217020e-01f, 6.209859252e-01f, 9.298583269e-01f, 3.679177165e-01f, 9.776388407e-01f, 2.102909982e-01f, 9.929106832e-01f, 1.188630387e-01f, 9.977563620e-01f, 6.694988906e-02f, 9.992902875e-01f, 3.766795248e-02f, 9.997755289e-01f, 2.118567377e-02f, 9.999290109e-01f, 1.191418990e-02f,
4.401430190e-01f, -8.979277015e-01f, 8.576571345e-01f, 5.142219663e-01f, -8.834316730e-01f, 4.685599506e-01f, 8.897171617e-01f, -4.565122128e-01f, 8.693974018e-01f, 4.941135347e-01f, -7.761065960e-01f, -6.306017041e-01f, -5.476494431e-01f, 8.367078900e-01f, 3.537396789e-01f, 9.353439212e-01f, 7.775726914e-01f, 6.287930012e-01f, 9.277747273e-01f, 3.731408715e-01f, 9.769689441e-01f, 2.133814991e-01f, 9.926977158e-01f, 1.206285134e-01f, 9.976888895e-01f, 6.794761121e-02f, 9.992689490e-01f, 3.822989017e-02f, 9.997687936e-01f, 2.150182985e-02f, 9.999268651e-01f, 1.209200546e-02f,
9.933903813e-01f, -1.147848144e-01f, 4.514202476e-01f, 8.923114538e-01f, -9.853413105e-01f, 1.705945879e-01f, 9.564402103e-01f, -2.919283211e-01f, 8.157250285e-01f, 5.784398317e-01f, -7.394371629e-01f, -6.732255816e-01f, -5.738303661e-01f, 8.189741969e-01f, 3.370516896e-01f, 9.414861202e-01f, 7.712460160e-01f, 6.365371943e-01f, 9.256617427e-01f, 3.783521950e-01f, 9.762892723e-01f, 2.164698690e-01f, 9.924816489e-01f, 1.223936230e-01f, 9.976204634e-01f, 6.894526631e-02f, 9.992473125e-01f, 3.879181668e-02f, 9.997619390e-01f, 2.181798220e-02f, 9.999247193e-01f, 1.226981916e-02f,
6.333191991e-01f, 7.738906741e-01f, -9.384513646e-02f, 9.955868125e-01f, -9.895353913e-01f, -1.442903578e-01f, 9.929971695e-01f, -1.181379855e-01f, 7.539022565e-01f, 6.569865942e-01f, -7.004299760e-01f, -7.137210965e-01f, -5.994372964e-01f, 8.004217148e-01f, 3.202570081e-01f, 9.473307133e-01f, 7.648422122e-01f, 6.442176700e-01f, 9.235194325e-01f, 3.835515678e-01f, 9.755998850e-01f, 2.195560932e-01f, 9.922624230e-01f, 1.241583377e-01f, 9.975510240e-01f, 6.994284689e-02f, 9.992253184e-01f, 3.935372457e-02f, 9.997550249e-01f, 2.213413455e-02f, 9.999225140e-01f, 1.244763471e-02f,
-3.090227246e-01f, 9.510546327e-01f, -6.102110744e-01f, 7.922388911e-01f, -8.955979943e-01f, -4.448643327e-01f, 9.982355237e-01f, 5.937835947e-02f, 6.845467091e-01f, 7.289689779e-01f, -6.592084765e-01f, -7.519602180e-01f, -6.244450212e-01f, 7.810688019e-01f, 3.033610582e-01f, 9.528756738e-01f, 7.583618760e-01f, 6.518337727e-01f, 9.213479757e-01f, 3.887388110e-01f, 9.749007225e-01f, 2.226400971e-01f, 9.920400381e-01f, 1.259226501e-01f, 9.974805713e-01f, 7.094036788e-02f, 9.992030263e-01f, 3.991562501e-02f, 9.997479320e-01f, 2.245028317e-02f, 9.999203086e-01f, 1.262544841e-02f,
-9.672505856e-01f, 2.538233697e-01f, -9.386403561e-01f, 3.448974490e-01f, -7.128450871e-01f, -7.013215423e-01f, 9.719900489e-01f, 2.350219339e-01f, 6.083510518e-01f, 7.936680317e-01f, -6.159027219e-01f, -7.878221869e-01f, -6.488281488e-01f, 7.609349489e-01f, 2.863692045e-01f, 9.581193328e-01f, 7.518057823e-01f, 6.593846679e-01f, 9.191473722e-01f, 3.939137757e-01f, 9.741917849e-01f, 2.257218957e-01f, 9.918145537e-01f, 1.276865751e-01f, 9.974091053e-01f, 7.193781435e-02f, 9.991804361e-01f, 4.047751427e-02f, 9.997408390e-01f, 2.276643179e-02f, 9.999180436e-01f, 1.280326117e-02f,
-7.361927032e-01f, -6.767719388e-01f, -9.779862761e-01f, -2.086692750e-01f, -4.593983889e-01f, -8.882303238e-01f, 9.150884748e-01f, 4.032530487e-01f, 5.260773301e-01f, 8.504367471e-01f, -5.706502199e-01f, -8.211932182e-01f, -6.725627184e-01f, 7.400401235e-01f, 2.692867517e-01f, 9.630600214e-01f, 7.451744676e-01f, 6.668695807e-01f, 9.169177413e-01f, 3.990762532e-01f, 9.734731317e-01f, 2.288014293e-01f, 9.915859103e-01f, 1.294501126e-01f, 9.973366857e-01f, 7.293518633e-02f, 9.991575480e-01f, 4.103938490e-02f, 9.997335672e-01f, 2.308257483e-02f, 9.999157190e-01f, 1.298107579e-02f,
1.717173457e-01f, -9.851462841e-01f, -7.161304951e-01f, -6.979663968e-01f, -1.603949666e-01f, -9.870529175e-01f, 8.293254972e-01f, 5.587657690e-01f, 4.385472536e-01f, 8.987081051e-01f, -5.235932469e-01f, -8.519684076e-01f, -6.956245899e-01f, 7.184054852e-01f, 2.521191835e-01f, 9.676961899e-01f, 7.384685278e-01f, 6.742879152e-01f, 9.146590829e-01f, 4.042260945e-01f, 9.727447033e-01f, 2.318786681e-01f, 9.913541675e-01f, 1.312132180e-01f, 9.972632527e-01f, 7.393248379e-02f, 9.991343021e-01f, 4.160124436e-02f, 9.997262359e-01f, 2.339871787e-02f, 9.999133945e-01f, 1.315888762e-02f,
9.217512608e-01f, -3.877816498e-01f, -2.337207645e-01f, -9.723037481e-01f, 1.545165181e-01f, -9.879902005e-01f, 7.174060345e-01f, 6.966552734e-01f, 3.466353416e-01f, 9.379999638e-01f, -4.748813212e-01f, -8.800498247e-01f, -7.179910541e-01f, 6.960523129e-01f, 2.348718494e-01f, 9.720263481e-01f, 7.316888571e-01f, 6.816387773e-01f, 9.123715162e-01f, 4.093632102e-01f, 9.720066190e-01f, 2.349535823e-01f, 9.911192656e-01f, 1.329759061e-01f, 9.971888065e-01f, 7.492970675e-02f, 9.991107583e-01f, 4.216309637e-02f, 9.997187853e-01f, 2.371485718e-02f, 9.999110699e-01f, 1.333669946e-02f,
8.243313432e-01f, 5.661076307e-01f, 3.206739426e-01f, -9.471896291e-01f, 4.541028738e-01f, -8.909492493e-01f, 5.828598738e-01f, 8.125726581e-01f, 2.512599528e-01f, 9.679196477e-01f, -4.246677160e-01f, -9.053493142e-01f, -7.396394610e-01f, 6.730033755e-01f, 2.175502628e-01f, 9.760491252e-01f, 7.248359919e-01f, 6.889214516e-01f, 9.100551009e-01f, 4.144873321e-01f, 9.712587595e-01f, 2.380261570e-01f, 9.908812046e-01f, 1.347381920e-01f, 9.971134067e-01f, 7.592686266e-02f, 9.990868568e-01f, 4.272492975e-02f, 9.997112155e-01f, 2.403099649e-02f, 9.999086857e-01f, 1.351451222e-02f,
-3.097503260e-02f, 9.995201826e-01f, 7.763037086e-01f, -6.303589940e-01f, 7.086563706e-01f, -7.055538297e-01f, 4.299306870e-01f, 9.028618932e-01f, 1.533735693e-01f, 9.881682992e-01f, -3.731119633e-01f, -9.277863503e-01f, -7.605484128e-01f, 6.492812634e-01f, 2.001598924e-01f, 9.797632694e-01f, 7.179107070e-01f, 6.961352229e-01f, 9.077098370e-01f, 4.195984006e-01f, 9.705011845e-01f, 2.410963625e-01f, 9.906400442e-01f, 1.365000308e-01f, 9.970369935e-01f, 7.692394406e-02f, 9.990627170e-01f, 4.328674823e-02f, 9.997035861e-01f, 2.434713021e-02f, 9.999062419e-01f, 1.369232405e-02f,
-8.578031063e-01f, 5.139784217e-01f, 9.928478599e-01f, -1.193865910e-01f, 8.929339647e-01f, -4.501876533e-01f, 2.634407580e-01f, 9.646756053e-01f, 5.395522714e-02f, 9.985433817e-01f, -3.203761876e-01f, -9.472904205e-01f, -7.806967497e-01f, 6.249100566e-01f, 1.827063411e-01f, 9.831675291e-01f, 7.109135985e-01f, 7.032793760e-01f, 9.053359628e-01f, 4.246961474e-01f, 9.697338939e-01f, 2.441641390e-01f, 9.903957844e-01f, 1.382614523e-01f, 9.969595671e-01f, 7.792093605e-02f, 9.990381598e-01f, 4.384855926e-02f, 9.996958375e-01f, 2.466326393e-02f, 9.999037981e-01f, 1.387013402e-02f,
-8.959709406e-01f, -4.441126585e-01f, 9.036121368e-01f, 4.283516109e-01f, 9.886589646e-01f, -1.501781940e-01f, 8.864288777e-02f, 9.960634708e-01f, -4.600222036e-02f, 9.989413619e-01f, -2.666280270e-01f, -9.637995362e-01f, -8.000645638e-01f, 5.999138951e-01f, 1.651948988e-01f, 9.862609506e-01f, 7.038453221e-01f, 7.103532553e-01f, 9.029334188e-01f, 4.297804832e-01f, 9.689569473e-01f, 2.472294867e-01f, 9.901483059e-01f, 1.400224417e-01f, 9.968811274e-01f, 7.891785353e-02f, 9.990133643e-01f, 4.441035166e-02f, 9.996879697e-01f, 2.497939393e-02f, 9.999012947e-01f, 1.404794492e-02f,
-1.103872433e-01f, -9.938886762e-01f, 5.360818505e-01f, 8.441659808e-01f, 9.863393307e-01f, 1.647261530e-01f, -8.895073086e-02f, 9.960360527e-01f, -1.455000341e-01f, 9.893582463e-01f, -2.120364457e-01f, -9.772617817e-01f, -8.186323047e-01f, 5.743179917e-01f, 1.476312131e-01f, 9.890424609e-01f, 6.967067122e-01f, 7.173560858e-01f, 9.005023241e-01f, 4.348512292e-01f, 9.681702852e-01f, 2.502923310e-01f, 9.898977876e-01f, 1.417829692e-01f, 9.968017340e-01f, 7.991469651e-02f, 9.989882708e-01f, 4.497213289e-02f, 9.996800423e-01f, 2.529552206e-02f, 9.998987913e-01f, 1.422575582e-02f,
7.766859531e-01f, -6.298879981e-01f, 3.445185488e-03f, 9.999940395e-01f, 8.862052560e-01f, 4.632928669e-01f, -2.637388706e-01f, 9.645941257e-01f, -2.435445338e-01f, 9.698897004e-01f, -1.567750126e-01f, -9.876343608e-01f, -8.363815546e-01f, 5.481476784e-01f, 1.300208420e-01f, 9.915112853e-01f, 6.894984245e-01f, 7.242871523e-01f, 8.980427384e-01f, 4.399082065e-01f, 9.673739672e-01f, 2.533527315e-01f, 9.896440506e-01f, 1.435430646e-01f, 9.967212677e-01f, 8.091145754e-02f, 9.989628196e-01f, 4.553389549e-02f, 9.996719956e-01f, 2.561164647e-02f, 9.998962879e-01f, 1.440356486e-02f,
9.496777058e-01f, 3.132287860e-01f, -5.302492976e-01f, 8.478417993e-01f, 6.981857419e-01f, 7.159166336e-01f, -4.302088320e-01f, 9.027293921e-01f, -3.391546607e-01f, 9.407306314e-01f, -1.010174751e-01f, -9.948846698e-01f, -8.532945514e-01f, 5.214292407e-01f, 1.123693660e-01f, 9.936665297e-01f, 6.822211742e-01f, 7.311458588e-01f, 8.955547810e-01f, 4.449512959e-01f, 9.665679932e-01f, 2.564105392e-01f, 9.893872738e-01f, 1.453027129e-01f, 9.966399074e-01f, 8.190813661e-02f, 9.989370108e-01f, 4.609564692e-02f, 9.996638298e-01f, 2.592777088e-02f, 9.998936653e-01f, 1.458137389e-02f,
2.495401055e-01f, 9.683644772e-01f, -9.006391764e-01f, 4.345676303e-01f, 4.409287572e-01f, 8.975421190e-01f, -5.831102729e-01f, 8.123930097e-01f, -4.313769937e-01f, 9.021717310e-01f, -4.494105279e-02f, -9.989896417e-01f, -8.693541884e-01f, 4.941895902e-01f, 9.468235075e-02f, 9.955075383e-01f, 6.748757362e-01f, 7.379313707e-01f, 8.930384517e-01f, 4.499803185e-01f, 9.657523036e-01f, 2.594658434e-01f, 9.891272783e-01f, 1.470618844e-01f, 9.965574741e-01f, 8.290474117e-02f, 9.989109635e-01f, 4.665738344e-02f, 9.996555448e-01f, 2.624388970e-02f, 9.998911023e-01f, 1.475918386e-02f,
-6.800234914e-01f, 7.331902981e-01f, -9.936468601e-01f, -1.125427037e-01f, 1.399453431e-01f, 9.901592135e-01f, -7.176206112e-01f, 6.964342594e-01f, -5.192891359e-01f, 8.545985818e-01f, 1.127792522e-02f, -9.999364018e-01f, -8.845446110e-01f, 4.664555788e-01f, 7.696539164e-02f, 9.970337749e-01f, 6.674628258e-01f, 7.446430922e-01f, 8.904939294e-01f, 4.549950957e-01f, 9.649269581e-01f, 2.625184953e-01f, 9.888642430e-01f, 1.488205791e-01f, 9.964740872e-01f, 8.390125632e-02f, 9.988845587e-01f, 4.721910506e-02f, 9.996472001e-01f, 2.656000853e-02f, 9.998884201e-01f, 1.493699197e-02f,
-9.843766689e-01f, -1.760756075e-01f, -7.806286812e-01f, -6.249951124e-01f, -1.749181598e-01f, 9.845829606e-01f, -8.294976354e-01f, 5.585102439e-01f, -6.020119190e-01f, 7.984871268e-01f, 6.746077538e-02f, -9.977219105e-01f, -8.988505006e-01f, 4.382553995e-01f, 5.922409892e-02f, 9.982447028e-01f, 6.599831581e-01f, 7.512803674e-01f, 8.879212737e-01f, 4.599954784e-01f, 9.640919566e-01f, 2.655685544e-01f, 9.885979891e-01f, 1.505788416e-01f, 9.963896871e-01f, 8.489768207e-02f, 9.988578558e-01f, 4.778081179e-02f, 9.996387959e-01f, 2.687612176e-02f, 9.998857379e-01f, 1.511479914e-02f,
-3.836984336e-01f, -9.234584570e-01f, -3.271927834e-01f, -9.449576139e-01f, -4.724333286e-01f, 8.813664317e-01f, -9.152126908e-01f, 4.029710889e-01f, -6.787203550e-01f, 7.343968153e-01f, 1.234308258e-01f, -9.923532009e-01f, -9.122576714e-01f, 4.096167684e-01f, 4.146407545e-02f, 9.991400242e-01f, 6.524375081e-01f, 7.578425407e-01f, 8.853204846e-01f, 4.649813473e-01f, 9.632473588e-01f, 2.686159313e-01f, 9.883286953e-01f, 1.523365974e-01f, 9.963042736e-01f, 8.589403331e-02f, 9.988307953e-01f, 4.834250361e-02f, 9.996302128e-01f, 2.719223499e-02f, 9.998830557e-01f, 1.529260725e-02f,
5.697503090e-01f, -8.218178153e-01f, 2.270120084e-01f, -9.738919735e-01f, -7.230991125e-01f, 6.907442808e-01f, -9.720626473e-01f, 2.347215265e-01f, -7.486464977e-01f, 6.629694104e-01f, 1.790106595e-01f, -9.838471413e-01f, -9.247525930e-01f, 3.805688024e-01f, 2.369106375e-02f, 9.997193217e-01f, 6.448265314e-01f, 7.643289566e-01f, 8.826917410e-01f, 4.699524939e-01f, 9.623931050e-01f, 2.716606259e-01f, 9.880561829e-01f, 1.540938765e-01f, 9.962179065e-01f, 8.689029515e-02f, 9.988034964e-01f, 4.890418053e-02f, 9.996215701e-01f, 2.750834450e-02f, 9.998803139e-01f, 1.547041349e-02f,
9.993732572e-01f, 3.539830074e-02f, 7.113042474e-01f, -7.028842568e-01f, -9.020542502e-01f, 4.316227138e-01f, -9.982538819e-01f, 5.906983837e-02f, -8.110930920e-01f, 5.849170685e-01f, 2.340240777e-01f, -9.722307920e-01f, -9.363229275e-01f, 3.511400521e-01f, 5.910437554e-03f, 9.999825358e-01f, 6.371511221e-01f, 7.707388997e-01f, 8.800350428e-01f, 4.749087691e-01f, 9.615292549e-01f, 2.747026384e-01f, 9.877806306e-01f, 1.558506787e-01f, 9.961305261e-01f, 8.788647503e-02f, 9.987758398e-01f, 4.946583882e-02f, 9.996128082e-01f, 2.782445215e-02f, 9.998775721e-01f, 1.564821973e-02f,
5.101770163e-01f, 8.600693941e-01f, 9.765252471e-01f, -2.154029608e-01f, -9.915538430e-01f, 1.296956539e-01f, -9.929606318e-01f, -1.184448823e-01f, -8.654354811e-01f, 5.010203719e-01f, 2.882981002e-01f, -9.575406909e-01f, -9.469569325e-01f, 3.213604093e-01f, -1.187205687e-02f, 9.999295473e-01f, 6.294120550e-01f, 7.770717740e-01f, 8.773505092e-01f, 4.798500240e-01f, 9.606557488e-01f, 2.777418792e-01f, 9.875019193e-01f, 1.576069742e-01f, 9.960421324e-01f, 8.888255060e-02f, 9.987478256e-01f, 5.002748594e-02f, 9.996039867e-01f, 2.814055420e-02f, 9.998747706e-01f, 1.582602598e-02f,
-4.480736256e-01f, 8.939966559e-01f, 9.409945607e-01f, 3.384217024e-01f, -9.827213287e-01f, -1.850914657e-01f, -9.563499093e-01f, -2.922239304e-01f, -9.111302495e-01f, 4.121184647e-01f, 3.416602314e-01f, -9.398235083e-01f, -9.566441774e-01f, 2.912592292e-01f, -2.965079620e-02f, 9.995602965e-01f, 6.216099858e-01f, 7.833269238e-01f, 8.746382594e-01f, 4.847761393e-01f, 9.597726464e-01f, 2.807783484e-01f, 9.872201085e-01f, 1.593627781e-01f, 9.959527254e-01f, 8.987855166e-02f, 9.987195730e-01f, 5.058911443e-02f, 9.995950460e-01f, 2.845665626e-02f, 9.998719096e-01f, 1.600383036e-02f,
-9.943674803e-01f, 1.059875116e-01f, 6.156554222e-01f, 7.880154848e-01f, -8.764333129e-01f, -4.815232456e-01f, -8.895764351e-01f, -4.567863345e-01f, -9.477217197e-01f, 3.190979958e-01f, 3.939426839e-01f, -9.191350341e-01f, -9.653747678e-01f, 2.608670294e-01f, -4.742016271e-02f, 9.988750219e-01f, 6.137457490e-01f, 7.895037532e-01f, 8.718983531e-01f, 4.896869063e-01f, 9.588799477e-01f, 2.838120162e-01f, 9.869351387e-01f, 1.611180753e-01f, 9.958623648e-01f, 9.087446332e-02f, 9.986909628e-01f, 5.115072429e-02f, 9.995859861e-01f, 2.877275459e-02f, 9.998690486e-01f, 1.618163660e-02f,
-6.264444590e-01f, -7.794660926e-01f, 1.007066220e-01f, 9.949161410e-01f, -6.832289696e-01f, -7.302041650e-01f, -7.947461605e-01f, -6.069419384e-01f, -9.748435616e-01f, 2.228900939e-01f, 4.449792802e-01f, -8.955408931e-01f, -9.731400609e-01f, 2.302137464e-01f, -6.517452747e-02f, 9.978739023e-01f, 6.058201790e-01f, 7.956016064e-01f, 8.691309094e-01f, 4.945821762e-01f, 9.579776525e-01f, 2.868428528e-01f, 9.866470695e-01f, 1.628728807e-01f, 9.957709908e-01f, 9.187027812e-02f, 9.986619949e-01f, 5.171232671e-02f, 9.995768070e-01f, 2.908885106e-02f, 9.998661876e-01f, 1.635944098e-02f,
3.174287081e-01f, -9.482821226e-01f, -4.452612102e-01f, 8.954007030e-01f, -4.222704768e-01f, -9.064698815e-01f, -6.748499870e-01f, -7.379549146e-01f, -9.922253489e-01f, 1.244542375e-01f, 4.946095049e-01f, -8.691152930e-01f, -9.799323082e-01f, 1.993305236e-01f, -8.290828764e-02f, 9.965571761e-01f, 5.978339314e-01f, 8.016199470e-01f, 8.663359284e-01f, 4.994617999e-01f, 9.570658207e-01f, 2.898707688e-01f, 9.863558412e-01f, 1.646271497e-01f, 9.956786036e-01f, 9.286600351e-02f, 9.986327887e-01f, 5.227390677e-02f, 9.995675683e-01f, 2.940494195e-02f, 9.998632669e-01f, 1.653724350e-02f,
9.694593549e-01f, -2.452519834e-01f, -8.540936708e-01f, 5.201192498e-01f, -1.194339693e-01f, -9.928421378e-01f, -5.336694121e-01f, -8.456931710e-01f, -9.996930361e-01f, 2.477485314e-02f, 5.426756740e-01f, -8.399423361e-01f, -9.857447147e-01f, 1.682477444e-01f, -1.006158292e-01f, 9.949253798e-01f, 5.897880197e-01f, 8.075581193e-01f, 8.635135293e-01f, 5.043256879e-01f, 9.561443329e-01f, 2.928958237e-01f, 9.860615730e-01f, 1.663808972e-01f, 9.955852628e-01f, 9.386163205e-02f, 9.986032248e-01f, 5.283546820e-02f, 9.995582104e-01f, 2.972103283e-02f, 9.998602867e-01f, 1.671504788e-02f,
7.301735282e-01f, 6.832616925e-01f, -9.998821616e-01f, -1.535241678e-02f, 1.952449679e-01f, -9.807544947e-01f, -3.756571114e-01f, -9.267587066e-01f, -9.971721768e-01f, -7.515111566e-02f, 5.890265703e-01f, -8.081136942e-01f, -9.905714393e-01f, 1.369969547e-01f, -1.182915568e-01f, 9.929789305e-01f, 5.816830993e-01f, 8.134155273e-01f, 8.606638908e-01f, 5.091735721e-01f, 9.552133679e-01f, 2.959179580e-01f, 9.857641459e-01f, 1.681341380e-01f, 9.954909086e-01f, 9.485717118e-02f, 9.985733628e-01f, 5.339701846e-02f, 9.995487928e-01f, 3.003711812e-02f, 9.998573065e-01f, 1.689285226e-02f,
-1.804304570e-01f, 9.835877419e-01f, -8.377248049e-01f, -5.460926294e-01f, 4.905616641e-01f, -8.714064956e-01f, -2.057968229e-01f, -9.785947204e-01f, -9.846878052e-01f, -1.743271649e-01f, 6.335148811e-01f, -7.737304568e-01f, -9.944077134e-01f, 1.056089550e-01f, -1.359298676e-01f, 9.907184839e-01f, 5.735200047e-01f, 8.191915751e-01f, 8.577870131e-01f, 5.140053630e-01f, 9.542728066e-01f, 2.989371121e-01f, 9.854635596e-01f, 1.698868275e-01f, 9.953955412e-01f, 9.585261345e-02f, 9.985432029e-01f, 5.395854637e-02f, 9.995392561e-01f, 3.035320155e-02f, 9.998542666e-01f, 1.707065292e-02f,
-9.251475334e-01f, 3.796077371e-01f, -4.175648987e-01f, -9.086471200e-01f, 7.372311950e-01f, -6.756405830e-01f, -2.944579907e-02f, -9.995663762e-01f, -9.623649120e-01f, -2.717604339e-01f, 6.760007739e-01f, -7.369009256e-01f, -9.972496629e-01f, 7.411535084e-02f, -1.535250843e-01f, 9.881447554e-01f, 5.652995706e-01f, 8.248857260e-01f, 8.548829556e-01f, 5.188208818e-01f, 9.533227086e-01f, 3.019533157e-01f, 9.851599336e-01f, 1.716389805e-01f, 9.952991605e-01f, 9.684795886e-02f, 9.985126853e-01f, 5.452005938e-02f, 9.995296001e-01f, 3.066928312e-02f, 9.998512268e-01f, 1.724845544e-02f,
-8.192882538e-01f, -5.733818412e-01f, 1.312005073e-01f, -9.913558364e-01f, 9.107885361e-01f, -4.128731191e-01f, 1.478339285e-01f, -9.890121818e-01f, -9.304261804e-01f, -3.664793074e-01f, 7.163491845e-01f, -6.977419257e-01f, -9.990944266e-01f, 4.254788160e-02f, -1.710718721e-01f, 9.852585793e-01f, 5.570225716e-01f, 8.304973245e-01f, 8.519519567e-01f, 5.236200094e-01f, 9.523630738e-01f, 3.049664497e-01f, 9.848531485e-01f, 1.733906120e-01f, 9.952018261e-01f, 9.784321487e-02f, 9.984818697e-01f, 5.508155748e-02f, 9.995198250e-01f, 3.098535910e-02f, 9.998481274e-01f, 1.742625609e-02f,
3.982087970e-02f, -9.992068410e-01f, 6.395553350e-01f, -7.687450647e-01f, 9.940242171e-01f, -1.091595069e-01f, 3.204510510e-01f, -9.472650886e-01f, -8.891909122e-01f, -4.575363994e-01f, 7.544332147e-01f, -6.563767791e-01f, -9.999401569e-01f, 1.093762368e-02f, -1.885645688e-01f, 9.820607901e-01f, 5.486899018e-01f, 8.360259533e-01f, 8.489939570e-01f, 5.284025669e-01f, 9.513939619e-01f, 3.079765737e-01f, 9.845432639e-01f, 1.751416773e-01f, 9.951034784e-01f, 9.883836657e-02f, 9.984506965e-01f, 5.564303696e-02f, 9.995099902e-01f, 3.130143136e-02f, 9.998450279e-01f, 1.760405675e-02f,
8.623188734e-01f, -5.063656569e-01f, 9.509409070e-01f, -3.093724847e-01f, 9.786828160e-01f, 2.053775787e-01f, 4.829612970e-01f, -8.756417036e-01f, -8.390715122e-01f, -5.440210700e-01f, 7.901318669e-01f, -6.129369140e-01f, -9.997860789e-01f, -2.068333142e-02f, -2.059976310e-01f, 9.785524607e-01f, 5.403022766e-01f, 8.414710164e-01f, 8.460091352e-01f, 5.331684351e-01f, 9.504152536e-01f, 3.109835982e-01f, 9.842302203e-01f, 1.768921912e-01f, 9.950041771e-01f, 9.983342141e-02f, 9.984192848e-01f, 5.620449409e-02f, 9.995000362e-01f, 3.161750361e-02f, 9.998418689e-01f, 1.778185740e-02f,
8.920048475e-01f, 4.520258009e-01f, 9.694527388e-01f, 2.452782542e-01f, 8.662855029e-01f, 4.995492697e-01f, 6.302406788e-01f, -7.763997912e-01f, -7.805679440e-01f, -6.250709295e-01f, 8.233328462e-01f, -5.675588250e-01f, -9.986322522e-01f, -5.228384212e-02f, -2.233655602e-01f, 9.747347236e-01f, 5.318607092e-01f, 8.468318582e-01f, 8.429974914e-01f, 5.379174352e-01f, 9.494271278e-01f, 3.139874935e-01f, 9.839141369e-01f, 1.786421537e-01f, 9.949038625e-01f, 1.008283719e-01f, 9.983875155e-01f, 5.676594004e-02f, 9.994900227e-01f, 3.193357214e-02f, 9.998387098e-01f, 1.795965619e-02f,
1.015857086e-01f, 9.948267937e-01f, 6.893923283e-01f, 7.243881822e-01f, 6.679785848e-01f, 7.441805601e-01f, 7.576409578e-01f, -6.526715755e-01f, -7.142657638e-01f, -6.998745203e-01f, 8.539305925e-01f, -5.203868747e-01f, -9.964799285e-01f, -8.383183926e-02f, -2.406628430e-01f, 9.706087708e-01f, 5.233659744e-01f, 8.521080017e-01f, 8.399593234e-01f, 5.426494479e-01f, 9.484294653e-01f, 3.169882894e-01f, 9.835948944e-01f, 1.803915352e-01f, 9.948025346e-01f, 1.018232331e-01f, 9.983554482e-01f, 5.732736737e-02f, 9.994798303e-01f, 3.224964067e-02f, 9.998354912e-01f, 1.813745499e-02f,
-7.822308540e-01f, 6.229886413e-01f, 1.970090568e-01f, 9.804016948e-01f, 4.034298062e-01f, 9.150105715e-01f, 8.611455560e-01f, -5.083584189e-01f, -6.408262849e-01f, -7.676859498e-01f, 8.818289638e-01f, -4.715693891e-01f, -9.933311343e-01f, -1.152962446e-01f, -2.578840256e-01f, 9.661758542e-01f, 5.148188472e-01f, 8.572989702e-01f, 8.368944526e-01f, 5.473642945e-01f, 9.474223256e-01f, 3.199858963e-01f, 9.832725525e-01f, 1.821403503e-01f, 9.947001934e-01f, 1.028179824e-01f, 9.983230233e-01f, 5.788877234e-02f, 9.994695783e-01f, 3.256569803e-02f, 9.998322725e-01f, 1.831525378e-02f,
-9.468680024e-01f, -3.216224015e-01f, -3.560463190e-01f, 9.344683290e-01f, 9.887336940e-02f, 9.951000214e-01f, 9.374901056e-01f, -3.480119109e-01f, -5.609837770e-01f, -8.278267980e-01f, 9.069392681e-01f, -4.212614298e-01f, -9.891891479e-01f, -1.466451287e-01f, -2.750236690e-01f, 9.614374638e-01f, 5.062202811e-01f, 8.624042273e-01f, 8.338031769e-01f, 5.520617962e-01f, 9.464057088e-01f, 3.229803145e-01f, 9.829471111e-01f, 1.838885993e-01f, 9.945968986e-01f, 1.038126275e-01f, 9.982903004e-01f, 5.845016241e-02f, 9.994592667e-01f, 3.288175911e-02f, 9.998289943e-01f, 1.849305071e-02f,
-2.409590483e-01f, -9.705352783e-01f, -7.994487882e-01f, 6.007342339e-01f, -2.154882401e-01f, 9.765064120e-01f, 9.842666984e-01f, -1.766892821e-01f, -4.755369425e-01f, -8.796957731e-01f, 9.291825294e-01f, -3.696212471e-01f, -9.840580225e-01f, -1.778476238e-01f, -2.920763195e-01f, 9.563950300e-01f, 4.975710809e-01f, 8.674232364e-01f, 8.306855559e-01f, 5.567418337e-01f, 9.453796148e-01f, 3.259714842e-01f, 9.826185107e-01f, 1.856362671e-01f, 9.944925904e-01f, 1.048071757e-01f, 9.982572794e-01f, 5.901153386e-02f, 9.994487762e-01f, 3.319781274e-02f, 9.998256564e-01f, 1.867084950e-02f,
6.864865422e-01f, -7.271425128e-01f, -9.966333508e-01f, 8.198728412e-02f, -5.084800720e-01f, 8.610737324e-01f, 1.000000000e+00f, 2.060413535e-04f, -3.853378594e-01f, -9.227755666e-01f, 9.484879971e-01f, -3.168129921e-01f, -9.779430032e-01f, -2.088720351e-01f, -3.090365231e-01f, 9.510501623e-01f, 4.888721108e-01f, 8.723554611e-01f, 8.275416493e-01f, 5.614042878e-01f, 9.443440437e-01f, 3.289594054e-01f, 9.822868705e-01f, 1.873833388e-01f, 9.943872690e-01f, 1.058016121e-01f, 9.982239604e-01f, 5.957288295e-02f, 9.994382262e-01f, 3.351386636e-02f, 9.998223782e-01f, 1.884864643e-02f,
9.827795625e-01f, 1.847817302e-01f, -8.868746758e-01f, -4.620101154e-01f, -7.510490417e-01f, 6.602464318e-01f, 9.841938019e-01f, 1.770948619e-01f, -2.912894785e-01f, -9.566349387e-01f, 9.647951126e-01f, -2.630026639e-01f, -9.708499908e-01f, -2.396878302e-01f, -3.258991241e-01f, 9.454045296e-01f, 4.801242650e-01f, 8.772004843e-01f, 8.243715763e-01f, 5.660489798e-01f, 9.432991147e-01f, 3.319440186e-01f, 9.819520712e-01f, 1.891298145e-01f, 9.942809343e-01f, 1.067959517e-01f, 9.981902838e-01f, 6.013421714e-02f, 9.994276166e-01f, 3.382991254e-02f, 9.998189807e-01f, 1.902644150e-02f,
3.755095899e-01f, 9.268184900e-01f, -5.039728284e-01f, -8.637195230e-01f, -9.191339612e-01f, 3.939450979e-01f, 9.373466372e-01f, 3.483982384e-01f, -1.943297088e-01f, -9.809362888e-01f, 9.780520201e-01f, -2.083608955e-01f, -9.627863169e-01f, -2.702637315e-01f, -3.426586390e-01f, 9.394599795e-01f, 4.713284373e-01f, 8.819577694e-01f, 8.211753964e-01f, 5.706758499e-01f, 9.422446489e-01f, 3.349253237e-01f, 9.816142321e-01f, 1.908757091e-01f, 9.941736460e-01f, 1.077901721e-01f, 9.981563091e-01f, 6.069553271e-02f, 9.994168282e-01f, 3.414595872e-02f, 9.998155832e-01f, 1.920423657e-02f,
-5.770022273e-01f, 8.167425990e-01f, 3.414078429e-02f, -9.994170070e-01f, -9.960693717e-01f, 8.857665956e-02f, 8.609359860e-01f, 5.087132454e-01f, -9.542828053e-02f, -9.954363108e-01f, 9.882167578e-01f, -1.530608535e-01f, -9.537598491e-01f, -3.005696237e-01f, -3.593098223e-01f, 9.332183003e-01f, 4.624853432e-01f, 8.866268992e-01f, 8.179532886e-01f, 5.752846003e-01f, 9.411808252e-01f, 3.379032910e-01f, 9.812732339e-01f, 1.926209927e-01f, 9.940654039e-01f, 1.087842956e-01f, 9.981220365e-01f, 6.125682592e-02f, 9.994059801e-01f, 3.446200117e-02f, 9.998121262e-01f, 1.938203163e-02f,
-9.990208149e-01f, -4.424267635e-02f, 5.617429614e-01f, -8.273118138e-01f, -9.742255807e-01f, -2.255758345e-01f, 7.573719025e-01f, 6.529837251e-01f, 4.425697960e-03f, -9.999902248e-01f, 9.952573776e-01f, -9.727646410e-02f, -9.437798262e-01f, -3.305747509e-01f, -3.758473992e-01f, 9.266815782e-01f, 4.535961151e-01f, 8.912073374e-01f, 8.147053123e-01f, 5.798751712e-01f, 9.401075840e-01f, 3.408778608e-01f, 9.809291363e-01f, 1.943656504e-01f, 9.939560890e-01f, 1.097783074e-01f, 9.980874062e-01f, 6.181810424e-02f, 9.993950725e-01f, 3.477803990e-02f, 9.998086691e-01f, 1.955982484e-02f,
-5.025443435e-01f, -8.645514250e-01f, 9.163355827e-01f, -4.004111886e-01f, -8.557689190e-01f, -5.173581839e-01f, 6.299206614e-01f, 7.766594887e-01f, 1.042364091e-01f, -9.945525527e-01f, 9.991515279e-01f, -4.118499532e-02f, -9.328559637e-01f, -3.602495193e-01f, -3.922660947e-01f, 9.198517799e-01f, 4.446615279e-01f, 8.956986666e-01f, 8.114315867e-01f, 5.844473839e-01f, 9.390249252e-01f, 3.438490629e-01f, 9.805819392e-01f, 1.961097270e-01f, 9.938458204e-01f, 1.107722074e-01f, 9.980525374e-01f, 6.237935647e-02f, 9.993839860e-01f, 3.509407118e-02f, 9.998052120e-01f, 1.973761991e-02f,
4.559690952e-01f, -8.899955750e-01f, 9.887145162e-01f, 1.498119384e-01f, -6.524437070e-01f, -7.578372359e-01f, 4.826020896e-01f, 8.758397102e-01f, 2.030046880e-01f, -9.791777730e-01f, 9.998869300e-01f, 1.503714453e-02f, -9.209993482e-01f, -3.895640969e-01f, -4.085607529e-01f, 9.127311110e-01f, 4.356824458e-01f, 9.001004100e-01f, 8.081322312e-01f, 5.890011191e-01f, 9.379329085e-01f, 3.468167782e-01f, 9.802316427e-01f, 1.978531629e-01f, 9.937345386e-01f, 1.117659956e-01f, 9.980172515e-01f, 6.294059008e-02f, 9.993728399e-01f, 3.541010246e-02f, 9.998016953e-01f, 1.991541311e-02f,
9.952666163e-01f, -9.718190879e-02f, 7.565875053e-01f, 6.538924575e-01f, -3.844182491e-01f, -9.231590629e-01f, 3.200624883e-01f, 9.473964572e-01f, 2.997455299e-01f, -9.540191889e-01f, 9.974612594e-01f, 7.121126354e-02f, -9.082219005e-01f, -4.184889197e-01f, -4.247261286e-01f, 9.053218961e-01f, 4.266598225e-01f, 9.044122100e-01f, 8.048072457e-01f, 5.935363173e-01f, 9.368314743e-01f, 3.497810662e-01f, 9.798783064e-01f, 1.995959580e-01f, 9.936223030e-01f, 1.127596796e-01f, 9.979817271e-01f, 6.350180507e-02f, 9.993616343e-01f, 3.572613373e-02f, 9.997981191e-01f, 2.009320445e-02f,
6.195206046e-01f, 7.849804163e-01f, 2.914465666e-01f, 9.565871358e-01f, -7.827047259e-02f, -9.969321489e-01f, 1.474282593e-01f, 9.890727401e-01f, 3.934913874e-01f, -9.193283319e-01f, 9.918821454e-01f, 1.271607429e-01f, -8.945361972e-01f, -4.469954967e-01f, -4.407573938e-01f, 8.976262808e-01f, 4.175945222e-01f, 9.086334705e-01f, 8.014568090e-01f, 5.980526209e-01f, 9.357206821e-01f, 3.527418077e-01f, 9.795218110e-01f, 2.013381571e-01f, 9.935090542e-01f, 1.137532443e-01f, 9.979458451e-01f, 6.406301260e-02f, 9.993502498e-01f, 3.604215756e-02f, 9.997945428e-01f, 2.027099766e-02f,
-3.258098066e-01f, 9.454353452e-01f, -2.634541392e-01f, 9.646719098e-01f, 2.356393039e-01f, -9.718405604e-01f, -2.985579334e-02f, 9.995542169e-01f, 4.833047390e-01f, -8.754521608e-01f, 9.831672907e-01f, 1.827077270e-01f, -8.799561262e-01f, -4.750549197e-01f, -4.566490650e-01f, 8.896468878e-01f, 4.084874690e-01f, 9.127639532e-01f, 7.980811000e-01f, 6.025500894e-01f, 9.346005321e-01f, 3.556990325e-01f, 9.791622162e-01f, 2.030797005e-01f, 9.933947921e-01f, 1.147466898e-01f, 9.979096651e-01f, 6.462418288e-02f, 9.993388057e-01f, 3.635817394e-02f, 9.997909069e-01f, 2.044878900e-02f,
-9.715921879e-01f, 2.366613895e-01f, -7.372213602e-01f, 6.756513119e-01f, 5.261809826e-01f, -8.503726125e-01f, -2.061982006e-01f, 9.785102606e-01f, 5.682899356e-01f, -8.228283525e-01f, 9.713441133e-01f, 2.376775593e-01f, -8.644961119e-01f, -5.026394725e-01f, -4.723965526e-01f, 8.813861012e-01f, 3.993395865e-01f, 9.168030620e-01f, 7.946801186e-01f, 6.070284247e-01f, 9.334710836e-01f, 3.586527407e-01f, 9.787995219e-01f, 2.048205882e-01f, 9.932795167e-01f, 1.157400310e-01f, 9.978731871e-01f, 6.518533826e-02f, 9.993273020e-01f, 3.667419404e-02f, 9.997872710e-01f, 2.062657848e-02f,
-7.240971923e-01f, -6.896979213e-01f, -9.839316607e-01f, 1.785455495e-01f, 7.645443082e-01f, -6.445711255e-01f, -3.760372102e-01f, 9.266045690e-01f, 6.475961804e-01f, -7.619836926e-01f, 9.564502239e-01f, 2.918955386e-01f, -8.481717706e-01f, -5.297213197e-01f, -4.879944921e-01f, 8.728467226e-01f, 3.901517391e-01f, 9.207505584e-01f, 7.912539840e-01f, 6.114876866e-01f, 9.323322177e-01f, 3.616028130e-01f, 9.784337282e-01f, 2.065608501e-01f, 9.931632876e-01f, 1.167332530e-01f, 9.978363514e-01f, 6.574647129e-02f, 9.993156195e-01f, 3.699020669e-02f, 9.997835755e-01f, 2.080436796e-02f,
1.891294271e-01f, -9.819521904e-01f, -9.276105762e-01f, -3.735487163e-01f, 9.270853400e-01f, -3.748503029e-01f, -5.340162516e-01f, 8.454742432e-01f, 7.204326391e-01f, -6.935249567e-01f, 9.385324121e-01f, 3.451911509e-01f, -8.309991956e-01f, -5.562736392e-01f, -5.034382939e-01f, 8.640311956e-01f, 3.809248805e-01f, 9.246059656e-01f, 7.878028154e-01f, 6.159275174e-01f, 9.311841130e-01f, 3.645493090e-01f, 9.780648947e-01f, 2.083004564e-01f, 9.930460453e-01f, 1.177263632e-01f, 9.977992177e-01f, 6.630758941e-02f, 9.993038774e-01f, 3.730621934e-02f, 9.997798800e-01f, 2.098215744e-02f,
9.284713268e-01f, -3.714041114e-01f, -5.856038332e-01f, -8.105974197e-01f, 9.976883531e-01f, -6.795591116e-02f, -6.751540303e-01f, 7.376767993e-01f, 7.860706449e-01f, -6.181366444e-01f, 9.176476598e-01f, 3.973950148e-01f, -8.129957914e-01f, -5.822695494e-01f, -5.187226534e-01f, 8.549425602e-01f, 3.716599345e-01f, 9.283689260e-01f, 7.843267918e-01f, 6.203478575e-01f, 9.300266504e-01f, 3.674921393e-01f, 9.776929021e-01f, 2.100393921e-01f, 9.929278493e-01f, 1.187193394e-01f, 9.977617860e-01f, 6.686867774e-02f, 9.992920160e-01f, 3.762222081e-02f, 9.997761250e-01f, 2.115994506e-02f,
8.141809702e-01f, 5.806111693e-01f, -6.324278563e-02f, -9.979981780e-01f, 9.693515897e-01f, 2.456775755e-01f, -7.949962020e-01f, 6.066144109e-01f, 8.438539505e-01f, -5.365729332e-01f, 8.938615918e-01f, 4.483429790e-01f, -7.941793799e-01f, -6.076834202e-01f, -5.338430405e-01f, 8.455836177e-01f, 3.623578250e-01f, 9.320390821e-01f, 7.808259130e-01f, 6.247486472e-01f, 9.288598895e-01f, 3.704313040e-01f, 9.773178697e-01f, 2.117776722e-01f, 9.928086400e-01f, 1.197122112e-01f, 9.977239966e-01f, 6.742975861e-02f, 9.992800951e-01f, 3.793822229e-02f, 9.997723103e-01f, 2.133773454e-02f,
-4.866360873e-02f, 9.988152385e-01f, 4.786024988e-01f, -8.780316710e-01f, 8.448832631e-01f, 5.349507332e-01f, -8.897646070e-01f, 4.564197063e-01f, 8.932062984e-01f, -4.496471286e-01f, 8.672499061e-01f, 4.978730977e-01f, -7.745689750e-01f, -6.324894428e-01f, -5.487948060e-01f, 8.359571099e-01f, 3.530194759e-01f, 9.356159568e-01f, 7.773004174e-01f, 6.291296482e-01f, 9.276838303e-01f, 3.733667731e-01f, 9.769397378e-01f, 2.135152817e-01f, 9.926884174e-01f, 1.207049638e-01f, 9.976859689e-01f, 6.799080223e-02f, 9.992680550e-01f, 3.825422376e-02f, 9.997684956e-01f, 2.151552029e-02f,
-8.667671084e-01f, 4.987131655e-01f, 8.730400801e-01f, -4.876484275e-01f, 6.366297007e-01f, 7.711696625e-01f, -9.564702511e-01f, 2.918297648e-01f, 9.336335659e-01f, -3.582294583e-01f, 8.378961682e-01f, 5.458296537e-01f, -7.541838884e-01f, -6.566632986e-01f, -5.635727644e-01f, 8.260664344e-01f, 3.436457217e-01f, 9.390993714e-01f, 7.737502456e-01f, 6.334908009e-01f, 9.264984727e-01f, 3.762984574e-01f, 9.765585065e-01f, 2.152522057e-01f, 9.925672412e-01f, 1.216975898e-01f, 9.976475835e-01f, 6.855183095e-02f, 9.992558956e-01f, 3.857021779e-02f, 9.997646809e-01f, 2.169330604e-02f,
-8.879688978e-01f, -4.599034786e-01f, 9.985986948e-01f, 5.292089656e-02f, 3.652422130e-01f, 9.309124947e-01f, -9.930093288e-01f, 1.180356890e-01f, 9.647326469e-01f, -2.632316053e-01f, 8.058937788e-01f, 5.920601487e-01f, -7.330448627e-01f, -6.801803112e-01f, -5.781728029e-01f, 8.159143329e-01f, 3.342377245e-01f, 9.424887896e-01f, 7.701756358e-01f, 6.378318667e-01f, 9.253038764e-01f, 3.792264462e-01f, 9.761741757e-01f, 2.169884592e-01f, 9.924450517e-01f, 1.226900965e-01f, 9.976088405e-01f, 6.911283731e-02f, 9.992436171e-01f, 3.888620436e-02f, 9.997608066e-01f, 2.187109366e-02f,
-9.277620912e-02f, -9.956870079e-01f, 8.166087270e-01f, 5.771915913e-01f, 5.763408914e-02f, 9.983377457e-01f, -9.982294440e-01f, -5.948119611e-02f, 9.861924052e-01f, -1.656036228e-01f, 7.713432908e-01f, 6.364192963e-01f, -7.111726999e-01f, -7.030173540e-01f, -5.925897360e-01f, 8.055044413e-01f, 3.247962892e-01f, 9.457839727e-01f, 7.665767074e-01f, 6.421527267e-01f, 9.241000414e-01f, 3.821505904e-01f, 9.757867455e-01f, 2.187240422e-01f, 9.923218489e-01f, 1.236824766e-01f, 9.975697994e-01f, 6.967382133e-02f, 9.992312789e-01f, 3.920219466e-02f, 9.997568727e-01f, 2.204887755e-02f,
7.877145410e-01f, -6.160404682e-01f, 3.831194937e-01f, 9.236987829e-01f, -2.556895912e-01f, 9.667589068e-01f, -9.719658494e-01f, -2.351220697e-01f, 9.977982640e-01f, -6.632189453e-02f, 7.343545556e-01f, 6.787660718e-01f, -6.885895729e-01f, -7.251513004e-01f, -6.068195105e-01f, 7.948396206e-01f, 3.153223693e-01f, 9.489846230e-01f, 7.629535198e-01f, 6.464533210e-01f, 9.228869677e-01f, 3.850709498e-01f, 9.753962755e-01f, 2.204589099e-01f, 9.921976924e-01f, 1.246747300e-01f, 9.975304604e-01f, 7.023479044e-02f, 9.992188811e-01f, 3.951817751e-02f, 9.997529387e-01f, 2.222666144e-02f,
9.439841509e-01f, 3.299908042e-01f, -1.683704406e-01f, 9.857237935e-01f, -5.436599255e-01f, 8.393055797e-01f, -9.150469303e-01f, -4.033473432e-01f, 9.994345903e-01f, 3.362342715e-02f, 6.950438619e-01f, 7.189673185e-01f, -6.653177142e-01f, -7.465603352e-01f, -6.208572388e-01f, 7.839236856e-01f, 3.058169186e-01f, 9.520903230e-01f, 7.593061924e-01f, 6.507335305e-01f, 9.216646552e-01f, 3.879874349e-01f, 9.750027061e-01f, 2.221930772e-01f, 9.920725226e-01f, 1.256668717e-01f, 9.974908233e-01f, 7.079573721e-02f, 9.992063046e-01f, 3.983415663e-02f, 9.997490048e-01f, 2.240444534e-02f,
2.323590964e-01f, 9.726300836e-01f, -6.679986119e-01f, 7.441624999e-01f, -7.777124643e-01f, 6.286201477e-01f, -8.292679787e-01f, -5.588511825e-01f, 9.910848737e-01f, 1.332318485e-01f, 6.535362005e-01f, 7.568953037e-01f, -6.413808465e-01f, -7.672226429e-01f, -6.346988082e-01f, 7.727596164e-01f, 2.962808907e-01f, 9.551008344e-01f, 7.556348443e-01f, 6.549931169e-01f, 9.204331040e-01f, 3.909000754e-01f, 9.746060371e-01f, 2.239265591e-01f, 9.919463396e-01f, 1.266588867e-01f, 9.974508882e-01f, 7.135665417e-02f, 9.991936684e-01f, 4.015012830e-02f, 9.997450113e-01f, 2.258222736e-02f
};
namespace pg8 {
#define PG8_LAS __attribute__((address_space(3)))
typedef unsigned short bf16_t;
typedef short bf16x8 __attribute__((ext_vector_type(8)));
typedef float f32x4 __attribute__((ext_vector_type(4)));
typedef unsigned u32x4 __attribute__((ext_vector_type(4)));
constexpr int BM = 256, BK = 64, HALF = 128, HTB = HALF * BK * 2  , STAGE_BYTES = 8 * HTB, NXCD = 8, WGM = 8;

__host__ __device__ __forceinline__ int lds_byte(int r, int c) { const int st = (r >> 4) * 2 + (c >> 5), rr = r & 15, cc = c & 31, ob = rr * 64 + cc * 2; return st * 1024 + (ob ^ (((ob >> 9) & 1) << 5)); }
__host__ __device__ __forceinline__ void stage_rc(int b, int& R, int& C) { const int st = b / 1024, sb = b % 1024, swz = sb ^ (((sb >> 9) & 1) << 5); R = (st >> 1) * 16 + swz / 64; C = (st & 1) * 32 + (swz % 64) / 2; }
__host__ __device__ __forceinline__ int perm32(int rho) { const int n = rho >> 4, i = rho & 15; return 8 * (i >> 2) + 4 * n + (i & 3); }

__device__ __forceinline__ int pg8_lane_id() { int r_; asm volatile("v_mbcnt_lo_u32_b32 %0, -1, 0\n\tv_mbcnt_hi_u32_b32 %0, -1, %0" : "=v"(r_)); return r_; }
struct Unit { int pm, pn, kc; };
struct Gemm { const bf16_t* A; const bf16_t* Bt; int M, N, K, ld; };

struct StaticOrder {
    int nM, nN, nwg, G, c;
    __host__ __device__ void init(int M, int N, int G_, int c_) { nM = M / BM; nN = N / BM; nwg = nM * nN; G = G_; c = c_; }
    __host__ __device__ bool next(int i, Unit& u) const {
        const long L = (long)i * G + c; if (L >= nwg) return false;
        int wgid = (int)L; { const int q = nwg / NXCD, r = nwg % NXCD, xcd = wgid % NXCD, off = wgid / NXCD; wgid = (xcd < r ? xcd * (q + 1) : r * (q + 1) + (xcd - r) * q) + off; }
        const int nig = WGM * nN, gid = wgid / nig, fm = gid * WGM, gsz = (nM - fm) < WGM ? (nM - fm) : WGM;
        u.pm = fm + ((wgid % nig) % gsz); u.pn = (wgid % nig) / gsz; u.kc = 0; return true;
    }
    __device__ __forceinline__ void a_ready(const Unit&) const {}
    __device__ __forceinline__ void done(const Unit&) const {}
};
struct CtxSplitOrder {
    int n, G, c, nN;
    __host__ __device__ void init(int nN_, int nch, int G_, int c_) { nN = nN_; n = 2 * nN_ * nch; G = G_; c = c_; }
    __host__ __device__ bool next(int i, Unit& u) const { const int L = i * G + c; if (L >= n) return false; const int tile = L % (2 * nN); u.kc = L / (2 * nN); u.pm = tile / nN; u.pn = tile % nN; return true; }
    __device__ __forceinline__ void a_ready(const Unit&) const {}
    __device__ __forceinline__ void done(const Unit&) const {}
};

__device__ __forceinline__ unsigned cvt_pk_bf16(float lo, float hi) { unsigned r; asm volatile("v_cvt_pk_bf16_f32 %0, %1, %2" : "=v"(r) : "v"(lo), "v"(hi)); return r; }
template <class Epi, class Sched, bool ALIGN_EPI = false, bool SP2 = false>
__device__ __forceinline__ void gemm_phase(PG8_LAS unsigned char* lds, const Gemm g, const Sched& S, const Epi& E, const int wave_in) {
    int tid_ = wave_in * 64 + pg8_lane_id(); asm volatile("" : "+v"(tid_));
    const int tid = tid_, wid = __builtin_amdgcn_readfirstlane(tid >> 6), lane = tid & 63, wr = wid >> 2, wc = wid & 3, fr = lane & 15, fq = lane >> 4;
    const int K = g.K, nt = K / BK, ld = g.ld;
    unsigned voffA[2], voffB[2];
#pragma unroll
    for (int i = 0; i < 2; ++i) { int R, C; stage_rc(tid * 16 + i * 8192, R, C); const int Rb = Epi::PERM ? ((R & ~31) + perm32(R & 31)) : R;
        voffA[i] = (unsigned)(R * ld + C) * 2u; voffB[i] = (unsigned)(Rb * ld + C) * 2u; }
    const size_t kstep = (size_t)(BK * 2);
    const size_t hstep = (size_t)HALF * ld * 2;
    const size_t tstep = 2 * hstep;
    const unsigned ldsw = (unsigned)wid * 1024u;
    const int aoff = lds_byte(wr * 64 + fr, fq * 8), boff = lds_byte(wc * 32 + fr, fq * 8);
#define PG8_SA(b, h) (((b) * 2 + (h)) * HTB)
#define PG8_SB(b, h) ((4 + (b) * 2 + (h)) * HTB)
#define PG8_STAGE(bufoff, gbase, voff) do { _Pragma("unroll") for (int _i = 0; _i < 2; ++_i) \
        __builtin_amdgcn_global_load_lds((const unsigned*)((const char*)(gbase) + (voff)[_i]), (PG8_LAS unsigned*)(lds + (bufoff) + ldsw + _i * 8192), 16, 0, 0); } while (0)
#define PG8_LDA(dst, b, h) do { _Pragma("unroll") for (int m = 0; m < 4; ++m) _Pragma("unroll") for (int k = 0; k < 2; ++k) dst[m][k] = *(const PG8_LAS bf16x8*)(lds + PG8_SA(b, h) + aoff + m * 2048 + k * 1024); } while (0)
#define PG8_LDB(dst, b, h) do { _Pragma("unroll") for (int n = 0; n < 2; ++n) _Pragma("unroll") for (int k = 0; k < 2; ++k) dst[n][k] = *(const PG8_LAS bf16x8*)(lds + PG8_SB(b, h) + boff + n * 2048 + k * 1024); } while (0)
#define PG8_MMA(ai, bj, At, Bt) do { __builtin_amdgcn_s_setprio(1); _Pragma("unroll") for (int m = 0; m < 4; ++m) _Pragma("unroll") for (int n = 0; n < 2; ++n) _Pragma("unroll") for (int k = 0; k < 2; ++k) \
        acc[ai][bj][m][n] = __builtin_amdgcn_mfma_f32_16x16x32_bf16(Bt[n][k], At[m][k], acc[ai][bj][m][n], 0, 0, 0); __builtin_amdgcn_s_setprio(0); } while (0)
#define PG8_WAIT_V(n) asm volatile("s_waitcnt vmcnt(" #n ")" ::: "memory")
#define PG8_WAIT_L(n) asm volatile("s_waitcnt lgkmcnt(" #n ")" ::: "memory")
#define PG8_BAR __builtin_amdgcn_s_barrier()
#define PG8_SCHED __builtin_amdgcn_sched_barrier(0)
    Unit cur, nxt; int ui = 0;
    if (!S.next(0, cur)) return;
    f32x4 acc[2][2][4][2];
#pragma unroll
    for (int a = 0; a < 2; ++a)
#pragma unroll
        for (int b = 0; b < 2; ++b)
#pragma unroll
            for (int m = 0; m < 4; ++m)
#pragma unroll
                for (int n = 0; n < 2; ++n) acc[a][b][m][n] = (f32x4){0.f, 0.f, 0.f, 0.f};
    bf16x8 At[4][2], B0[2][2], B1[2][2];
    const char* cA = (const char*)g.A + (size_t)cur.pm * tstep + (size_t)cur.kc * K * 2; const char* cB = (const char*)g.Bt + (size_t)cur.pn * tstep + (size_t)cur.kc * K * 2;
    S.a_ready(cur);
    if constexpr (SP2) {
        PG8_STAGE(PG8_SB(0, 0), cB, voffB); PG8_STAGE(PG8_SB(0, 1), cB + hstep, voffB); PG8_STAGE(PG8_SA(0, 0), cA, voffA); PG8_STAGE(PG8_SA(0, 1), cA + hstep, voffA);
        if (wr == 1) PG8_BAR;
        PG8_WAIT_V(2); PG8_BAR;
        PG8_STAGE(PG8_SB(1, 0), cB + kstep, voffB); PG8_STAGE(PG8_SA(1, 0), cA + kstep, voffA); PG8_STAGE(PG8_SB(1, 1), cB + hstep + kstep, voffB);
        PG8_WAIT_V(6); PG8_BAR;
    } else {
        PG8_STAGE(PG8_SB(0, 0), cB, voffB); PG8_STAGE(PG8_SA(0, 0), cA, voffA); PG8_STAGE(PG8_SB(0, 1), cB + hstep, voffB); PG8_STAGE(PG8_SA(0, 1), cA + hstep, voffA);
        if (wr == 1) PG8_BAR;
        PG8_WAIT_V(4); PG8_BAR;
        PG8_STAGE(PG8_SB(1, 0), cB + kstep, voffB); PG8_STAGE(PG8_SA(1, 0), cA + kstep, voffA); PG8_STAGE(PG8_SB(1, 1), cB + hstep + kstep, voffB);
        PG8_WAIT_V(6); PG8_BAR;
    }
    for (;;) {
        const bool has_next = S.next(ui + 1, nxt);
        const char* nA = has_next ? (const char*)g.A + (size_t)nxt.pm * tstep + (size_t)nxt.kc * K * 2 : cA; const char* nB = has_next ? (const char*)g.Bt + (size_t)nxt.pn * tstep + (size_t)nxt.kc * K * 2 : cB;
        for (int t = 0; t < nt; t += 2) {
            const bool last = (t == nt - 2);
            const char* a1 = cA + (size_t)(t + 1) * kstep;
            const char* a2 = last ? nA : cA + (size_t)(t + 2) * kstep; const char* b2 = last ? nB : cB + (size_t)(t + 2) * kstep;
            const char* a3 = a2 + kstep; const char* b3 = b2 + kstep;
            if (last && has_next) S.a_ready(nxt);
            if constexpr (SP2) {
            PG8_LDB(B0, 0, 0); PG8_LDB(B1, 0, 1); PG8_SCHED; PG8_LDA(At, 0, 0); PG8_STAGE(PG8_SA(1, 1), a1 + hstep, voffA);
            PG8_WAIT_V(8); PG8_WAIT_L(0); PG8_BAR; PG8_MMA(0, 0, At, B0); PG8_MMA(0, 1, At, B1); PG8_BAR; PG8_SCHED;
            PG8_LDA(At, 0, 1); PG8_STAGE(PG8_SB(0, 0), b2, voffB); PG8_STAGE(PG8_SB(0, 1), b2 + hstep, voffB); PG8_STAGE(PG8_SA(0, 0), a2, voffA);
            PG8_WAIT_V(8); PG8_WAIT_L(0); PG8_BAR; PG8_MMA(1, 0, At, B0); PG8_MMA(1, 1, At, B1); PG8_BAR; PG8_SCHED;
            PG8_LDB(B0, 1, 0); PG8_LDB(B1, 1, 1); PG8_SCHED; PG8_LDA(At, 1, 0); PG8_STAGE(PG8_SA(0, 1), a2 + hstep, voffA);
            PG8_WAIT_V(8); PG8_WAIT_L(0); PG8_BAR; PG8_MMA(0, 0, At, B0); PG8_MMA(0, 1, At, B1); PG8_BAR; PG8_SCHED;
            PG8_LDA(At, 1, 1); PG8_STAGE(PG8_SB(1, 0), b3, voffB); PG8_STAGE(PG8_SB(1, 1), b3 + hstep, voffB); PG8_STAGE(PG8_SA(1, 0), a3, voffA);
            PG8_WAIT_V(8); PG8_WAIT_L(0); PG8_BAR; PG8_MMA(1, 0, At, B0); PG8_MMA(1, 1, At, B1); PG8_BAR; PG8_SCHED;
            } else {
            PG8_LDB(B0, 0, 0); PG8_SCHED; PG8_LDA(At, 0, 0); PG8_STAGE(PG8_SA(1, 1), a1 + hstep, voffA);
            PG8_WAIT_L(8); PG8_BAR; PG8_WAIT_L(0); PG8_MMA(0, 0, At, B0); PG8_BAR; PG8_SCHED;
            PG8_LDB(B1, 0, 1); PG8_STAGE(PG8_SB(0, 0), b2, voffB);
            PG8_BAR; PG8_WAIT_L(0); PG8_MMA(0, 1, At, B1); PG8_BAR;
            PG8_LDA(At, 0, 1); PG8_STAGE(PG8_SA(0, 0), a2, voffA);
            PG8_BAR; PG8_WAIT_L(0); PG8_MMA(1, 0, At, B0); PG8_BAR; PG8_SCHED;
            PG8_STAGE(PG8_SB(0, 1), b2 + hstep, voffB);
            PG8_WAIT_V(6); PG8_BAR; PG8_MMA(1, 1, At, B1); PG8_BAR;
            PG8_LDB(B0, 1, 0); PG8_SCHED; PG8_LDA(At, 1, 0); PG8_STAGE(PG8_SA(0, 1), a2 + hstep, voffA);
            PG8_WAIT_L(8); PG8_BAR; PG8_WAIT_L(0); PG8_MMA(0, 0, At, B0); PG8_BAR; PG8_SCHED;
            PG8_LDB(B1, 1, 1); PG8_STAGE(PG8_SB(1, 0), b3, voffB);
            PG8_BAR; PG8_WAIT_L(0); PG8_MMA(0, 1, At, B1); PG8_BAR;
            PG8_LDA(At, 1, 1); PG8_STAGE(PG8_SA(1, 0), a3, voffA);
            PG8_BAR; PG8_WAIT_L(0); PG8_MMA(1, 0, At, B0); PG8_BAR; PG8_SCHED;
            PG8_STAGE(PG8_SB(1, 1), b3 + hstep, voffB);
            PG8_WAIT_V(6); PG8_BAR; PG8_MMA(1, 1, At, B1); PG8_BAR;
            }
        }
        if constexpr (ALIGN_EPI) { if (wr == 0) PG8_BAR; }
        if constexpr (!Epi::AFTER_DRAIN) { E(acc, cur, wr, wc, fr, fq); S.done(cur); }
        if (!has_next) break;
#pragma unroll
        for (int a = 0; a < 2; ++a)
#pragma unroll
            for (int b = 0; b < 2; ++b)
#pragma unroll
                for (int m = 0; m < 4; ++m)
#pragma unroll
                    for (int n = 0; n < 2; ++n) acc[a][b][m][n] = (f32x4){0.f, 0.f, 0.f, 0.f};
        cur = nxt; cA = nA; cB = nB; ++ui;
        if constexpr (ALIGN_EPI) { if (wr == 1) PG8_BAR; }
    }
    PG8_WAIT_V(0);
    if constexpr (!ALIGN_EPI) { if (wr == 0) PG8_BAR; }
    PG8_BAR;
    if constexpr (Epi::AFTER_DRAIN) { E.fused(acc, cur, wr, wc, fr, fq, lds, wid, lane); S.done(cur); }
#undef PG8_SA
#undef PG8_SB
#undef PG8_STAGE
#undef PG8_LDA
#undef PG8_LDB
#undef PG8_MMA
#undef PG8_WAIT_V
#undef PG8_WAIT_L
#undef PG8_BAR
#undef PG8_SCHED
}
}
namespace attn_body {
constexpr int QP=512,OP=512;
constexpr int NA_RPB_OFF=90112;
using bf16=__hip_bfloat16;
using bf16x8=__attribute__((ext_vector_type(8)))short;
using s16x4=__attribute__((ext_vector_type(4)))short;
using f32x16=__attribute__((ext_vector_type(16)))float;
using u32x4=__attribute__((ext_vector_type(4)))unsigned;
constexpr int D=64;
constexpr int NW=8,QBLK=32,QB=QBLK*NW,KVBLK=64;
__device__ __forceinline__ int crow(int r,int hi){return (r&3)+8*(r>>2)+4*hi;}
#define SBAR() __builtin_amdgcn_sched_barrier(0)
__device__ __forceinline__ void cmask(f32x16&p0,f32x16&p1,int jb,int qrel,int hi){
  const float NEG=-INFINITY; int kb=64*jb+4*hi;
  #pragma unroll
  for(int r=0;r<16;++r){int kv=kb+(r&3)+8*(r>>2); if(kv>qrel)p0[r]=NEG; if(kv+32>qrel)p1[r]=NEG;}
}

constexpr int NSLOT=3, SLOTB=8192;
constexpr int LDS_K=0, LDS_V=NSLOT*SLOTB, LDS_WS=2*NSLOT*SLOTB, LDS_OST=LDS_WS+NW*64*4, LDS_BYTES=LDS_OST+NW*4096;
constexpr float C2=0.125f*1.4426950408889634f;
__device__ __forceinline__ void glds16(const void*gsrc,unsigned lds_dst){unsigned keep;
  asm volatile("s_mov_b32 %0, m0\n\ts_mov_b32 m0, %2\n\ts_nop 0\n\tglobal_load_lds_dwordx4 %1, off\n\ts_mov_b32 m0, %0":"=&s"(keep):"v"(gsrc),"s"(lds_dst):"memory");}
__device__ __forceinline__ float max3f(float a,float b,float c){float r;asm("v_max3_f32 %0, %1, %2, %3":"=v"(r):"v"(a),"v"(b),"v"(c));return r;}
__device__ __forceinline__ float max2f(float a,float b){float r;asm("v_max_f32_e32 %0, %1, %2":"=v"(r):"v"(a),"v"(b));return r;}
__device__ __forceinline__ float fadd_s(float a,float b){float r;asm("v_add_f32_e32 %0, %1, %2":"=v"(r):"v"(a),"v"(b));return r;}
__device__ __forceinline__ float fsub_s(float a,float b){float r;asm("v_sub_f32_e32 %0, %1, %2":"=v"(r):"v"(a),"v"(b));return r;}
typedef float f32x2_t __attribute__((ext_vector_type(2))); typedef __bf16 bf16x2_t __attribute__((ext_vector_type(2)));
__device__ __forceinline__ unsigned cvtpk_s(float lo,float hi){f32x2_t v={lo,hi};bf16x2_t b=__builtin_convertvector(v,bf16x2_t);return __builtin_bit_cast(unsigned,b);}
#define WAIT_BAR(N) asm volatile("s_waitcnt vmcnt(" #N ") lgkmcnt(0)\n\ts_barrier":::"memory")

__device__ __forceinline__ void qkt(f32x16&p0,f32x16&p1,const char*Kslot,const bf16x8*qr,const f32x16&negm,int r32,int hi){
  const char*kb=Kslot+hi*1024+r32*16;
  #pragma unroll
  for(int d0=0;d0<4;++d0){
    const bf16x8 b0=*reinterpret_cast<const bf16x8*>(kb+d0*2048);
    const bf16x8 b1=*reinterpret_cast<const bf16x8*>(kb+d0*2048+512);
    if(d0==0){p0=__builtin_amdgcn_mfma_f32_32x32x16_bf16(b0,qr[0],negm,0,0,0);p1=__builtin_amdgcn_mfma_f32_32x32x16_bf16(b1,qr[0],negm,0,0,0);}
    else{p0=__builtin_amdgcn_mfma_f32_32x32x16_bf16(b0,qr[d0],p0,0,0,0);p1=__builtin_amdgcn_mfma_f32_32x32x16_bf16(b1,qr[d0],p1,0,0,0);}}
}
typedef __attribute__((address_space(3))) const char* lds_cptr;
typedef short v4i16_t __attribute__((ext_vector_type(4)));
__device__ __forceinline__ void kload8(bf16x8*kf,lds_cptr kp){
  kf[0]=*(const __attribute__((address_space(3))) bf16x8*)(kp);      kf[1]=*(const __attribute__((address_space(3))) bf16x8*)(kp+512);
  kf[2]=*(const __attribute__((address_space(3))) bf16x8*)(kp+2048); kf[3]=*(const __attribute__((address_space(3))) bf16x8*)(kp+2560);
  kf[4]=*(const __attribute__((address_space(3))) bf16x8*)(kp+4096); kf[5]=*(const __attribute__((address_space(3))) bf16x8*)(kp+4608);
  kf[6]=*(const __attribute__((address_space(3))) bf16x8*)(kp+6144); kf[7]=*(const __attribute__((address_space(3))) bf16x8*)(kp+6656);
}
__device__ __forceinline__ void kload2(bf16x8*kf,lds_cptr kp,int j){ kf[2*j]=*(const __attribute__((address_space(3))) bf16x8*)(kp+j*2048); kf[2*j+1]=*(const __attribute__((address_space(3))) bf16x8*)(kp+j*2048+512); }
__device__ __forceinline__ s16x4 vtr(lds_cptr p){ return __builtin_bit_cast(s16x4,__builtin_amdgcn_ds_read_tr16_b64_v4i16((__attribute__((address_space(3))) v4i16_t*)p)); }
__device__ __forceinline__ float rowmax(const f32x16&p0,const f32x16&p1){
  float a=max3f(p0[0],p0[1],p1[0]),b=max3f(p0[2],p0[3],p1[1]);a=max3f(a,p1[2],p1[3]);
  #pragma unroll
  for(int r=4;r<16;r+=4){a=max3f(a,p0[r],p0[r+1]);b=max3f(b,p0[r+2],p0[r+3]);a=max3f(a,p1[r],p1[r+1]);b=max3f(b,p1[r+2],p1[r+3]);}
  const float m=max2f(a,b);
  auto rr=__builtin_amdgcn_permlane32_swap(__float_as_uint(m),__float_as_uint(m),false,false);
  return max2f(__uint_as_float(rr[0]),__uint_as_float(rr[1]));
}
__device__ __forceinline__ void pv(f32x16*o,int vb,bf16x8 pa0,bf16x8 pa1,bf16x8 pa2,bf16x8 pa3){
  #pragma unroll
  for(int d0=0;d0<2;++d0){s16x4 lo[4],hi[4];
    #pragma unroll
    for(int ks=0;ks<4;++ks){
      asm volatile("ds_read_b64_tr_b16 %0,%1 offset:%c2":"=&v"(lo[ks]):"v"(vb),"i"(d0*4096+ks*1024):"memory");
      asm volatile("ds_read_b64_tr_b16 %0,%1 offset:%c2":"=&v"(hi[ks]):"v"(vb),"i"(d0*4096+ks*1024+512):"memory");}
    asm volatile("s_waitcnt lgkmcnt(0)":::"memory");SBAR();
    #define PK(k) (bf16x8){lo[k][0],lo[k][1],lo[k][2],lo[k][3],hi[k][0],hi[k][1],hi[k][2],hi[k][3]}
    o[d0]=__builtin_amdgcn_mfma_f32_32x32x16_bf16(pa0,PK(0),o[d0],0,0,0);
    o[d0]=__builtin_amdgcn_mfma_f32_32x32x16_bf16(pa1,PK(1),o[d0],0,0,0);
    o[d0]=__builtin_amdgcn_mfma_f32_32x32x16_bf16(pa2,PK(2),o[d0],0,0,0);
    o[d0]=__builtin_amdgcn_mfma_f32_32x32x16_bf16(pa3,PK(3),o[d0],0,0,0);
    #undef PK
  }
}

#ifndef ATTN_STORE16
#define ATTN_STORE16(p,v) (*(u32x4*)(p)=(v))
#endif
template<int THRL,bool NA> __device__ __forceinline__ void attn_unit(const bf16*Qp,const bf16*__restrict__ Kh,const bf16*__restrict__ Vh,bf16*Op,const int NT,char*shm,const int wave_in,const int kr0=0,const int nwin=0,const int qgr0=0,const float*rpb_h=nullptr){
  constexpr int KP=NA?512:128;
  int tid_=wave_in*64+pg8::pg8_lane_id(); asm volatile("":"+v"(tid_)); const int tid=tid_,lane=tid&63,r32=lane&31,hi=lane>>5; const int wid=__builtin_amdgcn_readfirstlane(tid>>6);
  const bf16*Qw=Qp+(long)(wid*QBLK)*QP;
  const unsigned lds0=(unsigned)(uintptr_t)shm;
  float*wsf=(float*)(shm+LDS_WS)+wid*64;
  float*rpbL=(float*)(shm+NA_RPB_OFF);
  if(NA){ for(int i=tid;i<465;i+=512)rpbL[i]=rpb_h[i]*1.4426950408889634f; }
  const int qgr=qgr0+(wid>>1),qc=(wid&1)*32+r32;
  const int rs=min(max(qgr-4,0),120),cs=min(max(qc-8,0),48);
  #define TROW(t) (NA?(((t)<4)?(8192+64*(t)):(min(kr0+(t)-4,127)*64)):(64*(t)))
  const bf16*ksrc=Kh+(long)lane*KP+wid*8;
  const bf16*vsrc=Vh+(long)(16*(wid&3)+(lane>>2))*KP+(wid>>2)*32+(lane&3)*8;
  const unsigned kdst=lds0+LDS_K+wid*1024, vdst=lds0+LDS_V+wid*1024;
  #define DMA_K(t,slot) glds16(ksrc+(long)TROW(t)*KP,(unsigned)__builtin_amdgcn_readfirstlane(kdst+(slot)))
  #define DMA_V(t,slot) glds16(vsrc+(long)TROW(t)*KP,(unsigned)__builtin_amdgcn_readfirstlane(vdst+(slot)))
  const int vb0=(int)(lds0+LDS_V)+((lane>>4)&1)*32+(lane&3)*8+(4*hi+((lane&15)>>2))*64;
  const char*Kbase=shm+LDS_K; bf16x8 kf[8];
  const lds_cptr shm3=(lds_cptr)shm; const lds_cptr kp0=shm3+LDS_K+hi*1024+r32*16; const lds_cptr vp0=shm3+LDS_V+((lane>>4)&1)*32+(lane&3)*8+(4*hi+((lane&15)>>2))*64;
  DMA_K(0,0);DMA_V(0,0);DMA_K(1,SLOTB);
  bf16x8 qr[4];
  #pragma unroll
  for(int d0=0;d0<4;++d0)qr[d0]=*reinterpret_cast<const bf16x8*>(&Qw[(long)r32*QP+d0*16+hi*8]);
  float mhat=0.f,l_reg=0.f;f32x16 o[2];o[0]=f32x16{};o[1]=f32x16{};f32x16 negm=f32x16{};asm volatile("":"+v"(negm));
  #define CMASK(P0,P1,t) do{ if(NA&&(t)>=4){ const int kr_=kr0+(t)-4; const bool rowok_=((t)-4<nwin)&&(kr_>=rs)&&(kr_<rs+8); \
      if(!rowok_){ _Pragma("unroll") for(int r=0;r<16;++r){P0[r]=-INFINITY;P1[r]=-INFINITY;} } \
      else{ const float*bp_=rpbL+((kr_-qgr+7)*31+15-qc+4*hi); const int dc_=4*hi-cs;      \
        _Pragma("unroll") for(int r=0;r<16;++r){ const int ko_=(r&3)+8*(r>>2); \
          P0[r]=((unsigned)(dc_+ko_)<16u)?P0[r]+bp_[ko_]:-INFINITY; \
          P1[r]=((unsigned)(dc_+ko_+32)<16u)?P1[r]+bp_[ko_+32]:-INFINITY; } } } }while(0)
  bool resc=false;
  #define START(P0,P1) do{ const float rm=rowmax(P0,P1); resc=false; \
    { const float dl=rm; mhat=fadd_s(mhat,dl); \
      _Pragma("unroll") for(int r=0;r<16;++r){P0[r]=fsub_s(P0[r],dl);P1[r]=fsub_s(P1[r],dl);} \
      _Pragma("unroll") for(int r=0;r<16;++r)negm[r]=-mhat; asm volatile("":"+v"(negm)); } \
    _Pragma("unroll") for(int r=0;r<16;++r)P0[r]=__builtin_amdgcn_exp2f(P0[r]); }while(0)
  #define RESC() do{ if(resc){ asm volatile("s_waitcnt lgkmcnt(0)":::"memory"); \
      _Pragma("unroll") for(int d_=0;d_<2;++d_) _Pragma("unroll") for(int r=0;r<16;++r)o[d_][r]*=wsf[crow(r,hi)]; } }while(0)
  f32x16 pA0,pA1,pB0,pB1;
  int sl_prev=0,sl_cur=0,sl_next=SLOTB;
  #define ROT() do{sl_prev=sl_cur;sl_cur=sl_next;sl_next=(sl_next==(NSLOT-1)*SLOTB)?0:sl_next+SLOTB;}while(0)
  DMA_K(2,2*SLOTB);
  WAIT_BAR(3);
  qkt(pA0,pA1,Kbase,qr,negm,r32,hi);asm volatile("s_nop 15\n\ts_nop 7":"+v"(pA0),"+v"(pA1));CMASK(pA0,pA1,0);
  START(pA0,pA1);
  _Pragma("unroll") for(int r=0;r<16;++r)pA1[r]=__builtin_amdgcn_exp2f(pA1[r]);
  WAIT_BAR(0);
  DMA_K(3,0);DMA_V(1,SLOTB);
  ROT();
  kload8(kf,kp0+sl_cur);
  WAIT_BAR(2);
  s16x4 vlo[8],vhi[8]; u32x4 pw0,pw1,pw2,pw3;
  #define PKW(P,B) cvtpk_s(P[B],P[B+1])
  #define PAF(k) __builtin_bit_cast(bf16x8,pw##k)
  #define VFR(i) (bf16x8){vlo[i][0],vlo[i][1],vlo[i][2],vlo[i][3],vhi[i][0],vhi[i][1],vhi[i][2],vhi[i][3]}
  #define PIN(x) asm volatile("":"+v"(x))
  #define MX3(a,b,c) __builtin_fmaxf(__builtin_fmaxf((a),(b)),(c))
  #define GAPA(MF,A0,A1,A2,A3,W0,W1,PW) do{ MF; sacc+=A0; sacc+=A1; sacc+=A2; sacc+=A3; PIN(sacc); W0; W1; PIN(PW); SBAR(); }while(0)
  #define EX(v) __builtin_amdgcn_exp2f(v)
  #define GAPB(MF,X,B) do{ MF; X[B]=EX(X[B]); X[B+1]=EX(X[B+1]); X[B+2]=EX(X[B+2]); X[B+3]=EX(X[B+3]); PIN(X); SBAR(); }while(0)
  #define VRD(i) do{ vlo[i]=vtr(vp_+(((i)>>2)*4096+((i)&3)*1024)); vhi[i]=vtr(vp_+(((i)>>2)*4096+((i)&3)*1024+512)); }while(0)
  #define KRD(G,j) do{ if(G){ kload2(kf,kp0+sl_next,j); SBAR(); } }while(0)
  #define STEP(C0,C1,P0,P1,t,GK,GV,GL) do{ SBAR(); \
    const lds_cptr vp_=vp0+sl_prev; \
    VRD(0); SBAR(); float sacc=(P0[0]+P0[1]); \
    GAPA(C0=__builtin_amdgcn_mfma_f32_32x32x16_bf16(kf[0],qr[0],negm,0,0,0), P0[2],P0[3],P0[4],P0[5],     pw0[0]=PKW(P0,0), pw0[1]=PKW(P0,2), pw0); \
    VRD(4); SBAR(); GAPA(C1=__builtin_amdgcn_mfma_f32_32x32x16_bf16(kf[1],qr[0],negm,0,0,0), P0[6],P0[7],P0[8],P0[9],     pw0[2]=PKW(P0,4), pw0[3]=PKW(P0,6), pw0); \
    VRD(1); SBAR(); GAPA(C0=__builtin_amdgcn_mfma_f32_32x32x16_bf16(kf[2],qr[1],C0,0,0,0),   P0[10],P0[11],P0[12],P0[13], pw1[0]=PKW(P0,8), pw1[1]=PKW(P0,10), pw1); \
    VRD(5); SBAR(); GAPA(C1=__builtin_amdgcn_mfma_f32_32x32x16_bf16(kf[3],qr[1],C1,0,0,0),   P0[14],P0[15],P1[0],P1[1],   pw1[2]=PKW(P0,12),pw1[3]=PKW(P0,14), pw1); \
    VRD(2); SBAR(); GAPA(C0=__builtin_amdgcn_mfma_f32_32x32x16_bf16(kf[4],qr[2],C0,0,0,0),   P1[2],P1[3],P1[4],P1[5],     pw2[0]=PKW(P1,0), pw2[1]=PKW(P1,2), pw2); \
    VRD(6); SBAR(); GAPA(C1=__builtin_amdgcn_mfma_f32_32x32x16_bf16(kf[5],qr[2],C1,0,0,0),   P1[6],P1[7],P1[8],P1[9],     pw2[2]=PKW(P1,4), pw2[3]=PKW(P1,6), pw2); \
    VRD(3); SBAR(); GAPA(C0=__builtin_amdgcn_mfma_f32_32x32x16_bf16(kf[6],qr[3],C0,0,0,0),   P1[10],P1[11],P1[12],P1[13], pw3[0]=PKW(P1,8), pw3[1]=PKW(P1,10), pw3); \
    VRD(7); SBAR(); GAPA(C1=__builtin_amdgcn_mfma_f32_32x32x16_bf16(kf[7],qr[3],C1,0,0,0),   P1[14],P1[15],0.f,0.f,       pw3[2]=PKW(P1,12),pw3[3]=PKW(P1,14), pw3); \
    l_reg+=sacc; \
    if(GK){DMA_K((t)+3,sl_cur);} if(GV){DMA_V((t)+1,sl_next);} \
    CMASK(C0,C1,t); \
    { float a=MX3(C0[0],C0[1],C1[0]),b=MX3(C0[2],C0[3],C1[1]); a=MX3(a,C1[2],C1[3]); \
      _Pragma("unroll") for(int r=4;r<16;r+=4){a=MX3(a,C0[r],C0[r+1]);b=MX3(b,C0[r+2],C0[r+3]);a=MX3(a,C1[r],C1[r+1]);b=MX3(b,C1[r+2],C1[r+3]);} \
      float rm=__builtin_fmaxf(a,b); { auto rr=__builtin_amdgcn_permlane32_swap(__float_as_uint(rm),__float_as_uint(rm),false,false); rm=__builtin_fmaxf(__uint_as_float(rr[0]),__uint_as_float(rr[1])); } \
      resc=false; \
      if(__builtin_expect(__any(rm>(float)THRL),0)){ const float dl=__builtin_fmaxf(rm,0.f); mhat+=dl; \
        _Pragma("unroll") for(int r=0;r<16;++r){C0[r]-=dl;C1[r]-=dl;} \
        _Pragma("unroll") for(int r=0;r<16;++r)negm[r]=-mhat; asm volatile("":"+v"(negm)); \
        const float f=__builtin_amdgcn_exp2f(-dl); l_reg*=f; if(hi==0)wsf[r32]=f; resc=true; } } \
    SBAR(); \
    GAPB(o[0]=__builtin_amdgcn_mfma_f32_32x32x16_bf16(PAF(0),VFR(0),o[0],0,0,0), C0,0); \
    GAPB(o[1]=__builtin_amdgcn_mfma_f32_32x32x16_bf16(PAF(0),VFR(4),o[1],0,0,0), C0,4); \
    KRD(GL,0); GAPB(o[0]=__builtin_amdgcn_mfma_f32_32x32x16_bf16(PAF(1),VFR(1),o[0],0,0,0), C0,8); \
    KRD(GL,1); GAPB(o[1]=__builtin_amdgcn_mfma_f32_32x32x16_bf16(PAF(1),VFR(5),o[1],0,0,0), C0,12); \
    KRD(GL,2); GAPB(o[0]=__builtin_amdgcn_mfma_f32_32x32x16_bf16(PAF(2),VFR(2),o[0],0,0,0), C1,0); \
    KRD(GL,3); GAPB(o[1]=__builtin_amdgcn_mfma_f32_32x32x16_bf16(PAF(2),VFR(6),o[1],0,0,0), C1,4); \
    GAPB(o[0]=__builtin_amdgcn_mfma_f32_32x32x16_bf16(PAF(3),VFR(3),o[0],0,0,0), C1,8); \
    GAPB(o[1]=__builtin_amdgcn_mfma_f32_32x32x16_bf16(PAF(3),VFR(7),o[1],0,0,0), C1,12); \
    }while(0)
  int t=1;
  for(;t+5<NT;t+=2){
    STEP(pB0,pB1,pA0,pA1,t,true,true,true);     WAIT_BAR(2); RESC(); ROT();
    STEP(pA0,pA1,pB0,pB1,t+1,true,true,true);   WAIT_BAR(2); RESC(); ROT();
  }
  #define ENDW(tt) do{ if((tt)+3<NT){WAIT_BAR(2);} else if((tt)+2<NT){WAIT_BAR(1);} else {WAIT_BAR(0);} }while(0)
  for(;t+1<NT;t+=2){
    STEP(pB0,pB1,pA0,pA1,t,(t+3<NT),(t+1<NT),(t+1<NT));       ENDW(t);   RESC(); ROT();
    STEP(pA0,pA1,pB0,pB1,t+1,(t+4<NT),(t+2<NT),(t+2<NT));     ENDW(t+1); RESC(); ROT();
  }
  STEP(pB0,pB1,pA0,pA1,NT-1,false,false,false); RESC();
  { float sacc=pB0[0]+pB0[1]; _Pragma("unroll") for(int r=2;r<16;++r)sacc+=pB0[r]; _Pragma("unroll") for(int r=0;r<16;++r)sacc+=pB1[r]; l_reg+=sacc;
    pw0=(u32x4){PKW(pB0,0),PKW(pB0,2),PKW(pB0,4),PKW(pB0,6)};pw1=(u32x4){PKW(pB0,8),PKW(pB0,10),PKW(pB0,12),PKW(pB0,14)};pw2=(u32x4){PKW(pB1,0),PKW(pB1,2),PKW(pB1,4),PKW(pB1,6)};pw3=(u32x4){PKW(pB1,8),PKW(pB1,10),PKW(pB1,12),PKW(pB1,14)};
    SBAR(); pv(o,vb0+sl_cur,PAF(0),PAF(1),PAF(2),PAF(3)); }
  #undef PKW
  #undef PAF
  #undef VFR
  #undef PIN
  #undef MX3
  #undef GAPA
  #undef GAPB
  #undef EX
  #undef VRD
  #undef KRD
  #undef STEP
  #undef ENDW
  {auto rr=__builtin_amdgcn_permlane32_swap(__float_as_uint(l_reg),__float_as_uint(l_reg),false,false);l_reg=__uint_as_float(rr[0])+__uint_as_float(rr[1]);}
  if(hi==0)wsf[32+r32]=l_reg;asm volatile("s_waitcnt lgkmcnt(0)":::"memory");
  float rli[16];
  #pragma unroll
  for(int r=0;r<16;++r)rli[r]=__builtin_amdgcn_rcpf(wsf[32+crow(r,hi)]);
  bf16*Ow=Op+(long)(wid*QBLK)*OP;
  { bf16*stg=(bf16*)(shm+LDS_OST)+wid*2048;
    #pragma unroll
    for(int r=0;r<16;++r){const int orow=crow(r,hi);
      #pragma unroll
      for(int d0=0;d0<2;++d0)stg[orow*64+d0*32+r32]=__float2bfloat16(o[d0][r]*rli[r]);}
    asm volatile("s_waitcnt lgkmcnt(0)":::"memory");
    #pragma unroll
    for(int i=0;i<4;++i){const int row=i*8+(lane>>3),ch=lane&7; const u32x4 v=*(const u32x4*)(stg+row*64+ch*8); ATTN_STORE16(Ow+(long)row*OP+ch*8,v);} }
  asm volatile("s_waitcnt lgkmcnt(0)\n\ts_barrier":::"memory");
  #undef DMA_K
  #undef DMA_V
  #undef CMASK
  #undef TROW
  #undef START
  #undef RESC
  #undef ROT
}
constexpr int ATTN_LDS_BYTES=LDS_BYTES;
#undef SBAR
#undef WAIT_BAR
}

#define LAS __attribute__((address_space(3)))
typedef unsigned short bf16;
typedef unsigned u32x4 __attribute__((ext_vector_type(4)));
typedef unsigned u32x2 __attribute__((ext_vector_type(2)));
typedef float f32x4 __attribute__((ext_vector_type(4)));
typedef float f32x16 __attribute__((ext_vector_type(16)));
typedef short bf16x8 __attribute__((ext_vector_type(8)));
typedef short s16x4 __attribute__((ext_vector_type(4)));

constexpr int DM = 1024, NL = 16384, MT = 16896, SEQ = 8192;
constexpr int INC = 4352, FF = 2816, FF2 = 5632, DEPTH = 4;
constexpr float EPS = 1e-6f;
constexpr float LOG2E = 1.4426950408889634f;
constexpr float C2 = 0.125f * 1.4426950408889634f;
constexpr int NWAVES = 8, NTHREADS = 512;

constexpr size_t MiB = 1u << 20;
constexpr size_t WS_MODS = 1 * MiB;
constexpr size_t WS_WIN = 2 * MiB;
constexpr size_t WS_WPA = 11 * MiB, WS_WPB = 12 * MiB;
constexpr size_t WS_WO = 13 * MiB;
constexpr size_t WS_WFI = 15 * MiB;
constexpr size_t WS_WFO = 26 * MiB;
constexpr size_t WS_X = 32 * MiB;
constexpr size_t WS_H = 98 * MiB;
constexpr size_t SZ512 = (size_t)MT * 512 * 2, SZ128 = (size_t)MT * 128 * 2, SZ1024 = (size_t)MT * 1024 * 2;
constexpr size_t WS_NAQ = 131 * MiB, WS_NAK = WS_NAQ + SZ512, WS_NAV = WS_NAK + SZ512, WS_GQ = WS_NAV + SZ512, WS_GK = WS_GQ + SZ512, WS_GV = WS_GK + SZ128;
constexpr size_t WS_SA = WS_GV + SZ128, WS_SB = WS_SA + SZ1024, WS_YA = WS_SB + SZ1024, WS_YB = WS_YA + SZ512, WS_END = WS_YB + SZ512;
constexpr size_t WS_SLAB = 240 * MiB;
static_assert(WS_SLAB >= WS_SB && WS_SLAB + (size_t)11 * 512 * DM * 4 <= WS_YA, "slab inside SB");
constexpr size_t WS_ACT = 131 * MiB;
static_assert(WS_ACT + (size_t)MT * FF * 2 <= WS_END, "act overlay");
static_assert(WS_WFO + (size_t)DM * FF * 2 <= WS_X && WS_WFI + (size_t)FF2 * DM * 2 <= WS_WFO && WS_WIN + (size_t)INC * DM * 2 <= WS_WPA, "weights map");

constexpr int RING_BYTES = 131072;
constexpr int LDS_BYTES = 147456;
constexpr int A_K = 0, A_V = 16384, A_WS = 32768, A_OST = 34816, A_RPB = 67584;

__device__ __forceinline__ unsigned f2bf(float f) { unsigned u = __builtin_bit_cast(unsigned, f); return (u + 0x7fffu + ((u >> 16) & 1u)) >> 16; }
__device__ __forceinline__ unsigned pk2(float lo, float hi) { return f2bf(lo) | (f2bf(hi) << 16); }
__device__ __forceinline__ float bflo(unsigned w) { return __builtin_bit_cast(float, w << 16); }
__device__ __forceinline__ float bfhi(unsigned w) { return __builtin_bit_cast(float, w & 0xffff0000u); }
__device__ __forceinline__ float shx(float v, int o, int ln) { return __builtin_bit_cast(float, __builtin_amdgcn_ds_bpermute((ln ^ o) << 2, __builtin_bit_cast(int, v))); }
__device__ __forceinline__ float wave_sum(float v, int ln) {
#pragma unroll
    for (int o = 1; o < 64; o <<= 1) v += shx(v, o, ln);
    return v;
}
__device__ __forceinline__ unsigned char* lws(unsigned char* p) { asm volatile("" : "+s"(p)); return p; }
__device__ __forceinline__ int launder(int v) { asm volatile("" : "+v"(v)); return v; }
__device__ __forceinline__ float sigmoidf_(float x) { return __builtin_amdgcn_rcpf(1.0f + __expf(-x)); }

using pg8::Unit; using pg8::cvt_pk_bf16;
typedef f32x4 Acc[2][2][4][2];

struct EpiIn {
    static constexpr bool PERM = true, AFTER_DRAIN = false;
    bf16 *NAQ, *NAK, *NAV, *GQ, *GK, *GV, *SA, *SB; const float* qgain; const float* kgain;
    __device__ __forceinline__ void operator()(const Acc& acc, const Unit& u, int wr, int wc, int fr, int fq) const {
        const int pm = u.pm, pn = u.pn;
        const int rbase = pm * 256 + wr * 64 + fr;
        const int kvd = pm < 32 ? 0 : (pm < 64 ? 256 : (pm == 64 ? -8192 : 0));
        if (pn < 6 || pn >= 9) {
            bf16* dst; int ld, colt, rowd = 0; float sc = 1.f; bool sig = false;
            if (pn < 2) { dst = NAQ; ld = 512; colt = pn * 256; sc = C2; }
            else if (pn < 4) { dst = NAK; ld = 512; colt = (pn - 2) * 256; rowd = kvd; }
            else if (pn < 6) { dst = NAV; ld = 512; colt = (pn - 4) * 256; rowd = kvd; }
            else if (pn < 13) { dst = SA; ld = 1024; colt = (pn - 9) * 256; sig = true; }
            else { dst = SB; ld = 1024; colt = (pn - 13) * 256; sig = true; }
            const int col0 = colt + wc * 32 + 8 * fq;
#pragma unroll
            for (int ai = 0; ai < 2; ++ai)
#pragma unroll
                for (int m = 0; m < 4; ++m) {
                    bf16* rowp = dst + (size_t)(rbase + ai * 128 + m * 16 + rowd) * ld + col0;
#pragma unroll
                    for (int bj = 0; bj < 2; ++bj) {
                        f32x4 v0 = acc[ai][bj][m][0], v1 = acc[ai][bj][m][1];
                        if (sig) {
#pragma unroll
                            for (int e = 0; e < 4; ++e) { v0[e] = sigmoidf_(v0[e]); v1[e] = sigmoidf_(v1[e]); }
                        } else { v0 = v0 * sc; v1 = v1 * sc; }
                        u32x4 w; w.x = cvt_pk_bf16(v0[0], v0[1]); w.y = cvt_pk_bf16(v0[2], v0[3]); w.z = cvt_pk_bf16(v1[0], v1[1]); w.w = cvt_pk_bf16(v1[2], v1[3]);
                        *(u32x4*)(rowp + bj * 128) = w;
                    }
                    __builtin_amdgcn_sched_barrier(0);
                }
        } else {
            const int hidx = 4 * (pn - 6) + wc;
            const bool isv = hidx >= 10, isk = (hidx >= 8) && !isv;
            bf16* dst; int ld, hcol, rowd; float sc = 1.f;
            if (isv) { dst = GV; ld = 128; hcol = (hidx - 10) * 64; rowd = kvd; }
            else if (isk) { dst = GK; ld = 128; hcol = (hidx - 8) * 64; rowd = kvd; }
            else { dst = GQ; ld = 512; hcol = hidx * 64; rowd = 0; sc = C2; }
            const float* gain = isk ? kgain : qgain;
            f32x4 gv[2][2];
#pragma unroll
            for (int bj = 0; bj < 2; ++bj)
#pragma unroll
                for (int n = 0; n < 2; ++n) gv[bj][n] = *(const f32x4*)(gain + 32 * bj + 8 * fq + 4 * n);
            const bool latent = pm < 64;
#pragma unroll
            for (int ai = 0; ai < 2; ++ai)
#pragma unroll
                for (int m = 0; m < 4; ++m) {
                    const int row = rbase + ai * 128 + m * 16;
                    bf16* rowp = dst + (size_t)(row + rowd) * ld + hcol + 8 * fq;
                    if (isv) {
#pragma unroll
                        for (int bj = 0; bj < 2; ++bj) {
                            const f32x4 v0 = acc[ai][bj][m][0], v1 = acc[ai][bj][m][1];
                            u32x4 w; w.x = cvt_pk_bf16(v0[0], v0[1]); w.y = cvt_pk_bf16(v0[2], v0[3]); w.z = cvt_pk_bf16(v1[0], v1[1]); w.w = cvt_pk_bf16(v1[2], v1[3]);
                            *(u32x4*)(rowp + bj * 32) = w;
                        }
                    } else {
                        float ss = 0.f;
#pragma unroll
                        for (int bj = 0; bj < 2; ++bj)
#pragma unroll
                            for (int n = 0; n < 2; ++n) { const f32x4 x = acc[ai][bj][m][n]; ss += (x[0] * x[0] + x[1] * x[1]) + (x[2] * x[2] + x[3] * x[3]); }
                        { const int ln_ = fq * 16 + fr; ss += shx(ss, 16, ln_); ss += shx(ss, 32, ln_); }
                        const float rinv = rsqrtf(ss * (1.0f / 64.0f) + EPS);
                        const int s = row & (SEQ - 1);
#pragma unroll
                        for (int bj = 0; bj < 2; ++bj) {
                            f32x4 v0 = acc[ai][bj][m][0] * rinv * gv[bj][0], v1 = acc[ai][bj][m][1] * rinv * gv[bj][1];
                            if (latent) {
                                const int pos = bj == 0 ? (s >> 6) : (s & 63);
                                const f32x4 t0 = *(const f32x4*)(ROPE_TAB + (pos * 16 + 4 * fq) * 2);
                                const f32x4 t1 = *(const f32x4*)(ROPE_TAB + (pos * 16 + 4 * fq) * 2 + 4);
                                f32x4 r0, r1;
                                r0[0] = v0[0] * t0[0] - v0[1] * t0[1]; r0[1] = v0[0] * t0[1] + v0[1] * t0[0];
                                r0[2] = v0[2] * t0[2] - v0[3] * t0[3]; r0[3] = v0[2] * t0[3] + v0[3] * t0[2];
                                r1[0] = v1[0] * t1[0] - v1[1] * t1[1]; r1[1] = v1[0] * t1[1] + v1[1] * t1[0];
                                r1[2] = v1[2] * t1[2] - v1[3] * t1[3]; r1[3] = v1[2] * t1[3] + v1[3] * t1[2];
                                v0 = r0; v1 = r1;
                            }
                            v0 = v0 * sc; v1 = v1 * sc;
                            u32x4 w; w.x = cvt_pk_bf16(v0[0], v0[1]); w.y = cvt_pk_bf16(v0[2], v0[3]); w.z = cvt_pk_bf16(v1[0], v1[1]); w.w = cvt_pk_bf16(v1[2], v1[3]);
                            *(u32x4*)(rowp + bj * 32) = w;
                        }
                    }
                    __builtin_amdgcn_sched_barrier(0);
                }
        }
    }
};

struct EpiMerge {
    static constexpr bool PERM = true, AFTER_DRAIN = false;
    const bf16* S; bf16* O; int second;
    __device__ __forceinline__ void operator()(const Acc& acc, const Unit& u, int wr, int wc, int fr, int fq) const {
        const int rbase = u.pm * 256 + wr * 64 + fr, col0 = u.pn * 256 + wc * 32 + 8 * fq;
#pragma unroll
        for (int ai = 0; ai < 2; ++ai)
#pragma unroll
            for (int m = 0; m < 4; ++m)
#pragma unroll
                for (int bj = 0; bj < 2; ++bj) {
                    const size_t off = (size_t)(rbase + ai * 128 + m * 16) * 1024 + col0 + bj * 128;
                    const u32x4 b = *(const u32x4*)(S + off);
                    u32x4 p = {0u, 0u, 0u, 0u};
                    if (second) p = *(const u32x4*)(O + off);
                    const f32x4 v0 = acc[ai][bj][m][0], v1 = acc[ai][bj][m][1];
                    u32x4 w;
                    w.x = cvt_pk_bf16(bflo(p.x) + v0[0] * bflo(b.x), bfhi(p.x) + v0[1] * bfhi(b.x)); w.y = cvt_pk_bf16(bflo(p.y) + v0[2] * bflo(b.y), bfhi(p.y) + v0[3] * bfhi(b.y));
                    w.z = cvt_pk_bf16(bflo(p.z) + v1[0] * bflo(b.z), bfhi(p.z) + v1[1] * bfhi(b.z)); w.w = cvt_pk_bf16(bflo(p.w) + v1[2] * bflo(b.w), bfhi(p.w) + v1[3] * bfhi(b.w));
                    *(u32x4*)(O + off) = w;
                }
    }
};

template <bool PARTIAL> struct EpiRes {
    static constexpr bool PERM = false, AFTER_DRAIN = false;
    float* X; const float* gate; float* slab;
    __device__ __forceinline__ void operator()(const Acc& acc, const Unit& u, int wr, int wc, int fr, int fq) const {
        const int pm = u.pm, v = PARTIAL ? 2 : (pm < 32 ? 0 : (pm < 64 ? 1 : 2));
        const int rbase = pm * 256 + wr * 64 + fr, col0 = u.pn * 256 + wc * 32 + 4 * fq;
        const float* g = gate + v * 6144 + col0;
        float* base = PARTIAL ? slab + (size_t)u.kc * 512 * DM : X;
        f32x4 gv[2][2];
#pragma unroll
        for (int bj = 0; bj < 2; ++bj)
#pragma unroll
            for (int n = 0; n < 2; ++n) gv[bj][n] = *(const f32x4*)(g + bj * 128 + 16 * n);
#pragma unroll
        for (int ai = 0; ai < 2; ++ai)
#pragma unroll
            for (int m = 0; m < 4; ++m) {
                float* rowp = base + (size_t)(rbase + ai * 128 + m * 16) * DM + col0;
#pragma unroll
                for (int bj = 0; bj < 2; ++bj)
#pragma unroll
                    for (int n = 0; n < 2; ++n) {
                        const f32x4 d = gv[bj][n] * acc[ai][bj][m][n];
                        f32x4* p = (f32x4*)(rowp + bj * 128 + 16 * n);
                        if constexpr (PARTIAL) *p = d; else *p = *p + d;
                    }
            }
    }
};

struct EpiSwiglu {
    static constexpr bool PERM = true, AFTER_DRAIN = false;
    bf16* O;
    __device__ __forceinline__ void operator()(const Acc& acc, const Unit& u, int wr, int wc, int fr, int fq) const {
        const int rbase = u.pm * 256 + wr * 64 + fr, col0 = u.pn * 128 + wc * 32 + 8 * fq;
#pragma unroll
        for (int ai = 0; ai < 2; ++ai)
#pragma unroll
            for (int m = 0; m < 4; ++m) {
                f32x4 r[2];
#pragma unroll
                for (int n = 0; n < 2; ++n) {
                    const f32x4 a = acc[ai][0][m][n], uu = acc[ai][1][m][n];
#pragma unroll
                    for (int e = 0; e < 4; ++e) r[n][e] = a[e] * sigmoidf_(a[e]) * uu[e];
                }
                u32x4 w; w.x = cvt_pk_bf16(r[0][0], r[0][1]); w.y = cvt_pk_bf16(r[0][2], r[0][3]); w.z = cvt_pk_bf16(r[1][0], r[1][1]); w.w = cvt_pk_bf16(r[1][2], r[1][3]);
                *(u32x4*)(O + (size_t)(rbase + ai * 128 + m * 16) * FF + col0) = w;
            }
    }
};

template <int MAP>
__device__ __forceinline__ void transpose_item(const float* W, int N, bf16* WT, int ldk, int koff, LAS float* scr, int item, int lane) {
    const int nblk = N / 32, kb = item / nblk, nb = item % nblk, k0 = 64 * kb, n0 = 32 * nb;
#pragma unroll 8
    for (int i = 0; i < 32; ++i) { const int kk = 2 * i + (lane >> 5); scr[kk * 33 + (lane & 31)] = W[(size_t)(k0 + kk) * N + n0 + (lane & 31)]; }
    asm volatile("s_waitcnt lgkmcnt(0)" ::: "memory");
    int r0 = n0;
    if (MAP == 1) { if (n0 >= 1536 && n0 < 2304) { const int tile = n0 >> 8, within = n0 & 255, hw = within >> 6, bj = (within & 63) >> 5; r0 = tile * 256 + 128 * bj + 32 * hw; } }
    if (MAP == 2) { if (n0 < FF) { r0 = (n0 >> 7) * 256 + (n0 & 127); } else { const int n1 = n0 - FF; r0 = (n1 >> 7) * 256 + 128 + (n1 & 127); } }
    const int c = lane & 7;
#pragma unroll
    for (int j = 0; j < 4; ++j) { const int n = (lane >> 3) + 8 * j; const LAS float* s = scr + (8 * c) * 33 + n;
        u32x4 o; o.x = pk2(s[0 * 33], s[1 * 33]); o.y = pk2(s[2 * 33], s[3 * 33]); o.z = pk2(s[4 * 33], s[5 * 33]); o.w = pk2(s[6 * 33], s[7 * 33]);
        *(u32x4*)(WT + (size_t)(r0 + n) * ldk + koff + k0 + 8 * c) = o; }
    asm volatile("s_waitcnt lgkmcnt(0)" ::: "memory");
}

struct Params {
    const float *x, *c, *ctx, *c_ctx, *w_mod, *b_mod, *norm1, *w_in, *na_rpb, *q_gain, *k_gain, *w_pa, *w_pb, *w_o, *norm2, *w_ffn_in, *w_ffn_out, *final_norm;
    float* out; unsigned char* ws;
};

__device__ __forceinline__ void phase_wconv(const Params& P, int l, unsigned char* ws, LAS unsigned char* lds, int gw, int NGW, int wave, int lane) {
    LAS float* scr = (LAS float*)(lds + wave * 16384);
    constexpr int I_IN = (DM / 64) * (INC / 32), I_PA = (512 / 64) * (DM / 32), I_O = (DM / 64) * (DM / 32), I_FI = (DM / 64) * (FF2 / 32), I_FO = (FF / 64) * (DM / 32);
    constexpr int NITEMS = I_IN + 2 * I_PA + I_O + I_FI + I_FO;
    for (int it = gw; it < NITEMS; it += NGW) {
        int r = it;
        if (r < I_IN) { transpose_item<1>(P.w_in + (size_t)l * DM * INC, INC, (bf16*)(ws + WS_WIN), DM, 0, scr, r, lane); continue; } r -= I_IN;
        if (r < I_PA) { transpose_item<0>(P.w_pa + (size_t)l * 512 * DM, DM, (bf16*)(ws + WS_WPA), 512, 0, scr, r, lane); continue; } r -= I_PA;
        if (r < I_PA) { transpose_item<0>(P.w_pb + (size_t)l * 512 * DM, DM, (bf16*)(ws + WS_WPB), 512, 0, scr, r, lane); continue; } r -= I_PA;
        if (r < I_O) { transpose_item<0>(P.w_o + (size_t)l * DM * DM, DM, (bf16*)(ws + WS_WO), DM, 0, scr, r, lane); continue; } r -= I_O;
        if (r < I_FI) { transpose_item<2>(P.w_ffn_in + (size_t)l * DM * FF2, FF2, (bf16*)(ws + WS_WFI), DM, 0, scr, r, lane); continue; } r -= I_FI;
        transpose_item<0>(P.w_ffn_out + (size_t)l * FF * DM, DM, (bf16*)(ws + WS_WFO), FF, 0, scr, r, lane);
    }
}

__device__ __forceinline__ void norm_row(const float* xrow, float* xcopy, const float* gamma, const float* sh, const float* sc, bf16* hrow, int lane, const float* part = nullptr, int npart = 0) {
    const f32x4* xr = (const f32x4*)xrow + lane;
    f32x4 v[4]; float s = 0.f;
#pragma unroll
    for (int j = 0; j < 4; ++j) v[j] = xr[64 * j];
    for (int c = 0; c < npart; ++c) { const f32x4* pr = (const f32x4*)(part + (size_t)c * 512 * DM) + lane;
#pragma unroll
        for (int j = 0; j < 4; ++j) v[j] = v[j] + pr[64 * j]; }
#pragma unroll
    for (int j = 0; j < 4; ++j) { s += (v[j].x * v[j].x + v[j].y * v[j].y) + (v[j].z * v[j].z + v[j].w * v[j].w); }
    const float r = rsqrtf(wave_sum(s, lane) * (1.0f / DM) + EPS);
    if (xcopy) {
#pragma unroll
        for (int j = 0; j < 4; ++j) ((f32x4*)xcopy + lane)[64 * j] = v[j];
    }
    unsigned long long* o8 = (unsigned long long*)hrow + lane;
#pragma unroll
    for (int j = 0; j < 4; ++j) {
        const f32x4 g = ((const f32x4*)gamma + lane)[64 * j], a = ((const f32x4*)sc + lane)[64 * j], b = ((const f32x4*)sh + lane)[64 * j];
        const f32x4 y = (v[j] * r) * g * (a + 1.0f) + b;
        o8[64 * j] = (unsigned long long)pk2(y.x, y.y) | ((unsigned long long)pk2(y.z, y.w) << 32);
    }
}

#define XB_TMO      128
#define XB_XCNT(j)  (256  + 64 * (j))
#define XB_XSUB(j)  (1280 + 64 * (j))
#define XB_XGEN(j)  (2304 + 64 * (j))
#define XB_TOP      3328
#define XB_TOPGEN   3392
#define XCD_BAR_WORDS 3456
#define XB_SPIN_CAP (1u << 18)

__device__ __forceinline__ unsigned xb_ld(unsigned* p)              { return __hip_atomic_load(p, __ATOMIC_RELAXED, __HIP_MEMORY_SCOPE_AGENT); }
__device__ __forceinline__ unsigned xb_add(unsigned* p, unsigned v) { return __hip_atomic_fetch_add(p, v, __ATOMIC_RELAXED, __HIP_MEMORY_SCOPE_AGENT); }
__device__ __forceinline__ unsigned xb_xcc_id() { return (unsigned)__builtin_amdgcn_s_getreg((3 << 11) | 20) & 0xFu; }
#define XB_SPIN(cond, bar) do { unsigned _sp = 0; while (cond) { __builtin_amdgcn_s_sleep(1); \
    if ((++_sp & 255u) == 0u) { if (xb_ld(&(bar)[XB_TMO])) break; if (_sp > XB_SPIN_CAP) { atomicAdd(&(bar)[XB_TMO], 1u); break; } } } } while (0)

struct XcdBarrier {
    unsigned* bar; unsigned x;
    volatile LAS unsigned* st;
};

__device__ __forceinline__ XcdBarrier xcd_barrier_post(unsigned* bar, volatile LAS unsigned* st) {
    XcdBarrier b; b.bar = bar; b.x = xb_xcc_id(); b.st = st;
    if (threadIdx.x == 0) (void)xb_add(&bar[XB_XCNT(b.x)], 1u);
    return b;
}
__device__ __forceinline__ void xcd_barrier_complete(unsigned* bar, unsigned x, unsigned& nloc, unsigned& nx) {
    const unsigned G = gridDim.x * gridDim.y * gridDim.z;
    unsigned sum, cnt, mine, sp = 0u;
    for (;;) {
        sum = 0u; cnt = 0u; mine = 0u;
#pragma unroll
        for (unsigned j = 0; j < 16; ++j) { const unsigned c = xb_ld(&bar[XB_XCNT(j)]); sum += c; cnt += (c > 0u) ? 1u : 0u; mine = (j == x) ? c : mine; }
        if (sum == G) break;
        __builtin_amdgcn_s_sleep(1);
        if ((++sp & 255u) == 0u) { if (xb_ld(&bar[XB_TMO])) break; if (sp > XB_SPIN_CAP) { atomicAdd(&bar[XB_TMO], 1u); break; } }
    }
    nloc = mine > 0u ? mine : 1u; nx = cnt > 0u ? cnt : 1u;
}

__device__ __forceinline__ void xcd_barrier(const XcdBarrier& b) {
    asm volatile("s_waitcnt vmcnt(0)" ::: "memory");
    __syncthreads();
    if (threadIdx.x == 0) {
        unsigned* bar = b.bar;
        __builtin_amdgcn_s_waitcnt(0);
        unsigned nloc = b.st[0], nx = b.st[1];
        if (nloc == 0u) { xcd_barrier_complete(bar, b.x, nloc, nx); b.st[0] = nloc; b.st[1] = nx; }
        const unsigned old = xb_add(&bar[XB_XSUB(b.x)], 1u);
        const unsigned gen = old / nloc;
        if (old + 1u == (gen + 1u) * nloc) {
            __builtin_amdgcn_fence(__ATOMIC_RELEASE, "agent");
            asm volatile("s_waitcnt vmcnt(0)" ::: "memory");
            const unsigned og = xb_add(&bar[XB_TOP], 1u);
            const unsigned tg = og / nx;
            if (og + 1u == (tg + 1u) * nx) xb_add(&bar[XB_TOPGEN], 1u);
            else XB_SPIN(xb_ld(&bar[XB_TOPGEN]) == tg, bar);
            __builtin_amdgcn_fence(__ATOMIC_ACQUIRE, "agent");
            xb_add(&bar[XB_XGEN(b.x)], 1u);
            asm volatile("s_waitcnt vmcnt(0)" ::: "memory");
        } else {
            XB_SPIN(xb_ld(&bar[XB_XGEN(b.x)]) == gen, bar);
            __builtin_amdgcn_fence(__ATOMIC_ACQUIRE, "agent");
            asm volatile("s_waitcnt vmcnt(0)" ::: "memory");
        }
    }
    __syncthreads();
}

#define MODS ((float*)(ws + WS_MODS))
#define mods (MODS + (size_t)l * 3 * 6144)
#define X ((float*)(ws + WS_X))
#define H ((bf16*)(ws + WS_H))
#define NAQ ((bf16*)(ws + WS_NAQ))
#define NAK ((bf16*)(ws + WS_NAK))
#define NAV ((bf16*)(ws + WS_NAV))
#define GQ ((bf16*)(ws + WS_GQ))
#define GK ((bf16*)(ws + WS_GK))
#define GV ((bf16*)(ws + WS_GV))
#define SA ((bf16*)(ws + WS_SA))
#define SB ((bf16*)(ws + WS_SB))
#define YA ((bf16*)(ws + WS_YA))
#define YB ((bf16*)(ws + WS_YB))
#define ACT ((bf16*)(ws + WS_ACT))
__global__ void __launch_bounds__(NTHREADS, 2) mega_fwd(Params P) {
    extern __shared__ __attribute__((aligned(16))) unsigned char lds[];
    cg::grid_group grid = cg::this_grid();
    LAS unsigned char* ldsl = (LAS unsigned char*)lds;
    const int wave = __builtin_amdgcn_readfirstlane((int)threadIdx.x >> 6);
#define FRESH_LANE() pg8::pg8_lane_id()
#define FRESH_TID() (wave * 64 + FRESH_LANE())
    const int G = gridDim.x, bx = blockIdx.x;
    const int vcu = (G % 8 == 0) ? (bx % 8) * (G / 8) + bx / 8 : bx;
    const int gw = vcu * NWAVES + wave, NGW = G * NWAVES;
    volatile LAS unsigned* MISC = (volatile LAS unsigned*)(ldsl + RING_BYTES);
    { const int t0 = FRESH_TID(); if (t0 < 64) MISC[t0] = 0u; }
    __syncthreads();
    const XcdBarrier xbar = xcd_barrier_post((unsigned*)P.ws, MISC + 8);
#define GRID_BAR() do { XcdBarrier b_ = xbar; b_.bar = (unsigned*)lws(P.ws); xcd_barrier(b_); } while (0)

    {
        unsigned char* ws = lws(P.ws); const int tid = FRESH_TID();
        float* sl = (float*)lds;
        f32x4* red = (f32x4*)(lds + 16384);
        for (int i = tid; i < 3072; i += NTHREADS) { const int v = i >> 10, k = i & 1023; const float xv = v < 2 ? P.c[v * 1024 + k] : P.c_ctx[k]; sl[i] = xv * sigmoidf_(xv); }
        __syncthreads();
        const int cgi = tid & 31, kc = tid >> 5;
        for (int item = bx; item < 192; item += G) {
            const int l = item / 48, jb = (item % 48) * 128;
            const float* w = P.w_mod + (size_t)l * DM * 6144 + jb + cgi * 4;
            f32x4 a0 = {0.f, 0.f, 0.f, 0.f}, a1 = a0, a2 = a0;
#pragma unroll 8
            for (int kk = 0; kk < 64; ++kk) { const int k = kc * 64 + kk; const f32x4 wv = *(const f32x4*)(w + (size_t)k * 6144);
                a0 = a0 + wv * sl[k]; a1 = a1 + wv * sl[1024 + k]; a2 = a2 + wv * sl[2048 + k]; }
            red[(kc * 3 + 0) * 32 + cgi] = a0; red[(kc * 3 + 1) * 32 + cgi] = a1; red[(kc * 3 + 2) * 32 + cgi] = a2;
            __syncthreads();
            if (tid < 384) { const int v = tid >> 7, cc = tid & 127; float s = 0.f;
#pragma unroll
                for (int q = 0; q < 16; ++q) s += ((const float*)&red[(q * 3 + v) * 32 + (cc >> 2)])[cc & 3];
                MODS[(size_t)(l * 3 + v) * 6144 + jb + cc] = s + P.b_mod[l * 6144 + jb + cc]; }
            __syncthreads();
        }
        __syncthreads();
        phase_wconv(P, 0, ws, ldsl, gw, NGW, wave, FRESH_LANE());
    }
    grid.sync();

    for (int l = 0; l < DEPTH; ++l) {
        const bool last = (l == DEPTH - 1);
        const int MG = last ? NL : MT;
        { unsigned char* ws = lws(P.ws);
        if (l > 0) phase_wconv(P, l, ws, ldsl, gw, NGW, wave, FRESH_LANE());
        const int ln = FRESH_LANE();
        for (int row = gw; row < MT; row += NGW) {
            const int v = row < NL ? (row >> 13) : 2;
            const float* xr = (l == 0) ? (row < NL ? P.x + (size_t)row * DM : P.ctx + (size_t)(row - NL) * DM) : X + (size_t)row * DM;
            const bool addp = (l > 0) && (row >= NL);
            norm_row(xr, (l == 0 || addp) ? X + (size_t)row * DM : nullptr, P.norm1 + l * DM, mods + v * 6144 + 0, mods + v * 6144 + 1024, H + (size_t)row * DM, ln,
                     (const float*)(ws + WS_SLAB) + (size_t)(row - NL) * DM, addp ? FF / 256 : 0);
        } }
        GRID_BAR();
        {
            unsigned char* ws = lws(P.ws);
            pg8::Gemm g{H, (const bf16*)(ws + WS_WIN), MT, INC, DM, DM}; pg8::StaticOrder S; S.init(MT, INC, G, bx);
            EpiIn E{NAQ, NAK, NAV, GQ, GK, GV, SA, SB, P.q_gain + l * 64, P.k_gain + l * 64};
            pg8::gemm_phase<EpiIn, pg8::StaticOrder, true, true>(ldsl, g, S, E, wave);
        }
        GRID_BAR();
        {
            unsigned char* ws = lws(P.ws);
            char* shm = (char*)lds;
            const int total = last ? 1024 : 1056;
            typedef attn_body::bf16 abf;
            for (int idx = vcu; idx < total; idx += G) {
                const bool isna = (idx >= 512) && (idx < 1040);
                if (!isna) {
                    const bool isc = idx >= 1040; const int un = isc ? idx - 1040 : idx;
                    const int b = isc ? (un >> 3) : (un >> 8), hq = isc ? (un & 7) : ((un >> 5) & 7), qb = un & 31, kvh = hq >> 2;
                    const size_t qrow = isc ? (size_t)(NL + b * 256) : (size_t)(b * SEQ + qb * 256), krow = (size_t)(b * 8448 + (isc ? 8192 : 0));
                    attn_body::attn_unit<8, false>((const abf*)(GQ + qrow * 512 + hq * 64), (const abf*)(GK + krow * 128 + kvh * 64), (const abf*)(GV + krow * 128 + kvh * 64),
                                                   (abf*)(YB + qrow * 512 + hq * 64), isc ? 4 : 132, shm, wave);
                } else {
                    const bool isc = idx >= 1024; const int un = isc ? idx - 1024 : idx - 512;
                    const int b = isc ? (un >> 3) : (un >> 8), h = isc ? (un & 7) : ((un >> 5) & 7), R = un & 31;
                    const int kr0 = min(max(4 * R - 4, 0), 120), kr1 = min(max(4 * R - 1, 0), 120) + 7, nwin = isc ? 0 : kr1 - kr0 + 1, NT = (4 + nwin + 1) & ~1;
                    const size_t qrow = isc ? (size_t)(NL + b * 256) : (size_t)(b * SEQ + R * 256);
                    attn_body::attn_unit<8, true>((const abf*)(NAQ + qrow * 512 + h * 64), (const abf*)(NAK + (size_t)(b * 8448) * 512 + h * 64), (const abf*)(NAV + (size_t)(b * 8448) * 512 + h * 64),
                                                  (abf*)(YA + qrow * 512 + h * 64), NT, shm, wave, kr0, nwin, 4 * R, P.na_rpb + (size_t)(l * 8 + h) * 465);
                }
            }
        }
        GRID_BAR();
        for (int pass = 0; pass < 2; ++pass) {
            unsigned char* ws = lws(P.ws);
            pg8::Gemm g{pass ? YB : YA, (const bf16*)(ws + (pass ? WS_WPB : WS_WPA)), MG, DM, 512, 512}; pg8::StaticOrder S; S.init(MG, DM, G, bx);
            EpiMerge E{pass ? SB : SA, H, pass};
            pg8::gemm_phase<EpiMerge, pg8::StaticOrder, true, true>(ldsl, g, S, E, wave);
        }
        GRID_BAR();
        {
            unsigned char* ws = lws(P.ws);
            pg8::Gemm g{H, (const bf16*)(ws + WS_WO), NL, DM, DM, DM}; pg8::StaticOrder S; S.init(NL, DM, G, bx);
            EpiRes<false> E{X, mods + 2048, nullptr};
            pg8::gemm_phase<EpiRes<false>, pg8::StaticOrder, true, true>(ldsl, g, S, E, wave);
        }
        if (!last) {
            unsigned char* ws = lws(P.ws);
            pg8::Gemm g{H + (size_t)NL * DM, (const bf16*)(ws + WS_WO), 512, DM, 256, DM}; pg8::CtxSplitOrder S; S.init(DM / 256, DM / 256, G, bx);
            EpiRes<true> E{X, mods + 2048, (float*)(ws + WS_SLAB)};
            pg8::gemm_phase<EpiRes<true>, pg8::CtxSplitOrder, false, true>(ldsl, g, S, E, wave);
        }
        GRID_BAR();
        { unsigned char* ws = lws(P.ws); const int ln = FRESH_LANE();
        for (int row = gw; row < MG; row += NGW) {
            const int v = row < NL ? (row >> 13) : 2;
            const bool addp = row >= NL;
            norm_row(X + (size_t)row * DM, addp ? X + (size_t)row * DM : nullptr, P.norm2 + l * DM, mods + v * 6144 + 3072, mods + v * 6144 + 4096, H + (size_t)row * DM, ln,
                     (const float*)(ws + WS_SLAB) + (size_t)(row - NL) * DM, addp ? DM / 256 : 0);
        } }
        GRID_BAR();
        {
            unsigned char* ws = lws(P.ws);
            pg8::Gemm g{H, (const bf16*)(ws + WS_WFI), MG, FF2, DM, DM}; pg8::StaticOrder S; S.init(MG, FF2, G, bx);
            EpiSwiglu E{ACT};
            pg8::gemm_phase<EpiSwiglu, pg8::StaticOrder, true, true>(ldsl, g, S, E, wave);
        }
        GRID_BAR();
        {
            unsigned char* ws = lws(P.ws);
            pg8::Gemm g{ACT, (const bf16*)(ws + WS_WFO), NL, DM, FF, FF}; pg8::StaticOrder S; S.init(NL, DM, G, bx);
            EpiRes<false> E{X, mods + 5120, nullptr};
            pg8::gemm_phase<EpiRes<false>, pg8::StaticOrder, true, true>(ldsl, g, S, E, wave);
        }
        if (!last) {
            unsigned char* ws = lws(P.ws);
            pg8::Gemm g{ACT + (size_t)NL * FF, (const bf16*)(ws + WS_WFO), 512, DM, 256, FF}; pg8::CtxSplitOrder S; S.init(DM / 256, FF / 256, G, bx);
            EpiRes<true> E{X, mods + 5120, (float*)(ws + WS_SLAB)};
            pg8::gemm_phase<EpiRes<true>, pg8::CtxSplitOrder, false, true>(ldsl, g, S, E, wave);
        }
        GRID_BAR();
    }
    unsigned char* ws = lws(P.ws); const int lane = FRESH_LANE();
    for (int row = gw; row < NL; row += NGW) {
        const f32x4* xr = (const f32x4*)(X + (size_t)row * DM) + lane;
        f32x4 v[4]; float s = 0.f;
#pragma unroll
        for (int j = 0; j < 4; ++j) { v[j] = xr[64 * j]; s += (v[j].x * v[j].x + v[j].y * v[j].y) + (v[j].z * v[j].z + v[j].w * v[j].w); }
        const float r = rsqrtf(wave_sum(s, lane) * (1.0f / DM) + EPS);
        f32x4* o = (f32x4*)(P.out + (size_t)row * DM) + lane;
#pragma unroll
        for (int j = 0; j < 4; ++j) o[64 * j] = (v[j] * r) * ((const f32x4*)P.final_norm + lane)[64 * j];
    }
}

#undef MODS
#undef mods
#undef X
#undef H
#undef NAQ
#undef NAK
#undef NAV
#undef GQ
#undef GK
#undef GV
#undef SA
#undef SB
#undef YA
#undef YB
#undef ACT
extern "C" void kernel_launch(void* const* d_in, const int* in_sizes, int n_in, void* d_out, int out_size, void* d_ws, size_t ws_size, hipStream_t stream) {
    static int grid = 0;
    if (grid == 0) {
        if (n_in != 18 || ws_size < WS_END) { fprintf(stderr, "kernel_launch: need 18 inputs and >= %zu bytes of workspace; got n_in %d ws %zu\n", (size_t)WS_END, n_in, ws_size); grid = -1; return; }
        int dev = 0, cus = 0, per_cu = 0;
        hipGetDevice(&dev);
        hipDeviceGetAttribute(&cus, hipDeviceAttributeMultiprocessorCount, dev);
        if (hipFuncSetAttribute((const void*)mega_fwd, hipFuncAttributeMaxDynamicSharedMemorySize, LDS_BYTES) != hipSuccess) { fprintf(stderr, "kernel_launch: hipFuncSetAttribute failed\n"); grid = -1; return; }
        if (hipOccupancyMaxActiveBlocksPerMultiprocessor(&per_cu, (const void*)mega_fwd, NTHREADS, LDS_BYTES) != hipSuccess || per_cu < 1) { fprintf(stderr, "kernel_launch: occupancy query says %d\n", per_cu); per_cu = 1; }
        (void)hipGetLastError();
        grid = cus * (per_cu > 1 ? 1 : per_cu);
    }
    if (grid < 0) return;
    if (hipMemsetAsync(d_ws, 0, 16384, stream) != hipSuccess) { fprintf(stderr, "kernel_launch: hipMemsetAsync failed\n"); return; }
    Params p{};
    const float** pp = (const float**)&p;
    for (int i = 0; i < 18; ++i) pp[i] = (const float*)d_in[i];
    p.out = (float*)d_out; p.ws = (unsigned char*)d_ws;
    void* args[] = {&p};
    hipError_t e = hipLaunchCooperativeKernel((const void*)mega_fwd, dim3(grid), dim3(NTHREADS), args, LDS_BYTES, stream);
    if (e != hipSuccess) fprintf(stderr, "cooperative launch failed: %s (grid %d)\n", hipGetErrorString(e), grid);
}
```
